# Optimizing an MI355X kernel written in HIP

```python
import math
import jax, jax.numpy as jnp
from jax import lax
import numpy as np

D_MODEL = 2048
BATCH = 4
SEQ = 4096
DEPTH = 4

D_MIX = D_MODEL
NORM_EPS = 1e-6
ML_HEADS = 4
ML_HEAD_DIM = 128
ML_WIDTH = ML_HEADS * ML_HEAD_DIM
ML_CONV = 4
ML_CHUNK = 64
MLA_HEADS = 8
MLA_NOPE = 128
MLA_ROPE = 64
MLA_V = 128
MLA_WIDTH = MLA_HEADS * MLA_V
MLA_Q_RANK = 512
MLA_KV_RANK = 256
ROPE_BASE = 10000.0
Q_BLOCK = 128
RW_HEAD_DIM = 64
RW_WIDTH = D_MIX - ML_WIDTH - MLA_WIDTH
RW_HEADS = RW_WIDTH // RW_HEAD_DIM
RW_DECAY_RANK = 64
RW_AAA_RANK = 64
RW_MV_RANK = 32
RW_GN_EPS = 64e-5
RW_MIX_WIDTH = 3 * RW_WIDTH + RW_DECAY_RANK + RW_AAA_RANK

IN_SIZES = (2 * ML_WIDTH, ML_WIDTH, ML_HEADS, ML_HEADS, ML_WIDTH, ML_WIDTH,
            MLA_Q_RANK, MLA_KV_RANK, MLA_ROPE, MLA_WIDTH,
            RW_MIX_WIDTH, RW_WIDTH)
D_IN = (5 * ML_WIDTH + 2 * ML_HEADS + MLA_Q_RANK + MLA_KV_RANK + MLA_ROPE + MLA_WIDTH
        + RW_MIX_WIDTH + RW_WIDTH)

kernel_name = 'hymba_style_mlstm_mla_rwkv7_trunk'


def split_offsets():
    return [int(o) for o in np.cumsum(np.array(IN_SIZES))[:-1]]


def rms_norm(x, g, eps=NORM_EPS):
    xf = x.astype(jnp.float32)
    y = xf * lax.rsqrt(jnp.mean(xf * xf, axis=-1, keepdims=True) + eps)
    return (y * g.astype(jnp.float32)).astype(x.dtype)


def head_layer_norm(x, g, b, eps):
    xf = x.astype(jnp.float32)
    mu = jnp.mean(xf, axis=-1, keepdims=True)
    var = jnp.mean(jnp.square(xf - mu), axis=-1, keepdims=True)
    y = (xf - mu) * lax.rsqrt(var + eps) * g.astype(jnp.float32)
    if b is not None:
        y = y + b.astype(jnp.float32)
    return y


def token_shift(x):
    return jnp.pad(x, ((0, 0), (1, 0), (0, 0)))[:, :-1]


def causal_conv(x, w, b):
    T = x.shape[1]
    K = w.shape[0]
    xp = jnp.pad(x, ((0, 0), (K - 1, 0), (0, 0)))
    y = b
    for j in range(K):
        y = y + w[j] * xp[:, j:j + T]
    return y


def mlstm_chunkwise(q, k, v, log_i, log_f):
    B, H, T, d = q.shape
    L = ML_CHUNK
    nc = T // L
    q = q * (d ** -0.5)

    def to_chunks(a):
        return jnp.moveaxis(a.reshape((B, H, nc, L) + a.shape[3:]), 2, 0)

    causal = jnp.tril(jnp.ones((L, L), dtype=bool))

    def step(carry, inp):
        C, n, m = carry
        qc, kc, vc, li, lf = inp
        b = jnp.cumsum(lf, axis=-1)
        m_inter = b + m[..., None]
        D = jnp.where(causal, b[..., :, None] - b[..., None, :] + li[..., None, :], -jnp.inf)
        m_t = jnp.maximum(m_inter, jnp.max(D, axis=-1))
        inter = jnp.exp(m_inter - m_t)
        S = jnp.einsum('bhld,bhsd->bhls', qc, kc) * jnp.exp(D - m_t[..., None])
        num = inter[..., None] * jnp.einsum('bhvk,bhlk->bhlv', C, qc) + jnp.einsum('bhls,bhsv->bhlv', S, vc)
        den = inter * jnp.einsum('bhk,bhlk->bhl', n, qc) + jnp.sum(S, axis=-1)
        h = num / jnp.maximum(jnp.abs(den), jnp.exp(-m_t))[..., None]
        b_last = b[..., -1]
        g_s = b_last[..., None] - b + li
        m_new = jnp.maximum(b_last + m, jnp.max(g_s, axis=-1))
        decay = jnp.exp(b_last + m - m_new)
        w_s = jnp.exp(g_s - m_new[..., None])
        C = decay[..., None, None] * C + jnp.einsum('bhs,bhsv,bhsk->bhvk', w_s, vc, kc)
        n = decay[..., None] * n + jnp.einsum('bhs,bhsk->bhk', w_s, kc)
        return (C, n, m_new), h

    init = (jnp.zeros((B, H, d, d), jnp.float32), jnp.zeros((B, H, d), jnp.float32),
            jnp.zeros((B, H), jnp.float32))
    _, h = lax.scan(step, init, (to_chunks(q), to_chunks(k), to_chunks(v),
                                 to_chunks(log_i), to_chunks(log_f)))
    return jnp.moveaxis(h, 0, 2).reshape(B, H, T, d)


def mlstm_branch(ml_qk, ml_v, ml_i, ml_f, ml_o, conv_w, conv_b, i_bias, f_bias, norm_g):
    B, T, _ = ml_qk.shape
    qk = jax.nn.silu(causal_conv(ml_qk, conv_w, conv_b))
    q, k = jnp.split(qk, 2, axis=-1)

    def to_heads(t):
        return t.astype(jnp.float32).reshape(B, T, ML_HEADS, ML_HEAD_DIM).transpose(0, 2, 1, 3)

    log_i = (ml_i + i_bias).astype(jnp.float32).transpose(0, 2, 1)
    log_f = jax.nn.log_sigmoid((ml_f + f_bias).astype(jnp.float32)).transpose(0, 2, 1)
    h = mlstm_chunkwise(to_heads(q), to_heads(k), to_heads(ml_v), log_i, log_f)
    h = head_layer_norm(h.transpose(0, 2, 1, 3), norm_g.reshape(ML_HEADS, ML_HEAD_DIM), None, NORM_EPS)
    return jax.nn.sigmoid(ml_o.astype(jnp.float32)) * h.reshape(B, T, ML_WIDTH)


def rope_cos_sin(positions):
    inv_freq = jnp.power(ROPE_BASE, -jnp.arange(0, MLA_ROPE, 2, dtype=jnp.float32) / MLA_ROPE)
    ang = positions.astype(jnp.float32)[..., None] * inv_freq
    return jnp.cos(ang)[:, :, None, :], jnp.sin(ang)[:, :, None, :]


def apply_rope(x, cos, sin):
    half = x.shape[-1] // 2
    x1, x2 = x[..., :half], x[..., half:]
    cos = cos.astype(x.dtype)
    sin = sin.astype(x.dtype)
    return jnp.concatenate([x1 * cos - x2 * sin, x2 * cos + x1 * sin], axis=-1)


def mla_branch(c_q, c_kv, k_rope, cos, sin, q_norm_g, w_uq, kv_norm_g, w_ukv):
    B, T, _ = c_q.shape
    q = (rms_norm(c_q, q_norm_g) @ w_uq).reshape(B, T, MLA_HEADS, MLA_NOPE + MLA_ROPE)
    q_nope, q_rope = q[..., :MLA_NOPE], apply_rope(q[..., MLA_NOPE:], cos, sin)
    kv = (rms_norm(c_kv, kv_norm_g) @ w_ukv).reshape(B, T, MLA_HEADS, MLA_NOPE + MLA_V)
    k_nope, v = kv[..., :MLA_NOPE], kv[..., MLA_NOPE:]
    k_r = apply_rope(k_rope[:, :, None, :], cos, sin)[:, :, 0]
    scale = (MLA_NOPE + MLA_ROPE) ** -0.5
    outs = []
    for blk in range(T // Q_BLOCK):
        s0 = blk * Q_BLOCK
        s1 = s0 + Q_BLOCK
        scores = (jnp.einsum('bqhd,bkhd->bhqk', q_nope[:, s0:s1], k_nope[:, :s1])
                  + jnp.einsum('bqhr,bkr->bhqk', q_rope[:, s0:s1], k_r[:, :s1]))
        scores = scores.astype(jnp.float32) * scale
        mask = (s0 + jnp.arange(Q_BLOCK))[:, None] >= jnp.arange(s1)[None, :]
        p = jax.nn.softmax(jnp.where(mask, scores, -jnp.inf), axis=-1).astype(v.dtype)
        outs.append(jnp.einsum('bhqk,bkhv->bqhv', p, v[:, :s1]))
    return jnp.concatenate(outs, axis=1).reshape(B, T, MLA_WIDTH)


def rwkv7_scan(r, w, k, v, a_vec, b_vec):
    B, T, H, N = r.shape

    def step(S, inp):
        rt, wt, kt, vt, at, bt = inp
        sa = jnp.einsum('bhvk,bhk->bhv', S, at)
        S = S * wt[:, :, None, :] + sa[..., None] * bt[:, :, None, :] + vt[..., None] * kt[:, :, None, :]
        return S, jnp.einsum('bhvk,bhk->bhv', S, rt)

    xs = tuple(jnp.moveaxis(t, 1, 0) for t in (r, w, k, v, a_vec, b_vec))
    _, y = lax.scan(step, jnp.zeros((B, H, N, N), jnp.float32), xs)
    return jnp.moveaxis(y, 0, 1)


def rwkv7_branch(rw_mix, v_first, vres, mu, w0, w2, a0, a2, k_k, k_a, r_k, ln_g, ln_b):
    B, T, _ = rw_mix.shape
    xm = rw_mix.astype(jnp.float32)
    xs = xm + mu * (token_shift(xm) - xm)
    r, k, v, xw, xa = jnp.split(xs, [RW_WIDTH, 2 * RW_WIDTH, 3 * RW_WIDTH,
                                     3 * RW_WIDTH + RW_DECAY_RANK], axis=-1)
    log_w = -jax.nn.softplus(-(w0 + jnp.tanh(xw) @ w2)) - 0.5
    decay = jnp.exp(-jnp.exp(log_w))
    a = jax.nn.sigmoid(a0 + xa @ a2)
    if vres is None:
        v_first = v
    else:
        v0, v1, v2 = vres
        v = v + (v_first - v) * jax.nn.sigmoid(v0 + (v @ v1) @ v2)

    def heads(t):
        return t.reshape(B, T, RW_HEADS, RW_HEAD_DIM)

    kk = heads(k * k_k)
    kk = kk / jnp.maximum(jnp.sqrt(jnp.sum(kk * kk, axis=-1, keepdims=True)), 1e-12)
    a_h = heads(a)
    k_h = heads(k * (1.0 + (a - 1.0) * k_a))
    r_h, v_h = heads(r), heads(v)
    y = rwkv7_scan(r_h, heads(decay), k_h, v_h, -kk, kk * a_h)
    y = head_layer_norm(y, ln_g.reshape(RW_HEADS, RW_HEAD_DIM), ln_b.reshape(RW_HEADS, RW_HEAD_DIM), RW_GN_EPS)
    y = y + jnp.sum(r_h * k_h * r_k, axis=-1, keepdims=True) * v_h
    return y.reshape(B, T, RW_WIDTH), v_first


def setup_inputs(seed: int = 0) -> dict:
    key = jax.random.key(seed)
    ks = jax.random.split(key, 32)

    def nrm(k, shape, scale):
        return scale * jax.random.normal(k, shape, jnp.float32)

    def uni(k, shape, lo, hi):
        return jax.random.uniform(k, shape, jnp.float32, lo, hi)

    x = jax.random.normal(ks[0], (BATCH, SEQ, D_MODEL), jnp.float32)
    offs = jax.random.randint(ks[1], (BATCH, 1), 0, 1024)
    positions = (jnp.arange(SEQ)[None, :] + offs).astype(jnp.int32)
    return {
        'x': x,
        'positions': positions,
        'norm_g': 1.0 + nrm(ks[2], (DEPTH, D_MODEL), 0.02),
        'w_in': nrm(ks[3], (DEPTH, D_MODEL, D_IN), D_MODEL ** -0.5),
        'ml_conv_w': nrm(ks[4], (DEPTH, ML_CONV, 2 * ML_WIDTH), 0.5),
        'ml_conv_b': nrm(ks[5], (DEPTH, 2 * ML_WIDTH), 0.01),
        'ml_i_bias': nrm(ks[6], (DEPTH, ML_HEADS), 0.1),
        'ml_f_bias': uni(ks[7], (DEPTH, ML_HEADS), 3.0, 6.0),
        'ml_norm_g': 1.0 + nrm(ks[8], (DEPTH, ML_WIDTH), 0.02),
        'mla_q_norm_g': 1.0 + nrm(ks[9], (DEPTH, MLA_Q_RANK), 0.02),
        'mla_w_uq': nrm(ks[10], (DEPTH, MLA_Q_RANK, MLA_HEADS * (MLA_NOPE + MLA_ROPE)), MLA_Q_RANK ** -0.5),
        'mla_kv_norm_g': 1.0 + nrm(ks[11], (DEPTH, MLA_KV_RANK), 0.02),
        'mla_w_ukv': nrm(ks[12], (DEPTH, MLA_KV_RANK, MLA_HEADS * (MLA_NOPE + MLA_V)), MLA_KV_RANK ** -0.5),
        'rw_mu': uni(ks[13], (DEPTH, RW_MIX_WIDTH), 0.0, 1.0),
        'rw_w0': uni(ks[14], (DEPTH, RW_WIDTH), -4.0, 0.0),
        'rw_w2': nrm(ks[15], (DEPTH, RW_DECAY_RANK, RW_WIDTH), 0.5 * RW_DECAY_RANK ** -0.5),
        'rw_a0': nrm(ks[16], (DEPTH, RW_WIDTH), 0.1),
        'rw_a2': nrm(ks[17], (DEPTH, RW_AAA_RANK, RW_WIDTH), 0.5 * RW_AAA_RANK ** -0.5),
        'rw_v0': nrm(ks[18], (DEPTH - 1, RW_WIDTH), 0.1),
        'rw_v1': nrm(ks[19], (DEPTH - 1, RW_WIDTH, RW_MV_RANK), RW_WIDTH ** -0.5),
        'rw_v2': nrm(ks[20], (DEPTH - 1, RW_MV_RANK, RW_WIDTH), 0.5 * RW_MV_RANK ** -0.5),
        'rw_k_k': 0.85 + nrm(ks[21], (DEPTH, RW_WIDTH), 0.05),
        'rw_k_a': 1.0 + nrm(ks[22], (DEPTH, RW_WIDTH), 0.05),
        'rw_r_k': nrm(ks[23], (DEPTH, RW_HEADS, RW_HEAD_DIM), 0.1),
        'rw_ln_g': 1.0 + nrm(ks[24], (DEPTH, RW_WIDTH), 0.02),
        'rw_ln_b': nrm(ks[25], (DEPTH, RW_WIDTH), 0.01),
        'w_out': nrm(ks[26], (DEPTH, D_MIX, D_MODEL), 0.5 * D_MIX ** -0.5),
        'final_norm_g': 1.0 + nrm(ks[27], (D_MODEL,), 0.02),
    }


def reference(x, positions, norm_g, w_in, ml_conv_w, ml_conv_b, ml_i_bias, ml_f_bias, ml_norm_g,
              mla_q_norm_g, mla_w_uq, mla_kv_norm_g, mla_w_ukv,
              rw_mu, rw_w0, rw_w2, rw_a0, rw_a2, rw_v0, rw_v1, rw_v2, rw_k_k, rw_k_a, rw_r_k,
              rw_ln_g, rw_ln_b, w_out, final_norm_g):
    cos, sin = rope_cos_sin(positions)
    offsets = split_offsets()
    v_first = None
    for l in range(DEPTH):
        h = rms_norm(x, norm_g[l])
        proj = h @ w_in[l]
        (ml_qk, ml_v, ml_i, ml_f, ml_o, ml_z, mla_cq, mla_ckv, mla_kr, mla_z,
         rw_mix, rw_z) = jnp.split(proj, offsets, axis=-1)
        y_ml = mlstm_branch(ml_qk, ml_v, ml_i, ml_f, ml_o, ml_conv_w[l], ml_conv_b[l],
                            ml_i_bias[l], ml_f_bias[l], ml_norm_g[l])
        y_mla = mla_branch(mla_cq, mla_ckv, mla_kr, cos, sin, mla_q_norm_g[l], mla_w_uq[l],
                           mla_kv_norm_g[l], mla_w_ukv[l])
        vres = None if l == 0 else (rw_v0[l - 1], rw_v1[l - 1], rw_v2[l - 1])
        y_rw, v_first = rwkv7_branch(rw_mix, v_first, vres, rw_mu[l], rw_w0[l], rw_w2[l], rw_a0[l],
                                     rw_a2[l], rw_k_k[l], rw_k_a[l], rw_r_k[l], rw_ln_g[l], rw_ln_b[l])
        mixed = jnp.concatenate([jax.nn.silu(ml_z) * y_ml.astype(x.dtype),
                                 jax.nn.silu(mla_z) * y_mla.astype(x.dtype),
                                 jax.nn.silu(rw_z) * y_rw.astype(x.dtype)], axis=-1)
        x = x + mixed @ w_out[l]
    return rms_norm(x, final_norm_g)
```

```cpp
#include <hip/hip_runtime.h>
#include <cstdio>
#include <cstdint>
#include <cstring>
namespace pg8 {
#define PG8_LAS __attribute__((address_space(3)))
typedef unsigned short bf16_t;
typedef short bf16x8 __attribute__((ext_vector_type(8)));
typedef float f32x4 __attribute__((ext_vector_type(4)));
typedef unsigned u32x4 __attribute__((ext_vector_type(4)));
constexpr int BM = 256, BK = 64, HALF = 128, HTB = HALF * BK * 2  , STAGE_BYTES = 8 * HTB, NXCD = 8, WGM = 8;

__host__ __device__ __forceinline__ int lds_byte(int r, int c) { const int st = (r >> 4) * 2 + (c >> 5), rr = r & 15, cc = c & 31, ob = rr * 64 + cc * 2; return st * 1024 + (ob ^ (((ob >> 9) & 1) << 5)); }
__host__ __device__ __forceinline__ void stage_rc(int b, int& R, int& C) { const int st = b / 1024, sb = b % 1024, swz = sb ^ (((sb >> 9) & 1) << 5); R = (st >> 1) * 16 + swz / 64; C = (st & 1) * 32 + (swz % 64) / 2; }
__host__ __device__ __forceinline__ int perm32(int rho) { const int n = rho >> 4, i = rho & 15; return 8 * (i >> 2) + 4 * n + (i & 3); }

struct Unit { int pm, pn; };
struct Gemm { const bf16_t* A; const bf16_t* Bt; int M, N, K; };

struct StaticOrder {
    int nM, nN, nwg, G, c;
    __host__ __device__ void init(int M, int N, int G_, int c_) { nM = M / BM; nN = N / BM; nwg = nM * nN; G = G_; c = c_; }
    __host__ __device__ bool next(int i, Unit& u) const {
        const long L = (long)i * G + c; if (L >= nwg) return false;
        int wgid = (int)L; { const int q = nwg / NXCD, r = nwg % NXCD, xcd = wgid % NXCD, off = wgid / NXCD; wgid = (xcd < r ? xcd * (q + 1) : r * (q + 1) + (xcd - r) * q) + off; }
        const int nig = WGM * nN, gid = wgid / nig, fm = gid * WGM, gsz = (nM - fm) < WGM ? (nM - fm) : WGM;
        u.pm = fm + ((wgid % nig) % gsz); u.pn = (wgid % nig) / gsz; return true;
    }
    __device__ __forceinline__ void a_ready(const Unit&) const {}
    __device__ __forceinline__ void done(const Unit&) const {}
};

__device__ __forceinline__ unsigned cvt_pk_bf16(float lo, float hi) { unsigned r; asm volatile("v_cvt_pk_bf16_f32 %0, %1, %2" : "=v"(r) : "v"(lo), "v"(hi)); return r; }
typedef float f32x2 __attribute__((ext_vector_type(2)));
typedef unsigned u32x2 __attribute__((ext_vector_type(2)));
struct EpiProj {
    static constexpr bool PERM = true, AFTER_DRAIN = false;
    bf16_t* O; int ldc; float* spec; int spec_tile;
    __device__ __forceinline__ void operator()(const f32x4 (&acc)[2][2][4][2], const Unit& u, int wr, int wc, int fr, int fq) const {
        const int row0 = u.pm * BM + wr * 64 + fr, col0 = u.pn * BM + wc * 32 + 8 * fq;
        if (u.pn == spec_tile) {
            float* sp0 = spec + (size_t)row0 * 256 + wc * 32 + 8 * fq;
#pragma unroll
            for (int ai = 0; ai < 2; ++ai)
#pragma unroll
                for (int m = 0; m < 4; ++m) { float* sp_p = sp0 + (size_t)(ai * HALF + m * 16) * 256;
#pragma unroll
                    for (int bj = 0; bj < 2; ++bj) { *(f32x4*)(sp_p + bj * HALF) = acc[ai][bj][m][0]; *(f32x4*)(sp_p + bj * HALF + 4) = acc[ai][bj][m][1]; } }
        }
        bf16_t* o0 = O + (size_t)row0 * ldc + col0;
#pragma unroll
        for (int ai = 0; ai < 2; ++ai)
#pragma unroll
            for (int m = 0; m < 4; ++m) { bf16_t* rowp = o0 + (size_t)(ai * HALF + m * 16) * ldc;
#pragma unroll
                for (int bj = 0; bj < 2; ++bj) { const f32x4 v0 = acc[ai][bj][m][0], v1 = acc[ai][bj][m][1];
                    u32x4 w; w.x = cvt_pk_bf16(v0[0], v0[1]); w.y = cvt_pk_bf16(v0[2], v0[3]); w.z = cvt_pk_bf16(v1[0], v1[1]); w.w = cvt_pk_bf16(v1[2], v1[3]);
                    *(u32x4*)(rowp + bj * HALF) = w; } }
    }
};
struct EpiQ {
    static constexpr bool PERM = true, AFTER_DRAIN = false;
    bf16_t* O; const float* cs;
    __device__ __forceinline__ void operator()(const f32x4 (&acc)[2][2][4][2], const Unit& u, int wr, int wc, int fr, int fq) const {
        const int row0 = u.pm * BM + wr * 64 + fr, col0 = u.pn * BM + wc * 32 + 8 * fq;
#pragma unroll
        for (int ai = 0; ai < 2; ++ai)
#pragma unroll
            for (int m = 0; m < 4; ++m) { const int row = row0 + ai * HALF + m * 16; bf16_t* rowp = O + (size_t)row * 1536 + col0;
#pragma unroll
                for (int bj = 0; bj < 2; ++bj) { f32x4 v0 = acc[ai][bj][m][0], v1 = acc[ai][bj][m][1];
                    const int d = (col0 + bj * HALF) % 192;
                    if (d >= 128) { const int i0 = (d - 128) >> 1; const f32x4* cp = (const f32x4*)(cs + (size_t)row * 64 + i0 * 2); const f32x4 c0 = cp[0], c1 = cp[1];
                        f32x4 r0, r1;
                        r0[0] = v0[0] * c0[0] - v0[1] * c0[1]; r0[1] = v0[1] * c0[0] + v0[0] * c0[1];
                        r0[2] = v0[2] * c0[2] - v0[3] * c0[3]; r0[3] = v0[3] * c0[2] + v0[2] * c0[3];
                        r1[0] = v1[0] * c1[0] - v1[1] * c1[1]; r1[1] = v1[1] * c1[0] + v1[0] * c1[1];
                        r1[2] = v1[2] * c1[2] - v1[3] * c1[3]; r1[3] = v1[3] * c1[2] + v1[2] * c1[3];
                        v0 = r0; v1 = r1; }
                    u32x4 w; w.x = cvt_pk_bf16(v0[0], v0[1]); w.y = cvt_pk_bf16(v0[2], v0[3]); w.z = cvt_pk_bf16(v1[0], v1[1]); w.w = cvt_pk_bf16(v1[2], v1[3]);
                    *(u32x4*)(rowp + bj * HALF) = w; } }
    }
};
struct EpiPlain {
    static constexpr bool PERM = true, AFTER_DRAIN = false;
    bf16_t* O; int ldc;
    __device__ __forceinline__ void operator()(const f32x4 (&acc)[2][2][4][2], const Unit& u, int wr, int wc, int fr, int fq) const {
        const int row0 = u.pm * BM + wr * 64 + fr, col0 = u.pn * BM + wc * 32 + 8 * fq;
#pragma unroll
        for (int ai = 0; ai < 2; ++ai)
#pragma unroll
            for (int m = 0; m < 4; ++m) { bf16_t* rowp = O + (size_t)(row0 + ai * HALF + m * 16) * ldc + col0;
#pragma unroll
                for (int bj = 0; bj < 2; ++bj) { const f32x4 v0 = acc[ai][bj][m][0], v1 = acc[ai][bj][m][1];
                    u32x4 w; w.x = cvt_pk_bf16(v0[0], v0[1]); w.y = cvt_pk_bf16(v0[2], v0[3]); w.z = cvt_pk_bf16(v1[0], v1[1]); w.w = cvt_pk_bf16(v1[2], v1[3]);
                    *(u32x4*)(rowp + bj * HALF) = w; } }
    }
};
struct EpiResid {
    static constexpr bool PERM = false, AFTER_DRAIN = false;
    const float* base; float* out; int ldc;
    __device__ __forceinline__ void operator()(const f32x4 (&acc)[2][2][4][2], const Unit& u, int wr, int wc, int fr, int fq) const {
        const int row0 = u.pm * BM + wr * 64 + fr, col0 = u.pn * BM + wc * 32 + 4 * fq;
#pragma unroll
        for (int ai = 0; ai < 2; ++ai)
#pragma unroll
            for (int m = 0; m < 4; ++m) { const size_t off = (size_t)(row0 + ai * HALF + m * 16) * ldc + col0;
#pragma unroll
                for (int bj = 0; bj < 2; ++bj)
#pragma unroll
                    for (int n = 0; n < 2; ++n) { const f32x4 bs = *(const f32x4*)(base + off + bj * HALF + n * 16); *(f32x4*)(out + off + bj * HALF + n * 16) = bs + acc[ai][bj][m][n]; } }
    }
};
template <class Epi, class Sched, bool ALIGN_EPI = false, bool SP2 = false>
__device__ __forceinline__ void gemm_phase(PG8_LAS unsigned char* lds, const Gemm g, const Sched& S, const Epi& E) {
    int tid_o = threadIdx.x; asm volatile("" : "+v"(tid_o));
    const int tid = tid_o, wid = __builtin_amdgcn_readfirstlane(tid >> 6), lane = tid & 63, wr = wid >> 2, wc = wid & 3, fr = lane & 15, fq = lane >> 4;
    const int K = g.K, nt = K / BK;
    unsigned voffA[2], voffB[2];
#pragma unroll
    for (int i = 0; i < 2; ++i) { int R, C; stage_rc(tid * 16 + i * 8192, R, C); const int Rb = Epi::PERM ? ((R & ~31) + perm32(R & 31)) : R;
        voffA[i] = (unsigned)(R * K + C) * 2u; voffB[i] = (unsigned)(Rb * K + C) * 2u; }
    const size_t kstep = (size_t)(BK * 2);
    const size_t hstep = (size_t)HALF * K * 2;
    const size_t tstep = 2 * hstep;
    const unsigned ldsw = (unsigned)wid * 1024u;
    const int aoff = lds_byte(wr * 64 + fr, fq * 8), boff = lds_byte(wc * 32 + fr, fq * 8);
#define PG8_SA(b, h) (((b) * 2 + (h)) * HTB)
#define PG8_SB(b, h) ((4 + (b) * 2 + (h)) * HTB)
#define PG8_STAGE(bufoff, gbase, voff) do { _Pragma("unroll") for (int _i = 0; _i < 2; ++_i) \
        __builtin_amdgcn_global_load_lds((const unsigned*)((const char*)(gbase) + (voff)[_i]), (PG8_LAS unsigned*)(lds + (bufoff) + ldsw + _i * 8192), 16, 0, 0); } while (0)
#define PG8_LDA(dst, b, h) do { _Pragma("unroll") for (int m = 0; m < 4; ++m) _Pragma("unroll") for (int k = 0; k < 2; ++k) dst[m][k] = *(const PG8_LAS bf16x8*)(lds + PG8_SA(b, h) + aoff + m * 2048 + k * 1024); } while (0)
#define PG8_LDB(dst, b, h) do { _Pragma("unroll") for (int n = 0; n < 2; ++n) _Pragma("unroll") for (int k = 0; k < 2; ++k) dst[n][k] = *(const PG8_LAS bf16x8*)(lds + PG8_SB(b, h) + boff + n * 2048 + k * 1024); } while (0)
#define PG8_MMA(ai, bj, At, Bt) do { __builtin_amdgcn_s_setprio(1); _Pragma("unroll") for (int m = 0; m < 4; ++m) _Pragma("unroll") for (int n = 0; n < 2; ++n) _Pragma("unroll") for (int k = 0; k < 2; ++k) \
        acc[ai][bj][m][n] = __builtin_amdgcn_mfma_f32_16x16x32_bf16(Bt[n][k], At[m][k], acc[ai][bj][m][n], 0, 0, 0); __builtin_amdgcn_s_setprio(0); } while (0)
#define PG8_WAIT_V(n) asm volatile("s_waitcnt vmcnt(" #n ")" ::: "memory")
#define PG8_WAIT_L(n) asm volatile("s_waitcnt lgkmcnt(" #n ")" ::: "memory")
#define PG8_BAR __builtin_amdgcn_s_barrier()
#define PG8_SCHED __builtin_amdgcn_sched_barrier(0)
    Unit cur, nxt; int ui = 0;
    if (!S.next(0, cur)) return;
    f32x4 acc[2][2][4][2];
#pragma unroll
    for (int a = 0; a < 2; ++a)
#pragma unroll
        for (int b = 0; b < 2; ++b)
#pragma unroll
            for (int m = 0; m < 4; ++m)
#pragma unroll
                for (int n = 0; n < 2; ++n) acc[a][b][m][n] = (f32x4){0.f, 0.f, 0.f, 0.f};
    bf16x8 At[4][2], B0[2][2], B1[2][2];
    const char* cA = (const char*)g.A + (size_t)cur.pm * tstep; const char* cB = (const char*)g.Bt + (size_t)cur.pn * tstep;
    S.a_ready(cur);
    if constexpr (SP2) {
        PG8_STAGE(PG8_SB(0, 0), cB, voffB); PG8_STAGE(PG8_SB(0, 1), cB + hstep, voffB); PG8_STAGE(PG8_SA(0, 0), cA, voffA); PG8_STAGE(PG8_SA(0, 1), cA + hstep, voffA);
        if (wr == 1) PG8_BAR;
        PG8_WAIT_V(2); PG8_BAR;
        PG8_STAGE(PG8_SB(1, 0), cB + kstep, voffB); PG8_STAGE(PG8_SA(1, 0), cA + kstep, voffA); PG8_STAGE(PG8_SB(1, 1), cB + hstep + kstep, voffB);
        PG8_WAIT_V(6); PG8_BAR;
    } else {
        PG8_STAGE(PG8_SB(0, 0), cB, voffB); PG8_STAGE(PG8_SA(0, 0), cA, voffA); PG8_STAGE(PG8_SB(0, 1), cB + hstep, voffB); PG8_STAGE(PG8_SA(0, 1), cA + hstep, voffA);
        if (wr == 1) PG8_BAR;
        PG8_WAIT_V(4); PG8_BAR;
        PG8_STAGE(PG8_SB(1, 0), cB + kstep, voffB); PG8_STAGE(PG8_SA(1, 0), cA + kstep, voffA); PG8_STAGE(PG8_SB(1, 1), cB + hstep + kstep, voffB);
        PG8_WAIT_V(6); PG8_BAR;
    }
    for (;;) {
        const bool has_next = S.next(ui + 1, nxt);
        const char* nA = has_next ? (const char*)g.A + (size_t)nxt.pm * tstep : cA; const char* nB = has_next ? (const char*)g.Bt + (size_t)nxt.pn * tstep : cB;
        for (int t = 0; t < nt; t += 2) {
            const bool last = (t == nt - 2);
            const char* a1 = cA + (size_t)(t + 1) * kstep;
            const char* a2 = last ? nA : cA + (size_t)(t + 2) * kstep; const char* b2 = last ? nB : cB + (size_t)(t + 2) * kstep;
            const char* a3 = a2 + kstep; const char* b3 = b2 + kstep;
            if (last && has_next) S.a_ready(nxt);
            if constexpr (SP2) {
            PG8_LDB(B0, 0, 0); PG8_LDB(B1, 0, 1); PG8_SCHED; PG8_LDA(At, 0, 0); PG8_STAGE(PG8_SA(1, 1), a1 + hstep, voffA);
            PG8_WAIT_V(8); PG8_WAIT_L(0); PG8_BAR; PG8_MMA(0, 0, At, B0); PG8_MMA(0, 1, At, B1); PG8_BAR; PG8_SCHED;
            PG8_LDA(At, 0, 1); PG8_STAGE(PG8_SB(0, 0), b2, voffB); PG8_STAGE(PG8_SB(0, 1), b2 + hstep, voffB); PG8_STAGE(PG8_SA(0, 0), a2, voffA);
            PG8_WAIT_V(8); PG8_WAIT_L(0); PG8_BAR; PG8_MMA(1, 0, At, B0); PG8_MMA(1, 1, At, B1); PG8_BAR; PG8_SCHED;
            PG8_LDB(B0, 1, 0); PG8_LDB(B1, 1, 1); PG8_SCHED; PG8_LDA(At, 1, 0); PG8_STAGE(PG8_SA(0, 1), a2 + hstep, voffA);
            PG8_WAIT_V(8); PG8_WAIT_L(0); PG8_BAR; PG8_MMA(0, 0, At, B0); PG8_MMA(0, 1, At, B1); PG8_BAR; PG8_SCHED;
            PG8_LDA(At, 1, 1); PG8_STAGE(PG8_SB(1, 0), b3, voffB); PG8_STAGE(PG8_SB(1, 1), b3 + hstep, voffB); PG8_STAGE(PG8_SA(1, 0), a3, voffA);
            PG8_WAIT_V(8); PG8_WAIT_L(0); PG8_BAR; PG8_MMA(1, 0, At, B0); PG8_MMA(1, 1, At, B1); PG8_BAR; PG8_SCHED;
            } else {
            PG8_LDB(B0, 0, 0); PG8_SCHED; PG8_LDA(At, 0, 0); PG8_STAGE(PG8_SA(1, 1), a1 + hstep, voffA);
            PG8_WAIT_L(8); PG8_BAR; PG8_WAIT_L(0); PG8_MMA(0, 0, At, B0); PG8_BAR; PG8_SCHED;
            PG8_LDB(B1, 0, 1); PG8_STAGE(PG8_SB(0, 0), b2, voffB);
            PG8_BAR; PG8_WAIT_L(0); PG8_MMA(0, 1, At, B1); PG8_BAR;
            PG8_LDA(At, 0, 1); PG8_STAGE(PG8_SA(0, 0), a2, voffA);
            PG8_BAR; PG8_WAIT_L(0); PG8_MMA(1, 0, At, B0); PG8_BAR; PG8_SCHED;
            PG8_STAGE(PG8_SB(0, 1), b2 + hstep, voffB);
            PG8_WAIT_V(6); PG8_BAR; PG8_MMA(1, 1, At, B1); PG8_BAR;
            PG8_LDB(B0, 1, 0); PG8_SCHED; PG8_LDA(At, 1, 0); PG8_STAGE(PG8_SA(0, 1), a2 + hstep, voffA);
            PG8_WAIT_L(8); PG8_BAR; PG8_WAIT_L(0); PG8_MMA(0, 0, At, B0); PG8_BAR; PG8_SCHED;
            PG8_LDB(B1, 1, 1); PG8_STAGE(PG8_SB(1, 0), b3, voffB);
            PG8_BAR; PG8_WAIT_L(0); PG8_MMA(0, 1, At, B1); PG8_BAR;
            PG8_LDA(At, 1, 1); PG8_STAGE(PG8_SA(1, 0), a3, voffA);
            PG8_BAR; PG8_WAIT_L(0); PG8_MMA(1, 0, At, B0); PG8_BAR; PG8_SCHED;
            PG8_STAGE(PG8_SB(1, 1), b3 + hstep, voffB);
            PG8_WAIT_V(6); PG8_BAR; PG8_MMA(1, 1, At, B1); PG8_BAR;
            }
        }
        if constexpr (ALIGN_EPI) { if (wr == 0) PG8_BAR; }
        if constexpr (!Epi::AFTER_DRAIN) { E(acc, cur, wr, wc, fr, fq); S.done(cur); }
        if (!has_next) break;
#pragma unroll
        for (int a = 0; a < 2; ++a)
#pragma unroll
            for (int b = 0; b < 2; ++b)
#pragma unroll
                for (int m = 0; m < 4; ++m)
#pragma unroll
                    for (int n = 0; n < 2; ++n) acc[a][b][m][n] = (f32x4){0.f, 0.f, 0.f, 0.f};
        cur = nxt; cA = nA; cB = nB; ++ui;
        if constexpr (ALIGN_EPI) { if (wr == 1) PG8_BAR; }
    }
    PG8_WAIT_V(0);
    if constexpr (!ALIGN_EPI) { if (wr == 0) PG8_BAR; }
    PG8_BAR;
    if constexpr (Epi::AFTER_DRAIN) { E.fused(acc, cur, wr, wc, fr, fq, lds, wid, lane); S.done(cur); }
#undef PG8_SA
#undef PG8_SB
#undef PG8_STAGE
#undef PG8_LDA
#undef PG8_LDB
#undef PG8_MMA
#undef PG8_WAIT_V
#undef PG8_WAIT_L
#undef PG8_BAR
#undef PG8_SCHED
}
}
#define GAS __attribute__((address_space(1)))
#define LAS __attribute__((address_space(3)))
typedef unsigned short bf16;
typedef unsigned v4u __attribute__((ext_vector_type(4)));
typedef float f32x4 __attribute__((ext_vector_type(4)));
typedef short bf16x8 __attribute__((ext_vector_type(8)));
typedef GAS unsigned gu32;
typedef GAS unsigned long long gu64;
#define RLX_AGENT __ATOMIC_RELAXED, __HIP_MEMORY_SCOPE_AGENT
#define LDS_WAIT() asm volatile("s_waitcnt lgkmcnt(0)" ::: "memory")
#define VM_WAIT() asm volatile("s_waitcnt vmcnt(0)" ::: "memory")
__device__ __forceinline__ unsigned long long rt() { return __builtin_amdgcn_s_memrealtime(); }
__device__ __forceinline__ unsigned f2bf(float f) { unsigned u = __builtin_bit_cast(unsigned, f); return (u + 0x7fffu + ((u >> 16) & 1u)) >> 16; }
__device__ __forceinline__ unsigned pk2(float lo, float hi) { return f2bf(lo) | (f2bf(hi) << 16); }

#define XB_TMO      128
#define XB_XCNT(j)  (256  + 64 * (j))
#define XB_XSUB(j)  (1280 + 64 * (j))
#define XB_XGEN(j)  (2304 + 64 * (j))
#define XB_TOP      3328
#define XB_TOPGEN   3392
#define XCD_BAR_WORDS 3456
#define XB_SPIN_CAP (1u << 18)

__device__ __forceinline__ unsigned xb_ld(unsigned* p)              { return __hip_atomic_load(p, __ATOMIC_RELAXED, __HIP_MEMORY_SCOPE_AGENT); }
__device__ __forceinline__ unsigned xb_add(unsigned* p, unsigned v) { return __hip_atomic_fetch_add(p, v, __ATOMIC_RELAXED, __HIP_MEMORY_SCOPE_AGENT); }
__device__ __forceinline__ unsigned xb_xcc_id() { return (unsigned)__builtin_amdgcn_s_getreg((3 << 11) | 20) & 0xFu; }
#define XB_SPIN(cond, bar) do { unsigned _sp = 0; while (cond) { __builtin_amdgcn_s_sleep(1); \
    if ((++_sp & 255u) == 0u) { if (xb_ld(&(bar)[XB_TMO])) break; if (_sp > XB_SPIN_CAP) { atomicAdd(&(bar)[XB_TMO], 1u); break; } } } } while (0)

struct XcdBarrier {
    unsigned* bar; unsigned x;
    volatile LAS unsigned* st;
};

__device__ __forceinline__ XcdBarrier xcd_barrier_post(unsigned* bar, volatile LAS unsigned* st) {
    XcdBarrier b; b.bar = bar; b.x = xb_xcc_id(); b.st = st;
    if (threadIdx.x == 0) (void)xb_add(&bar[XB_XCNT(b.x)], 1u);
    return b;
}
__device__ __forceinline__ void xcd_barrier_complete(unsigned* bar, unsigned x, unsigned& nloc, unsigned& nx) {
    const unsigned G = gridDim.x * gridDim.y * gridDim.z;
    unsigned sum, cnt, mine, sp = 0u;
    for (;;) {
        sum = 0u; cnt = 0u; mine = 0u;
#pragma unroll
        for (unsigned j = 0; j < 16; ++j) { const unsigned c = xb_ld(&bar[XB_XCNT(j)]); sum += c; cnt += (c > 0u) ? 1u : 0u; mine = (j == x) ? c : mine; }
        if (sum == G) break;
        __builtin_amdgcn_s_sleep(1);
        if ((++sp & 255u) == 0u) { if (xb_ld(&bar[XB_TMO])) break; if (sp > XB_SPIN_CAP) { atomicAdd(&bar[XB_TMO], 1u); break; } }
    }
    nloc = mine > 0u ? mine : 1u; nx = cnt > 0u ? cnt : 1u;
}

__device__ __forceinline__ void xcd_barrier(const XcdBarrier& b) {
    asm volatile("s_waitcnt vmcnt(0)" ::: "memory");
    __syncthreads();
    if (threadIdx.x == 0) {
        unsigned* bar = b.bar;
        __builtin_amdgcn_s_waitcnt(0);
        unsigned nloc = b.st[0], nx = b.st[1];
        if (nloc == 0u) { xcd_barrier_complete(bar, b.x, nloc, nx); b.st[0] = nloc; b.st[1] = nx; }
        const unsigned old = xb_add(&bar[XB_XSUB(b.x)], 1u);
        const unsigned gen = old / nloc;
        if (old + 1u == (gen + 1u) * nloc) {
            __builtin_amdgcn_fence(__ATOMIC_RELEASE, "agent");
            asm volatile("s_waitcnt vmcnt(0)" ::: "memory");
            const unsigned og = xb_add(&bar[XB_TOP], 1u);
            const unsigned tg = og / nx;
            if (og + 1u == (tg + 1u) * nx) xb_add(&bar[XB_TOPGEN], 1u);
            else XB_SPIN(xb_ld(&bar[XB_TOPGEN]) == tg, bar);
            __builtin_amdgcn_fence(__ATOMIC_ACQUIRE, "agent");
            xb_add(&bar[XB_XGEN(b.x)], 1u);
            asm volatile("s_waitcnt vmcnt(0)" ::: "memory");
        } else {
            XB_SPIN(xb_ld(&bar[XB_XGEN(b.x)]) == gen, bar);
            __builtin_amdgcn_fence(__ATOMIC_ACQUIRE, "agent");
            asm volatile("s_waitcnt vmcnt(0)" ::: "memory");
        }
    }
    __syncthreads();
}
constexpr int BATCH = 4, T = 4096, DM = 2048, DEPTH = 4, M = BATCH * T;
constexpr int D_IN = 6600, NPROJ = 6656;
constexpr int SC_MLQK = 0, SC_MLV = 1024, SC_MLI = 1536, SC_MLF = 1540, SC_MLO = 1544, SC_MLZ = 2056, SC_CQ = 2568, SC_CKV = 3080, SC_KR = 3336, SC_MLAZ = 3400, SC_RW = 4424, SC_RWZ = 6088;
constexpr int PC_MLQK = 0, PC_MLV = 1024, PC_MLO = 1536, PC_MLZ = 2048, PC_CQ = 2560, PC_CKV = 3072, PC_MLAZ = 3328, PC_RW = 4352, PC_SPEC = 5888, PC_RWZ = 6144;
constexpr int SPEC_TILE = PC_SPEC / 256;
constexpr int NQ = 1536, NKV = 2048;
constexpr float NORM_EPS = 1e-6f, RW_GN_EPS = 64e-5f;
namespace att {
typedef unsigned short bf16_t;
typedef short bf16x8 __attribute__((ext_vector_type(8)));
typedef short s16x4 __attribute__((ext_vector_type(4)));
typedef float f32x16 __attribute__((ext_vector_type(16)));
typedef float f32x4 __attribute__((ext_vector_type(4)));
typedef unsigned u32x4 __attribute__((ext_vector_type(4)));
constexpr int NW = 8, QBLK = 32, KVBLK = 64, QB = NW * QBLK;
constexpr int QP = 1536, KVP = 2048, KRP = 64, OP = 2048;
constexpr int SHM_V = KVBLK * 128 * 2, SHM_K = KVBLK * 128 * 2, SHM_R = KVBLK * 64 * 2;
constexpr int OFF_V = 0, OFF_K = 2 * SHM_V, OFF_R = OFF_K + SHM_K, OFF_WS = OFF_R + SHM_R, OFF_Q = OFF_WS + NW * 64 * 4, LDS_BYTES = OFF_Q + NW * 12288;
constexpr float SCALE = 0.07216878364870322f;
constexpr float THR = 8.f;
constexpr unsigned WBIG = 1u << 30;
#define KSWZ(row, colB) ((row) * 256 + ((colB) ^ (((row) & 7) << 4)))
#define RSWZ(row, colB) ((row) * 128 + ((colB) ^ (((row) & 7) << 4)))
#define SBAR() __builtin_amdgcn_sched_barrier(0)
__device__ __forceinline__ int v_st(int k, int c) { const int kk = (k & ~0xC) | ((k & 4) << 1) | ((k & 8) >> 1); return ((kk >> 3) * 4 + (c >> 5)) * 512 + ((kk & 7) * 32 + (c & 31)) * 2; }
__device__ __forceinline__ int v_rd_base(int lane) { return ((lane & 3) << 3) | (((lane >> 2) & 3) << 6) | (((lane >> 4) & 1) << 5) | (((lane >> 5) & 1) << 8); }
constexpr int v_rd_off(int d0, int ks, int half) { return d0 * 512 + ks * 4096 + half * 2048; }
__device__ __forceinline__ int crow(int r, int hi) { return (r & 3) + 8 * (r >> 2) + 4 * hi; }
__device__ __forceinline__ unsigned cvtpk(float lo, float hi) { unsigned r; asm volatile("v_cvt_pk_bf16_f32 %0, %1, %2" : "=v"(r) : "v"(lo), "v"(hi)); return r; }
__device__ __forceinline__ bf16x8 load8(const bf16_t* p) { return *reinterpret_cast<const bf16x8*>(p); }
__device__ __forceinline__ float bf2f(bf16_t v) { return __uint_as_float((unsigned)v << 16); }
__device__ __forceinline__ void mask_tile(f32x16& p0, f32x16& p1, int dq, unsigned W) {
    const float NEG = -__builtin_inff();
#pragma unroll
    for (int r = 0; r < 16; ++r) {
        const int c = (r & 3) + 8 * (r >> 2);
        if ((unsigned)(dq - c) >= W) p0[r] = NEG;
        if ((unsigned)(dq - c - 32) >= W) p1[r] = NEG;
    }
}
__device__ __forceinline__ void partialSM(f32x16& p0, f32x16& p1, float& m_reg, float& mn, float& alpha) {
    float pmax = p0[0]; for (int r = 1; r < 16; ++r) pmax = fmaxf(pmax, p0[r]); for (int r = 0; r < 16; ++r) pmax = fmaxf(pmax, p1[r]);
    { auto rr = __builtin_amdgcn_permlane32_swap(__float_as_uint(pmax), __float_as_uint(pmax), false, false);
      pmax = fmaxf(__uint_as_float(rr[0]), __uint_as_float(rr[1])); }
    constexpr float C2 = 1.4426950408889634f * SCALE;
    if (__builtin_expect(__all((pmax - m_reg) * SCALE <= THR), 1)) { mn = m_reg; alpha = 1.f; }
    else { mn = fmaxf(m_reg, pmax); alpha = __builtin_amdgcn_exp2f((m_reg - mn) * C2); m_reg = mn; }
    const float mnL = -mn * C2;
    for (int r = 0; r < 16; ++r) p0[r] = fmaf(p0[r], C2, mnL); for (int r = 0; r < 16; ++r) p1[r] = fmaf(p1[r], C2, mnL);
    for (int r = 0; r < 16; ++r) p0[r] = __builtin_amdgcn_exp2f(p0[r]);
}
__device__ __forceinline__ void finishSM(f32x16& p0, f32x16& p1, float alpha, float& l_reg, bf16x8& pa0, bf16x8& pa1, bf16x8& pa2, bf16x8& pa3) {
    for (int r = 0; r < 16; ++r) p1[r] = __builtin_amdgcn_exp2f(p1[r]);
    float ps = 0; for (int r = 0; r < 16; ++r) ps += p0[r]; for (int r = 0; r < 16; ++r) ps += p1[r];
    { auto rr = __builtin_amdgcn_permlane32_swap(__float_as_uint(ps), __float_as_uint(ps), false, false);
      ps = __uint_as_float(rr[0]) + __uint_as_float(rr[1]); }
    l_reg = l_reg * alpha + ps;
#define PK4(P, B_, OUT) do { unsigned a0 = cvtpk(P[B_+0], P[B_+1]), a1 = cvtpk(P[B_+2], P[B_+3]);                          \
        unsigned b0 = cvtpk(P[B_+4], P[B_+5]), b1 = cvtpk(P[B_+6], P[B_+7]);                                             \
        auto r0 = __builtin_amdgcn_permlane32_swap(a0, b0, false, false); auto r1 = __builtin_amdgcn_permlane32_swap(a1, b1, false, false); \
        u32x4 w = {r0[0], r1[0], r0[1], r1[1]}; OUT = *reinterpret_cast<bf16x8*>(&w); } while (0)
    PK4(p0, 0, pa0); PK4(p0, 8, pa1); PK4(p1, 0, pa2); PK4(p1, 8, pa3);
#undef PK4
}
__device__ __forceinline__ void qkt(f32x16& p0, f32x16& p1, const char* K_lds, const char* R_lds, const char* Qw, int r32, int hi) {
    p0 = f32x16{}; p1 = f32x16{};
    const char* kb[4]; const char* rb[4];
#pragma unroll
    for (int dd = 0; dd < 4; ++dd) { kb[dd] = K_lds + KSWZ(r32, (dd * 16 + hi * 8) * 2); rb[dd] = R_lds + RSWZ(r32, (dd * 16 + hi * 8) * 2); }
#pragma unroll
    for (int d0 = 0; d0 < 8; ++d0) { const char* a = kb[d0 & 3] + (d0 >> 2) * 128;
        bf16x8 b0 = *reinterpret_cast<const bf16x8*>(a);
        bf16x8 b1 = *reinterpret_cast<const bf16x8*>(a + 32 * 256);
        bf16x8 q = *reinterpret_cast<const bf16x8*>(Qw + d0 * 1024);
        p0 = __builtin_amdgcn_mfma_f32_32x32x16_bf16(b0, q, p0, 0, 0, 0);
        p1 = __builtin_amdgcn_mfma_f32_32x32x16_bf16(b1, q, p1, 0, 0, 0); }
#pragma unroll
    for (int e = 0; e < 4; ++e) { const char* a = rb[e];
        bf16x8 b0 = *reinterpret_cast<const bf16x8*>(a);
        bf16x8 b1 = *reinterpret_cast<const bf16x8*>(a + 32 * 128);
        bf16x8 q = *reinterpret_cast<const bf16x8*>(Qw + (8 + e) * 1024);
        p0 = __builtin_amdgcn_mfma_f32_32x32x16_bf16(b0, q, p0, 0, 0, 0);
        p1 = __builtin_amdgcn_mfma_f32_32x32x16_bf16(b1, q, p1, 0, 0, 0); }
}
template <int VB>
__device__ __forceinline__ void pv_tile(f32x16* o, int vb0, bf16x8 pa0, bf16x8 pa1, bf16x8 pa2, bf16x8 pa3) {
#define TRRD(dst, off) asm volatile("ds_read_b64_tr_b16 %0, %1 offset:%2" : "=&v"(dst) : "v"(vb0), "i"(off) : "memory")
#define PV_D0(d0) do { s16x4 l0, l1, l2, l3, h0, h1, h2, h3; constexpr int b_ = OFF_V + VB * SHM_V + v_rd_off(d0, 0, 0); \
        TRRD(l0, b_); TRRD(h0, b_ + 2048); TRRD(l1, b_ + 4096); TRRD(h1, b_ + 6144); TRRD(l2, b_ + 8192); TRRD(h2, b_ + 10240); TRRD(l3, b_ + 12288); TRRD(h3, b_ + 14336); \
        asm volatile("s_waitcnt lgkmcnt(0)" ::: "memory"); SBAR();   \
        o[d0] = __builtin_amdgcn_mfma_f32_32x32x16_bf16(pa0, (bf16x8){l0[0], l0[1], l0[2], l0[3], h0[0], h0[1], h0[2], h0[3]}, o[d0], 0, 0, 0);   \
        o[d0] = __builtin_amdgcn_mfma_f32_32x32x16_bf16(pa1, (bf16x8){l1[0], l1[1], l1[2], l1[3], h1[0], h1[1], h1[2], h1[3]}, o[d0], 0, 0, 0);   \
        o[d0] = __builtin_amdgcn_mfma_f32_32x32x16_bf16(pa2, (bf16x8){l2[0], l2[1], l2[2], l2[3], h2[0], h2[1], h2[2], h2[3]}, o[d0], 0, 0, 0);   \
        o[d0] = __builtin_amdgcn_mfma_f32_32x32x16_bf16(pa3, (bf16x8){l3[0], l3[1], l3[2], l3[3], h3[0], h3[1], h3[2], h3[3]}, o[d0], 0, 0, 0); } while (0)
    PV_D0(0); PV_D0(1); PV_D0(2); PV_D0(3);
#undef PV_D0
#undef TRRD
}
struct BlockRef { const bf16_t* Q; const bf16_t* K; const bf16_t* V; const bf16_t* KR; bf16_t* O; const bf16_t* Z; const float* CSq; int P0; };
struct Seam { bf16x8 qr[12]; bf16x8 st_v0, st_v1, st_k0, st_k1, st_r; };
#define ROWKV(p, k0, rr) ((p) + (size_t)((k0) + (rr)) * KVP + sc)
#define VMW() asm volatile("s_waitcnt vmcnt(0)" ::: "memory")
#define VMWN(n) asm volatile("s_waitcnt vmcnt(%0)" :: "i"(n) : "memory")
#define SLOAD_H(Kp, Vp, Rp, k0) do { S.st_v0 = load8(ROWKV(Vp, k0, sr)); S.st_v1 = load8(ROWKV(Vp, k0, 32 + sr));              \
                         S.st_k0 = load8(ROWKV(Kp, k0, sr)); S.st_k1 = load8(ROWKV(Kp, k0, 32 + sr)); S.st_r = load8((Rp) + (size_t)((k0) + rr_) * KRP + rc_); } while (0)
#define SWRITE_HK() do { *(bf16x8*)(K_lds + kws) = S.st_k0; *(bf16x8*)(K_lds + kws + 32 * 256) = S.st_k1; *(bf16x8*)(R_lds + rws) = S.st_r; } while (0)
#define SWRITE_HV(bf) do { *(bf16x8*)(V_lds + (bf) * SHM_V + vst0) = S.st_v0; *(bf16x8*)(V_lds + (bf) * SHM_V + vst1) = S.st_v1; } while (0)
#define SWRITE_H(bf) do { SWRITE_HV(bf); SWRITE_HK(); } while (0)
__device__ __forceinline__ void attn_prime(const BlockRef& cur, char* lds, Seam& S) {
    int tid_o = threadIdx.x; asm volatile("" : "+v"(tid_o));
    const int tid = tid_o, wid = __builtin_amdgcn_readfirstlane(tid >> 6), lane = tid & 63, r32 = lane & 31, hi = lane >> 5;
    const int sr = tid >> 4, sc = (tid & 15) * 8, kws = KSWZ(sr, sc * 2), rr_ = tid >> 3, rc_ = (tid & 7) * 8, rws = RSWZ(rr_, rc_ * 2);
    char* K_lds = lds + OFF_K; char* R_lds = lds + OFF_R;
#pragma unroll
    for (int d0 = 0; d0 < 12; ++d0) S.qr[d0] = load8(cur.Q + (size_t)(wid * QBLK + r32) * QP + d0 * 16 + hi * 8);
    SLOAD_H(cur.K, cur.V, cur.KR, 0); VMW(); SWRITE_HK();
    __syncthreads();
}
__device__ __forceinline__ void attn_block(const BlockRef& cur, const BlockRef& nxt, char* lds, Seam& S) {
    int tid_o = threadIdx.x; asm volatile("" : "+v"(tid_o));
    const int tid = tid_o, wid = __builtin_amdgcn_readfirstlane(tid >> 6), lane = tid & 63, r32 = lane & 31, hi = lane >> 5;
    const int NT = cur.P0 / KVBLK + 4;
    const int qlo = cur.P0 + wid * QBLK, qm = qlo + r32 - 4 * hi;
    char* V_lds = lds + OFF_V; char* K_lds = lds + OFF_K; char* R_lds = lds + OFF_R;
    float* ws = (float*)(lds + OFF_WS) + wid * 64; float* li_l = ws, * al_l = ws + 32;
    float m_reg = -1e30f, l_reg = 0; f32x16 o[4] = {};
    const int sr = tid >> 4, sc = (tid & 15) * 8, vst0 = v_st(sr, sc), vst1 = v_st(32 + sr, sc), kws = KSWZ(sr, sc * 2), rr_ = tid >> 3, rc_ = (tid & 7) * 8, rws = RSWZ(rr_, rc_ * 2);
    const int vb0 = (int)(uintptr_t)lds + v_rd_base(lane);
    char* Qw = lds + OFF_Q + wid * 12288 + lane * 16;
    const bf16_t* Kh = cur.K; const bf16_t* Vh = cur.V; const bf16_t* Rh = cur.KR;
#define RESC(a) do { if (__any((a) < 1.f)) { if (hi == 0) al_l[r32] = (a); asm volatile("s_waitcnt lgkmcnt(0)" ::: "memory");              \
                     for (int d_ = 0; d_ < 4; ++d_) for (int r = 0; r < 16; ++r) o[d_][r] *= al_l[crow(r, hi)]; } } while (0)
#define KBASE(t) ((t) * KVBLK)
#define MASKT(P0_, P1_, t) do { const int kb_ = KBASE(t); if (kb_ + KVBLK - 1 > qlo) mask_tile(P0_, P1_, qm - kb_, WBIG); } while (0)
    constexpr int NQL = 12;
#define SEAM_K0() do { VMWN(NQL); SWRITE_HK(); SBAR(); } while (0)
    f32x16 pA0, pA1, pB0, pB1; float mnA, mnB, alA, alB; bf16x8 pa0, pa1, pa2, pa3;
#pragma unroll
    for (int e = 0; e < 4; ++e) { const f32x4* cp = (const f32x4*)(cur.CSq + (size_t)(wid * QBLK + r32) * 64 + (e * 8 + hi * 4) * 2); const f32x4 c0 = cp[0], c1 = cp[1];
        const bf16x8 raw = S.qr[8 + e]; float x[8];
#pragma unroll
        for (int j = 0; j < 8; ++j) x[j] = __uint_as_float((unsigned)(unsigned short)raw[j] << 16);
        u32x4 w;
        w.x = cvtpk(x[0] * c0[0] - x[1] * c0[1], x[1] * c0[0] + x[0] * c0[1]); w.y = cvtpk(x[2] * c0[2] - x[3] * c0[3], x[3] * c0[2] + x[2] * c0[3]);
        w.z = cvtpk(x[4] * c1[0] - x[5] * c1[1], x[5] * c1[0] + x[4] * c1[1]); w.w = cvtpk(x[6] * c1[2] - x[7] * c1[3], x[7] * c1[2] + x[6] * c1[3]);
        S.qr[8 + e] = *reinterpret_cast<bf16x8*>(&w); }
#pragma unroll
    for (int d0 = 0; d0 < 12; ++d0) *(bf16x8*)(Qw + d0 * 1024) = S.qr[d0];
    SWRITE_HV(0); SBAR();
    SLOAD_H(Kh, Vh, Rh, KBASE(1));
    SBAR(); qkt(pA0, pA1, K_lds, R_lds, Qw, r32, hi);
    MASKT(pA0, pA1, 0); partialSM(pA0, pA1, m_reg, mnA, alA);
    __syncthreads();
    VMW(); SWRITE_H(1);
    __syncthreads();
#define HALF_STEP(PX0, PX1, mnX, alX, PY0, PY1, alY, t, VB, SB) do {                                                          \
        SBAR(); qkt(PX0, PX1, K_lds, R_lds, Qw, r32, hi);                                                                     \
        finishSM(PY0, PY1, alY, l_reg, pa0, pa1, pa2, pa3); SBAR();                                                           \
        if ((t) + 1 < NT) { SLOAD_H(Kh, Vh, Rh, KBASE((t) + 1)); SBAR(); }                                                    \
        pv_tile<VB>(o, vb0, pa0, pa1, pa2, pa3); MASKT(PX0, PX1, (t)); partialSM(PX0, PX1, m_reg, mnX, alX);                  \
        __syncthreads();                                                                                                      \
        if ((t) + 1 < NT) { VMW(); SWRITE_H(SB); }                                                                            \
        RESC(alX); __syncthreads(); } while (0)
    for (int t = 1; t + 1 < NT; t += 2) {
        HALF_STEP(pB0, pB1, mnB, alB, pA0, pA1, alA, t, 0, 0);
        HALF_STEP(pA0, pA1, mnA, alA, pB0, pB1, alB, t + 1, 1, 1);
    }
    SBAR(); qkt(pB0, pB1, K_lds, R_lds, Qw, r32, hi); SBAR();
    SLOAD_H(nxt.K, nxt.V, nxt.KR, 0); SBAR();
    finishSM(pA0, pA1, alA, l_reg, pa0, pa1, pa2, pa3); SBAR();
    pv_tile<0>(o, vb0, pa0, pa1, pa2, pa3);
    MASKT(pB0, pB1, NT - 1); partialSM(pB0, pB1, m_reg, mnB, alB); __syncthreads(); RESC(alB);
    finishSM(pB0, pB1, alB, l_reg, pa0, pa1, pa2, pa3); SBAR(); pv_tile<1>(o, vb0, pa0, pa1, pa2, pa3);
    SBAR();
#pragma unroll
    for (int d0 = 0; d0 < 12; ++d0) S.qr[d0] = load8(nxt.Q + (size_t)(wid * QBLK + r32) * QP + d0 * 16 + hi * 8);
    SBAR(); SEAM_K0();
    if (hi == 0) li_l[r32] = l_reg; asm volatile("s_waitcnt lgkmcnt(0)" ::: "memory");
    float rli[16];
#pragma unroll
    for (int r = 0; r < 16; ++r) rli[r] = __builtin_amdgcn_rcpf(li_l[crow(r, hi)]);
    bf16_t* Ow = cur.O + (size_t)(wid * QBLK) * OP; const bf16_t* Zw = cur.Z + (size_t)(wid * QBLK) * NPROJ;
#pragma unroll
    for (int r = 0; r < 16; ++r) { const int orow = crow(r, hi);
#pragma unroll
        for (int d0 = 0; d0 < 4; ++d0) { const float z = bf2f(Zw[(size_t)orow * NPROJ + d0 * 32 + r32]);
            const float v = o[d0][r] * rli[r] * (z / (1.f + __expf(-z)));
            const float vn = __shfl_xor(v, 1);
            if ((r32 & 1) == 0) *(unsigned*)(Ow + (size_t)orow * OP + d0 * 32 + r32) = cvtpk(v, vn); } }
    __syncthreads();
#undef RESC
#undef KBASE
#undef MASKT
#undef SEAM_K0
#undef HALF_STEP
}
#undef ROWKV
#undef VMW
#undef VMWN
#undef SLOAD_H
#undef SWRITE_HK
#undef SWRITE_HV
#undef SWRITE_H
#undef KSWZ
#undef RSWZ
#undef SBAR
}
constexpr size_t MiB = 1u << 20;
constexpr size_t WS_CTL = 0, CTL_ZERO_BYTES = 1 * MiB;
constexpr size_t WS_WIN = 1 * MiB;
constexpr size_t WS_WUQ = WS_WIN + 104 * MiB;
constexpr size_t WS_WUKV = WS_WUQ + 6 * MiB;
constexpr size_t WS_WOUT = WS_WUKV + 4 * MiB;
constexpr size_t WS_CS = WS_WOUT + 32 * MiB;
constexpr size_t WS_XN = WS_CS + 4 * MiB;
constexpr size_t WS_PROJ = WS_XN + 64 * MiB;
constexpr size_t WS_SPEC = WS_PROJ + 208 * MiB;
constexpr size_t WS_CQN = WS_SPEC + 16 * MiB;
constexpr size_t WS_CKVN = WS_CQN + 16 * MiB;
constexpr size_t WS_KR = WS_CKVN + 8 * MiB;
constexpr size_t WS_Q = WS_KR + 2 * MiB;
constexpr size_t WS_KV = WS_Q + 48 * MiB;
constexpr size_t WS_QKC = WS_KV + 64 * MiB;
constexpr size_t WS_GATE = WS_QKC + 32 * MiB;
constexpr size_t WS_RWW = WS_GATE + 1 * MiB;
constexpr size_t WS_RWB = WS_RWW + 32 * MiB;
constexpr size_t WS_VFIRST = WS_RWB + 80 * MiB;
constexpr size_t WS_BONUS = WS_VFIRST + 16 * MiB;
constexpr size_t WS_END = WS_BONUS + 1 * MiB;
constexpr int CW_BAR = 4096;
constexpr int LDS_BYTES = 163840, RING_BYTES = 158720, MISC_OFF = RING_BYTES + 320;
static_assert(att::LDS_BYTES <= RING_BYTES, "attention LDS");

typedef unsigned short bf16_t;
__device__ __forceinline__ float bf2f(unsigned v) { return __uint_as_float(v << 16); }
__device__ __forceinline__ float wave_sum(float v) {
#pragma unroll
    for (int o = 1; o < 64; o <<= 1) v += __shfl_xor(v, o);
    return v;
}
__device__ __forceinline__ float sigmoidf_(float x) { return 1.f / (1.f + __expf(-x)); }
__device__ __forceinline__ float siluf_(float x) { return x / (1.f + __expf(-x)); }
__device__ __forceinline__ float softplusf_(float x) { return fmaxf(x, 0.f) + log1pf(__expf(-fabsf(x))); }

struct Args { const float* in[28]; float* out; unsigned char* ws; int ph_lo, ph_hi; };

struct MapWin { __device__ __forceinline__ int operator()(int n) const {
    if (n < 1536) return n;
    if (n < 2048) return SC_MLO + (n - 1536);
    if (n < 2560) return SC_MLZ + (n - 2048);
    if (n < 3072) return SC_CQ + (n - 2560);
    if (n < 3328) return SC_CKV + (n - 3072);
    if (n < 4352) return SC_MLAZ + (n - 3328);
    if (n < 5888) return SC_RW + (n - 4352);
    if (n < 6144) { const int j = n - 5888;
        if (j < 128) return SC_RW + 1536 + j;
        if (j < 192) { const int q = j - 128; return SC_KR + ((q & 1) ? 32 + (q >> 1) : (q >> 1)); }
        if (j < 196) return SC_MLI + (j - 192);
        if (j < 200) return SC_MLF + (j - 196);
        return -1; }
    return SC_RWZ + (n - 6144); } };
struct MapUq { __device__ __forceinline__ int operator()(int n) const { const int h = n / 192, d = n % 192; if (d < 128) return n; const int q = d - 128; return h * 192 + 128 + ((q & 1) ? 32 + (q >> 1) : (q >> 1)); } };
struct MapId { __device__ __forceinline__ int operator()(int n) const { return n; } };

template <class Map>
__device__ __forceinline__ void transpose_item(const float* W, int K, int Nsrc, bf16_t* WT, const float* gain, LAS float* scr, int kb, int nb, int lane, Map map) {
    const int k0 = 64 * kb, n0 = 32 * nb, sc = map(n0 + (lane & 31));
#pragma unroll 8
    for (int i = 0; i < 32; ++i) { const int kk = 2 * i + (lane >> 5); float v = 0.f;
        if (sc >= 0) { v = W[(size_t)(k0 + kk) * Nsrc + sc]; if (gain) v *= gain[k0 + kk]; }
        scr[kk * 33 + (lane & 31)] = v; }
    LDS_WAIT(); asm volatile("" ::: "memory");
    const int c = lane & 7;
#pragma unroll
    for (int j = 0; j < 4; ++j) { const int n = (lane >> 3) + 8 * j; const LAS float* s = scr + (8 * c) * 33 + n;
        v4u o; o.x = pk2(s[0 * 33], s[1 * 33]); o.y = pk2(s[2 * 33], s[3 * 33]); o.z = pk2(s[4 * 33], s[5 * 33]); o.w = pk2(s[6 * 33], s[7 * 33]);
        *(v4u*)(WT + (size_t)(n0 + n) * K + k0 + 8 * c) = o; }
    LDS_WAIT(); asm volatile("" ::: "memory");
}

template <int MODE>
__device__ __forceinline__ void norm_row(const float* xrow, bf16_t* orow, float* frow, const float* g, int lane) {
    const f32x4* xr = (const f32x4*)xrow + lane;
    f32x4 v[8]; float s = 0.f;
#pragma unroll
    for (int j = 0; j < 8; ++j) { v[j] = xr[64 * j]; s += (v[j].x * v[j].x + v[j].y * v[j].y) + (v[j].z * v[j].z + v[j].w * v[j].w); }
    const float rstd = 1.f / sqrtf(wave_sum(s) * (1.f / DM) + NORM_EPS);
    if (MODE == 0) { unsigned long long* o8 = (unsigned long long*)orow + lane;
#pragma unroll
        for (int j = 0; j < 8; ++j) o8[64 * j] = (unsigned long long)pk2(v[j].x * rstd, v[j].y * rstd) | ((unsigned long long)pk2(v[j].z * rstd, v[j].w * rstd) << 32);
    } else { f32x4* o = (f32x4*)frow + lane; const f32x4* gr = (const f32x4*)g + lane;
#pragma unroll
        for (int j = 0; j < 8; ++j) { const f32x4 gg = gr[64 * j]; o[64 * j] = v[j] * rstd * gg; } }
}

__device__ __forceinline__ att::BlockRef mk_block(const bf16_t* Q, const bf16_t* KV, const bf16_t* KR, bf16_t* MIXED, const bf16_t* PROJ, const float* CS, int L_, int pass_) {
    const int bh = L_ >> 3, x = L_ & 7, qb = pass_ ? 15 - x : x, b = bh >> 3, h = bh & 7; att::BlockRef r;
    const size_t rb = (size_t)b * T, rq = rb + (size_t)qb * 256;
    r.Q = Q + rq * NQ + h * 192; r.K = KV + rb * NKV + h * 256; r.V = r.K + 128; r.KR = KR + rb * 64; r.O = MIXED + rq * DM + 512 + h * 128; r.Z = PROJ + rq * NPROJ + PC_MLAZ + h * 128; r.CSq = CS + rq * 64; r.P0 = qb * 256; return r;
}
__global__ void __launch_bounds__(512, 2) fwd(Args args) {
    extern __shared__ __attribute__((aligned(16))) unsigned char lds[];
    const int tid = threadIdx.x, lane = tid & 63, wave = __builtin_amdgcn_readfirstlane(tid >> 6);
    const int G = gridDim.x, bid = blockIdx.x;
    unsigned char* ws = args.ws;
    volatile LAS unsigned* MISC = (volatile LAS unsigned*)((LAS unsigned char*)lds + MISC_OFF);
    for (int u = tid; u < (LDS_BYTES - RING_BYTES) / 4; u += 512) ((LAS unsigned*)((LAS unsigned char*)lds + RING_BYTES))[u] = 0u;
    __syncthreads();
    const bool one_launch = (args.ph_hi - args.ph_lo) > 1;
    XcdBarrier bar; bar.bar = (unsigned*)(ws + WS_CTL) + CW_BAR; bar.x = 0; bar.st = nullptr;
    if (one_launch) bar = xcd_barrier_post((unsigned*)(ws + WS_CTL) + CW_BAR, MISC + 8);
    const int lo = args.ph_lo, hi = args.ph_hi;
#define IN(k) (lo <= (k) && (k) < hi)
#define SEAM(k) do { if (IN(k) && IN((k) + 1)) xcd_barrier(bar); } while (0)

    const float* x_in = args.in[0]; const int* positions = (const int*)args.in[1];
    float* X = args.out;
    bf16_t* WIN = (bf16_t*)(ws + WS_WIN); bf16_t* WUQ = (bf16_t*)(ws + WS_WUQ); bf16_t* WUKV = (bf16_t*)(ws + WS_WUKV); bf16_t* WOUT = (bf16_t*)(ws + WS_WOUT);
    float* CS = (float*)(ws + WS_CS); bf16_t* XN = (bf16_t*)(ws + WS_XN); bf16_t* MIXED = XN; bf16_t* PROJ = (bf16_t*)(ws + WS_PROJ); float* SPEC = (float*)(ws + WS_SPEC);
    bf16_t* CQN = (bf16_t*)(ws + WS_CQN); bf16_t* CKVN = (bf16_t*)(ws + WS_CKVN); bf16_t* KR = (bf16_t*)(ws + WS_KR); bf16_t* Q = (bf16_t*)(ws + WS_Q); bf16_t* KV = (bf16_t*)(ws + WS_KV);
    bf16_t* QKC = (bf16_t*)(ws + WS_QKC); float* LI = (float*)(ws + WS_GATE); float* LF = LI + (size_t)M * 4;
    float* RWW = (float*)(ws + WS_RWW); bf16_t* RWB = (bf16_t*)(ws + WS_RWB); bf16_t* VFIRST = (bf16_t*)(ws + WS_VFIRST); float* BONUS = (float*)(ws + WS_BONUS);
    constexpr size_t RWS = (size_t)M * 512;

    if (IN(0)) {
#ifndef NO_PRO
        LAS float* scr = (LAS float*)((LAS unsigned char*)lds + wave * 16384);
        const int gw = bid * 8 + wave, NGW = G * 8;
        constexpr int I_IN = (DM / 64) * (NPROJ / 32), I_UQ = (512 / 64) * (NQ / 32), I_UKV = (256 / 64) * (NKV / 32), I_OUT = (DM / 64) * (DM / 32), I_L = I_IN + I_UQ + I_UKV + I_OUT;
        for (int it = gw; it < DEPTH * I_L; it += NGW) {
            const int l = it / I_L; int r = it % I_L;
            if (r < I_IN) { transpose_item(args.in[3] + (size_t)l * DM * D_IN, DM, D_IN, WIN + (size_t)l * NPROJ * DM, args.in[2] + l * DM, scr, r / (NPROJ / 32), r % (NPROJ / 32), lane, MapWin()); continue; } r -= I_IN;
            if (r < I_UQ) { transpose_item(args.in[10] + (size_t)l * 512 * NQ, 512, NQ, WUQ + (size_t)l * NQ * 512, args.in[9] + l * 512, scr, r / (NQ / 32), r % (NQ / 32), lane, MapUq()); continue; } r -= I_UQ;
            if (r < I_UKV) { transpose_item(args.in[12] + (size_t)l * 256 * NKV, 256, NKV, WUKV + (size_t)l * NKV * 256, args.in[11] + l * 256, scr, r / (NKV / 32), r % (NKV / 32), lane, MapId()); continue; } r -= I_UKV;
            transpose_item(args.in[26] + (size_t)l * DM * DM, DM, DM, WOUT + (size_t)l * DM * DM, (const float*)nullptr, scr, r / (DM / 32), r % (DM / 32), lane, MapId());
        }
        for (int i = bid * 512 + tid; i < M * 32; i += G * 512) { const int m = i >> 5, j = i & 31;
            const float inv_freq = powf(10000.f, -(float)(2 * j) / 64.f);
            const float ang = (float)positions[m] * inv_freq;
            const double a = (double)ang; const double n = rint(a * 0.15915494309189535); const float r = (float)(a - n * 6.283185307179586);
            CS[2 * i] = cosf(r); CS[2 * i + 1] = sinf(r); }
        for (int m = gw; m < M; m += NGW) norm_row<0>(x_in + (size_t)m * DM, XN + (size_t)m * DM, nullptr, nullptr, lane);
#endif
    }
    SEAM(0);

#ifdef FIXL
    for (int l = 0; l < 1; ++l) {
#else
    for (int l = 0; l < DEPTH; ++l) {
#endif
        const int pb = 1 + l * 6;
        int tid_o = threadIdx.x; asm volatile("" : "+v"(tid_o));
        const int tid = tid_o, lane = tid & 63, wave = __builtin_amdgcn_readfirstlane(tid >> 6);
        if (IN(pb + 0)) {
#ifndef NO_G1
            pg8::Gemm g{XN, WIN + (size_t)l * NPROJ * DM, M, NPROJ, DM}; pg8::StaticOrder S; S.init(M, NPROJ, G, bid);
            pg8::EpiProj E{PROJ, NPROJ, SPEC, SPEC_TILE};
            pg8::gemm_phase<pg8::EpiProj, pg8::StaticOrder, true, true>((LAS unsigned char*)lds, g, S, E);
#endif
        }
        SEAM(pb + 0);
        if (IN(pb + 1)) {
#ifndef NO_PREP
            LAS float* L = (LAS float*)lds;
            LAS float* xw_t = L;
            LAS float* xa_s = L + 512;
            LAS float* t1 = L + 1024;
            LAS float* vbuf = L + 1280;
            const float* mu = args.in[13] + l * 1664; const float* w0 = args.in[14] + l * 512; const float* w2 = args.in[15] + (size_t)l * 64 * 512;
            const float* a0 = args.in[16] + l * 512; const float* a2 = args.in[17] + (size_t)l * 64 * 512;
            const float* v0 = args.in[18] + (l > 0 ? (l - 1) * 512 : 0); const float* v1 = args.in[19] + (size_t)(l > 0 ? l - 1 : 0) * 512 * 32; const float* v2 = args.in[20] + (size_t)(l > 0 ? l - 1 : 0) * 32 * 512;
            const float* k_k = args.in[21] + l * 512; const float* k_a = args.in[22] + l * 512; const float* r_k = args.in[23] + l * 512;
            const float* conv_w = args.in[4] + (size_t)l * 4 * 1024; const float* conv_b = args.in[5] + l * 1024;
            const float* i_bias = args.in[6] + l * 4; const float* f_bias = args.in[7] + l * 4;
            const int c = tid;
            for (int g8 = bid; g8 < M / 8; g8 += G) {
                const int m0 = g8 * 8, t0 = m0 % T;
                float r_[8], k_[8], v_[8];
                { const float mur = mu[c], muk = mu[512 + c], muv = mu[1024 + c];
                  float pr = 0.f, pk = 0.f, pv = 0.f;
                  if (t0 > 0) { const bf16_t* pp = PROJ + (size_t)(m0 - 1) * NPROJ + PC_RW + c; pr = bf2f(pp[0]); pk = bf2f(pp[512]); pv = bf2f(pp[1024]); }
#pragma unroll
                  for (int i = 0; i < 8; ++i) { const bf16_t* pp = PROJ + (size_t)(m0 + i) * NPROJ + PC_RW + c; const float cr = bf2f(pp[0]), ck = bf2f(pp[512]), cv = bf2f(pp[1024]);
                      r_[i] = cr + mur * (pr - cr); k_[i] = ck + muk * (pk - ck); v_[i] = cv + muv * (pv - cv); pr = cr; pk = ck; pv = cv; } }
                if (tid < 128) { const int j = tid & 63, which = tid >> 6; const float mm = mu[1536 + which * 64 + j];
                    float pv = 0.f; if (t0 > 0) pv = SPEC[(size_t)(m0 - 1) * 256 + which * 64 + j];
                    for (int i = 0; i < 8; ++i) { const float cv = SPEC[(size_t)(m0 + i) * 256 + which * 64 + j]; const float xs = cv + mm * (pv - cv); pv = cv;
                        if (which == 0) xw_t[i * 64 + j] = tanhf(xs); else xa_s[i * 64 + j] = xs; } }
                if (l > 0) {
#pragma unroll
                    for (int i = 0; i < 8; ++i) vbuf[i * 512 + c] = v_[i]; }
                __syncthreads();
                float lw[8], la[8];
                { const float w0c = w0[c], a0c = a0[c];
#pragma unroll
                  for (int i = 0; i < 8; ++i) { lw[i] = w0c; la[i] = a0c; }
                  for (int j = 0; j < 64; ++j) { const float w2v = w2[j * 512 + c], a2v = a2[j * 512 + c];
#pragma unroll
                      for (int i = 0; i < 8; ++i) { lw[i] += xw_t[i * 64 + j] * w2v; la[i] += xa_s[i * 64 + j] * a2v; } } }
                if (l > 0) {
                    if (tid < 256) { const int i = tid >> 5, j = tid & 31; float s = 0.f;
                        for (int cc = 0; cc < 512; ++cc) s += vbuf[i * 512 + cc] * v1[cc * 32 + j];
                        t1[i * 32 + j] = s; }
                    __syncthreads();
                    float gsum[8]; const float v0c = v0[c];
#pragma unroll
                    for (int i = 0; i < 8; ++i) gsum[i] = v0c;
                    for (int j = 0; j < 32; ++j) { const float v2v = v2[j * 512 + c];
#pragma unroll
                        for (int i = 0; i < 8; ++i) gsum[i] += t1[i * 32 + j] * v2v; }
#pragma unroll
                    for (int i = 0; i < 8; ++i) { const float vf = bf2f(VFIRST[(size_t)(m0 + i) * 512 + c]); v_[i] = v_[i] + (vf - v_[i]) * sigmoidf_(gsum[i]); }
                } else {
#pragma unroll
                    for (int i = 0; i < 8; ++i) VFIRST[(size_t)(m0 + i) * 512 + c] = (bf16_t)f2bf(v_[i]);
                }
                { const float kkc = k_k[c], kac = k_a[c], rkc = r_k[c];
#pragma unroll
                  for (int i = 0; i < 8; ++i) { const size_t o = (size_t)(m0 + i) * 512 + c;
                      const float logw = -softplusf_(-lw[i]) - 0.5f; const float dec = __expf(-__expf(logw)); const float a = sigmoidf_(la[i]);
                      float kk = k_[i] * kkc; const float ss = wave_sum(kk * kk); kk = kk / fmaxf(sqrtf(ss), 1e-12f);
                      const float kh = k_[i] * (1.f + (a - 1.f) * kac);
                      const float bon = wave_sum(r_[i] * kh * rkc);
                      RWW[o] = dec; RWB[o] = (bf16_t)f2bf(r_[i]); RWB[RWS + o] = (bf16_t)f2bf(kh); RWB[2 * RWS + o] = (bf16_t)f2bf(v_[i]); RWB[3 * RWS + o] = (bf16_t)f2bf(-kk); RWB[4 * RWS + o] = (bf16_t)f2bf(kk * a);
                      if (lane == 0) BONUS[(size_t)(m0 + i) * 8 + wave] = bon; } }
                { const int m = m0 + wave;
                  { const v4u raw = *(const v4u*)(PROJ + (size_t)m * NPROJ + PC_CQ + lane * 8); float f[8];
                    f[0] = bf2f(raw.x & 0xffffu); f[1] = bf2f(raw.x >> 16); f[2] = bf2f(raw.y & 0xffffu); f[3] = bf2f(raw.y >> 16); f[4] = bf2f(raw.z & 0xffffu); f[5] = bf2f(raw.z >> 16); f[6] = bf2f(raw.w & 0xffffu); f[7] = bf2f(raw.w >> 16);
                    float s = 0.f;
#pragma unroll
                    for (int e = 0; e < 8; ++e) s += f[e] * f[e];
                    const float rstd = 1.f / sqrtf(wave_sum(s) * (1.f / 512.f) + NORM_EPS);
                    v4u o; o.x = pk2(f[0] * rstd, f[1] * rstd); o.y = pk2(f[2] * rstd, f[3] * rstd); o.z = pk2(f[4] * rstd, f[5] * rstd); o.w = pk2(f[6] * rstd, f[7] * rstd);
                    *(v4u*)(CQN + (size_t)m * 512 + lane * 8) = o; }
                  { const unsigned long long raw = *(const unsigned long long*)(PROJ + (size_t)m * NPROJ + PC_CKV + lane * 4); float f[4];
                    f[0] = bf2f((unsigned)raw & 0xffffu); f[1] = bf2f(((unsigned)raw) >> 16); f[2] = bf2f((unsigned)(raw >> 32) & 0xffffu); f[3] = bf2f((unsigned)(raw >> 48));
                    const float s = f[0] * f[0] + f[1] * f[1] + f[2] * f[2] + f[3] * f[3];
                    const float rstd = 1.f / sqrtf(wave_sum(s) * (1.f / 256.f) + NORM_EPS);
                    *(unsigned long long*)(CKVN + (size_t)m * 256 + lane * 4) = (unsigned long long)pk2(f[0] * rstd, f[1] * rstd) | ((unsigned long long)pk2(f[2] * rstd, f[3] * rstd) << 32); }
                  { const float vv = SPEC[(size_t)m * 256 + 128 + lane]; const float pt = __shfl_xor(vv, 1); const int i = lane >> 1;
                    const float cs_ = CS[((size_t)m * 32 + i) * 2], sn_ = CS[((size_t)m * 32 + i) * 2 + 1];
                    const float o = (lane & 1) ? (vv * cs_ + pt * sn_) : (vv * cs_ - pt * sn_);
                    KR[(size_t)m * 64 + lane] = (bf16_t)f2bf(o); } }
#pragma unroll
                for (int hh = 0; hh < 2; ++hh) { const int ch = c + hh * 512;
                    const float cw0 = conv_w[ch], cw1 = conv_w[1024 + ch], cw2 = conv_w[2048 + ch], cw3 = conv_w[3072 + ch], cb = conv_b[ch];
                    float x0 = 0.f, x1 = 0.f, x2 = 0.f;
                    if (t0 >= 3) { x0 = bf2f(PROJ[(size_t)(m0 - 3) * NPROJ + PC_MLQK + ch]); x1 = bf2f(PROJ[(size_t)(m0 - 2) * NPROJ + PC_MLQK + ch]); x2 = bf2f(PROJ[(size_t)(m0 - 1) * NPROJ + PC_MLQK + ch]); }
                    const float sc_ = hh == 0 ? 0.08838834764831845f : 1.f;
#pragma unroll
                    for (int i = 0; i < 8; ++i) { const float x3 = bf2f(PROJ[(size_t)(m0 + i) * NPROJ + PC_MLQK + ch]);
                        const float y = cb + cw0 * x0 + cw1 * x1 + cw2 * x2 + cw3 * x3;
                        QKC[(size_t)(m0 + i) * 1024 + ch] = (bf16_t)f2bf(siluf_(y) * sc_);
                        x0 = x1; x1 = x2; x2 = x3; } }
                if (tid < 64) { const int i = tid >> 3, gh = tid & 7; const float val = SPEC[(size_t)(m0 + i) * 256 + 192 + gh];
                    if (gh < 4) LI[(size_t)(m0 + i) * 4 + gh] = val + i_bias[gh];
                    else { const float xx = val + f_bias[gh - 4]; LF[(size_t)(m0 + i) * 4 + gh - 4] = -softplusf_(-xx); } }
                __syncthreads();
            }
#endif
        }
        SEAM(pb + 1);
        if (IN(pb + 2)) {
#ifndef NO_G23
            { pg8::Gemm g{CQN, WUQ + (size_t)l * NQ * 512, M, NQ, 512}; pg8::StaticOrder S; S.init(M, NQ, G, bid);
              pg8::EpiPlain E{Q, NQ};
              pg8::gemm_phase<pg8::EpiPlain, pg8::StaticOrder, true, true>((LAS unsigned char*)lds, g, S, E); }
            { pg8::Gemm g{CKVN, WUKV + (size_t)l * NKV * 256, M, NKV, 256}; pg8::StaticOrder S; S.init(M, NKV, G, bid);
              pg8::EpiPlain E{KV, NKV};
              pg8::gemm_phase<pg8::EpiPlain, pg8::StaticOrder, true, true>((LAS unsigned char*)lds, g, S, E); }
#endif
        }
        SEAM(pb + 2);
        if (IN(pb + 3)) {
#ifndef NO_SCANS
            if (bid < 32 && G >= 64) {
                const int b = bid >> 3, h = bid & 7, row = tid >> 3, kq = tid & 7;
                LAS float* tin = (LAS float*)lds;
                LAS float* ybuf = tin + 6 * 1024;
                const float* ln_g = args.in[24] + l * 512 + h * 64; const float* ln_b = args.in[25] + l * 512 + h * 64;
                float S8[8];
#pragma unroll
                for (int j = 0; j < 8; ++j) S8[j] = 0.f;
                for (int t0 = 0; t0 < T; t0 += 16) {
#pragma unroll
                    for (int i = 0; i < 12; ++i) { const int idx = tid + 512 * i, arr = idx >> 10, rem = idx & 1023, tt = rem >> 6, cc = rem & 63;
                        const size_t o = (size_t)(b * T + t0 + tt) * 512 + h * 64 + cc;
                        float val;
                        if (arr == 1) val = RWW[o]; else { const int ba = arr == 0 ? 0 : arr - 1; val = bf2f(RWB[(size_t)ba * RWS + o]); }
                        tin[idx] = val; }
                    __syncthreads();
                    for (int tt = 0; tt < 16; ++tt) {
                        const LAS float* base = tin + tt * 64 + kq * 8;
                        const f32x4 r0 = *(const LAS f32x4*)(base), r1 = *(const LAS f32x4*)(base + 4);
                        const f32x4 w0_ = *(const LAS f32x4*)(base + 1024), w1_ = *(const LAS f32x4*)(base + 1024 + 4);
                        const f32x4 k0_ = *(const LAS f32x4*)(base + 2048), k1_ = *(const LAS f32x4*)(base + 2048 + 4);
                        const f32x4 a0_ = *(const LAS f32x4*)(base + 4096), a1_ = *(const LAS f32x4*)(base + 4096 + 4);
                        const f32x4 b0_ = *(const LAS f32x4*)(base + 5120), b1_ = *(const LAS f32x4*)(base + 5120 + 4);
                        const float vv = tin[3072 + tt * 64 + row];
                        float sa = 0.f;
#pragma unroll
                        for (int j = 0; j < 4; ++j) sa += S8[j] * a0_[j] + S8[4 + j] * a1_[j];
                        sa += __shfl_xor(sa, 1); sa += __shfl_xor(sa, 2); sa += __shfl_xor(sa, 4);
                        float y = 0.f;
#pragma unroll
                        for (int j = 0; j < 4; ++j) { S8[j] = S8[j] * w0_[j] + sa * b0_[j] + vv * k0_[j]; S8[4 + j] = S8[4 + j] * w1_[j] + sa * b1_[j] + vv * k1_[j]; y += S8[j] * r0[j] + S8[4 + j] * r1[j]; }
                        y += __shfl_xor(y, 1); y += __shfl_xor(y, 2); y += __shfl_xor(y, 4);
                        if (kq == 0) ybuf[tt * 64 + row] = y;
                    }
                    __syncthreads();
#pragma unroll
                    for (int q = 0; q < 2; ++q) { const int tt = wave * 2 + q; const size_t m = (size_t)b * T + t0 + tt;
                        const float y = ybuf[tt * 64 + lane]; const float mean = wave_sum(y) * (1.f / 64.f); const float d = y - mean; const float var = wave_sum(d * d) * (1.f / 64.f);
                        float yn = d / sqrtf(var + RW_GN_EPS) * ln_g[lane] + ln_b[lane];
                        yn += BONUS[m * 8 + h] * tin[3072 + tt * 64 + lane];
                        const float z = bf2f(PROJ[m * NPROJ + PC_RWZ + h * 64 + lane]);
                        MIXED[m * DM + 1536 + h * 64 + lane] = (bf16_t)f2bf(siluf_(z) * yn); }
                    __syncthreads();
                }
            } else if (bid < 48 && G >= 64) {
                const int u = bid - 32, b = u >> 2, h = u & 3, row = tid >> 2, kq = tid & 3;
                LAS float* tq = (LAS float*)lds;
                LAS float* tk = tq + 2048; LAS float* tv = tk + 2048; LAS float* hb = tv + 2048; LAS float* tg = hb + 2048;
                const float* ng = args.in[8] + l * 512 + h * 128;
                float C[32], n[32];
#pragma unroll
                for (int j = 0; j < 32; ++j) { C[j] = 0.f; n[j] = 0.f; }
                for (int t0 = 0; t0 < T; t0 += 16) {
#pragma unroll
                    for (int i = 0; i < 4; ++i) { const int idx = tid + 512 * i, tt = idx >> 7, d = idx & 127; const size_t m = (size_t)b * T + t0 + tt;
                        tq[idx] = bf2f(QKC[m * 1024 + h * 128 + d]); tk[idx] = bf2f(QKC[m * 1024 + 512 + h * 128 + d]); tv[idx] = bf2f(PROJ[m * NPROJ + PC_MLV + h * 128 + d]); }
                    if (tid < 16) { const size_t m = (size_t)b * T + t0 + tid; tg[tid * 2] = LI[m * 4 + h]; tg[tid * 2 + 1] = LF[m * 4 + h]; }
                    __syncthreads();
                    for (int tt = 0; tt < 16; ++tt) {
                        const float ig = __expf(tg[tt * 2]), fg = __expf(tg[tt * 2 + 1]);
                        const float vi = tv[tt * 128 + row] * ig;
                        float num = 0.f, den = 0.f;
#pragma unroll
                        for (int j4 = 0; j4 < 8; ++j4) { const f32x4 kk = *(const LAS f32x4*)(tk + tt * 128 + kq * 32 + j4 * 4), qq = *(const LAS f32x4*)(tq + tt * 128 + kq * 32 + j4 * 4);
#pragma unroll
                            for (int e = 0; e < 4; ++e) { const int j = j4 * 4 + e; C[j] = fg * C[j] + vi * kk[e]; n[j] = fg * n[j] + ig * kk[e]; num += C[j] * qq[e]; den += n[j] * qq[e]; } }
                        num += __shfl_xor(num, 1); num += __shfl_xor(num, 2); den += __shfl_xor(den, 1); den += __shfl_xor(den, 2);
                        if (kq == 0) hb[tt * 128 + row] = num / fmaxf(fabsf(den), 1.f);
                    }
                    __syncthreads();
#pragma unroll
                    for (int q = 0; q < 2; ++q) { const int tt = wave * 2 + q; const size_t m = (size_t)b * T + t0 + tt;
                        const float h0 = hb[tt * 128 + lane], h1 = hb[tt * 128 + 64 + lane]; const float mean = wave_sum(h0 + h1) * (1.f / 128.f); const float d0 = h0 - mean, d1 = h1 - mean;
                        const float rstd = 1.f / sqrtf(wave_sum(d0 * d0 + d1 * d1) * (1.f / 128.f) + NORM_EPS);
#pragma unroll
                        for (int e = 0; e < 2; ++e) { const int d = lane + 64 * e; const float hn = (e ? d1 : d0) * rstd * ng[d];
                            const float og = bf2f(PROJ[m * NPROJ + PC_MLO + h * 128 + d]), z = bf2f(PROJ[m * NPROJ + PC_MLZ + h * 128 + d]);
                            MIXED[m * DM + h * 128 + d] = (bf16_t)f2bf(siluf_(z) * sigmoidf_(og) * hn); } }
                    __syncthreads();
                }
            } else
#endif
            {
#ifndef NO_ATT
                const int first = (G >= 64) ? bid - 48 : bid, stride = (G >= 64) ? G - 48 : G; constexpr int total = BATCH * 8 * 8;
                if (first < total) {
                    att::Seam S; int L = first, pass = 0;
#define mk(L_, pass_) mk_block(Q, KV, KR, MIXED, PROJ, CS, (L_), (pass_))
                    att::BlockRef cur = mk(L, 0);
                    att::attn_prime(cur, (char*)lds, S);
                    for (;;) {
                        const bool more_pass = pass == 0, more_item = L + stride < total, last = !more_pass && !more_item;
                        int Ln = L, passn = pass + 1; if (!more_pass) { passn = 0; Ln = more_item ? L + stride : L; }
                        const att::BlockRef nxt = last ? cur : mk(Ln, passn);
                        att::attn_block(cur, nxt, (char*)lds, S);
                        if (last) break;
                        cur = nxt; L = Ln; pass = passn;
                    }
#undef mk
                }
#endif
            }
        }
        SEAM(pb + 3);
        if (IN(pb + 4)) {
#ifndef NO_G4
            pg8::Gemm g{MIXED, WOUT + (size_t)l * DM * DM, M, DM, DM}; pg8::StaticOrder S; S.init(M, DM, G, bid);
            pg8::EpiResid E{l == 0 ? x_in : (const float*)X, X, DM};
            pg8::gemm_phase<pg8::EpiResid, pg8::StaticOrder, true, true>((LAS unsigned char*)lds, g, S, E);
#endif
        }
        SEAM(pb + 4);
        if (IN(pb + 5)) {
            const int gw = bid * 8 + wave, NGW = G * 8;
            if (l + 1 < DEPTH) { for (int m = gw; m < M; m += NGW) norm_row<0>(X + (size_t)m * DM, XN + (size_t)m * DM, nullptr, nullptr, lane); }
            else { for (int m = gw; m < M; m += NGW) norm_row<1>(X + (size_t)m * DM, nullptr, X + (size_t)m * DM, args.in[27], lane); }
        }
        SEAM(pb + 5);
    }
#undef IN
#undef SEAM
}

constexpr int N_PHASES = 1 + DEPTH * 6;
#ifndef MK_ONE_LAUNCH
#define MK_ONE_LAUNCH 0
#endif
extern "C" void kernel_launch(void* const* d_in, const int* in_sizes, int n_in, void* d_out, int out_size, void* d_ws, size_t ws_size, hipStream_t stream) {
    static int grid = 0;
    if (grid == 0) {
        if (n_in != 28 || out_size != M * DM || ws_size < WS_END) { fprintf(stderr, "kernel_launch: unexpected shapes (n_in %d, out %d, ws %zu < %zu)\n", n_in, out_size, ws_size, (size_t)WS_END); grid = -1; return; }
        int dev = 0, cus = 0;
        if (hipGetDevice(&dev) != hipSuccess || hipDeviceGetAttribute(&cus, hipDeviceAttributeMultiprocessorCount, dev) != hipSuccess) { grid = -1; return; }
        if (hipFuncSetAttribute((const void*)fwd, hipFuncAttributeMaxDynamicSharedMemorySize, LDS_BYTES) != hipSuccess) { fprintf(stderr, "kernel_launch: hipFuncSetAttribute failed\n"); grid = -1; return; }
        int per_cu = 0;
        if (hipOccupancyMaxActiveBlocksPerMultiprocessor(&per_cu, (const void*)fwd, 512, LDS_BYTES) != hipSuccess || per_cu < 1) fprintf(stderr, "kernel_launch: occupancy query says %d\n", per_cu);
        (void)hipGetLastError();
        grid = cus;
    }
    if (grid < 0) return;
    if (hipMemsetAsync((char*)d_ws + WS_CTL, 0, CTL_ZERO_BYTES, stream) != hipSuccess) return;
    Args a; memset(&a, 0, sizeof(a));
    for (int i = 0; i < 28; ++i) a.in[i] = (const float*)d_in[i];
    a.out = (float*)d_out; a.ws = (unsigned char*)d_ws;
#if MK_ONE_LAUNCH
    a.ph_lo = 0; a.ph_hi = N_PHASES;
    hipLaunchKernelGGL(fwd, dim3(grid), dim3(512), LDS_BYTES, stream, a);
#else
    for (int p = 0; p < N_PHASES; ++p) { a.ph_lo = p; a.ph_hi = p + 1; hipLaunchKernelGGL(fwd, dim3(grid), dim3(512), LDS_BYTES, stream, a); }
#endif
}
```

```cpp
#include <hip/hip_runtime.h>
#include <cstdio>
#include <cstdint>
#include <cstring>
namespace pg8 {
#define PG8_LAS __attribute__((address_space(3)))
typedef unsigned short bf16_t;
typedef short bf16x8 __attribute__((ext_vector_type(8)));
typedef float f32x4 __attribute__((ext_vector_type(4)));
typedef unsigned u32x4 __attribute__((ext_vector_type(4)));
constexpr int BM = 256, BK = 64, HALF = 128, HTB = HALF * BK * 2  , STAGE_BYTES = 8 * HTB, NXCD = 8, WGM = 8;

__host__ __device__ __forceinline__ int lds_byte(int r, int c) { const int st = (r >> 4) * 2 + (c >> 5), rr = r & 15, cc = c & 31, ob = rr * 64 + cc * 2; return st * 1024 + (ob ^ (((ob >> 9) & 1) << 5)); }
__host__ __device__ __forceinline__ void stage_rc(int b, int& R, int& C) { const int st = b / 1024, sb = b % 1024, swz = sb ^ (((sb >> 9) & 1) << 5); R = (st >> 1) * 16 + swz / 64; C = (st & 1) * 32 + (swz % 64) / 2; }
__host__ __device__ __forceinline__ int perm32(int rho) { const int n = rho >> 4, i = rho & 15; return 8 * (i >> 2) + 4 * n + (i & 3); }

struct Unit { int pm, pn; };
struct Gemm { const bf16_t* A; const bf16_t* Bt; int M, N, K; };

struct StaticOrder {
    int nM, nN, nwg, G, c;
    __host__ __device__ void init(int M, int N, int G_, int c_) { nM = M / BM; nN = N / BM; nwg = nM * nN; G = G_; c = c_; }
    __host__ __device__ bool next(int i, Unit& u) const {
        const long L = (long)i * G + c; if (L >= nwg) return false;
        int wgid = (int)L; { const int q = nwg / NXCD, r = nwg % NXCD, xcd = wgid % NXCD, off = wgid / NXCD; wgid = (xcd < r ? xcd * (q + 1) : r * (q + 1) + (xcd - r) * q) + off; }
        const int nig = WGM * nN, gid = wgid / nig, fm = gid * WGM, gsz = (nM - fm) < WGM ? (nM - fm) : WGM;
        u.pm = fm + ((wgid % nig) % gsz); u.pn = (wgid % nig) / gsz; return true;
    }
    __device__ __forceinline__ void a_ready(const Unit&) const {}
    __device__ __forceinline__ void done(const Unit&) const {}
};

__device__ __forceinline__ unsigned cvt_pk_bf16(float lo, float hi) { unsigned r; asm volatile("v_cvt_pk_bf16_f32 %0, %1, %2" : "=v"(r) : "v"(lo), "v"(hi)); return r; }
typedef float f32x2 __attribute__((ext_vector_type(2)));
typedef unsigned u32x2 __attribute__((ext_vector_type(2)));
struct EpiProj {
    static constexpr bool PERM = true, AFTER_DRAIN = false;
    bf16_t* O; int ldc; float* spec; int spec_tile;
    __device__ __forceinline__ void operator()(const f32x4 (&acc)[2][2][4][2], const Unit& u, int wr, int wc, int fr, int fq) const {
        const int row0 = u.pm * BM + wr * 64 + fr, col0 = u.pn * BM + wc * 32 + 8 * fq;
        if (u.pn == spec_tile) {
            float* sp0 = spec + (size_t)row0 * 256 + wc * 32 + 8 * fq;
#pragma unroll
            for (int ai = 0; ai < 2; ++ai)
#pragma unroll
                for (int m = 0; m < 4; ++m) { float* sp_p = sp0 + (size_t)(ai * HALF + m * 16) * 256;
#pragma unroll
                    for (int bj = 0; bj < 2; ++bj) { *(f32x4*)(sp_p + bj * HALF) = acc[ai][bj][m][0]; *(f32x4*)(sp_p + bj * HALF + 4) = acc[ai][bj][m][1]; } }
        }
        bf16_t* o0 = O + (size_t)row0 * ldc + col0;
#pragma unroll
        for (int ai = 0; ai < 2; ++ai)
#pragma unroll
            for (int m = 0; m < 4; ++m) { bf16_t* rowp = o0 + (size_t)(ai * HALF + m * 16) * ldc;
#pragma unroll
                for (int bj = 0; bj < 2; ++bj) { const f32x4 v0 = acc[ai][bj][m][0], v1 = acc[ai][bj][m][1];
                    u32x4 w; w.x = cvt_pk_bf16(v0[0], v0[1]); w.y = cvt_pk_bf16(v0[2], v0[3]); w.z = cvt_pk_bf16(v1[0], v1[1]); w.w = cvt_pk_bf16(v1[2], v1[3]);
                    *(u32x4*)(rowp + bj * HALF) = w; } }
    }
};
struct EpiQ {
    static constexpr bool PERM = true, AFTER_DRAIN = false;
    bf16_t* O; const float* cs;
    __device__ __forceinline__ void operator()(const f32x4 (&acc)[2][2][4][2], const Unit& u, int wr, int wc, int fr, int fq) const {
        const int row0 = u.pm * BM + wr * 64 + fr, col0 = u.pn * BM + wc * 32 + 8 * fq;
#pragma unroll
        for (int ai = 0; ai < 2; ++ai)
#pragma unroll
            for (int m = 0; m < 4; ++m) { const int row = row0 + ai * HALF + m * 16; bf16_t* rowp = O + (size_t)row * 1536 + col0;
#pragma unroll
                for (int bj = 0; bj < 2; ++bj) { f32x4 v0 = acc[ai][bj][m][0], v1 = acc[ai][bj][m][1];
                    const int d = (col0 + bj * HALF) % 192;
                    if (d >= 128) { const int i0 = (d - 128) >> 1; const f32x4* cp = (const f32x4*)(cs + (size_t)row * 64 + i0 * 2); const f32x4 c0 = cp[0], c1 = cp[1];
                        f32x4 r0, r1;
                        r0[0] = v0[0] * c0[0] - v0[1] * c0[1]; r0[1] = v0[1] * c0[0] + v0[0] * c0[1];
                        r0[2] = v0[2] * c0[2] - v0[3] * c0[3]; r0[3] = v0[3] * c0[2] + v0[2] * c0[3];
                        r1[0] = v1[0] * c1[0] - v1[1] * c1[1]; r1[1] = v1[1] * c1[0] + v1[0] * c1[1];
                        r1[2] = v1[2] * c1[2] - v1[3] * c1[3]; r1[3] = v1[3] * c1[2] + v1[2] * c1[3];
                        v0 = r0; v1 = r1; }
                    u32x4 w; w.x = cvt_pk_bf16(v0[0], v0[1]); w.y = cvt_pk_bf16(v0[2], v0[3]); w.z = cvt_pk_bf16(v1[0], v1[1]); w.w = cvt_pk_bf16(v1[2], v1[3]);
                    *(u32x4*)(rowp + bj * HALF) = w; } }
    }
};
struct EpiPlain {
    static constexpr bool PERM = true, AFTER_DRAIN = false;
    bf16_t* O; int ldc;
    __device__ __forceinline__ void operator()(const f32x4 (&acc)[2][2][4][2], const Unit& u, int wr, int wc, int fr, int fq) const {
        const int row0 = u.pm * BM + wr * 64 + fr, col0 = u.pn * BM + wc * 32 + 8 * fq;
#pragma unroll
        for (int ai = 0; ai < 2; ++ai)
#pragma unroll
            for (int m = 0; m < 4; ++m) { bf16_t* rowp = O + (size_t)(row0 + ai * HALF + m * 16) * ldc + col0;
#pragma unroll
                for (int bj = 0; bj < 2; ++bj) { const f32x4 v0 = acc[ai][bj][m][0], v1 = acc[ai][bj][m][1];
                    u32x4 w; w.x = cvt_pk_bf16(v0[0], v0[1]); w.y = cvt_pk_bf16(v0[2], v0[3]); w.z = cvt_pk_bf16(v1[0], v1[1]); w.w = cvt_pk_bf16(v1[2], v1[3]);
                    *(u32x4*)(rowp + bj * HALF) = w; } }
    }
};
struct EpiResid {
    static constexpr bool PERM = false, AFTER_DRAIN = false;
    const float* base; float* out; int ldc;
    __device__ __forceinline__ void operator()(const f32x4 (&acc)[2][2][4][2], const Unit& u, int wr, int wc, int fr, int fq) const {
        const int row0 = u.pm * BM + wr * 64 + fr, col0 = u.pn * BM + wc * 32 + 4 * fq;
#pragma unroll
        for (int ai = 0; ai < 2; ++ai)
#pragma unroll
            for (int m = 0; m < 4; ++m) { const size_t off = (size_t)(row0 + ai * HALF + m * 16) * ldc + col0;
#pragma unroll
                for (int bj = 0; bj < 2; ++bj)
#pragma unroll
                    for (int n = 0; n < 2; ++n) { const f32x4 bs = *(const f32x4*)(base + off + bj * HALF + n * 16); *(f32x4*)(out + off + bj * HALF + n * 16) = bs + acc[ai][bj][m][n]; } }
    }
};
template <class Epi, class Sched, bool ALIGN_EPI = false, bool SP2 = false>
__device__ __forceinline__ void gemm_phase(PG8_LAS unsigned char* lds, const Gemm g, const Sched& S, const Epi& E) {
    int tid_o = threadIdx.x; asm volatile("" : "+v"(tid_o));
    const int tid = tid_o, wid = __builtin_amdgcn_readfirstlane(tid >> 6), lane = tid & 63, wr = wid >> 2, wc = wid & 3, fr = lane & 15, fq = lane >> 4;
    const int K = g.K, nt = K / BK;
    unsigned voffA[2], voffB[2];
#pragma unroll
    for (int i = 0; i < 2; ++i) { int R, C; stage_rc(tid * 16 + i * 8192, R, C); const int Rb = Epi::PERM ? ((R & ~31) + perm32(R & 31)) : R;
        voffA[i] = (unsigned)(R * K + C) * 2u; voffB[i] = (unsigned)(Rb * K + C) * 2u; }
    const size_t kstep = (size_t)(BK * 2);
    const size_t hstep = (size_t)HALF * K * 2;
    const size_t tstep = 2 * hstep;
    const unsigned ldsw = (unsigned)wid * 1024u;
    const int aoff = lds_byte(wr * 64 + fr, fq * 8), boff = lds_byte(wc * 32 + fr, fq * 8);
#define PG8_SA(b, h) (((b) * 2 + (h)) * HTB)
#define PG8_SB(b, h) ((4 + (b) * 2 + (h)) * HTB)
#define PG8_STAGE(bufoff, gbase, voff) do { _Pragma("unroll") for (int _i = 0; _i < 2; ++_i) \
        __builtin_amdgcn_global_load_lds((const unsigned*)((const char*)(gbase) + (voff)[_i]), (PG8_LAS unsigned*)(lds + (bufoff) + ldsw + _i * 8192), 16, 0, 0); } while (0)
#define PG8_LDA(dst, b, h) do { _Pragma("unroll") for (int m = 0; m < 4; ++m) _Pragma("unroll") for (int k = 0; k < 2; ++k) dst[m][k] = *(const PG8_LAS bf16x8*)(lds + PG8_SA(b, h) + aoff + m * 2048 + k * 1024); } while (0)
#define PG8_LDB(dst, b, h) do { _Pragma("unroll") for (int n = 0; n < 2; ++n) _Pragma("unroll") for (int k = 0; k < 2; ++k) dst[n][k] = *(const PG8_LAS bf16x8*)(lds + PG8_SB(b, h) + boff + n * 2048 + k * 1024); } while (0)
#define PG8_MMA(ai, bj, At, Bt) do { __builtin_amdgcn_s_setprio(1); _Pragma("unroll") for (int m = 0; m < 4; ++m) _Pragma("unroll") for (int n = 0; n < 2; ++n) _Pragma("unroll") for (int k = 0; k < 2; ++k) \
        acc[ai][bj][m][n] = __builtin_amdgcn_mfma_f32_16x16x32_bf16(Bt[n][k], At[m][k], acc[ai][bj][m][n], 0, 0, 0); __builtin_amdgcn_s_setprio(0); } while (0)
#define PG8_WAIT_V(n) asm volatile("s_waitcnt vmcnt(" #n ")" ::: "memory")
#define PG8_WAIT_L(n) asm volatile("s_waitcnt lgkmcnt(" #n ")" ::: "memory")
#define PG8_BAR __builtin_amdgcn_s_barrier()
#define PG8_SCHED __builtin_amdgcn_sched_barrier(0)
    Unit cur, nxt; int ui = 0;
    if (!S.next(0, cur)) return;
    f32x4 acc[2][2][4][2];
#pragma unroll
    for (int a = 0; a < 2; ++a)
#pragma unroll
        for (int b = 0; b < 2; ++b)
#pragma unroll
            for (int m = 0; m < 4; ++m)
#pragma unroll
                for (int n = 0; n < 2; ++n) acc[a][b][m][n] = (f32x4){0.f, 0.f, 0.f, 0.f};
    bf16x8 At[4][2], B0[2][2], B1[2][2];
    const char* cA = (const char*)g.A + (size_t)cur.pm * tstep; const char* cB = (const char*)g.Bt + (size_t)cur.pn * tstep;
    S.a_ready(cur);
    if constexpr (SP2) {
        PG8_STAGE(PG8_SB(0, 0), cB, voffB); PG8_STAGE(PG8_SB(0, 1), cB + hstep, voffB); PG8_STAGE(PG8_SA(0, 0), cA, voffA); PG8_STAGE(PG8_SA(0, 1), cA + hstep, voffA);
        if (wr == 1) PG8_BAR;
        PG8_WAIT_V(2); PG8_BAR;
        PG8_STAGE(PG8_SB(1, 0), cB + kstep, voffB); PG8_STAGE(PG8_SA(1, 0), cA + kstep, voffA); PG8_STAGE(PG8_SB(1, 1), cB + hstep + kstep, voffB);
        PG8_WAIT_V(6); PG8_BAR;
    } else {
        PG8_STAGE(PG8_SB(0, 0), cB, voffB); PG8_STAGE(PG8_SA(0, 0), cA, voffA); PG8_STAGE(PG8_SB(0, 1), cB + hstep, voffB); PG8_STAGE(PG8_SA(0, 1), cA + hstep, voffA);
        if (wr == 1) PG8_BAR;
        PG8_WAIT_V(4); PG8_BAR;
        PG8_STAGE(PG8_SB(1, 0), cB + kstep, voffB); PG8_STAGE(PG8_SA(1, 0), cA + kstep, voffA); PG8_STAGE(PG8_SB(1, 1), cB + hstep + kstep, voffB);
        PG8_WAIT_V(6); PG8_BAR;
    }
    for (;;) {
        const bool has_next = S.next(ui + 1, nxt);
        const char* nA = has_next ? (const char*)g.A + (size_t)nxt.pm * tstep : cA; const char* nB = has_next ? (const char*)g.Bt + (size_t)nxt.pn * tstep : cB;
        for (int t = 0; t < nt; t += 2) {
            const bool last = (t == nt - 2);
            const char* a1 = cA + (size_t)(t + 1) * kstep;
            const char* a2 = last ? nA : cA + (size_t)(t + 2) * kstep; const char* b2 = last ? nB : cB + (size_t)(t + 2) * kstep;
            const char* a3 = a2 + kstep; const char* b3 = b2 + kstep;
            if (last && has_next) S.a_ready(nxt);
            if constexpr (SP2) {
            PG8_LDB(B0, 0, 0); PG8_LDB(B1, 0, 1); PG8_SCHED; PG8_LDA(At, 0, 0); PG8_STAGE(PG8_SA(1, 1), a1 + hstep, voffA);
            PG8_WAIT_V(8); PG8_WAIT_L(0); PG8_BAR; PG8_MMA(0, 0, At, B0); PG8_MMA(0, 1, At, B1); PG8_BAR; PG8_SCHED;
            PG8_LDA(At, 0, 1); PG8_STAGE(PG8_SB(0, 0), b2, voffB); PG8_STAGE(PG8_SB(0, 1), b2 + hstep, voffB); PG8_STAGE(PG8_SA(0, 0), a2, voffA);
            PG8_WAIT_V(8); PG8_WAIT_L(0); PG8_BAR; PG8_MMA(1, 0, At, B0); PG8_MMA(1, 1, At, B1); PG8_BAR; PG8_SCHED;
            PG8_LDB(B0, 1, 0); PG8_LDB(B1, 1, 1); PG8_SCHED; PG8_LDA(At, 1, 0); PG8_STAGE(PG8_SA(0, 1), a2 + hstep, voffA);
            PG8_WAIT_V(8); PG8_WAIT_L(0); PG8_BAR; PG8_MMA(0, 0, At, B0); PG8_MMA(0, 1, At, B1); PG8_BAR; PG8_SCHED;
            PG8_LDA(At, 1, 1); PG8_STAGE(PG8_SB(1, 0), b3, voffB); PG8_STAGE(PG8_SB(1, 1), b3 + hstep, voffB); PG8_STAGE(PG8_SA(1, 0), a3, voffA);
            PG8_WAIT_V(8); PG8_WAIT_L(0); PG8_BAR; PG8_MMA(1, 0, At, B0); PG8_MMA(1, 1, At, B1); PG8_BAR; PG8_SCHED;
            } else {
            PG8_LDB(B0, 0, 0); PG8_SCHED; PG8_LDA(At, 0, 0); PG8_STAGE(PG8_SA(1, 1), a1 + hstep, voffA);
            PG8_WAIT_L(8); PG8_BAR; PG8_WAIT_L(0); PG8_MMA(0, 0, At, B0); PG8_BAR; PG8_SCHED;
            PG8_LDB(B1, 0, 1); PG8_STAGE(PG8_SB(0, 0), b2, voffB);
            PG8_BAR; PG8_WAIT_L(0); PG8_MMA(0, 1, At, B1); PG8_BAR;
            PG8_LDA(At, 0, 1); PG8_STAGE(PG8_SA(0, 0), a2, voffA);
            PG8_BAR; PG8_WAIT_L(0); PG8_MMA(1, 0, At, B0); PG8_BAR; PG8_SCHED;
            PG8_STAGE(PG8_SB(0, 1), b2 + hstep, voffB);
            PG8_WAIT_V(6); PG8_BAR; PG8_MMA(1, 1, At, B1); PG8_BAR;
            PG8_LDB(B0, 1, 0); PG8_SCHED; PG8_LDA(At, 1, 0); PG8_STAGE(PG8_SA(0, 1), a2 + hstep, voffA);
            PG8_WAIT_L(8); PG8_BAR; PG8_WAIT_L(0); PG8_MMA(0, 0, At, B0); PG8_BAR; PG8_SCHED;
            PG8_LDB(B1, 1, 1); PG8_STAGE(PG8_SB(1, 0), b3, voffB);
            PG8_BAR; PG8_WAIT_L(0); PG8_MMA(0, 1, At, B1); PG8_BAR;
            PG8_LDA(At, 1, 1); PG8_STAGE(PG8_SA(1, 0), a3, voffA);
            PG8_BAR; PG8_WAIT_L(0); PG8_MMA(1, 0, At, B0); PG8_BAR; PG8_SCHED;
            PG8_STAGE(PG8_SB(1, 1), b3 + hstep, voffB);
            PG8_WAIT_V(6); PG8_BAR; PG8_MMA(1, 1, At, B1); PG8_BAR;
            }
        }
        if constexpr (ALIGN_EPI) { if (wr == 0) PG8_BAR; }
        if constexpr (!Epi::AFTER_DRAIN) { E(acc, cur, wr, wc, fr, fq); S.done(cur); }
        if (!has_next) break;
#pragma unroll
        for (int a = 0; a < 2; ++a)
#pragma unroll
            for (int b = 0; b < 2; ++b)
#pragma unroll
                for (int m = 0; m < 4; ++m)
#pragma unroll
                    for (int n = 0; n < 2; ++n) acc[a][b][m][n] = (f32x4){0.f, 0.f, 0.f, 0.f};
        cur = nxt; cA = nA; cB = nB; ++ui;
        if constexpr (ALIGN_EPI) { if (wr == 1) PG8_BAR; }
    }
    PG8_WAIT_V(0);
    if constexpr (!ALIGN_EPI) { if (wr == 0) PG8_BAR; }
    PG8_BAR;
    if constexpr (Epi::AFTER_DRAIN) { E.fused(acc, cur, wr, wc, fr, fq, lds, wid, lane); S.done(cur); }
#undef PG8_SA
#undef PG8_SB
#undef PG8_STAGE
#undef PG8_LDA
#undef PG8_LDB
#undef PG8_MMA
#undef PG8_WAIT_V
#undef PG8_WAIT_L
#undef PG8_BAR
#undef PG8_SCHED
}
}
#define GAS __attribute__((address_space(1)))
#define LAS __attribute__((address_space(3)))
typedef unsigned short bf16;
typedef unsigned v4u __attribute__((ext_vector_type(4)));
typedef float f32x4 __attribute__((ext_vector_type(4)));
typedef short bf16x8 __attribute__((ext_vector_type(8)));
typedef GAS unsigned gu32;
typedef GAS unsigned long long gu64;
#define RLX_AGENT __ATOMIC_RELAXED, __HIP_MEMORY_SCOPE_AGENT
#define LDS_WAIT() asm volatile("s_waitcnt lgkmcnt(0)" ::: "memory")
#define VM_WAIT() asm volatile("s_waitcnt vmcnt(0)" ::: "memory")
__device__ __forceinline__ unsigned long long rt() { return __builtin_amdgcn_s_memrealtime(); }
__device__ __forceinline__ unsigned f2bf(float f) { unsigned u = __builtin_bit_cast(unsigned, f); return (u + 0x7fffu + ((u >> 16) & 1u)) >> 16; }
__device__ __forceinline__ unsigned pk2(float lo, float hi) { return f2bf(lo) | (f2bf(hi) << 16); }

#define XB_TMO      128
#define XB_XCNT(j)  (256  + 64 * (j))
#define XB_XSUB(j)  (1280 + 64 * (j))
#define XB_XGEN(j)  (2304 + 64 * (j))
#define XB_TOP      3328
#define XB_TOPGEN   3392
#define XCD_BAR_WORDS 3456
#define XB_SPIN_CAP (1u << 18)

__device__ __forceinline__ unsigned xb_ld(unsigned* p)              { return __hip_atomic_load(p, __ATOMIC_RELAXED, __HIP_MEMORY_SCOPE_AGENT); }
__device__ __forceinline__ unsigned xb_add(unsigned* p, unsigned v) { return __hip_atomic_fetch_add(p, v, __ATOMIC_RELAXED, __HIP_MEMORY_SCOPE_AGENT); }
__device__ __forceinline__ unsigned xb_xcc_id() { return (unsigned)__builtin_amdgcn_s_getreg((3 << 11) | 20) & 0xFu; }
#define XB_SPIN(cond, bar) do { unsigned _sp = 0; while (cond) { __builtin_amdgcn_s_sleep(1); \
    if ((++_sp & 255u) == 0u) { if (xb_ld(&(bar)[XB_TMO])) break; if (_sp > XB_SPIN_CAP) { atomicAdd(&(bar)[XB_TMO], 1u); break; } } } } while (0)

struct XcdBarrier {
    unsigned* bar; unsigned x;
    volatile LAS unsigned* st;
};

__device__ __forceinline__ XcdBarrier xcd_barrier_post(unsigned* bar, volatile LAS unsigned* st) {
    XcdBarrier b; b.bar = bar; b.x = xb_xcc_id(); b.st = st;
    if (threadIdx.x == 0) (void)xb_add(&bar[XB_XCNT(b.x)], 1u);
    return b;
}
__device__ __forceinline__ void xcd_barrier_complete(unsigned* bar, unsigned x, unsigned& nloc, unsigned& nx) {
    const unsigned G = gridDim.x * gridDim.y * gridDim.z;
    unsigned sum, cnt, mine, sp = 0u;
    for (;;) {
        sum = 0u; cnt = 0u; mine = 0u;
#pragma unroll
        for (unsigned j = 0; j < 16; ++j) { const unsigned c = xb_ld(&bar[XB_XCNT(j)]); sum += c; cnt += (c > 0u) ? 1u : 0u; mine = (j == x) ? c : mine; }
        if (sum == G) break;
        __builtin_amdgcn_s_sleep(1);
        if ((++sp & 255u) == 0u) { if (xb_ld(&bar[XB_TMO])) break; if (sp > XB_SPIN_CAP) { atomicAdd(&bar[XB_TMO], 1u); break; } }
    }
    nloc = mine > 0u ? mine : 1u; nx = cnt > 0u ? cnt : 1u;
}

__device__ __forceinline__ void xcd_barrier(const XcdBarrier& b) {
    asm volatile("s_waitcnt vmcnt(0)" ::: "memory");
    __syncthreads();
    if (threadIdx.x == 0) {
        unsigned* bar = b.bar;
        __builtin_amdgcn_s_waitcnt(0);
        unsigned nloc = b.st[0], nx = b.st[1];
        if (nloc == 0u) { xcd_barrier_complete(bar, b.x, nloc, nx); b.st[0] = nloc; b.st[1] = nx; }
        const unsigned old = xb_add(&bar[XB_XSUB(b.x)], 1u);
        const unsigned gen = old / nloc;
        if (old + 1u == (gen + 1u) * nloc) {
            __builtin_amdgcn_fence(__ATOMIC_RELEASE, "agent");
            asm volatile("s_waitcnt vmcnt(0)" ::: "memory");
            const unsigned og = xb_add(&bar[XB_TOP], 1u);
            const unsigned tg = og / nx;
            if (og + 1u == (tg + 1u) * nx) xb_add(&bar[XB_TOPGEN], 1u);
            else XB_SPIN(xb_ld(&bar[XB_TOPGEN]) == tg, bar);
            __builtin_amdgcn_fence(__ATOMIC_ACQUIRE, "agent");
            xb_add(&bar[XB_XGEN(b.x)], 1u);
            asm volatile("s_waitcnt vmcnt(0)" ::: "memory");
        } else {
            XB_SPIN(xb_ld(&bar[XB_XGEN(b.x)]) == gen, bar);
            __builtin_amdgcn_fence(__ATOMIC_ACQUIRE, "agent");
            asm volatile("s_waitcnt vmcnt(0)" ::: "memory");
        }
    }
    __syncthreads();
}
constexpr int BATCH = 4, T = 4096, DM = 2048, DEPTH = 4, M = BATCH * T;
constexpr int D_IN = 6600, NPROJ = 6656;
constexpr int SC_MLQK = 0, SC_MLV = 1024, SC_MLI = 1536, SC_MLF = 1540, SC_MLO = 1544, SC_MLZ = 2056, SC_CQ = 2568, SC_CKV = 3080, SC_KR = 3336, SC_MLAZ = 3400, SC_RW = 4424, SC_RWZ = 6088;
constexpr int PC_MLQK = 0, PC_MLV = 1024, PC_MLO = 1536, PC_MLZ = 2048, PC_CQ = 2560, PC_CKV = 3072, PC_MLAZ = 3328, PC_RW = 4352, PC_SPEC = 5888, PC_RWZ = 6144;
constexpr int SPEC_TILE = PC_SPEC / 256;
constexpr int NQ = 1536, NKV = 2048;
constexpr float NORM_EPS = 1e-6f, RW_GN_EPS = 64e-5f;
namespace att {
typedef unsigned short bf16_t;
typedef short bf16x8 __attribute__((ext_vector_type(8)));
typedef short s16x4 __attribute__((ext_vector_type(4)));
typedef float f32x16 __attribute__((ext_vector_type(16)));
typedef float f32x4 __attribute__((ext_vector_type(4)));
typedef unsigned u32x4 __attribute__((ext_vector_type(4)));
constexpr int NW = 8, QBLK = 32, KVBLK = 64, QB = NW * QBLK;
constexpr int QP = 1536, KVP = 2048, KRP = 64, OP = 2048;
constexpr int SHM_V = KVBLK * 128 * 2, SHM_K = KVBLK * 128 * 2, SHM_R = KVBLK * 64 * 2;
constexpr int OFF_V = 0, OFF_K = 2 * SHM_V, OFF_R = OFF_K + SHM_K, OFF_WS = OFF_R + SHM_R, OFF_Q = OFF_WS + NW * 64 * 4, LDS_BYTES = OFF_Q + NW * 12288;
constexpr float SCALE = 0.07216878364870322f;
constexpr float THR = 8.f;
constexpr unsigned WBIG = 1u << 30;
#define KSWZ(row, colB) ((row) * 256 + ((colB) ^ (((row) & 7) << 4)))
#define RSWZ(row, colB) ((row) * 128 + ((colB) ^ (((row) & 7) << 4)))
#define SBAR() __builtin_amdgcn_sched_barrier(0)
__device__ __forceinline__ int v_st(int k, int c) { const int kk = (k & ~0xC) | ((k & 4) << 1) | ((k & 8) >> 1); return ((kk >> 3) * 4 + (c >> 5)) * 512 + ((kk & 7) * 32 + (c & 31)) * 2; }
__device__ __forceinline__ int v_rd_base(int lane) { return ((lane & 3) << 3) | (((lane >> 2) & 3) << 6) | (((lane >> 4) & 1) << 5) | (((lane >> 5) & 1) << 8); }
constexpr int v_rd_off(int d0, int ks, int half) { return d0 * 512 + ks * 4096 + half * 2048; }
__device__ __forceinline__ int crow(int r, int hi) { return (r & 3) + 8 * (r >> 2) + 4 * hi; }
__device__ __forceinline__ unsigned cvtpk(float lo, float hi) { unsigned r; asm volatile("v_cvt_pk_bf16_f32 %0, %1, %2" : "=v"(r) : "v"(lo), "v"(hi)); return r; }
__device__ __forceinline__ bf16x8 load8(const bf16_t* p) { return *reinterpret_cast<const bf16x8*>(p); }
__device__ __forceinline__ float bf2f(bf16_t v) { return __uint_as_float((unsigned)v << 16); }
__device__ __forceinline__ void mask_tile(f32x16& p0, f32x16& p1, int dq, unsigned W) {
    const float NEG = -__builtin_inff();
#pragma unroll
    for (int r = 0; r < 16; ++r) {
        const int c = (r & 3) + 8 * (r >> 2);
        if ((unsigned)(dq - c) >= W) p0[r] = NEG;
        if ((unsigned)(dq - c - 32) >= W) p1[r] = NEG;
    }
}
__device__ __forceinline__ void partialSM(f32x16& p0, f32x16& p1, float& m_reg, float& mn, float& alpha) {
    float pmax = p0[0]; for (int r = 1; r < 16; ++r) pmax = fmaxf(pmax, p0[r]); for (int r = 0; r < 16; ++r) pmax = fmaxf(pmax, p1[r]);
    { auto rr = __builtin_amdgcn_permlane32_swap(__float_as_uint(pmax), __float_as_uint(pmax), false, false);
      pmax = fmaxf(__uint_as_float(rr[0]), __uint_as_float(rr[1])); }
    constexpr float C2 = 1.4426950408889634f * SCALE;
    if (__builtin_expect(__all((pmax - m_reg) * SCALE <= THR), 1)) { mn = m_reg; alpha = 1.f; }
    else { mn = fmaxf(m_reg, pmax); alpha = __builtin_amdgcn_exp2f((m_reg - mn) * C2); m_reg = mn; }
    const float mnL = -mn * C2;
    for (int r = 0; r < 16; ++r) p0[r] = fmaf(p0[r], C2, mnL); for (int r = 0; r < 16; ++r) p1[r] = fmaf(p1[r], C2, mnL);
    for (int r = 0; r < 16; ++r) p0[r] = __builtin_amdgcn_exp2f(p0[r]);
}
__device__ __forceinline__ void finishSM(f32x16& p0, f32x16& p1, float alpha, float& l_reg, bf16x8& pa0, bf16x8& pa1, bf16x8& pa2, bf16x8& pa3) {
    for (int r = 0; r < 16; ++r) p1[r] = __builtin_amdgcn_exp2f(p1[r]);
    float ps = 0; for (int r = 0; r < 16; ++r) ps += p0[r]; for (int r = 0; r < 16; ++r) ps += p1[r];
    { auto rr = __builtin_amdgcn_permlane32_swap(__float_as_uint(ps), __float_as_uint(ps), false, false);
      ps = __uint_as_float(rr[0]) + __uint_as_float(rr[1]); }
    l_reg = l_reg * alpha + ps;
#define PK4(P, B_, OUT) do { unsigned a0 = cvtpk(P[B_+0], P[B_+1]), a1 = cvtpk(P[B_+2], P[B_+3]);                          \
        unsigned b0 = cvtpk(P[B_+4], P[B_+5]), b1 = cvtpk(P[B_+6], P[B_+7]);                                             \
        auto r0 = __builtin_amdgcn_permlane32_swap(a0, b0, false, false); auto r1 = __builtin_amdgcn_permlane32_swap(a1, b1, false, false); \
        u32x4 w = {r0[0], r1[0], r0[1], r1[1]}; OUT = *reinterpret_cast<bf16x8*>(&w); } while (0)
    PK4(p0, 0, pa0); PK4(p0, 8, pa1); PK4(p1, 0, pa2); PK4(p1, 8, pa3);
#undef PK4
}
__device__ __forceinline__ void qkt(f32x16& p0, f32x16& p1, const char* K_lds, const char* R_lds, const char* Qw, int r32, int hi) {
    p0 = f32x16{}; p1 = f32x16{};
    const char* kb[4]; const char* rb[4];
#pragma unroll
    for (int dd = 0; dd < 4; ++dd) { kb[dd] = K_lds + KSWZ(r32, (dd * 16 + hi * 8) * 2); rb[dd] = R_lds + RSWZ(r32, (dd * 16 + hi * 8) * 2); }
#pragma unroll
    for (int d0 = 0; d0 < 8; ++d0) { const char* a = kb[d0 & 3] + (d0 >> 2) * 128;
        bf16x8 b0 = *reinterpret_cast<const bf16x8*>(a);
        bf16x8 b1 = *reinterpret_cast<const bf16x8*>(a + 32 * 256);
        bf16x8 q = *reinterpret_cast<const bf16x8*>(Qw + d0 * 1024);
        p0 = __builtin_amdgcn_mfma_f32_32x32x16_bf16(b0, q, p0, 0, 0, 0);
        p1 = __builtin_amdgcn_mfma_f32_32x32x16_bf16(b1, q, p1, 0, 0, 0); }
#pragma unroll
    for (int e = 0; e < 4; ++e) { const char* a = rb[e];
        bf16x8 b0 = *reinterpret_cast<const bf16x8*>(a);
        bf16x8 b1 = *reinterpret_cast<const bf16x8*>(a + 32 * 128);
        bf16x8 q = *reinterpret_cast<const bf16x8*>(Qw + (8 + e) * 1024);
        p0 = __builtin_amdgcn_mfma_f32_32x32x16_bf16(b0, q, p0, 0, 0, 0);
        p1 = __builtin_amdgcn_mfma_f32_32x32x16_bf16(b1, q, p1, 0, 0, 0); }
}
template <int VB>
__device__ __forceinline__ void pv_tile(f32x16* o, int vb0, bf16x8 pa0, bf16x8 pa1, bf16x8 pa2, bf16x8 pa3) {
#define TRRD(dst, off) asm volatile("ds_read_b64_tr_b16 %0, %1 offset:%2" : "=&v"(dst) : "v"(vb0), "i"(off) : "memory")
#define PV_D0(d0) do { s16x4 l0, l1, l2, l3, h0, h1, h2, h3; constexpr int b_ = OFF_V + VB * SHM_V + v_rd_off(d0, 0, 0); \
        TRRD(l0, b_); TRRD(h0, b_ + 2048); TRRD(l1, b_ + 4096); TRRD(h1, b_ + 6144); TRRD(l2, b_ + 8192); TRRD(h2, b_ + 10240); TRRD(l3, b_ + 12288); TRRD(h3, b_ + 14336); \
        asm volatile("s_waitcnt lgkmcnt(0)" ::: "memory"); SBAR();   \
        o[d0] = __builtin_amdgcn_mfma_f32_32x32x16_bf16(pa0, (bf16x8){l0[0], l0[1], l0[2], l0[3], h0[0], h0[1], h0[2], h0[3]}, o[d0], 0, 0, 0);   \
        o[d0] = __builtin_amdgcn_mfma_f32_32x32x16_bf16(pa1, (bf16x8){l1[0], l1[1], l1[2], l1[3], h1[0], h1[1], h1[2], h1[3]}, o[d0], 0, 0, 0);   \
        o[d0] = __builtin_amdgcn_mfma_f32_32x32x16_bf16(pa2, (bf16x8){l2[0], l2[1], l2[2], l2[3], h2[0], h2[1], h2[2], h2[3]}, o[d0], 0, 0, 0);   \
        o[d0] = __builtin_amdgcn_mfma_f32_32x32x16_bf16(pa3, (bf16x8){l3[0], l3[1], l3[2], l3[3], h3[0], h3[1], h3[2], h3[3]}, o[d0], 0, 0, 0); } while (0)
    PV_D0(0); PV_D0(1); PV_D0(2); PV_D0(3);
#undef PV_D0
#undef TRRD
}
struct BlockRef { const bf16_t* Q; const bf16_t* K; const bf16_t* V; const bf16_t* KR; bf16_t* O; const bf16_t* Z; const float* CSq; int P0; };
struct Seam { bf16x8 qr[12]; bf16x8 st_v0, st_v1, st_k0, st_k1, st_r; };
#define ROWKV(p, k0, rr) ((p) + (size_t)((k0) + (rr)) * KVP + sc)
#define VMW() asm volatile("s_waitcnt vmcnt(0)" ::: "memory")
#define VMWN(n) asm volatile("s_waitcnt vmcnt(%0)" :: "i"(n) : "memory")
#define SLOAD_H(Kp, Vp, Rp, k0) do { S.st_v0 = load8(ROWKV(Vp, k0, sr)); S.st_v1 = load8(ROWKV(Vp, k0, 32 + sr));              \
                         S.st_k0 = load8(ROWKV(Kp, k0, sr)); S.st_k1 = load8(ROWKV(Kp, k0, 32 + sr)); S.st_r = load8((Rp) + (size_t)((k0) + rr_) * KRP + rc_); } while (0)
#define SWRITE_HK() do { *(bf16x8*)(K_lds + kws) = S.st_k0; *(bf16x8*)(K_lds + kws + 32 * 256) = S.st_k1; *(bf16x8*)(R_lds + rws) = S.st_r; } while (0)
#define SWRITE_HV(bf) do { *(bf16x8*)(V_lds + (bf) * SHM_V + vst0) = S.st_v0; *(bf16x8*)(V_lds + (bf) * SHM_V + vst1) = S.st_v1; } while (0)
#define SWRITE_H(bf) do { SWRITE_HV(bf); SWRITE_HK(); } while (0)
__device__ __forceinline__ void attn_prime(const BlockRef& cur, char* lds, Seam& S) {
    int tid_o = threadIdx.x; asm volatile("" : "+v"(tid_o));
    const int tid = tid_o, wid = __builtin_amdgcn_readfirstlane(tid >> 6), lane = tid & 63, r32 = lane & 31, hi = lane >> 5;
    const int sr = tid >> 4, sc = (tid & 15) * 8, kws = KSWZ(sr, sc * 2), rr_ = tid >> 3, rc_ = (tid & 7) * 8, rws = RSWZ(rr_, rc_ * 2);
    char* K_lds = lds + OFF_K; char* R_lds = lds + OFF_R;
#pragma unroll
    for (int d0 = 0; d0 < 12; ++d0) S.qr[d0] = load8(cur.Q + (size_t)(wid * QBLK + r32) * QP + d0 * 16 + hi * 8);
    SLOAD_H(cur.K, cur.V, cur.KR, 0); VMW(); SWRITE_HK();
    __syncthreads();
}
__device__ __forceinline__ void attn_block(const BlockRef& cur, const BlockRef& nxt, char* lds, Seam& S) {
    int tid_o = threadIdx.x; asm volatile("" : "+v"(tid_o));
    const int tid = tid_o, wid = __builtin_amdgcn_readfirstlane(tid >> 6), lane = tid & 63, r32 = lane & 31, hi = lane >> 5;
    const int NT = cur.P0 / KVBLK + 4;
    const int qlo = cur.P0 + wid * QBLK, qm = qlo + r32 - 4 * hi;
    char* V_lds = lds + OFF_V; char* K_lds = lds + OFF_K; char* R_lds = lds + OFF_R;
    float* ws = (float*)(lds + OFF_WS) + wid * 64; float* li_l = ws, * al_l = ws + 32;
    float m_reg = -1e30f, l_reg = 0; f32x16 o[4] = {};
    const int sr = tid >> 4, sc = (tid & 15) * 8, vst0 = v_st(sr, sc), vst1 = v_st(32 + sr, sc), kws = KSWZ(sr, sc * 2), rr_ = tid >> 3, rc_ = (tid & 7) * 8, rws = RSWZ(rr_, rc_ * 2);
    const int vb0 = (int)(uintptr_t)lds + v_rd_base(lane);
    char* Qw = lds + OFF_Q + wid * 12288 + lane * 16;
    const bf16_t* Kh = cur.K; const bf16_t* Vh = cur.V; const bf16_t* Rh = cur.KR;
#define RESC(a) do { if (__any((a) < 1.f)) { if (hi == 0) al_l[r32] = (a); asm volatile("s_waitcnt lgkmcnt(0)" ::: "memory");              \
                     for (int d_ = 0; d_ < 4; ++d_) for (int r = 0; r < 16; ++r) o[d_][r] *= al_l[crow(r, hi)]; } } while (0)
#define KBASE(t) ((t) * KVBLK)
#define MASKT(P0_, P1_, t) do { const int kb_ = KBASE(t); if (kb_ + KVBLK - 1 > qlo) mask_tile(P0_, P1_, qm - kb_, WBIG); } while (0)
    constexpr int NQL = 12;
#define SEAM_K0() do { VMWN(NQL); SWRITE_HK(); SBAR(); } while (0)
    f32x16 pA0, pA1, pB0, pB1; float mnA, mnB, alA, alB; bf16x8 pa0, pa1, pa2, pa3;
#pragma unroll
    for (int e = 0; e < 4; ++e) { const f32x4* cp = (const f32x4*)(cur.CSq + (size_t)(wid * QBLK + r32) * 64 + (e * 8 + hi * 4) * 2); const f32x4 c0 = cp[0], c1 = cp[1];
        const bf16x8 raw = S.qr[8 + e]; float x[8];
#pragma unroll
        for (int j = 0; j < 8; ++j) x[j] = __uint_as_float((unsigned)(unsigned short)raw[j] << 16);
        u32x4 w;
        w.x = cvtpk(x[0] * c0[0] - x[1] * c0[1], x[1] * c0[0] + x[0] * c0[1]); w.y = cvtpk(x[2] * c0[2] - x[3] * c0[3], x[3] * c0[2] + x[2] * c0[3]);
        w.z = cvtpk(x[4] * c1[0] - x[5] * c1[1], x[5] * c1[0] + x[4] * c1[1]); w.w = cvtpk(x[6] * c1[2] - x[7] * c1[3], x[7] * c1[2] + x[6] * c1[3]);
        S.qr[8 + e] = *reinterpret_cast<bf16x8*>(&w); }
#pragma unroll
    for (int d0 = 0; d0 < 12; ++d0) *(bf16x8*)(Qw + d0 * 1024) = S.qr[d0];
    SWRITE_HV(0); SBAR();
    SLOAD_H(Kh, Vh, Rh, KBASE(1));
    SBAR(); qkt(pA0, pA1, K_lds, R_lds, Qw, r32, hi);
    MASKT(pA0, pA1, 0); partialSM(pA0, pA1, m_reg, mnA, alA);
    __syncthreads();
    VMW(); SWRITE_H(1);
    __syncthreads();
#define HALF_STEP(PX0, PX1, mnX, alX, PY0, PY1, alY, t, VB, SB) do {                                                          \
        SBAR(); qkt(PX0, PX1, K_lds, R_lds, Qw, r32, hi);                                                                     \
        finishSM(PY0, PY1, alY, l_reg, pa0, pa1, pa2, pa3); SBAR();                                                           \
        if ((t) + 1 < NT) { SLOAD_H(Kh, Vh, Rh, KBASE((t) + 1)); SBAR(); }                                                    \
        pv_tile<VB>(o, vb0, pa0, pa1, pa2, pa3); MASKT(PX0, PX1, (t)); partialSM(PX0, PX1, m_reg, mnX, alX);                  \
        __syncthreads();                                                                                                      \
        if ((t) + 1 < NT) { VMW(); SWRITE_H(SB); }                                                                            \
        RESC(alX); __syncthreads(); } while (0)
    for (int t = 1; t + 1 < NT; t += 2) {
        HALF_STEP(pB0, pB1, mnB, alB, pA0, pA1, alA, t, 0, 0);
        HALF_STEP(pA0, pA1, mnA, alA, pB0, pB1, alB, t + 1, 1, 1);
    }
    SBAR(); qkt(pB0, pB1, K_lds, R_lds, Qw, r32, hi); SBAR();
    SLOAD_H(nxt.K, nxt.V, nxt.KR, 0); SBAR();
    finishSM(pA0, pA1, alA, l_reg, pa0, pa1, pa2, pa3); SBAR();
    pv_tile<0>(o, vb0, pa0, pa1, pa2, pa3);
    MASKT(pB0, pB1, NT - 1); partialSM(pB0, pB1, m_reg, mnB, alB); __syncthreads(); RESC(alB);
    finishSM(pB0, pB1, alB, l_reg, pa0, pa1, pa2, pa3); SBAR(); pv_tile<1>(o, vb0, pa0, pa1, pa2, pa3);
    SBAR();
#pragma unroll
    for (int d0 = 0; d0 < 12; ++d0) S.qr[d0] = load8(nxt.Q + (size_t)(wid * QBLK + r32) * QP + d0 * 16 + hi * 8);
    SBAR(); SEAM_K0();
    if (hi == 0) li_l[r32] = l_reg; asm volatile("s_waitcnt lgkmcnt(0)" ::: "memory");
    float rli[16];
#pragma unroll
    for (int r = 0; r < 16; ++r) rli[r] = __builtin_amdgcn_rcpf(li_l[crow(r, hi)]);
    bf16_t* Ow = cur.O + (size_t)(wid * QBLK) * OP; const bf16_t* Zw = cur.Z + (size_t)(wid * QBLK) * NPROJ;
#pragma unroll
    for (int r = 0; r < 16; ++r) { const int orow = crow(r, hi);
#pragma unroll
        for (int d0 = 0; d0 < 4; ++d0) { const float z = bf2f(Zw[(size_t)orow * NPROJ + d0 * 32 + r32]);
            const float v = o[d0][r] * rli[r] * (z / (1.f + __expf(-z)));
            const float vn = __shfl_xor(v, 1);
            if ((r32 & 1) == 0) *(unsigned*)(Ow + (size_t)orow * OP + d0 * 32 + r32) = cvtpk(v, vn); } }
    __syncthreads();
#undef RESC
#undef KBASE
#undef MASKT
#undef SEAM_K0
#undef HALF_STEP
}
#undef ROWKV
#undef VMW
#undef VMWN
#undef SLOAD_H
#undef SWRITE_HK
#undef SWRITE_HV
#undef SWRITE_H
#undef KSWZ
#undef RSWZ
#undef SBAR
}
constexpr size_t MiB = 1u << 20;
constexpr size_t WS_CTL = 0, CTL_ZERO_BYTES = 1 * MiB;
constexpr size_t WS_WIN = 1 * MiB;
constexpr size_t WS_WUQ = WS_WIN + 104 * MiB;
constexpr size_t WS_WUKV = WS_WUQ + 6 * MiB;
constexpr size_t WS_WOUT = WS_WUKV + 4 * MiB;
constexpr size_t WS_CS = WS_WOUT + 32 * MiB;
constexpr size_t WS_XN = WS_CS + 4 * MiB;
constexpr size_t WS_PROJ = WS_XN + 64 * MiB;
constexpr size_t WS_SPEC = WS_PROJ + 208 * MiB;
constexpr size_t WS_CQN = WS_SPEC + 16 * MiB;
constexpr size_t WS_CKVN = WS_CQN + 16 * MiB;
constexpr size_t WS_KR = WS_CKVN + 8 * MiB;
constexpr size_t WS_Q = WS_KR + 2 * MiB;
constexpr size_t WS_KV = WS_Q + 48 * MiB;
constexpr size_t WS_QKC = WS_KV + 64 * MiB;
constexpr size_t WS_GATE = WS_QKC + 32 * MiB;
constexpr size_t WS_RWW = WS_GATE + 1 * MiB;
constexpr size_t WS_RWB = WS_RWW + 32 * MiB;
constexpr size_t WS_VFIRST = WS_RWB + 80 * MiB;
constexpr size_t WS_BONUS = WS_VFIRST + 16 * MiB;
constexpr size_t WS_END = WS_BONUS + 1 * MiB;
constexpr int CW_BAR = 4096;
constexpr int LDS_BYTES = 163840, RING_BYTES = 158720, MISC_OFF = RING_BYTES + 320;
static_assert(att::LDS_BYTES <= RING_BYTES, "attention LDS");

typedef unsigned short bf16_t;
__device__ __forceinline__ float bf2f(unsigned v) { return __uint_as_float(v << 16); }
__device__ __forceinline__ float wave_sum(float v) {
#pragma unroll
    for (int o = 1; o < 64; o <<= 1) v += __shfl_xor(v, o);
    return v;
}
__device__ __forceinline__ float sigmoidf_(float x) { return 1.f / (1.f + __expf(-x)); }
__device__ __forceinline__ float siluf_(float x) { return x / (1.f + __expf(-x)); }
__device__ __forceinline__ float softplusf_(float x) { return fmaxf(x, 0.f) + log1pf(__expf(-fabsf(x))); }

struct Args { const float* in[28]; float* out; unsigned char* ws; int ph_lo, ph_hi; };

struct MapWin { __device__ __forceinline__ int operator()(int n) const {
    if (n < 1536) return n;
    if (n < 2048) return SC_MLO + (n - 1536);
    if (n < 2560) return SC_MLZ + (n - 2048);
    if (n < 3072) return SC_CQ + (n - 2560);
    if (n < 3328) return SC_CKV + (n - 3072);
    if (n < 4352) return SC_MLAZ + (n - 3328);
    if (n < 5888) return SC_RW + (n - 4352);
    if (n < 6144) { const int j = n - 5888;
        if (j < 128) return SC_RW + 1536 + j;
        if (j < 192) { const int q = j - 128; return SC_KR + ((q & 1) ? 32 + (q >> 1) : (q >> 1)); }
        if (j < 196) return SC_MLI + (j - 192);
        if (j < 200) return SC_MLF + (j - 196);
        return -1; }
    return SC_RWZ + (n - 6144); } };
struct MapUq { __device__ __forceinline__ int operator()(int n) const { const int h = n / 192, d = n % 192; if (d < 128) return n; const int q = d - 128; return h * 192 + 128 + ((q & 1) ? 32 + (q >> 1) : (q >> 1)); } };
struct MapId { __device__ __forceinline__ int operator()(int n) const { return n; } };

template <class Map>
__device__ __forceinline__ void transpose_item(const float* W, int K, int Nsrc, bf16_t* WT, const float* gain, LAS float* scr, int kb, int nb, int lane, Map map) {
    const int k0 = 64 * kb, n0 = 32 * nb, sc = map(n0 + (lane & 31));
#pragma unroll 8
    for (int i = 0; i < 32; ++i) { const int kk = 2 * i + (lane >> 5); float v = 0.f;
        if (sc >= 0) { v = W[(size_t)(k0 + kk) * Nsrc + sc]; if (gain) v *= gain[k0 + kk]; }
        scr[kk * 33 + (lane & 31)] = v; }
    LDS_WAIT(); asm volatile("" ::: "memory");
    const int c = lane & 7;
#pragma unroll
    for (int j = 0; j < 4; ++j) { const int n = (lane >> 3) + 8 * j; const LAS float* s = scr + (8 * c) * 33 + n;
        v4u o; o.x = pk2(s[0 * 33], s[1 * 33]); o.y = pk2(s[2 * 33], s[3 * 33]); o.z = pk2(s[4 * 33], s[5 * 33]); o.w = pk2(s[6 * 33], s[7 * 33]);
        *(v4u*)(WT + (size_t)(n0 + n) * K + k0 + 8 * c) = o; }
    LDS_WAIT(); asm volatile("" ::: "memory");
}

template <int MODE>
__device__ __forceinline__ void norm_row(const float* xrow, bf16_t* orow, float* frow, const float* g, int lane) {
    const f32x4* xr = (const f32x4*)xrow + lane;
    f32x4 v[8]; float s = 0.f;
#pragma unroll
    for (int j = 0; j < 8; ++j) { v[j] = xr[64 * j]; s += (v[j].x * v[j].x + v[j].y * v[j].y) + (v[j].z * v[j].z + v[j].w * v[j].w); }
    const float rstd = 1.f / sqrtf(wave_sum(s) * (1.f / DM) + NORM_EPS);
    if (MODE == 0) { unsigned long long* o8 = (unsigned long long*)orow + lane;
#pragma unroll
        for (int j = 0; j < 8; ++j) o8[64 * j] = (unsigned long long)pk2(v[j].x * rstd, v[j].y * rstd) | ((unsigned long long)pk2(v[j].z * rstd, v[j].w * rstd) << 32);
    } else { f32x4* o = (f32x4*)frow + lane; const f32x4* gr = (const f32x4*)g + lane;
#pragma unroll
        for (int j = 0; j < 8; ++j) { const f32x4 gg = gr[64 * j]; o[64 * j] = v[j] * rstd * gg; } }
}

__device__ __forceinline__ att::BlockRef mk_block(const bf16_t* Q, const bf16_t* KV, const bf16_t* KR, bf16_t* MIXED, const bf16_t* PROJ, const float* CS, int L_, int pass_) {
    const int bh = L_ >> 3, x = L_ & 7, qb = pass_ ? 15 - x : x, b = bh >> 3, h = bh & 7; att::BlockRef r;
    const size_t rb = (size_t)b * T, rq = rb + (size_t)qb * 256;
    r.Q = Q + rq * NQ + h * 192; r.K = KV + rb * NKV + h * 256; r.V = r.K + 128; r.KR = KR + rb * 64; r.O = MIXED + rq * DM + 512 + h * 128; r.Z = PROJ + rq * NPROJ + PC_MLAZ + h * 128; r.CSq = CS + rq * 64; r.P0 = qb * 256; return r;
}
__global__ void __launch_bounds__(512, 2) fwd(Args args) {
    extern __shared__ __attribute__((aligned(16))) unsigned char lds[];
    const int tid = threadIdx.x, lane = tid & 63, wave = __builtin_amdgcn_readfirstlane(tid >> 6);
    const int G = gridDim.x, bid = blockIdx.x;
    unsigned char* ws = args.ws;
    volatile LAS unsigned* MISC = (volatile LAS unsigned*)((LAS unsigned char*)lds + MISC_OFF);
    for (int u = tid; u < (LDS_BYTES - RING_BYTES) / 4; u += 512) ((LAS unsigned*)((LAS unsigned char*)lds + RING_BYTES))[u] = 0u;
    __syncthreads();
    const bool one_launch = (args.ph_hi - args.ph_lo) > 1;
    XcdBarrier bar; bar.bar = (unsigned*)(ws + WS_CTL) + CW_BAR; bar.x = 0; bar.st = nullptr;
    if (one_launch) bar = xcd_barrier_post((unsigned*)(ws + WS_CTL) + CW_BAR, MISC + 8);
    const int lo = args.ph_lo, hi = args.ph_hi;
#define IN(k) (lo <= (k) && (k) < hi)
#define SEAM(k) do { if (IN(k) && IN((k) + 1)) xcd_barrier(bar); } while (0)

    const float* x_in = args.in[0]; const int* positions = (const int*)args.in[1];
    float* X = args.out;
    bf16_t* WIN = (bf16_t*)(ws + WS_WIN); bf16_t* WUQ = (bf16_t*)(ws + WS_WUQ); bf16_t* WUKV = (bf16_t*)(ws + WS_WUKV); bf16_t* WOUT = (bf16_t*)(ws + WS_WOUT);
    float* CS = (float*)(ws + WS_CS); bf16_t* XN = (bf16_t*)(ws + WS_XN); bf16_t* MIXED = XN; bf16_t* PROJ = (bf16_t*)(ws + WS_PROJ); float* SPEC = (float*)(ws + WS_SPEC);
    bf16_t* CQN = (bf16_t*)(ws + WS_CQN); bf16_t* CKVN = (bf16_t*)(ws + WS_CKVN); bf16_t* KR = (bf16_t*)(ws + WS_KR); bf16_t* Q = (bf16_t*)(ws + WS_Q); bf16_t* KV = (bf16_t*)(ws + WS_KV);
    bf16_t* QKC = (bf16_t*)(ws + WS_QKC); float* LI = (float*)(ws + WS_GATE); float* LF = LI + (size_t)M * 4;
    float* RWW = (float*)(ws + WS_RWW); bf16_t* RWB = (bf16_t*)(ws + WS_RWB); bf16_t* VFIRST = (bf16_t*)(ws + WS_VFIRST); float* BONUS = (float*)(ws + WS_BONUS);
    constexpr size_t RWS = (size_t)M * 512;

    if (IN(0)) {
#ifndef NO_PRO
        LAS float* scr = (LAS float*)((LAS unsigned char*)lds + wave * 16384);
        const int gw = bid * 8 + wave, NGW = G * 8;
        constexpr int I_IN = (DM / 64) * (NPROJ / 32), I_UQ = (512 / 64) * (NQ / 32), I_UKV = (256 / 64) * (NKV / 32), I_OUT = (DM / 64) * (DM / 32), I_L = I_IN + I_UQ + I_UKV + I_OUT;
        for (int it = gw; it < DEPTH * I_L; it += NGW) {
            const int l = it / I_L; int r = it % I_L;
            if (r < I_IN) { transpose_item(args.in[3] + (size_t)l * DM * D_IN, DM, D_IN, WIN + (size_t)l * NPROJ * DM, args.in[2] + l * DM, scr, r / (NPROJ / 32), r % (NPROJ / 32), lane, MapWin()); continue; } r -= I_IN;
            if (r < I_UQ) { transpose_item(args.in[10] + (size_t)l * 512 * NQ, 512, NQ, WUQ + (size_t)l * NQ * 512, args.in[9] + l * 512, scr, r / (NQ / 32), r % (NQ / 32), lane, MapUq()); continue; } r -= I_UQ;
            if (r < I_UKV) { transpose_item(args.in[12] + (size_t)l * 256 * NKV, 256, NKV, WUKV + (size_t)l * NKV * 256, args.in[11] + l * 256, scr, r / (NKV / 32), r % (NKV / 32), lane, MapId()); continue; } r -= I_UKV;
            transpose_item(args.in[26] + (size_t)l * DM * DM, DM, DM, WOUT + (size_t)l * DM * DM, (const float*)nullptr, scr, r / (DM / 32), r % (DM / 32), lane, MapId());
        }
        for (int i = bid * 512 + tid; i < M * 32; i += G * 512) { const int m = i >> 5, j = i & 31;
            const float inv_freq = powf(10000.f, -(float)(2 * j) / 64.f);
            const float ang = (float)positions[m] * inv_freq;
            const double a = (double)ang; const double n = rint(a * 0.15915494309189535); const float r = (float)(a - n * 6.283185307179586);
            CS[2 * i] = cosf(r); CS[2 * i + 1] = sinf(r); }
        for (int m = gw; m < M; m += NGW) norm_row<0>(x_in + (size_t)m * DM, XN + (size_t)m * DM, nullptr, nullptr, lane);
#endif
    }
    SEAM(0);

#ifdef FIXL
    for (int l = 0; l < 1; ++l) {
#else
    for (int l = 0; l < DEPTH; ++l) {
#endif
        const int pb = 1 + l * 6;
        int tid_o = threadIdx.x; asm volatile("" : "+v"(tid_o));
        const int tid = tid_o, lane = tid & 63, wave = __builtin_amdgcn_readfirstlane(tid >> 6);
        if (IN(pb + 0)) {
#ifndef NO_G1
            pg8::Gemm g{XN, WIN + (size_t)l * NPROJ * DM, M, NPROJ, DM}; pg8::StaticOrder S; S.init(M, NPROJ, G, bid);
            pg8::EpiProj E{PROJ, NPROJ, SPEC, SPEC_TILE};
            pg8::gemm_phase<pg8::EpiProj, pg8::StaticOrder, true, true>((LAS unsigned char*)lds, g, S, E);
#endif
        }
        SEAM(pb + 0);
        if (IN(pb + 1)) {
#ifndef NO_PREP
            LAS float* L = (LAS float*)lds;
            LAS float* xw_t = L;
            LAS float* xa_s = L + 512;
            LAS float* t1 = L + 1024;
            LAS float* vbuf = L + 1280;
            const float* mu = args.in[13] + l * 1664; const float* w0 = args.in[14] + l * 512; const float* w2 = args.in[15] + (size_t)l * 64 * 512;
            const float* a0 = args.in[16] + l * 512; const float* a2 = args.in[17] + (size_t)l * 64 * 512;
            const float* v0 = args.in[18] + (l > 0 ? (l - 1) * 512 : 0); const float* v1 = args.in[19] + (size_t)(l > 0 ? l - 1 : 0) * 512 * 32; const float* v2 = args.in[20] + (size_t)(l > 0 ? l - 1 : 0) * 32 * 512;
            const float* k_k = args.in[21] + l * 512; const float* k_a = args.in[22] + l * 512; const float* r_k = args.in[23] + l * 512;
            const float* conv_w = args.in[4] + (size_t)l * 4 * 1024; const float* conv_b = args.in[5] + l * 1024;
            const float* i_bias = args.in[6] + l * 4; const float* f_bias = args.in[7] + l * 4;
            const int c = tid;
            for (int g8 = bid; g8 < M / 8; g8 += G) {
                const int m0 = g8 * 8, t0 = m0 % T;
                float r_[8], k_[8], v_[8];
                { const float mur = mu[c], muk = mu[512 + c], muv = mu[1024 + c];
                  float pr = 0.f, pk = 0.f, pv = 0.f;
                  if (t0 > 0) { const bf16_t* pp = PROJ + (size_t)(m0 - 1) * NPROJ + PC_RW + c; pr = bf2f(pp[0]); pk = bf2f(pp[512]); pv = bf2f(pp[1024]); }
#pragma unroll
                  for (int i = 0; i < 8; ++i) { const bf16_t* pp = PROJ + (size_t)(m0 + i) * NPROJ + PC_RW + c; const float cr = bf2f(pp[0]), ck = bf2f(pp[512]), cv = bf2f(pp[1024]);
                      r_[i] = cr + mur * (pr - cr); k_[i] = ck + muk * (pk - ck); v_[i] = cv + muv * (pv - cv); pr = cr; pk = ck; pv = cv; } }
                if (tid < 128) { const int j = tid & 63, which = tid >> 6; const float mm = mu[1536 + which * 64 + j];
                    float pv = 0.f; if (t0 > 0) pv = SPEC[(size_t)(m0 - 1) * 256 + which * 64 + j];
                    for (int i = 0; i < 8; ++i) { const float cv = SPEC[(size_t)(m0 + i) * 256 + which * 64 + j]; const float xs = cv + mm * (pv - cv); pv = cv;
                        if (which == 0) xw_t[i * 64 + j] = tanhf(xs); else xa_s[i * 64 + j] = xs; } }
                if (l > 0) {
#pragma unroll
                    for (int i = 0; i < 8; ++i) vbuf[i * 512 + c] = v_[i]; }
                __syncthreads();
                float lw[8], la[8];
                { const float w0c = w0[c], a0c = a0[c];
#pragma unroll
                  for (int i = 0; i < 8; ++i) { lw[i] = w0c; la[i] = a0c; }
                  for (int j = 0; j < 64; ++j) { const float w2v = w2[j * 512 + c], a2v = a2[j * 512 + c];
#pragma unroll
                      for (int i = 0; i < 8; ++i) { lw[i] += xw_t[i * 64 + j] * w2v; la[i] += xa_s[i * 64 + j] * a2v; } } }
                if (l > 0) {
                    if (tid < 256) { const int i = tid >> 5, j = tid & 31; float s = 0.f;
                        for (int cc = 0; cc < 512; ++cc) s += vbuf[i * 512 + cc] * v1[cc * 32 + j];
                        t1[i * 32 + j] = s; }
                    __syncthreads();
                    float gsum[8]; const float v0c = v0[c];
#pragma unroll
                    for (int i = 0; i < 8; ++i) gsum[i] = v0c;
                    for (int j = 0; j < 32; ++j) { const float v2v = v2[j * 512 + c];
#pragma unroll
                        for (int i = 0; i < 8; ++i) gsum[i] += t1[i * 32 + j] * v2v; }
#pragma unroll
                    for (int i = 0; i < 8; ++i) { const float vf = bf2f(VFIRST[(size_t)(m0 + i) * 512 + c]); v_[i] = v_[i] + (vf - v_[i]) * sigmoidf_(gsum[i]); }
                } else {
#pragma unroll
                    for (int i = 0; i < 8; ++i) VFIRST[(size_t)(m0 + i) * 512 + c] = (bf16_t)f2bf(v_[i]);
                }
                { const float kkc = k_k[c], kac = k_a[c], rkc = r_k[c];
#pragma unroll
                  for (int i = 0; i < 8; ++i) { const size_t o = (size_t)(m0 + i) * 512 + c;
                      const float logw = -softplusf_(-lw[i]) - 0.5f; const float dec = __expf(-__expf(logw)); const float a = sigmoidf_(la[i]);
                      float kk = k_[i] * kkc; const float ss = wave_sum(kk * kk); kk = kk / fmaxf(sqrtf(ss), 1e-12f);
                      const float kh = k_[i] * (1.f + (a - 1.f) * kac);
                      const float bon = wave_sum(r_[i] * kh * rkc);
                      RWW[o] = dec; RWB[o] = (bf16_t)f2bf(r_[i]); RWB[RWS + o] = (bf16_t)f2bf(kh); RWB[2 * RWS + o] = (bf16_t)f2bf(v_[i]); RWB[3 * RWS + o] = (bf16_t)f2bf(-kk); RWB[4 * RWS + o] = (bf16_t)f2bf(kk * a);
                      if (lane == 0) BONUS[(size_t)(m0 + i) * 8 + wave] = bon; } }
                { const int m = m0 + wave;
                  { const v4u raw = *(const v4u*)(PROJ + (size_t)m * NPROJ + PC_CQ + lane * 8); float f[8];
                    f[0] = bf2f(raw.x & 0xffffu); f[1] = bf2f(raw.x >> 16); f[2] = bf2f(raw.y & 0xffffu); f[3] = bf2f(raw.y >> 16); f[4] = bf2f(raw.z & 0xffffu); f[5] = bf2f(raw.z >> 16); f[6] = bf2f(raw.w & 0xffffu); f[7] = bf2f(raw.w >> 16);
                    float s = 0.f;
#pragma unroll
                    for (int e = 0; e < 8; ++e) s += f[e] * f[e];
                    const float rstd = 1.f / sqrtf(wave_sum(s) * (1.f / 512.f) + NORM_EPS);
                    v4u o; o.x = pk2(f[0] * rstd, f[1] * rstd); o.y = pk2(f[2] * rstd, f[3] * rstd); o.z = pk2(f[4] * rstd, f[5] * rstd); o.w = pk2(f[6] * rstd, f[7] * rstd);
                    *(v4u*)(CQN + (size_t)m * 512 + lane * 8) = o; }
                  { const unsigned long long raw = *(const unsigned long long*)(PROJ + (size_t)m * NPROJ + PC_CKV + lane * 4); float f[4];
                    f[0] = bf2f((unsigned)raw & 0xffffu); f[1] = bf2f(((unsigned)raw) >> 16); f[2] = bf2f((unsigned)(raw >> 32) & 0xffffu); f[3] = bf2f((unsigned)(raw >> 48));
                    const float s = f[0] * f[0] + f[1] * f[1] + f[2] * f[2] + f[3] * f[3];
                    const float rstd = 1.f / sqrtf(wave_sum(s) * (1.f / 256.f) + NORM_EPS);
                    *(unsigned long long*)(CKVN + (size_t)m * 256 + lane * 4) = (unsigned long long)pk2(f[0] * rstd, f[1] * rstd) | ((unsigned long long)pk2(f[2] * rstd, f[3] * rstd) << 32); }
                  { const float vv = SPEC[(size_t)m * 256 + 128 + lane]; const float pt = __shfl_xor(vv, 1); const int i = lane >> 1;
                    const float cs_ = CS[((size_t)m * 32 + i) * 2], sn_ = CS[((size_t)m * 32 + i) * 2 + 1];
                    const float o = (lane & 1) ? (vv * cs_ + pt * sn_) : (vv * cs_ - pt * sn_);
                    KR[(size_t)m * 64 + lane] = (bf16_t)f2bf(o); } }
#pragma unroll
                for (int hh = 0; hh < 2; ++hh) { const int ch = c + hh * 512;
                    const float cw0 = conv_w[ch], cw1 = conv_w[1024 + ch], cw2 = conv_w[2048 + ch], cw3 = conv_w[3072 + ch], cb = conv_b[ch];
                    float x0 = 0.f, x1 = 0.f, x2 = 0.f;
                    if (t0 >= 3) { x0 = bf2f(PROJ[(size_t)(m0 - 3) * NPROJ + PC_MLQK + ch]); x1 = bf2f(PROJ[(size_t)(m0 - 2) * NPROJ + PC_MLQK + ch]); x2 = bf2f(PROJ[(size_t)(m0 - 1) * NPROJ + PC_MLQK + ch]); }
                    const float sc_ = hh == 0 ? 0.08838834764831845f : 1.f;
#pragma unroll
                    for (int i = 0; i < 8; ++i) { const float x3 = bf2f(PROJ[(size_t)(m0 + i) * NPROJ + PC_MLQK + ch]);
                        const float y = cb + cw0 * x0 + cw1 * x1 + cw2 * x2 + cw3 * x3;
                        QKC[(size_t)(m0 + i) * 1024 + ch] = (bf16_t)f2bf(siluf_(y) * sc_);
                        x0 = x1; x1 = x2; x2 = x3; } }
                if (tid < 64) { const int i = tid >> 3, gh = tid & 7; const float val = SPEC[(size_t)(m0 + i) * 256 + 192 + gh];
                    if (gh < 4) LI[(size_t)(m0 + i) * 4 + gh] = val + i_bias[gh];
                    else { const float xx = val + f_bias[gh - 4]; LF[(size_t)(m0 + i) * 4 + gh - 4] = -softplusf_(-xx); } }
                __syncthreads();
            }
#endif
        }
        SEAM(pb + 1);
        if (IN(pb + 2)) {
#ifndef NO_G23
            { pg8::Gemm g{CQN, WUQ + (size_t)l * NQ * 512, M, NQ, 512}; pg8::StaticOrder S; S.init(M, NQ, G, bid);
              pg8::EpiPlain E{Q, NQ};
              pg8::gemm_phase<pg8::EpiPlain, pg8::StaticOrder, true, true>((LAS unsigned char*)lds, g, S, E); }
            { pg8::Gemm g{CKVN, WUKV + (size_t)l * NKV * 256, M, NKV, 256}; pg8::StaticOrder S; S.init(M, NKV, G, bid);
              pg8::EpiPlain E{KV, NKV};
              pg8::gemm_phase<pg8::EpiPlain, pg8::StaticOrder, true, true>((LAS unsigned char*)lds, g, S, E); }
#endif
        }
        SEAM(pb + 2);
        if (IN(pb + 3)) {
#ifndef NO_SCANS
            if (bid < 32 && G >= 64) {
                const int b = bid >> 3, h = bid & 7, row = tid >> 3, kq = tid & 7;
                LAS float* tin = (LAS float*)lds;
                LAS float* ybuf = tin + 6 * 1024;
                const float* ln_g = args.in[24] + l * 512 + h * 64; const float* ln_b = args.in[25] + l * 512 + h * 64;
                float S8[8];
#pragma unroll
                for (int j = 0; j < 8; ++j) S8[j] = 0.f;
                for (int t0 = 0; t0 < T; t0 += 16) {
#pragma unroll
                    for (int i = 0; i < 12; ++i) { const int idx = tid + 512 * i, arr = idx >> 10, rem = idx & 1023, tt = rem >> 6, cc = rem & 63;
                        const size_t o = (size_t)(b * T + t0 + tt) * 512 + h * 64 + cc;
                        float val;
                        if (arr == 1) val = RWW[o]; else { const int ba = arr == 0 ? 0 : arr - 1; val = bf2f(RWB[(size_t)ba * RWS + o]); }
                        tin[idx] = val; }
                    __syncthreads();
                    for (int tt = 0; tt < 16; ++tt) {
                        const LAS float* base = tin + tt * 64 + kq * 8;
                        const f32x4 r0 = *(const LAS f32x4*)(base), r1 = *(const LAS f32x4*)(base + 4);
                        const f32x4 w0_ = *(const LAS f32x4*)(base + 1024), w1_ = *(const LAS f32x4*)(base + 1024 + 4);
                        const f32x4 k0_ = *(const LAS f32x4*)(base + 2048), k1_ = *(const LAS f32x4*)(base + 2048 + 4);
                        const f32x4 a0_ = *(const LAS f32x4*)(base + 4096), a1_ = *(const LAS f32x4*)(base + 4096 + 4);
                        const f32x4 b0_ = *(const LAS f32x4*)(base + 5120), b1_ = *(const LAS f32x4*)(base + 5120 + 4);
                        const float vv = tin[3072 + tt * 64 + row];
                        float sa = 0.f;
#pragma unroll
                        for (int j = 0; j < 4; ++j) sa += S8[j] * a0_[j] + S8[4 + j] * a1_[j];
                        sa += __shfl_xor(sa, 1); sa += __shfl_xor(sa, 2); sa += __shfl_xor(sa, 4);
                        float y = 0.f;
#pragma unroll
                        for (int j = 0; j < 4; ++j) { S8[j] = S8[j] * w0_[j] + sa * b0_[j] + vv * k0_[j]; S8[4 + j] = S8[4 + j] * w1_[j] + sa * b1_[j] + vv * k1_[j]; y += S8[j] * r0[j] + S8[4 + j] * r1[j]; }
                        y += __shfl_xor(y, 1); y += __shfl_xor(y, 2); y += __shfl_xor(y, 4);
                        if (kq == 0) ybuf[tt * 64 + row] = y;
                    }
                    __syncthreads();
#pragma unroll
                    for (int q = 0; q < 2; ++q) { const int tt = wave * 2 + q; const size_t m = (size_t)b * T + t0 + tt;
                        const float y = ybuf[tt * 64 + lane]; const float mean = wave_sum(y) * (1.f / 64.f); const float d = y - mean; const float var = wave_sum(d * d) * (1.f / 64.f);
                        float yn = d / sqrtf(var + RW_GN_EPS) * ln_g[lane] + ln_b[lane];
                        yn += BONUS[m * 8 + h] * tin[3072 + tt * 64 + lane];
                        const float z = bf2f(PROJ[m * NPROJ + PC_RWZ + h * 64 + lane]);
                        MIXED[m * DM + 1536 + h * 64 + lane] = (bf16_t)f2bf(siluf_(z) * yn); }
                    __syncthreads();
                }
            } else if (bid < 48 && G >= 64) {
                const int u = bid - 32, b = u >> 2, h = u & 3, row = tid >> 2, kq = tid & 3;
                LAS float* tq = (LAS float*)lds;
                LAS float* tk = tq + 2048; LAS float* tv = tk + 2048; LAS float* hb = tv + 2048; LAS float* tg = hb + 2048;
                const float* ng = args.in[8] + l * 512 + h * 128;
                float C[32], n[32];
#pragma unroll
                for (int j = 0; j < 32; ++j) { C[j] = 0.f; n[j] = 0.f; }
                for (int t0 = 0; t0 < T; t0 += 16) {
#pragma unroll
                    for (int i = 0; i < 4; ++i) { const int idx = tid + 512 * i, tt = idx >> 7, d = idx & 127; const size_t m = (size_t)b * T + t0 + tt;
                        tq[idx] = bf2f(QKC[m * 1024 + h * 128 + d]); tk[idx] = bf2f(QKC[m * 1024 + 512 + h * 128 + d]); tv[idx] = bf2f(PROJ[m * NPROJ + PC_MLV + h * 128 + d]); }
                    if (tid < 16) { const size_t m = (size_t)b * T + t0 + tid; tg[tid * 2] = LI[m * 4 + h]; tg[tid * 2 + 1] = LF[m * 4 + h]; }
                    __syncthreads();
                    for (int tt = 0; tt < 16; ++tt) {
                        const float ig = __expf(tg[tt * 2]), fg = __expf(tg[tt * 2 + 1]);
                        const float vi = tv[tt * 128 + row] * ig;
                        float num = 0.f, den = 0.f;
#pragma unroll
                        for (int j4 = 0; j4 < 8; ++j4) { const f32x4 kk = *(const LAS f32x4*)(tk + tt * 128 + kq * 32 + j4 * 4), qq = *(const LAS f32x4*)(tq + tt * 128 + kq * 32 + j4 * 4);
#pragma unroll
                            for (int e = 0; e < 4; ++e) { const int j = j4 * 4 + e; C[j] = fg * C[j] + vi * kk[e]; n[j] = fg * n[j] + ig * kk[e]; num += C[j] * qq[e]; den += n[j] * qq[e]; } }
                        num += __shfl_xor(num, 1); num += __shfl_xor(num, 2); den += __shfl_xor(den, 1); den += __shfl_xor(den, 2);
                        if (kq == 0) hb[tt * 128 + row] = num / fmaxf(fabsf(den), 1.f);
                    }
                    __syncthreads();
#pragma unroll
                    for (int q = 0; q < 2; ++q) { const int tt = wave * 2 + q; const size_t m = (size_t)b * T + t0 + tt;
                        const float h0 = hb[tt * 128 + lane], h1 = hb[tt * 128 + 64 + lane]; const float mean = wave_sum(h0 + h1) * (1.f / 128.f); const float d0 = h0 - mean, d1 = h1 - mean;
                        const float rstd = 1.f / sqrtf(wave_sum(d0 * d0 + d1 * d1) * (1.f / 128.f) + NORM_EPS);
#pragma unroll
                        for (int e = 0; e < 2; ++e) { const int d = lane + 64 * e; const float hn = (e ? d1 : d0) * rstd * ng[d];
                            const float og = bf2f(PROJ[m * NPROJ + PC_MLO + h * 128 + d]), z = bf2f(PROJ[m * NPROJ + PC_MLZ + h * 128 + d]);
                            MIXED[m * DM + h * 128 + d] = (bf16_t)f2bf(siluf_(z) * sigmoidf_(og) * hn); } }
                    __syncthreads();
                }
            } else
#endif
            {
#ifndef NO_ATT
                const int first = (G >= 64) ? bid - 48 : bid, stride = (G >= 64) ? G - 48 : G; constexpr int total = BATCH * 8 * 8;
                if (first < total) {
                    att::Seam S; int L = first, pass = 0;
#define mk(L_, pass_) mk_block(Q, KV, KR, MIXED, PROJ, CS, (L_), (pass_))
                    att::BlockRef cur = mk(L, 0);
                    att::attn_prime(cur, (char*)lds, S);
                    for (;;) {
                        const bool more_pass = pass == 0, more_item = L + stride < total, last = !more_pass && !more_item;
                        int Ln = L, passn = pass + 1; if (!more_pass) { passn = 0; Ln = more_item ? L + stride : L; }
                        const att::BlockRef nxt = last ? cur : mk(Ln, passn);
                        att::attn_block(cur, nxt, (char*)lds, S);
                        if (last) break;
                        cur = nxt; L = Ln; pass = passn;
                    }
#undef mk
                }
#endif
            }
        }
        SEAM(pb + 3);
        if (IN(pb + 4)) {
#ifndef NO_G4
            pg8::Gemm g{MIXED, WOUT + (size_t)l * DM * DM, M, DM, DM}; pg8::StaticOrder S; S.init(M, DM, G, bid);
            pg8::EpiResid E{l == 0 ? x_in : (const float*)X, X, DM};
            pg8::gemm_phase<pg8::EpiResid, pg8::StaticOrder, true, true>((LAS unsigned char*)lds, g, S, E);
#endif
        }
        SEAM(pb + 4);
        if (IN(pb + 5)) {
            const int gw = bid * 8 + wave, NGW = G * 8;
            if (l + 1 < DEPTH) { for (int m = gw; m < M; m += NGW) norm_row<0>(X + (size_t)m * DM, XN + (size_t)m * DM, nullptr, nullptr, lane); }
            else { for (int m = gw; m < M; m += NGW) norm_row<1>(X + (size_t)m * DM, nullptr, X + (size_t)m * DM, args.in[27], lane); }
        }
        SEAM(pb + 5);
    }
#undef IN
#undef SEAM
}

constexpr int N_PHASES = 1 + DEPTH * 6;
#ifndef MK_ONE_LAUNCH
#define MK_ONE_LAUNCH 1
#endif
extern "C" void kernel_launch(void* const* d_in, const int* in_sizes, int n_in, void* d_out, int out_size, void* d_ws, size_t ws_size, hipStream_t stream) {
    static int grid = 0;
    if (grid == 0) {
        if (n_in != 28 || out_size != M * DM || ws_size < WS_END) { fprintf(stderr, "kernel_launch: unexpected shapes (n_in %d, out %d, ws %zu < %zu)\n", n_in, out_size, ws_size, (size_t)WS_END); grid = -1; return; }
        int dev = 0, cus = 0;
        if (hipGetDevice(&dev) != hipSuccess || hipDeviceGetAttribute(&cus, hipDeviceAttributeMultiprocessorCount, dev) != hipSuccess) { grid = -1; return; }
        if (hipFuncSetAttribute((const void*)fwd, hipFuncAttributeMaxDynamicSharedMemorySize, LDS_BYTES) != hipSuccess) { fprintf(stderr, "kernel_launch: hipFuncSetAttribute failed\n"); grid = -1; return; }
        int per_cu = 0;
        if (hipOccupancyMaxActiveBlocksPerMultiprocessor(&per_cu, (const void*)fwd, 512, LDS_BYTES) != hipSuccess || per_cu < 1) fprintf(stderr, "kernel_launch: occupancy query says %d\n", per_cu);
        (void)hipGetLastError();
        grid = cus;
    }
    if (grid < 0) return;
    if (hipMemsetAsync((char*)d_ws + WS_CTL, 0, CTL_ZERO_BYTES, stream) != hipSuccess) return;
    Args a; memset(&a, 0, sizeof(a));
    for (int i = 0; i < 28; ++i) a.in[i] = (const float*)d_in[i];
    a.out = (float*)d_out; a.ws = (unsigned char*)d_ws;
#if MK_ONE_LAUNCH
    a.ph_lo = 0; a.ph_hi = N_PHASES;
    hipLaunchKernelGGL(fwd, dim3(grid), dim3(512), LDS_BYTES, stream, a);
#else
    for (int p = 0; p < N_PHASES; ++p) { a.ph_lo = p; a.ph_hi = p + 1; hipLaunchKernelGGL(fwd, dim3(grid), dim3(512), LDS_BYTES, stream, a); }
#endif
}
```

```cpp
#include <hip/hip_runtime.h>
#include <cstdio>
#include <cstdint>
#include <cstring>
namespace pg8 {
#define PG8_LAS __attribute__((address_space(3)))
typedef unsigned short bf16_t;
typedef short bf16x8 __attribute__((ext_vector_type(8)));
typedef float f32x4 __attribute__((ext_vector_type(4)));
typedef unsigned u32x4 __attribute__((ext_vector_type(4)));
constexpr int BM = 256, BK = 64, HALF = 128, HTB = HALF * BK * 2  , STAGE_BYTES = 8 * HTB, NXCD = 8, WGM = 8;

__host__ __device__ __forceinline__ int lds_byte(int r, int c) { const int st = (r >> 4) * 2 + (c >> 5), rr = r & 15, cc = c & 31, ob = rr * 64 + cc * 2; return st * 1024 + (ob ^ (((ob >> 9) & 1) << 5)); }
__host__ __device__ __forceinline__ void stage_rc(int b, int& R, int& C) { const int st = b / 1024, sb = b % 1024, swz = sb ^ (((sb >> 9) & 1) << 5); R = (st >> 1) * 16 + swz / 64; C = (st & 1) * 32 + (swz % 64) / 2; }
__host__ __device__ __forceinline__ int perm32(int rho) { const int n = rho >> 4, i = rho & 15; return 8 * (i >> 2) + 4 * n + (i & 3); }

struct Unit { int pm, pn; };
struct Gemm { const bf16_t* A; const bf16_t* Bt; int M, N, K; };

struct StaticOrder {
    int nM, nN, nwg, G, c;
    __host__ __device__ void init(int M, int N, int G_, int c_) { nM = M / BM; nN = N / BM; nwg = nM * nN; G = G_; c = c_; }
    __host__ __device__ bool next(int i, Unit& u) const {
        const long L = (long)i * G + c; if (L >= nwg) return false;
        int wgid = (int)L; { const int q = nwg / NXCD, r = nwg % NXCD, xcd = wgid % NXCD, off = wgid / NXCD; wgid = (xcd < r ? xcd * (q + 1) : r * (q + 1) + (xcd - r) * q) + off; }
        const int nig = WGM * nN, gid = wgid / nig, fm = gid * WGM, gsz = (nM - fm) < WGM ? (nM - fm) : WGM;
        u.pm = fm + ((wgid % nig) % gsz); u.pn = (wgid % nig) / gsz; return true;
    }
    __device__ __forceinline__ void a_ready(const Unit&) const {}
    __device__ __forceinline__ void done(const Unit&) const {}
};

__device__ __forceinline__ unsigned cvt_pk_bf16(float lo, float hi) { unsigned r; asm volatile("v_cvt_pk_bf16_f32 %0, %1, %2" : "=v"(r) : "v"(lo), "v"(hi)); return r; }
typedef float f32x2 __attribute__((ext_vector_type(2)));
typedef unsigned u32x2 __attribute__((ext_vector_type(2)));
struct EpiProj {
    static constexpr bool PERM = true, AFTER_DRAIN = false;
    bf16_t* O; int ldc; float* spec; int spec_tile;
    __device__ __forceinline__ void operator()(const f32x4 (&acc)[2][2][4][2], const Unit& u, int wr, int wc, int fr, int fq) const {
        const int row0 = u.pm * BM + wr * 64 + fr, col0 = u.pn * BM + wc * 32 + 8 * fq;
        if (u.pn == spec_tile) {
            float* sp0 = spec + (size_t)row0 * 256 + wc * 32 + 8 * fq;
#pragma unroll
            for (int ai = 0; ai < 2; ++ai)
#pragma unroll
                for (int m = 0; m < 4; ++m) { float* sp_p = sp0 + (size_t)(ai * HALF + m * 16) * 256;
#pragma unroll
                    for (int bj = 0; bj < 2; ++bj) { *(f32x4*)(sp_p + bj * HALF) = acc[ai][bj][m][0]; *(f32x4*)(sp_p + bj * HALF + 4) = acc[ai][bj][m][1]; } }
        }
        bf16_t* o0 = O + (size_t)row0 * ldc + col0;
#pragma unroll
        for (int ai = 0; ai < 2; ++ai)
#pragma unroll
            for (int m = 0; m < 4; ++m) { bf16_t* rowp = o0 + (size_t)(ai * HALF + m * 16) * ldc;
#pragma unroll
                for (int bj = 0; bj < 2; ++bj) { const f32x4 v0 = acc[ai][bj][m][0], v1 = acc[ai][bj][m][1];
                    u32x4 w; w.x = cvt_pk_bf16(v0[0], v0[1]); w.y = cvt_pk_bf16(v0[2], v0[3]); w.z = cvt_pk_bf16(v1[0], v1[1]); w.w = cvt_pk_bf16(v1[2], v1[3]);
                    *(u32x4*)(rowp + bj * HALF) = w; } }
    }
};
struct EpiQ {
    static constexpr bool PERM = true, AFTER_DRAIN = false;
    bf16_t* O; const float* cs;
    __device__ __forceinline__ void operator()(const f32x4 (&acc)[2][2][4][2], const Unit& u, int wr, int wc, int fr, int fq) const {
        const int row0 = u.pm * BM + wr * 64 + fr, col0 = u.pn * BM + wc * 32 + 8 * fq;
#pragma unroll
        for (int ai = 0; ai < 2; ++ai)
#pragma unroll
            for (int m = 0; m < 4; ++m) { const int row = row0 + ai * HALF + m * 16; bf16_t* rowp = O + (size_t)row * 1536 + col0;
#pragma unroll
                for (int bj = 0; bj < 2; ++bj) { f32x4 v0 = acc[ai][bj][m][0], v1 = acc[ai][bj][m][1];
                    const int d = (col0 + bj * HALF) % 192;
                    if (d >= 128) { const int i0 = (d - 128) >> 1; const f32x4* cp = (const f32x4*)(cs + (size_t)row * 64 + i0 * 2); const f32x4 c0 = cp[0], c1 = cp[1];
                        f32x4 r0, r1;
                        r0[0] = v0[0] * c0[0] - v0[1] * c0[1]; r0[1] = v0[1] * c0[0] + v0[0] * c0[1];
                        r0[2] = v0[2] * c0[2] - v0[3] * c0[3]; r0[3] = v0[3] * c0[2] + v0[2] * c0[3];
                        r1[0] = v1[0] * c1[0] - v1[1] * c1[1]; r1[1] = v1[1] * c1[0] + v1[0] * c1[1];
                        r1[2] = v1[2] * c1[2] - v1[3] * c1[3]; r1[3] = v1[3] * c1[2] + v1[2] * c1[3];
                        v0 = r0; v1 = r1; }
                    u32x4 w; w.x = cvt_pk_bf16(v0[0], v0[1]); w.y = cvt_pk_bf16(v0[2], v0[3]); w.z = cvt_pk_bf16(v1[0], v1[1]); w.w = cvt_pk_bf16(v1[2], v1[3]);
                    *(u32x4*)(rowp + bj * HALF) = w; } }
    }
};
struct EpiPlain {
    static constexpr bool PERM = true, AFTER_DRAIN = false;
    bf16_t* O; int ldc;
    __device__ __forceinline__ void operator()(const f32x4 (&acc)[2][2][4][2], const Unit& u, int wr, int wc, int fr, int fq) const {
        const int row0 = u.pm * BM + wr * 64 + fr, col0 = u.pn * BM + wc * 32 + 8 * fq;
#pragma unroll
        for (int ai = 0; ai < 2; ++ai)
#pragma unroll
            for (int m = 0; m < 4; ++m) { bf16_t* rowp = O + (size_t)(row0 + ai * HALF + m * 16) * ldc + col0;
#pragma unroll
                for (int bj = 0; bj < 2; ++bj) { const f32x4 v0 = acc[ai][bj][m][0], v1 = acc[ai][bj][m][1];
                    u32x4 w; w.x = cvt_pk_bf16(v0[0], v0[1]); w.y = cvt_pk_bf16(v0[2], v0[3]); w.z = cvt_pk_bf16(v1[0], v1[1]); w.w = cvt_pk_bf16(v1[2], v1[3]);
                    *(u32x4*)(rowp + bj * HALF) = w; } }
    }
};
struct EpiResid {
    static constexpr bool PERM = false, AFTER_DRAIN = false;
    const float* base; float* out; int ldc;
    __device__ __forceinline__ void operator()(const f32x4 (&acc)[2][2][4][2], const Unit& u, int wr, int wc, int fr, int fq) const {
        const int row0 = u.pm * BM + wr * 64 + fr, col0 = u.pn * BM + wc * 32 + 4 * fq;
#pragma unroll
        for (int ai = 0; ai < 2; ++ai)
#pragma unroll
            for (int m = 0; m < 4; ++m) { const size_t off = (size_t)(row0 + ai * HALF + m * 16) * ldc + col0;
#pragma unroll
                for (int bj = 0; bj < 2; ++bj)
#pragma unroll
                    for (int n = 0; n < 2; ++n) { const f32x4 bs = *(const f32x4*)(base + off + bj * HALF + n * 16); *(f32x4*)(out + off + bj * HALF + n * 16) = bs + acc[ai][bj][m][n]; } }
    }
};
template <class Epi, class Sched, bool ALIGN_EPI = false, bool SP2 = false>
__device__ __forceinline__ void gemm_phase(PG8_LAS unsigned char* lds, const Gemm g, const Sched& S, const Epi& E) {
    int tid_o = threadIdx.x; asm volatile("" : "+v"(tid_o));
    const int tid = tid_o, wid = __builtin_amdgcn_readfirstlane(tid >> 6), lane = tid & 63, wr = wid >> 2, wc = wid & 3, fr = lane & 15, fq = lane >> 4;
    const int K = g.K, nt = K / BK;
    unsigned voffA[2], voffB[2];
#pragma unroll
    for (int i = 0; i < 2; ++i) { int R, C; stage_rc(tid * 16 + i * 8192, R, C); const int Rb = Epi::PERM ? ((R & ~31) + perm32(R & 31)) : R;
        voffA[i] = (unsigned)(R * K + C) * 2u; voffB[i] = (unsigned)(Rb * K + C) * 2u; }
    const size_t kstep = (size_t)(BK * 2);
    const size_t hstep = (size_t)HALF * K * 2;
    const size_t tstep = 2 * hstep;
    const unsigned ldsw = (unsigned)wid * 1024u;
    const int aoff = lds_byte(wr * 64 + fr, fq * 8), boff = lds_byte(wc * 32 + fr, fq * 8);
#define PG8_SA(b, h) (((b) * 2 + (h)) * HTB)
#define PG8_SB(b, h) ((4 + (b) * 2 + (h)) * HTB)
#define PG8_STAGE(bufoff, gbase, voff) do { _Pragma("unroll") for (int _i = 0; _i < 2; ++_i) \
        __builtin_amdgcn_global_load_lds((const unsigned*)((const char*)(gbase) + (voff)[_i]), (PG8_LAS unsigned*)(lds + (bufoff) + ldsw + _i * 8192), 16, 0, 0); } while (0)
#define PG8_LDA(dst, b, h) do { _Pragma("unroll") for (int m = 0; m < 4; ++m) _Pragma("unroll") for (int k = 0; k < 2; ++k) dst[m][k] = *(const PG8_LAS bf16x8*)(lds + PG8_SA(b, h) + aoff + m * 2048 + k * 1024); } while (0)
#define PG8_LDB(dst, b, h) do { _Pragma("unroll") for (int n = 0; n < 2; ++n) _Pragma("unroll") for (int k = 0; k < 2; ++k) dst[n][k] = *(const PG8_LAS bf16x8*)(lds + PG8_SB(b, h) + boff + n * 2048 + k * 1024); } while (0)
#define PG8_MMA(ai, bj, At, Bt) do { __builtin_amdgcn_s_setprio(1); _Pragma("unroll") for (int m = 0; m < 4; ++m) _Pragma("unroll") for (int n = 0; n < 2; ++n) _Pragma("unroll") for (int k = 0; k < 2; ++k) \
        acc[ai][bj][m][n] = __builtin_amdgcn_mfma_f32_16x16x32_bf16(Bt[n][k], At[m][k], acc[ai][bj][m][n], 0, 0, 0); __builtin_amdgcn_s_setprio(0); } while (0)
#define PG8_WAIT_V(n) asm volatile("s_waitcnt vmcnt(" #n ")" ::: "memory")
#define PG8_WAIT_L(n) asm volatile("s_waitcnt lgkmcnt(" #n ")" ::: "memory")
#define PG8_BAR __builtin_amdgcn_s_barrier()
#define PG8_SCHED __builtin_amdgcn_sched_barrier(0)
    Unit cur, nxt; int ui = 0;
    if (!S.next(0, cur)) return;
    f32x4 acc[2][2][4][2];
#pragma unroll
    for (int a = 0; a < 2; ++a)
#pragma unroll
        for (int b = 0; b < 2; ++b)
#pragma unroll
            for (int m = 0; m < 4; ++m)
#pragma unroll
                for (int n = 0; n < 2; ++n) acc[a][b][m][n] = (f32x4){0.f, 0.f, 0.f, 0.f};
    bf16x8 At[4][2], B0[2][2], B1[2][2];
    const char* cA = (const char*)g.A + (size_t)cur.pm * tstep; const char* cB = (const char*)g.Bt + (size_t)cur.pn * tstep;
    S.a_ready(cur);
    if constexpr (SP2) {
        PG8_STAGE(PG8_SB(0, 0), cB, voffB); PG8_STAGE(PG8_SB(0, 1), cB + hstep, voffB); PG8_STAGE(PG8_SA(0, 0), cA, voffA); PG8_STAGE(PG8_SA(0, 1), cA + hstep, voffA);
        if (wr == 1) PG8_BAR;
        PG8_WAIT_V(2); PG8_BAR;
        PG8_STAGE(PG8_SB(1, 0), cB + kstep, voffB); PG8_STAGE(PG8_SA(1, 0), cA + kstep, voffA); PG8_STAGE(PG8_SB(1, 1), cB + hstep + kstep, voffB);
        PG8_WAIT_V(6); PG8_BAR;
    } else {
        PG8_STAGE(PG8_SB(0, 0), cB, voffB); PG8_STAGE(PG8_SA(0, 0), cA, voffA); PG8_STAGE(PG8_SB(0, 1), cB + hstep, voffB); PG8_STAGE(PG8_SA(0, 1), cA + hstep, voffA);
        if (wr == 1) PG8_BAR;
        PG8_WAIT_V(4); PG8_BAR;
        PG8_STAGE(PG8_SB(1, 0), cB + kstep, voffB); PG8_STAGE(PG8_SA(1, 0), cA + kstep, voffA); PG8_STAGE(PG8_SB(1, 1), cB + hstep + kstep, voffB);
        PG8_WAIT_V(6); PG8_BAR;
    }
    for (;;) {
        const bool has_next = S.next(ui + 1, nxt);
        const char* nA = has_next ? (const char*)g.A + (size_t)nxt.pm * tstep : cA; const char* nB = has_next ? (const char*)g.Bt + (size_t)nxt.pn * tstep : cB;
        for (int t = 0; t < nt; t += 2) {
            const bool last = (t == nt - 2);
            const char* a1 = cA + (size_t)(t + 1) * kstep;
            const char* a2 = last ? nA : cA + (size_t)(t + 2) * kstep; const char* b2 = last ? nB : cB + (size_t)(t + 2) * kstep;
            const char* a3 = a2 + kstep; const char* b3 = b2 + kstep;
            if (last && has_next) S.a_ready(nxt);
            if constexpr (SP2) {
            PG8_LDB(B0, 0, 0); PG8_LDB(B1, 0, 1); PG8_SCHED; PG8_LDA(At, 0, 0); PG8_STAGE(PG8_SA(1, 1), a1 + hstep, voffA);
            PG8_WAIT_V(8); PG8_WAIT_L(0); PG8_BAR; PG8_MMA(0, 0, At, B0); PG8_MMA(0, 1, At, B1); PG8_BAR; PG8_SCHED;
            PG8_LDA(At, 0, 1); PG8_STAGE(PG8_SB(0, 0), b2, voffB); PG8_STAGE(PG8_SB(0, 1), b2 + hstep, voffB); PG8_STAGE(PG8_SA(0, 0), a2, voffA);
            PG8_WAIT_V(8); PG8_WAIT_L(0); PG8_BAR; PG8_MMA(1, 0, At, B0); PG8_MMA(1, 1, At, B1); PG8_BAR; PG8_SCHED;
            PG8_LDB(B0, 1, 0); PG8_LDB(B1, 1, 1); PG8_SCHED; PG8_LDA(At, 1, 0); PG8_STAGE(PG8_SA(0, 1), a2 + hstep, voffA);
            PG8_WAIT_V(8); PG8_WAIT_L(0); PG8_BAR; PG8_MMA(0, 0, At, B0); PG8_MMA(0, 1, At, B1); PG8_BAR; PG8_SCHED;
            PG8_LDA(At, 1, 1); PG8_STAGE(PG8_SB(1, 0), b3, voffB); PG8_STAGE(PG8_SB(1, 1), b3 + hstep, voffB); PG8_STAGE(PG8_SA(1, 0), a3, voffA);
            PG8_WAIT_V(8); PG8_WAIT_L(0); PG8_BAR; PG8_MMA(1, 0, At, B0); PG8_MMA(1, 1, At, B1); PG8_BAR; PG8_SCHED;
            } else {
            PG8_LDB(B0, 0, 0); PG8_SCHED; PG8_LDA(At, 0, 0); PG8_STAGE(PG8_SA(1, 1), a1 + hstep, voffA);
            PG8_WAIT_L(8); PG8_BAR; PG8_WAIT_L(0); PG8_MMA(0, 0, At, B0); PG8_BAR; PG8_SCHED;
            PG8_LDB(B1, 0, 1); PG8_STAGE(PG8_SB(0, 0), b2, voffB);
            PG8_BAR; PG8_WAIT_L(0); PG8_MMA(0, 1, At, B1); PG8_BAR;
            PG8_LDA(At, 0, 1); PG8_STAGE(PG8_SA(0, 0), a2, voffA);
            PG8_BAR; PG8_WAIT_L(0); PG8_MMA(1, 0, At, B0); PG8_BAR; PG8_SCHED;
            PG8_STAGE(PG8_SB(0, 1), b2 + hstep, voffB);
            PG8_WAIT_V(6); PG8_BAR; PG8_MMA(1, 1, At, B1); PG8_BAR;
            PG8_LDB(B0, 1, 0); PG8_SCHED; PG8_LDA(At, 1, 0); PG8_STAGE(PG8_SA(0, 1), a2 + hstep, voffA);
            PG8_WAIT_L(8); PG8_BAR; PG8_WAIT_L(0); PG8_MMA(0, 0, At, B0); PG8_BAR; PG8_SCHED;
            PG8_LDB(B1, 1, 1); PG8_STAGE(PG8_SB(1, 0), b3, voffB);
            PG8_BAR; PG8_WAIT_L(0); PG8_MMA(0, 1, At, B1); PG8_BAR;
            PG8_LDA(At, 1, 1); PG8_STAGE(PG8_SA(1, 0), a3, voffA);
            PG8_BAR; PG8_WAIT_L(0); PG8_MMA(1, 0, At, B0); PG8_BAR; PG8_SCHED;
            PG8_STAGE(PG8_SB(1, 1), b3 + hstep, voffB);
            PG8_WAIT_V(6); PG8_BAR; PG8_MMA(1, 1, At, B1); PG8_BAR;
            }
        }
        if constexpr (ALIGN_EPI) { if (wr == 0) PG8_BAR; }
        if constexpr (!Epi::AFTER_DRAIN) { E(acc, cur, wr, wc, fr, fq); S.done(cur); }
        if (!has_next) break;
#pragma unroll
        for (int a = 0; a < 2; ++a)
#pragma unroll
            for (int b = 0; b < 2; ++b)
#pragma unroll
                for (int m = 0; m < 4; ++m)
#pragma unroll
                    for (int n = 0; n < 2; ++n) acc[a][b][m][n] = (f32x4){0.f, 0.f, 0.f, 0.f};
        cur = nxt; cA = nA; cB = nB; ++ui;
        if constexpr (ALIGN_EPI) { if (wr == 1) PG8_BAR; }
    }
    PG8_WAIT_V(0);
    if constexpr (!ALIGN_EPI) { if (wr == 0) PG8_BAR; }
    PG8_BAR;
    if constexpr (Epi::AFTER_DRAIN) { E.fused(acc, cur, wr, wc, fr, fq, lds, wid, lane); S.done(cur); }
#undef PG8_SA
#undef PG8_SB
#undef PG8_STAGE
#undef PG8_LDA
#undef PG8_LDB
#undef PG8_MMA
#undef PG8_WAIT_V
#undef PG8_WAIT_L
#undef PG8_BAR
#undef PG8_SCHED
}
}
#define GAS __attribute__((address_space(1)))
#define LAS __attribute__((address_space(3)))
typedef unsigned short bf16;
typedef unsigned v4u __attribute__((ext_vector_type(4)));
typedef float f32x4 __attribute__((ext_vector_type(4)));
typedef short bf16x8 __attribute__((ext_vector_type(8)));
typedef GAS unsigned gu32;
typedef GAS unsigned long long gu64;
#define RLX_AGENT __ATOMIC_RELAXED, __HIP_MEMORY_SCOPE_AGENT
#define LDS_WAIT() asm volatile("s_waitcnt lgkmcnt(0)" ::: "memory")
#define VM_WAIT() asm volatile("s_waitcnt vmcnt(0)" ::: "memory")
__device__ __forceinline__ unsigned long long rt() { return __builtin_amdgcn_s_memrealtime(); }
__device__ __forceinline__ unsigned f2bf(float f) { unsigned u = __builtin_bit_cast(unsigned, f); return (u + 0x7fffu + ((u >> 16) & 1u)) >> 16; }
__device__ __forceinline__ unsigned pk2(float lo, float hi) { return f2bf(lo) | (f2bf(hi) << 16); }

#define XB_TMO      128
#define XB_XCNT(j)  (256  + 64 * (j))
#define XB_XSUB(j)  (1280 + 64 * (j))
#define XB_XGEN(j)  (2304 + 64 * (j))
#define XB_TOP      3328
#define XB_TOPGEN   3392
#define XCD_BAR_WORDS 3456
#define XB_SPIN_CAP (1u << 18)

__device__ __forceinline__ unsigned xb_ld(unsigned* p)              { return __hip_atomic_load(p, __ATOMIC_RELAXED, __HIP_MEMORY_SCOPE_AGENT); }
__device__ __forceinline__ unsigned xb_add(unsigned* p, unsigned v) { return __hip_atomic_fetch_add(p, v, __ATOMIC_RELAXED, __HIP_MEMORY_SCOPE_AGENT); }
__device__ __forceinline__ unsigned xb_xcc_id() { return (unsigned)__builtin_amdgcn_s_getreg((3 << 11) | 20) & 0xFu; }
#define XB_SPIN(cond, bar) do { unsigned _sp = 0; while (cond) { __builtin_amdgcn_s_sleep(1); \
    if ((++_sp & 255u) == 0u) { if (xb_ld(&(bar)[XB_TMO])) break; if (_sp > XB_SPIN_CAP) { atomicAdd(&(bar)[XB_TMO], 1u); break; } } } } while (0)

struct XcdBarrier {
    unsigned* bar; unsigned x;
    volatile LAS unsigned* st;
};

__device__ __forceinline__ XcdBarrier xcd_barrier_post(unsigned* bar, volatile LAS unsigned* st) {
    XcdBarrier b; b.bar = bar; b.x = xb_xcc_id(); b.st = st;
    if (threadIdx.x == 0) (void)xb_add(&bar[XB_XCNT(b.x)], 1u);
    return b;
}
__device__ __forceinline__ void xcd_barrier_complete(unsigned* bar, unsigned x, unsigned& nloc, unsigned& nx) {
    const unsigned G = gridDim.x * gridDim.y * gridDim.z;
    unsigned sum, cnt, mine, sp = 0u;
    for (;;) {
        sum = 0u; cnt = 0u; mine = 0u;
#pragma unroll
        for (unsigned j = 0; j < 16; ++j) { const unsigned c = xb_ld(&bar[XB_XCNT(j)]); sum += c; cnt += (c > 0u) ? 1u : 0u; mine = (j == x) ? c : mine; }
        if (sum == G) break;
        __builtin_amdgcn_s_sleep(1);
        if ((++sp & 255u) == 0u) { if (xb_ld(&bar[XB_TMO])) break; if (sp > XB_SPIN_CAP) { atomicAdd(&bar[XB_TMO], 1u); break; } }
    }
    nloc = mine > 0u ? mine : 1u; nx = cnt > 0u ? cnt : 1u;
}

__device__ __forceinline__ void xcd_barrier(const XcdBarrier& b) {
    asm volatile("s_waitcnt vmcnt(0)" ::: "memory");
    __syncthreads();
    if (threadIdx.x == 0) {
        unsigned* bar = b.bar;
        __builtin_amdgcn_s_waitcnt(0);
        unsigned nloc = b.st[0], nx = b.st[1];
        if (nloc == 0u) { xcd_barrier_complete(bar, b.x, nloc, nx); b.st[0] = nloc; b.st[1] = nx; }
        const unsigned old = xb_add(&bar[XB_XSUB(b.x)], 1u);
        const unsigned gen = old / nloc;
        if (old + 1u == (gen + 1u) * nloc) {
            __builtin_amdgcn_fence(__ATOMIC_RELEASE, "agent");
            asm volatile("s_waitcnt vmcnt(0)" ::: "memory");
            const unsigned og = xb_add(&bar[XB_TOP], 1u);
            const unsigned tg = og / nx;
            if (og + 1u == (tg + 1u) * nx) xb_add(&bar[XB_TOPGEN], 1u);
            else XB_SPIN(xb_ld(&bar[XB_TOPGEN]) == tg, bar);
            __builtin_amdgcn_fence(__ATOMIC_ACQUIRE, "agent");
            xb_add(&bar[XB_XGEN(b.x)], 1u);
            asm volatile("s_waitcnt vmcnt(0)" ::: "memory");
        } else {
            XB_SPIN(xb_ld(&bar[XB_XGEN(b.x)]) == gen, bar);
            __builtin_amdgcn_fence(__ATOMIC_ACQUIRE, "agent");
            asm volatile("s_waitcnt vmcnt(0)" ::: "memory");
        }
    }
    __syncthreads();
}
constexpr int BATCH = 4, T = 4096, DM = 2048, DEPTH = 4, M = BATCH * T;
constexpr int D_IN = 6600, NPROJ = 6656;
constexpr int SC_MLQK = 0, SC_MLV = 1024, SC_MLI = 1536, SC_MLF = 1540, SC_MLO = 1544, SC_MLZ = 2056, SC_CQ = 2568, SC_CKV = 3080, SC_KR = 3336, SC_MLAZ = 3400, SC_RW = 4424, SC_RWZ = 6088;
constexpr int PC_MLQK = 0, PC_MLV = 1024, PC_MLO = 1536, PC_MLZ = 2048, PC_CQ = 2560, PC_CKV = 3072, PC_MLAZ = 3328, PC_RW = 4352, PC_SPEC = 5888, PC_RWZ = 6144;
constexpr int SPEC_TILE = PC_SPEC / 256;
constexpr int NQ = 1536, NKV = 2048;
constexpr float NORM_EPS = 1e-6f, RW_GN_EPS = 64e-5f;
typedef unsigned short bf16_t;
__device__ __forceinline__ float bf2f(unsigned v) { return __uint_as_float(v << 16); }
__device__ __forceinline__ float wave_sum(float v) {
#pragma unroll
    for (int o = 1; o < 64; o <<= 1) v += __shfl_xor(v, o);
    return v;
}
__device__ __forceinline__ float sigmoidf_(float x) { return 1.f / (1.f + __expf(-x)); }
__device__ __forceinline__ float siluf_(float x) { return x / (1.f + __expf(-x)); }
__device__ __forceinline__ float softplusf_(float x) { return fmaxf(x, 0.f) + log1pf(__expf(-fabsf(x))); }

namespace att {
typedef unsigned short bf16_t;
typedef short bf16x8 __attribute__((ext_vector_type(8)));
typedef short s16x4 __attribute__((ext_vector_type(4)));
typedef float f32x16 __attribute__((ext_vector_type(16)));
typedef float f32x4 __attribute__((ext_vector_type(4)));
typedef unsigned u32x4 __attribute__((ext_vector_type(4)));
constexpr int NW = 8, QBLK = 32, KVBLK = 64, QB = NW * QBLK;
constexpr int QP = 1536, KVP = 2048, KRP = 64, OP = 2048;
constexpr int SHM_V = KVBLK * 128 * 2, SHM_K = KVBLK * 128 * 2, SHM_R = KVBLK * 64 * 2;
constexpr int OFF_V = 0, OFF_K = 2 * SHM_V, OFF_R = OFF_K + SHM_K, OFF_WS = OFF_R + SHM_R, OFF_Q = OFF_WS + NW * 64 * 4, LDS_BYTES = OFF_Q + NW * 12288;
constexpr float SCALE = 0.07216878364870322f;
constexpr float THR = 8.f;
constexpr unsigned WBIG = 1u << 30;
#define KSWZ(row, colB) ((row) * 256 + ((colB) ^ (((row) & 7) << 4)))
#define RSWZ(row, colB) ((row) * 128 + ((colB) ^ (((row) & 7) << 4)))
#define SBAR() __builtin_amdgcn_sched_barrier(0)
__device__ __forceinline__ int v_st(int k, int c) { const int kk = (k & ~0xC) | ((k & 4) << 1) | ((k & 8) >> 1); return ((kk >> 3) * 4 + (c >> 5)) * 512 + ((kk & 7) * 32 + (c & 31)) * 2; }
__device__ __forceinline__ int v_rd_base(int lane) { return ((lane & 3) << 3) | (((lane >> 2) & 3) << 6) | (((lane >> 4) & 1) << 5) | (((lane >> 5) & 1) << 8); }
constexpr int v_rd_off(int d0, int ks, int half) { return d0 * 512 + ks * 4096 + half * 2048; }
__device__ __forceinline__ int crow(int r, int hi) { return (r & 3) + 8 * (r >> 2) + 4 * hi; }
__device__ __forceinline__ unsigned cvtpk(float lo, float hi) { unsigned r; asm volatile("v_cvt_pk_bf16_f32 %0, %1, %2" : "=v"(r) : "v"(lo), "v"(hi)); return r; }
__device__ __forceinline__ bf16x8 load8(const bf16_t* p) { return *reinterpret_cast<const bf16x8*>(p); }
__device__ __forceinline__ float bf2f(bf16_t v) { return __uint_as_float((unsigned)v << 16); }
__device__ __forceinline__ void mask_tile(f32x16& p0, f32x16& p1, int dq, unsigned W) {
    const float NEG = -__builtin_inff();
#pragma unroll
    for (int r = 0; r < 16; ++r) {
        const int c = (r & 3) + 8 * (r >> 2);
        if ((unsigned)(dq - c) >= W) p0[r] = NEG;
        if ((unsigned)(dq - c - 32) >= W) p1[r] = NEG;
    }
}
__device__ __forceinline__ void partialSM(f32x16& p0, f32x16& p1, float& m_reg, float& mn, float& alpha) {
    float pmax = p0[0]; for (int r = 1; r < 16; ++r) pmax = fmaxf(pmax, p0[r]); for (int r = 0; r < 16; ++r) pmax = fmaxf(pmax, p1[r]);
    { auto rr = __builtin_amdgcn_permlane32_swap(__float_as_uint(pmax), __float_as_uint(pmax), false, false);
      pmax = fmaxf(__uint_as_float(rr[0]), __uint_as_float(rr[1])); }
    constexpr float C2 = 1.4426950408889634f * SCALE;
    if (__builtin_expect(__all((pmax - m_reg) * SCALE <= THR), 1)) { mn = m_reg; alpha = 1.f; }
    else { mn = fmaxf(m_reg, pmax); alpha = __builtin_amdgcn_exp2f((m_reg - mn) * C2); m_reg = mn; }
    const float mnL = -mn * C2;
    for (int r = 0; r < 16; ++r) p0[r] = fmaf(p0[r], C2, mnL); for (int r = 0; r < 16; ++r) p1[r] = fmaf(p1[r], C2, mnL);
    for (int r = 0; r < 16; ++r) p0[r] = __builtin_amdgcn_exp2f(p0[r]);
}
__device__ __forceinline__ void finishSM(f32x16& p0, f32x16& p1, float alpha, float& l_reg, bf16x8& pa0, bf16x8& pa1, bf16x8& pa2, bf16x8& pa3) {
    for (int r = 0; r < 16; ++r) p1[r] = __builtin_amdgcn_exp2f(p1[r]);
    float ps = 0; for (int r = 0; r < 16; ++r) ps += p0[r]; for (int r = 0; r < 16; ++r) ps += p1[r];
    { auto rr = __builtin_amdgcn_permlane32_swap(__float_as_uint(ps), __float_as_uint(ps), false, false);
      ps = __uint_as_float(rr[0]) + __uint_as_float(rr[1]); }
    l_reg = l_reg * alpha + ps;
#define PK4(P, B_, OUT) do { unsigned a0 = cvtpk(P[B_+0], P[B_+1]), a1 = cvtpk(P[B_+2], P[B_+3]);                          \
        unsigned b0 = cvtpk(P[B_+4], P[B_+5]), b1 = cvtpk(P[B_+6], P[B_+7]);                                             \
        auto r0 = __builtin_amdgcn_permlane32_swap(a0, b0, false, false); auto r1 = __builtin_amdgcn_permlane32_swap(a1, b1, false, false); \
        u32x4 w = {r0[0], r1[0], r0[1], r1[1]}; OUT = *reinterpret_cast<bf16x8*>(&w); } while (0)
    PK4(p0, 0, pa0); PK4(p0, 8, pa1); PK4(p1, 0, pa2); PK4(p1, 8, pa3);
#undef PK4
}
__device__ __forceinline__ void qkt(f32x16& p0, f32x16& p1, const char* K_lds, const char* R_lds, const char* Qw, int r32, int hi) {
    p0 = f32x16{}; p1 = f32x16{};
    const char* kb[4]; const char* rb[4];
#pragma unroll
    for (int dd = 0; dd < 4; ++dd) { kb[dd] = K_lds + KSWZ(r32, (dd * 16 + hi * 8) * 2); rb[dd] = R_lds + RSWZ(r32, (dd * 16 + hi * 8) * 2); }
#pragma unroll
    for (int d0 = 0; d0 < 8; ++d0) { const char* a = kb[d0 & 3] + (d0 >> 2) * 128;
        bf16x8 b0 = *reinterpret_cast<const bf16x8*>(a);
        bf16x8 b1 = *reinterpret_cast<const bf16x8*>(a + 32 * 256);
        bf16x8 q = *reinterpret_cast<const bf16x8*>(Qw + d0 * 1024);
        p0 = __builtin_amdgcn_mfma_f32_32x32x16_bf16(b0, q, p0, 0, 0, 0);
        p1 = __builtin_amdgcn_mfma_f32_32x32x16_bf16(b1, q, p1, 0, 0, 0); }
#pragma unroll
    for (int e = 0; e < 4; ++e) { const char* a = rb[e];
        bf16x8 b0 = *reinterpret_cast<const bf16x8*>(a);
        bf16x8 b1 = *reinterpret_cast<const bf16x8*>(a + 32 * 128);
        bf16x8 q = *reinterpret_cast<const bf16x8*>(Qw + (8 + e) * 1024);
        p0 = __builtin_amdgcn_mfma_f32_32x32x16_bf16(b0, q, p0, 0, 0, 0);
        p1 = __builtin_amdgcn_mfma_f32_32x32x16_bf16(b1, q, p1, 0, 0, 0); }
}
template <int VB>
__device__ __forceinline__ void pv_tile(f32x16* o, int vb0, bf16x8 pa0, bf16x8 pa1, bf16x8 pa2, bf16x8 pa3) {
#define TRRD(dst, off) asm volatile("ds_read_b64_tr_b16 %0, %1 offset:%2" : "=&v"(dst) : "v"(vb0), "i"(off) : "memory")
#define PV_D0(d0) do { s16x4 l0, l1, l2, l3, h0, h1, h2, h3; constexpr int b_ = OFF_V + VB * SHM_V + v_rd_off(d0, 0, 0); \
        TRRD(l0, b_); TRRD(h0, b_ + 2048); TRRD(l1, b_ + 4096); TRRD(h1, b_ + 6144); TRRD(l2, b_ + 8192); TRRD(h2, b_ + 10240); TRRD(l3, b_ + 12288); TRRD(h3, b_ + 14336); \
        asm volatile("s_waitcnt lgkmcnt(0)" ::: "memory"); SBAR();   \
        o[d0] = __builtin_amdgcn_mfma_f32_32x32x16_bf16(pa0, (bf16x8){l0[0], l0[1], l0[2], l0[3], h0[0], h0[1], h0[2], h0[3]}, o[d0], 0, 0, 0);   \
        o[d0] = __builtin_amdgcn_mfma_f32_32x32x16_bf16(pa1, (bf16x8){l1[0], l1[1], l1[2], l1[3], h1[0], h1[1], h1[2], h1[3]}, o[d0], 0, 0, 0);   \
        o[d0] = __builtin_amdgcn_mfma_f32_32x32x16_bf16(pa2, (bf16x8){l2[0], l2[1], l2[2], l2[3], h2[0], h2[1], h2[2], h2[3]}, o[d0], 0, 0, 0);   \
        o[d0] = __builtin_amdgcn_mfma_f32_32x32x16_bf16(pa3, (bf16x8){l3[0], l3[1], l3[2], l3[3], h3[0], h3[1], h3[2], h3[3]}, o[d0], 0, 0, 0); } while (0)
    PV_D0(0); PV_D0(1); PV_D0(2); PV_D0(3);
#undef PV_D0
#undef TRRD
}
struct BlockRef { const bf16_t* Q; const bf16_t* K; const bf16_t* V; const bf16_t* KR; bf16_t* O; const bf16_t* Z; const float* CSq; int P0; };
struct Seam { bf16x8 qr[12]; bf16x8 st_v0, st_v1, st_k0, st_k1, st_r; };
#define ROWKV(p, k0, rr) ((p) + (size_t)((k0) + (rr)) * KVP + sc)
#define VMW() asm volatile("s_waitcnt vmcnt(0)" ::: "memory")
#define VMWN(n) asm volatile("s_waitcnt vmcnt(%0)" :: "i"(n) : "memory")
#define SLOAD_H(Kp, Vp, Rp, k0) do { S.st_v0 = load8(ROWKV(Vp, k0, sr)); S.st_v1 = load8(ROWKV(Vp, k0, 32 + sr));              \
                         S.st_k0 = load8(ROWKV(Kp, k0, sr)); S.st_k1 = load8(ROWKV(Kp, k0, 32 + sr)); S.st_r = load8((Rp) + (size_t)((k0) + rr_) * KRP + rc_); } while (0)
#define SWRITE_HK() do { *(bf16x8*)(K_lds + kws) = S.st_k0; *(bf16x8*)(K_lds + kws + 32 * 256) = S.st_k1; *(bf16x8*)(R_lds + rws) = S.st_r; } while (0)
#define SWRITE_HV(bf) do { *(bf16x8*)(V_lds + (bf) * SHM_V + vst0) = S.st_v0; *(bf16x8*)(V_lds + (bf) * SHM_V + vst1) = S.st_v1; } while (0)
#define SWRITE_H(bf) do { SWRITE_HV(bf); SWRITE_HK(); } while (0)
__device__ __forceinline__ void attn_prime(const BlockRef& cur, char* lds, Seam& S) {
    int tid_o = threadIdx.x; asm volatile("" : "+v"(tid_o));
    const int tid = tid_o, wid = __builtin_amdgcn_readfirstlane(tid >> 6), lane = tid & 63, r32 = lane & 31, hi = lane >> 5;
    const int sr = tid >> 4, sc = (tid & 15) * 8, kws = KSWZ(sr, sc * 2), rr_ = tid >> 3, rc_ = (tid & 7) * 8, rws = RSWZ(rr_, rc_ * 2);
    char* K_lds = lds + OFF_K; char* R_lds = lds + OFF_R;
#pragma unroll
    for (int d0 = 0; d0 < 12; ++d0) S.qr[d0] = load8(cur.Q + (size_t)(wid * QBLK + r32) * QP + d0 * 16 + hi * 8);
    SLOAD_H(cur.K, cur.V, cur.KR, 0); VMW(); SWRITE_HK();
    __syncthreads();
}
__device__ __forceinline__ void attn_block(const BlockRef& cur, const BlockRef& nxt, char* lds, Seam& S) {
    int tid_o = threadIdx.x; asm volatile("" : "+v"(tid_o));
    const int tid = tid_o, wid = __builtin_amdgcn_readfirstlane(tid >> 6), lane = tid & 63, r32 = lane & 31, hi = lane >> 5;
    const int NT = cur.P0 / KVBLK + 4;
    const int qlo = cur.P0 + wid * QBLK, qm = qlo + r32 - 4 * hi;
    char* V_lds = lds + OFF_V; char* K_lds = lds + OFF_K; char* R_lds = lds + OFF_R;
    float* ws = (float*)(lds + OFF_WS) + wid * 64; float* li_l = ws, * al_l = ws + 32;
    float m_reg = -1e30f, l_reg = 0; f32x16 o[4] = {};
    const int sr = tid >> 4, sc = (tid & 15) * 8, vst0 = v_st(sr, sc), vst1 = v_st(32 + sr, sc), kws = KSWZ(sr, sc * 2), rr_ = tid >> 3, rc_ = (tid & 7) * 8, rws = RSWZ(rr_, rc_ * 2);
    const int vb0 = (int)(uintptr_t)lds + v_rd_base(lane);
    char* Qw = lds + OFF_Q + wid * 12288 + lane * 16;
    const bf16_t* Kh = cur.K; const bf16_t* Vh = cur.V; const bf16_t* Rh = cur.KR;
#define RESC(a) do { if (__any((a) < 1.f)) { if (hi == 0) al_l[r32] = (a); asm volatile("s_waitcnt lgkmcnt(0)" ::: "memory");              \
                     for (int d_ = 0; d_ < 4; ++d_) for (int r = 0; r < 16; ++r) o[d_][r] *= al_l[crow(r, hi)]; } } while (0)
#define KBASE(t) ((t) * KVBLK)
#define MASKT(P0_, P1_, t) do { const int kb_ = KBASE(t); if (kb_ + KVBLK - 1 > qlo) mask_tile(P0_, P1_, qm - kb_, WBIG); } while (0)
    constexpr int NQL = 12;
#define SEAM_K0() do { VMWN(NQL); SWRITE_HK(); SBAR(); } while (0)
    f32x16 pA0, pA1, pB0, pB1; float mnA, mnB, alA, alB; bf16x8 pa0, pa1, pa2, pa3;
#pragma unroll
    for (int e = 0; e < 4; ++e) { const f32x4* cp = (const f32x4*)(cur.CSq + (size_t)(wid * QBLK + r32) * 64 + (e * 8 + hi * 4) * 2); const f32x4 c0 = cp[0], c1 = cp[1];
        const bf16x8 raw = S.qr[8 + e]; float x[8];
#pragma unroll
        for (int j = 0; j < 8; ++j) x[j] = __uint_as_float((unsigned)(unsigned short)raw[j] << 16);
        u32x4 w;
        w.x = cvtpk(x[0] * c0[0] - x[1] * c0[1], x[1] * c0[0] + x[0] * c0[1]); w.y = cvtpk(x[2] * c0[2] - x[3] * c0[3], x[3] * c0[2] + x[2] * c0[3]);
        w.z = cvtpk(x[4] * c1[0] - x[5] * c1[1], x[5] * c1[0] + x[4] * c1[1]); w.w = cvtpk(x[6] * c1[2] - x[7] * c1[3], x[7] * c1[2] + x[6] * c1[3]);
        S.qr[8 + e] = *reinterpret_cast<bf16x8*>(&w); }
#pragma unroll
    for (int d0 = 0; d0 < 12; ++d0) *(bf16x8*)(Qw + d0 * 1024) = S.qr[d0];
    SWRITE_HV(0); SBAR();
    SLOAD_H(Kh, Vh, Rh, KBASE(1));
    SBAR(); qkt(pA0, pA1, K_lds, R_lds, Qw, r32, hi);
    MASKT(pA0, pA1, 0); partialSM(pA0, pA1, m_reg, mnA, alA);
    __syncthreads();
    VMW(); SWRITE_H(1);
    __syncthreads();
#define HALF_STEP(PX0, PX1, mnX, alX, PY0, PY1, alY, t, VB, SB) do {                                                          \
        SBAR(); qkt(PX0, PX1, K_lds, R_lds, Qw, r32, hi);                                                                     \
        finishSM(PY0, PY1, alY, l_reg, pa0, pa1, pa2, pa3); SBAR();                                                           \
        if ((t) + 1 < NT) { SLOAD_H(Kh, Vh, Rh, KBASE((t) + 1)); SBAR(); }                                                    \
        pv_tile<VB>(o, vb0, pa0, pa1, pa2, pa3); MASKT(PX0, PX1, (t)); partialSM(PX0, PX1, m_reg, mnX, alX);                  \
        __syncthreads();                                                                                                      \
        if ((t) + 1 < NT) { VMW(); SWRITE_H(SB); }                                                                            \
        RESC(alX); __syncthreads(); } while (0)
    for (int t = 1; t + 1 < NT; t += 2) {
        HALF_STEP(pB0, pB1, mnB, alB, pA0, pA1, alA, t, 0, 0);
        HALF_STEP(pA0, pA1, mnA, alA, pB0, pB1, alB, t + 1, 1, 1);
    }
    SBAR(); qkt(pB0, pB1, K_lds, R_lds, Qw, r32, hi); SBAR();
    SLOAD_H(nxt.K, nxt.V, nxt.KR, 0); SBAR();
    finishSM(pA0, pA1, alA, l_reg, pa0, pa1, pa2, pa3); SBAR();
    pv_tile<0>(o, vb0, pa0, pa1, pa2, pa3);
    MASKT(pB0, pB1, NT - 1); partialSM(pB0, pB1, m_reg, mnB, alB); __syncthreads(); RESC(alB);
    finishSM(pB0, pB1, alB, l_reg, pa0, pa1, pa2, pa3); SBAR(); pv_tile<1>(o, vb0, pa0, pa1, pa2, pa3);
    SBAR();
#pragma unroll
    for (int d0 = 0; d0 < 12; ++d0) S.qr[d0] = load8(nxt.Q + (size_t)(wid * QBLK + r32) * QP + d0 * 16 + hi * 8);
    SBAR(); SEAM_K0();
    if (hi == 0) li_l[r32] = l_reg; asm volatile("s_waitcnt lgkmcnt(0)" ::: "memory");
    float rli[16];
#pragma unroll
    for (int r = 0; r < 16; ++r) rli[r] = __builtin_amdgcn_rcpf(li_l[crow(r, hi)]);
    bf16_t* Ow = cur.O + (size_t)(wid * QBLK) * OP; const bf16_t* Zw = cur.Z + (size_t)(wid * QBLK) * NPROJ;
#pragma unroll
    for (int r = 0; r < 16; ++r) { const int orow = crow(r, hi);
#pragma unroll
        for (int d0 = 0; d0 < 4; ++d0) { const float z = bf2f(Zw[(size_t)orow * NPROJ + d0 * 32 + r32]);
            const float v = o[d0][r] * rli[r] * (z / (1.f + __expf(-z)));
            const float vn = __shfl_xor(v, 1);
            if ((r32 & 1) == 0) *(unsigned*)(Ow + (size_t)orow * OP + d0 * 32 + r32) = cvtpk(v, vn); } }
    __syncthreads();
#undef RESC
#undef KBASE
#undef MASKT
#undef SEAM_K0
#undef HALF_STEP
}
#undef ROWKV
#undef VMW
#undef VMWN
#undef SLOAD_H
#undef SWRITE_HK
#undef SWRITE_HV
#undef SWRITE_H
#undef KSWZ
#undef RSWZ
#undef SBAR
}
namespace mm {
typedef short bf16x8 __attribute__((ext_vector_type(8)));
typedef float f32x4 __attribute__((ext_vector_type(4)));
typedef unsigned u32x2 __attribute__((ext_vector_type(2)));
#define MM_LAS __attribute__((address_space(3)))
__device__ __forceinline__ unsigned cvtpk(float lo, float hi) { unsigned r; asm volatile("v_cvt_pk_bf16_f32 %0, %1, %2" : "=v"(r) : "v"(lo), "v"(hi)); return r; }
template <int NK>
__device__ __forceinline__ void blk(f32x4& acc, const MM_LAS unsigned char* A, int apitch, const MM_LAS unsigned char* Bt, int bpitch, int lane) {
    const MM_LAS unsigned char* ap = A + (lane & 15) * apitch + (lane >> 4) * 16;
    const MM_LAS unsigned char* bp = Bt + (lane & 15) * bpitch + (lane >> 4) * 16;
#pragma unroll
    for (int ks = 0; ks < NK; ++ks) { const bf16x8 a = *(const MM_LAS bf16x8*)(ap + ks * 64), b = *(const MM_LAS bf16x8*)(bp + ks * 64); acc = __builtin_amdgcn_mfma_f32_16x16x32_bf16(a, b, acc, 0, 0, 0); }
}
__device__ __forceinline__ void store_T(const f32x4& acc, MM_LAS unsigned char* img, int pitch, int jbase, int ibase, int lane) {
    u32x2 w; w.x = cvtpk(acc[0], acc[1]); w.y = cvtpk(acc[2], acc[3]);
    *(MM_LAS u32x2*)(img + (jbase + (lane & 15)) * pitch + (ibase + 4 * (lane >> 4)) * 2) = w;
}
__device__ __forceinline__ float bfl(unsigned short v) { return __uint_as_float((unsigned)v << 16); }
__device__ __forceinline__ unsigned short f2b(float f) { return (unsigned short)(cvtpk(f, 0.f) & 0xffffu); }
}

namespace mlk {
constexpr int PQ = 272, PS = 144;
constexpr int O_QI = 0, O_KI = 17408, O_WKT = 34816, O_VT = 53248, O_CI = 73984, O_SI = 113152, O_TAB = 122368, LDS_END = 124416;
constexpr int HBP = 132;
}
__device__ __forceinline__ void mlstm_unit(unsigned char* lds_g, int b, int h, const bf16_t* QKC, const bf16_t* PROJ, const float* LI, const float* LF, const float* ng, bf16_t* MIXED) {
    using namespace mlk; using mm::f32x4; using mm::bf16x8;
    MM_LAS unsigned char* L = (MM_LAS unsigned char*)lds_g;
    int tid_o = threadIdx.x; asm volatile("" : "+v"(tid_o));
    const int tid = tid_o, lane = tid & 63, wave = __builtin_amdgcn_readfirstlane(tid >> 6);
    MM_LAS unsigned char *QI = L + O_QI, *KI = L + O_KI, *WKT = L + O_WKT, *VT = L + O_VT, *CI = L + O_CI, *SI = L + O_SI;
    MM_LAS float* TAB = (MM_LAS float*)(L + O_TAB);
    MM_LAS float* HB = (MM_LAS float*)L;
    for (int i = tid; i < 39168 / 4; i += 512) ((MM_LAS unsigned*)CI)[i] = 0u;
    for (int i = tid; i < 16 * PS / 4; i += 512) ((MM_LAS unsigned*)(VT + 128 * PS))[i] = (i < PS / 4) ? 0x3f803f80u : 0u;
    f32x4 cacc[9];
#pragma unroll
    for (int i = 0; i < 9; ++i) cacc[i] = (f32x4){0.f, 0.f, 0.f, 0.f};
    float m_run = 0.f;
    const int t = lane, cg = wave;
    const size_t mrow0 = (size_t)b * T;
    bf16x8 q0, q1, k0, k1, v0, v1; float li = 0.f, lf = 0.f;
#define ML_LOAD(c_) do { const size_t m_ = mrow0 + (size_t)(c_) * 64 + t; const bf16_t* qp = QKC + m_ * 1024 + h * 128 + 16 * cg; const bf16_t* vp = PROJ + m_ * NPROJ + PC_MLV + h * 128 + 16 * cg; \
        q0 = *(const bf16x8*)qp; q1 = *(const bf16x8*)(qp + 8); k0 = *(const bf16x8*)(qp + 512); k1 = *(const bf16x8*)(qp + 520); v0 = *(const bf16x8*)vp; v1 = *(const bf16x8*)(vp + 8); \
        if (wave == 0) { li = LI[m_ * 4 + h]; lf = LF[m_ * 4 + h]; } } while (0)
    ML_LOAD(0);
    for (int c = 0; c < 64; ++c) {
        if (wave == 0) {
            float bb = lf;
#pragma unroll
            for (int o = 1; o < 64; o <<= 1) { const float u = __shfl_up(bb, o); if (lane >= o) bb += u; }
            const float a = li - bb; float pm = a;
#pragma unroll
            for (int o = 1; o < 64; o <<= 1) { const float u = __shfl_up(pm, o); if (lane >= o) pm = fmaxf(pm, u); }
            const float mx = fmaxf(m_run, pm), mxL = __shfl(mx, 63), bL = __shfl(bb, 63);
            TAB[t] = a; TAB[64 + t] = mx; TAB[128 + t] = __expf(m_run - mx); TAB[192 + t] = __expf(-(bb + mx)); TAB[256 + t] = __expf(a - mxL);
            if (lane == 0) TAB[320] = __expf(m_run - mxL);
            m_run = bL + mxL;
        }
        __syncthreads();
        {
            *(MM_LAS bf16x8*)(QI + t * PQ + cg * 32) = q0; *(MM_LAS bf16x8*)(QI + t * PQ + cg * 32 + 16) = q1;
            *(MM_LAS bf16x8*)(KI + t * PQ + cg * 32) = k0; *(MM_LAS bf16x8*)(KI + t * PQ + cg * 32 + 16) = k1;
            const float wt = TAB[256 + t];
#pragma unroll
            for (int e = 0; e < 8; ++e) {
                *(MM_LAS unsigned short*)(WKT + (16 * cg + e) * PS + t * 2) = mm::f2b(wt * mm::bfl((unsigned short)k0[e]));
                *(MM_LAS unsigned short*)(WKT + (16 * cg + 8 + e) * PS + t * 2) = mm::f2b(wt * mm::bfl((unsigned short)k1[e]));
                *(MM_LAS unsigned short*)(VT + (16 * cg + e) * PS + t * 2) = (unsigned short)v0[e];
                *(MM_LAS unsigned short*)(VT + (16 * cg + 8 + e) * PS + t * 2) = (unsigned short)v1[e]; }
        }
        if (c + 1 < 64) ML_LOAD(c + 1);
        __syncthreads();
        {
            const int bi = wave >> 1;
#pragma unroll
            for (int jj = 0; jj < 2; ++jj) { const int bj = 2 * (wave & 1) + jj; f32x4 acc = (f32x4){0.f, 0.f, 0.f, 0.f};
                if (bi <= bj) { mm::blk<4>(acc, KI + bi * 16 * PQ, PQ, QI + bj * 16 * PQ, PQ, lane);
                    const int tt = 16 * bj + (lane & 15); const float mxt = TAB[64 + tt];
#pragma unroll
                    for (int r = 0; r < 4; ++r) { const int s = 16 * bi + 4 * (lane >> 4) + r; acc[r] = (s <= tt) ? acc[r] * __expf(TAB[s] - mxt) : 0.f; } }
                mm::store_T(acc, SI, PS, 16 * bj, 16 * bi, lane); }
        }
        __syncthreads();
        f32x4 res[5];
        {
#pragma unroll
            for (int n = 0; n < 5; ++n) { const int id = wave + 8 * n; res[n] = (f32x4){0.f, 0.f, 0.f, 0.f};
                if (id < 36) { const int vb = id >> 2, tb = id & 3; f32x4 ai = (f32x4){0.f, 0.f, 0.f, 0.f}, aa = (f32x4){0.f, 0.f, 0.f, 0.f};
                    mm::blk<4>(ai, QI + tb * 16 * PQ, PQ, CI + vb * 16 * PQ, PQ, lane);
                    mm::blk<2>(aa, SI + tb * 16 * PS, PS, VT + vb * 16 * PS, PS, lane);
#pragma unroll
                    for (int r = 0; r < 4; ++r) res[n][r] = TAB[128 + 16 * tb + 4 * (lane >> 4) + r] * ai[r] + aa[r]; } }
            const float decay = TAB[320];
#pragma unroll
            for (int vb = 0; vb < 9; ++vb) { cacc[vb] = cacc[vb] * decay; mm::blk<2>(cacc[vb], WKT + wave * 16 * PS, PS, VT + vb * 16 * PS, PS, lane); }
        }
        const float em_l = TAB[192 + 16 * (wave & 3) + 4 * (lane >> 4) + 0], em_1 = TAB[192 + 16 * (wave & 3) + 4 * (lane >> 4) + 1], em_2 = TAB[192 + 16 * (wave & 3) + 4 * (lane >> 4) + 2], em_3 = TAB[192 + 16 * (wave & 3) + 4 * (lane >> 4) + 3];
        __syncthreads();
        {
#pragma unroll
            for (int n = 0; n < 5; ++n) { const int id = wave + 8 * n;
                if (id < 36) { const int vb = id >> 2, tb = id & 3, j = lane & 15;
#pragma unroll
                    for (int r = 0; r < 4; ++r) { const int tt = 16 * tb + 4 * (lane >> 4) + r;
                        if (vb < 8 || j == 0) HB[tt * HBP + 16 * vb + j] = res[n][r];
                        else if (j == 1) HB[tt * HBP + 129] = (r == 0 ? em_l : r == 1 ? em_1 : r == 2 ? em_2 : em_3); } } }
#pragma unroll
            for (int vb = 0; vb < 9; ++vb) mm::store_T(cacc[vb], CI, PQ, 16 * vb, 16 * wave, lane);
        }
        __syncthreads();
        {
#pragma unroll
            for (int q = 0; q < 8; ++q) { const int tt = wave * 8 + q; const size_t m = mrow0 + (size_t)c * 64 + tt;
                const float dn = fmaxf(fabsf(HB[tt * HBP + 128]), HB[tt * HBP + 129]);
                const float h0 = HB[tt * HBP + lane] / dn, h1 = HB[tt * HBP + 64 + lane] / dn;
                const float mean = wave_sum(h0 + h1) * (1.f / 128.f); const float d0 = h0 - mean, d1 = h1 - mean;
                const float rstd = 1.f / sqrtf(wave_sum(d0 * d0 + d1 * d1) * (1.f / 128.f) + NORM_EPS);
#pragma unroll
                for (int e = 0; e < 2; ++e) { const int d = lane + 64 * e; const float hn = (e ? d1 : d0) * rstd * ng[d];
                    const float og = bf2f(PROJ[m * NPROJ + PC_MLO + h * 128 + d]), z = bf2f(PROJ[m * NPROJ + PC_MLZ + h * 128 + d]);
                    MIXED[m * DM + h * 128 + d] = (bf16_t)f2bf(siluf_(z) * sigmoidf_(og) * hn); } }
        }
    }
    __syncthreads();
#undef ML_LOAD
}
constexpr size_t MiB = 1u << 20;
constexpr size_t WS_CTL = 0, CTL_ZERO_BYTES = 1 * MiB;
constexpr size_t WS_WIN = 1 * MiB;
constexpr size_t WS_WUQ = WS_WIN + 104 * MiB;
constexpr size_t WS_WUKV = WS_WUQ + 6 * MiB;
constexpr size_t WS_WOUT = WS_WUKV + 4 * MiB;
constexpr size_t WS_CS = WS_WOUT + 32 * MiB;
constexpr size_t WS_XN = WS_CS + 4 * MiB;
constexpr size_t WS_PROJ = WS_XN + 64 * MiB;
constexpr size_t WS_SPEC = WS_PROJ + 208 * MiB;
constexpr size_t WS_CQN = WS_SPEC + 16 * MiB;
constexpr size_t WS_CKVN = WS_CQN + 16 * MiB;
constexpr size_t WS_KR = WS_CKVN + 8 * MiB;
constexpr size_t WS_Q = WS_KR + 2 * MiB;
constexpr size_t WS_KV = WS_Q + 48 * MiB;
constexpr size_t WS_QKC = WS_KV + 64 * MiB;
constexpr size_t WS_GATE = WS_QKC + 32 * MiB;
constexpr size_t WS_RWW = WS_GATE + 1 * MiB;
constexpr size_t WS_RWB = WS_RWW + 32 * MiB;
constexpr size_t WS_VFIRST = WS_RWB + 80 * MiB;
constexpr size_t WS_BONUS = WS_VFIRST + 16 * MiB;
constexpr size_t WS_END = WS_BONUS + 1 * MiB;
constexpr int CW_BAR = 4096;
constexpr int LDS_BYTES = 163840, RING_BYTES = 158720, MISC_OFF = RING_BYTES + 320;
static_assert(att::LDS_BYTES <= RING_BYTES, "attention LDS");

struct Args { const float* in[28]; float* out; unsigned char* ws; int ph_lo, ph_hi; };

struct MapWin { __device__ __forceinline__ int operator()(int n) const {
    if (n < 1536) return n;
    if (n < 2048) return SC_MLO + (n - 1536);
    if (n < 2560) return SC_MLZ + (n - 2048);
    if (n < 3072) return SC_CQ + (n - 2560);
    if (n < 3328) return SC_CKV + (n - 3072);
    if (n < 4352) return SC_MLAZ + (n - 3328);
    if (n < 5888) return SC_RW + (n - 4352);
    if (n < 6144) { const int j = n - 5888;
        if (j < 128) return SC_RW + 1536 + j;
        if (j < 192) { const int q = j - 128; return SC_KR + ((q & 1) ? 32 + (q >> 1) : (q >> 1)); }
        if (j < 196) return SC_MLI + (j - 192);
        if (j < 200) return SC_MLF + (j - 196);
        return -1; }
    return SC_RWZ + (n - 6144); } };
struct MapUq { __device__ __forceinline__ int operator()(int n) const { const int h = n / 192, d = n % 192; if (d < 128) return n; const int q = d - 128; return h * 192 + 128 + ((q & 1) ? 32 + (q >> 1) : (q >> 1)); } };
struct MapId { __device__ __forceinline__ int operator()(int n) const { return n; } };

template <class Map>
__device__ __forceinline__ void transpose_item(const float* W, int K, int Nsrc, bf16_t* WT, const float* gain, LAS float* scr, int kb, int nb, int lane, Map map) {
    const int k0 = 64 * kb, n0 = 32 * nb, sc = map(n0 + (lane & 31));
#pragma unroll 8
    for (int i = 0; i < 32; ++i) { const int kk = 2 * i + (lane >> 5); float v = 0.f;
        if (sc >= 0) { v = W[(size_t)(k0 + kk) * Nsrc + sc]; if (gain) v *= gain[k0 + kk]; }
        scr[kk * 33 + (lane & 31)] = v; }
    LDS_WAIT(); asm volatile("" ::: "memory");
    const int c = lane & 7;
#pragma unroll
    for (int j = 0; j < 4; ++j) { const int n = (lane >> 3) + 8 * j; const LAS float* s = scr + (8 * c) * 33 + n;
        v4u o; o.x = pk2(s[0 * 33], s[1 * 33]); o.y = pk2(s[2 * 33], s[3 * 33]); o.z = pk2(s[4 * 33], s[5 * 33]); o.w = pk2(s[6 * 33], s[7 * 33]);
        *(v4u*)(WT + (size_t)(n0 + n) * K + k0 + 8 * c) = o; }
    LDS_WAIT(); asm volatile("" ::: "memory");
}

template <int MODE>
__device__ __forceinline__ void norm_row(const float* xrow, bf16_t* orow, float* frow, const float* g, int lane) {
    const f32x4* xr = (const f32x4*)xrow + lane;
    f32x4 v[8]; float s = 0.f;
#pragma unroll
    for (int j = 0; j < 8; ++j) { v[j] = xr[64 * j]; s += (v[j].x * v[j].x + v[j].y * v[j].y) + (v[j].z * v[j].z + v[j].w * v[j].w); }
    const float rstd = 1.f / sqrtf(wave_sum(s) * (1.f / DM) + NORM_EPS);
    if (MODE == 0) { unsigned long long* o8 = (unsigned long long*)orow + lane;
#pragma unroll
        for (int j = 0; j < 8; ++j) o8[64 * j] = (unsigned long long)pk2(v[j].x * rstd, v[j].y * rstd) | ((unsigned long long)pk2(v[j].z * rstd, v[j].w * rstd) << 32);
    } else { f32x4* o = (f32x4*)frow + lane; const f32x4* gr = (const f32x4*)g + lane;
#pragma unroll
        for (int j = 0; j < 8; ++j) { const f32x4 gg = gr[64 * j]; o[64 * j] = v[j] * rstd * gg; } }
}

__device__ __forceinline__ att::BlockRef mk_block(const bf16_t* Q, const bf16_t* KV, const bf16_t* KR, bf16_t* MIXED, const bf16_t* PROJ, const float* CS, int L_, int pass_) {
    const int bh = L_ >> 3, x = L_ & 7, qb = pass_ ? 15 - x : x, b = bh >> 3, h = bh & 7; att::BlockRef r;
    const size_t rb = (size_t)b * T, rq = rb + (size_t)qb * 256;
    r.Q = Q + rq * NQ + h * 192; r.K = KV + rb * NKV + h * 256; r.V = r.K + 128; r.KR = KR + rb * 64; r.O = MIXED + rq * DM + 512 + h * 128; r.Z = PROJ + rq * NPROJ + PC_MLAZ + h * 128; r.CSq = CS + rq * 64; r.P0 = qb * 256; return r;
}
__global__ void __launch_bounds__(512, 2) fwd(Args args) {
    extern __shared__ __attribute__((aligned(16))) unsigned char lds[];
    const int tid = threadIdx.x, lane = tid & 63, wave = __builtin_amdgcn_readfirstlane(tid >> 6);
    const int G = gridDim.x, bid = blockIdx.x;
    unsigned char* ws = args.ws;
    volatile LAS unsigned* MISC = (volatile LAS unsigned*)((LAS unsigned char*)lds + MISC_OFF);
    for (int u = tid; u < (LDS_BYTES - RING_BYTES) / 4; u += 512) ((LAS unsigned*)((LAS unsigned char*)lds + RING_BYTES))[u] = 0u;
    __syncthreads();
    const bool one_launch = (args.ph_hi - args.ph_lo) > 1;
    XcdBarrier bar; bar.bar = (unsigned*)(ws + WS_CTL) + CW_BAR; bar.x = 0; bar.st = nullptr;
    if (one_launch) bar = xcd_barrier_post((unsigned*)(ws + WS_CTL) + CW_BAR, MISC + 8);
    const int lo = args.ph_lo, hi = args.ph_hi;
#define IN(k) (lo <= (k) && (k) < hi)
#define SEAM(k) do { if (IN(k) && IN((k) + 1)) xcd_barrier(bar); } while (0)

    const float* x_in = args.in[0]; const int* positions = (const int*)args.in[1];
    float* X = args.out;
    bf16_t* WIN = (bf16_t*)(ws + WS_WIN); bf16_t* WUQ = (bf16_t*)(ws + WS_WUQ); bf16_t* WUKV = (bf16_t*)(ws + WS_WUKV); bf16_t* WOUT = (bf16_t*)(ws + WS_WOUT);
    float* CS = (float*)(ws + WS_CS); bf16_t* XN = (bf16_t*)(ws + WS_XN); bf16_t* MIXED = XN; bf16_t* PROJ = (bf16_t*)(ws + WS_PROJ); float* SPEC = (float*)(ws + WS_SPEC);
    bf16_t* CQN = (bf16_t*)(ws + WS_CQN); bf16_t* CKVN = (bf16_t*)(ws + WS_CKVN); bf16_t* KR = (bf16_t*)(ws + WS_KR); bf16_t* Q = (bf16_t*)(ws + WS_Q); bf16_t* KV = (bf16_t*)(ws + WS_KV);
    bf16_t* QKC = (bf16_t*)(ws + WS_QKC); float* LI = (float*)(ws + WS_GATE); float* LF = LI + (size_t)M * 4;
    float* RWW = (float*)(ws + WS_RWW); bf16_t* RWB = (bf16_t*)(ws + WS_RWB); bf16_t* VFIRST = (bf16_t*)(ws + WS_VFIRST); float* BONUS = (float*)(ws + WS_BONUS);
    constexpr size_t RWS = (size_t)M * 512;

    if (IN(0)) {
#ifndef NO_PRO
        LAS float* scr = (LAS float*)((LAS unsigned char*)lds + wave * 16384);
        const int gw = bid * 8 + wave, NGW = G * 8;
        constexpr int I_IN = (DM / 64) * (NPROJ / 32), I_UQ = (512 / 64) * (NQ / 32), I_UKV = (256 / 64) * (NKV / 32), I_OUT = (DM / 64) * (DM / 32), I_L = I_IN + I_UQ + I_UKV + I_OUT;
        for (int it = gw; it < DEPTH * I_L; it += NGW) {
            const int l = it / I_L; int r = it % I_L;
            if (r < I_IN) { transpose_item(args.in[3] + (size_t)l * DM * D_IN, DM, D_IN, WIN + (size_t)l * NPROJ * DM, args.in[2] + l * DM, scr, r / (NPROJ / 32), r % (NPROJ / 32), lane, MapWin()); continue; } r -= I_IN;
            if (r < I_UQ) { transpose_item(args.in[10] + (size_t)l * 512 * NQ, 512, NQ, WUQ + (size_t)l * NQ * 512, args.in[9] + l * 512, scr, r / (NQ / 32), r % (NQ / 32), lane, MapUq()); continue; } r -= I_UQ;
            if (r < I_UKV) { transpose_item(args.in[12] + (size_t)l * 256 * NKV, 256, NKV, WUKV + (size_t)l * NKV * 256, args.in[11] + l * 256, scr, r / (NKV / 32), r % (NKV / 32), lane, MapId()); continue; } r -= I_UKV;
            transpose_item(args.in[26] + (size_t)l * DM * DM, DM, DM, WOUT + (size_t)l * DM * DM, (const float*)nullptr, scr, r / (DM / 32), r % (DM / 32), lane, MapId());
        }
        for (int i = bid * 512 + tid; i < M * 32; i += G * 512) { const int m = i >> 5, j = i & 31;
            const float inv_freq = powf(10000.f, -(float)(2 * j) / 64.f);
            const float ang = (float)positions[m] * inv_freq;
            const double a = (double)ang; const double n = rint(a * 0.15915494309189535); const float r = (float)(a - n * 6.283185307179586);
            CS[2 * i] = cosf(r); CS[2 * i + 1] = sinf(r); }
        for (int m = gw; m < M; m += NGW) norm_row<0>(x_in + (size_t)m * DM, XN + (size_t)m * DM, nullptr, nullptr, lane);
#endif
    }
    SEAM(0);

#ifdef FIXL
    for (int l = 0; l < 1; ++l) {
#else
    for (int l = 0; l < DEPTH; ++l) {
#endif
        const int pb = 1 + l * 6;
        int tid_o = threadIdx.x; asm volatile("" : "+v"(tid_o));
        const int tid = tid_o, lane = tid & 63, wave = __builtin_amdgcn_readfirstlane(tid >> 6);
        if (IN(pb + 0)) {
#ifndef NO_G1
            pg8::Gemm g{XN, WIN + (size_t)l * NPROJ * DM, M, NPROJ, DM}; pg8::StaticOrder S; S.init(M, NPROJ, G, bid);
            pg8::EpiProj E{PROJ, NPROJ, SPEC, SPEC_TILE};
            pg8::gemm_phase<pg8::EpiProj, pg8::StaticOrder, true, true>((LAS unsigned char*)lds, g, S, E);
#endif
        }
        SEAM(pb + 0);
        if (IN(pb + 1)) {
#ifndef NO_PREP
            LAS float* L = (LAS float*)lds;
            LAS float* xw_t = L;
            LAS float* xa_s = L + 512;
            LAS float* t1 = L + 1024;
            LAS float* vbuf = L + 1280;
            const float* mu = args.in[13] + l * 1664; const float* w0 = args.in[14] + l * 512; const float* w2 = args.in[15] + (size_t)l * 64 * 512;
            const float* a0 = args.in[16] + l * 512; const float* a2 = args.in[17] + (size_t)l * 64 * 512;
            const float* v0 = args.in[18] + (l > 0 ? (l - 1) * 512 : 0); const float* v1 = args.in[19] + (size_t)(l > 0 ? l - 1 : 0) * 512 * 32; const float* v2 = args.in[20] + (size_t)(l > 0 ? l - 1 : 0) * 32 * 512;
            const float* k_k = args.in[21] + l * 512; const float* k_a = args.in[22] + l * 512; const float* r_k = args.in[23] + l * 512;
            const float* conv_w = args.in[4] + (size_t)l * 4 * 1024; const float* conv_b = args.in[5] + l * 1024;
            const float* i_bias = args.in[6] + l * 4; const float* f_bias = args.in[7] + l * 4;
            const int c = tid;
            for (int g8 = bid; g8 < M / 8; g8 += G) {
                const int m0 = g8 * 8, t0 = m0 % T;
                float r_[8], k_[8], v_[8];
                { const float mur = mu[c], muk = mu[512 + c], muv = mu[1024 + c];
                  float pr = 0.f, pk = 0.f, pv = 0.f;
                  if (t0 > 0) { const bf16_t* pp = PROJ + (size_t)(m0 - 1) * NPROJ + PC_RW + c; pr = bf2f(pp[0]); pk = bf2f(pp[512]); pv = bf2f(pp[1024]); }
#pragma unroll
                  for (int i = 0; i < 8; ++i) { const bf16_t* pp = PROJ + (size_t)(m0 + i) * NPROJ + PC_RW + c; const float cr = bf2f(pp[0]), ck = bf2f(pp[512]), cv = bf2f(pp[1024]);
                      r_[i] = cr + mur * (pr - cr); k_[i] = ck + muk * (pk - ck); v_[i] = cv + muv * (pv - cv); pr = cr; pk = ck; pv = cv; } }
                if (tid < 128) { const int j = tid & 63, which = tid >> 6; const float mm = mu[1536 + which * 64 + j];
                    float pv = 0.f; if (t0 > 0) pv = SPEC[(size_t)(m0 - 1) * 256 + which * 64 + j];
                    for (int i = 0; i < 8; ++i) { const float cv = SPEC[(size_t)(m0 + i) * 256 + which * 64 + j]; const float xs = cv + mm * (pv - cv); pv = cv;
                        if (which == 0) xw_t[i * 64 + j] = tanhf(xs); else xa_s[i * 64 + j] = xs; } }
                if (l > 0) {
#pragma unroll
                    for (int i = 0; i < 8; ++i) vbuf[i * 512 + c] = v_[i]; }
                __syncthreads();
                float lw[8], la[8];
                { const float w0c = w0[c], a0c = a0[c];
#pragma unroll
                  for (int i = 0; i < 8; ++i) { lw[i] = w0c; la[i] = a0c; }
                  for (int j = 0; j < 64; ++j) { const float w2v = w2[j * 512 + c], a2v = a2[j * 512 + c];
#pragma unroll
                      for (int i = 0; i < 8; ++i) { lw[i] += xw_t[i * 64 + j] * w2v; la[i] += xa_s[i * 64 + j] * a2v; } } }
                if (l > 0) {
                    if (tid < 256) { const int i = tid >> 5, j = tid & 31; float s = 0.f;
                        for (int cc = 0; cc < 512; ++cc) s += vbuf[i * 512 + cc] * v1[cc * 32 + j];
                        t1[i * 32 + j] = s; }
                    __syncthreads();
                    float gsum[8]; const float v0c = v0[c];
#pragma unroll
                    for (int i = 0; i < 8; ++i) gsum[i] = v0c;
                    for (int j = 0; j < 32; ++j) { const float v2v = v2[j * 512 + c];
#pragma unroll
                        for (int i = 0; i < 8; ++i) gsum[i] += t1[i * 32 + j] * v2v; }
#pragma unroll
                    for (int i = 0; i < 8; ++i) { const float vf = bf2f(VFIRST[(size_t)(m0 + i) * 512 + c]); v_[i] = v_[i] + (vf - v_[i]) * sigmoidf_(gsum[i]); }
                } else {
#pragma unroll
                    for (int i = 0; i < 8; ++i) VFIRST[(size_t)(m0 + i) * 512 + c] = (bf16_t)f2bf(v_[i]);
                }
                { const float kkc = k_k[c], kac = k_a[c], rkc = r_k[c];
#pragma unroll
                  for (int i = 0; i < 8; ++i) { const size_t o = (size_t)(m0 + i) * 512 + c;
                      const float logw = -softplusf_(-lw[i]) - 0.5f; const float dec = __expf(-__expf(logw)); const float a = sigmoidf_(la[i]);
                      float kk = k_[i] * kkc; const float ss = wave_sum(kk * kk); kk = kk / fmaxf(sqrtf(ss), 1e-12f);
                      const float kh = k_[i] * (1.f + (a - 1.f) * kac);
                      const float bon = wave_sum(r_[i] * kh * rkc);
                      RWW[o] = dec; RWB[o] = (bf16_t)f2bf(r_[i]); RWB[RWS + o] = (bf16_t)f2bf(kh); RWB[2 * RWS + o] = (bf16_t)f2bf(v_[i]); RWB[3 * RWS + o] = (bf16_t)f2bf(-kk); RWB[4 * RWS + o] = (bf16_t)f2bf(kk * a);
                      if (lane == 0) BONUS[(size_t)(m0 + i) * 8 + wave] = bon; } }
                { const int m = m0 + wave;
                  { const v4u raw = *(const v4u*)(PROJ + (size_t)m * NPROJ + PC_CQ + lane * 8); float f[8];
                    f[0] = bf2f(raw.x & 0xffffu); f[1] = bf2f(raw.x >> 16); f[2] = bf2f(raw.y & 0xffffu); f[3] = bf2f(raw.y >> 16); f[4] = bf2f(raw.z & 0xffffu); f[5] = bf2f(raw.z >> 16); f[6] = bf2f(raw.w & 0xffffu); f[7] = bf2f(raw.w >> 16);
                    float s = 0.f;
#pragma unroll
                    for (int e = 0; e < 8; ++e) s += f[e] * f[e];
                    const float rstd = 1.f / sqrtf(wave_sum(s) * (1.f / 512.f) + NORM_EPS);
                    v4u o; o.x = pk2(f[0] * rstd, f[1] * rstd); o.y = pk2(f[2] * rstd, f[3] * rstd); o.z = pk2(f[4] * rstd, f[5] * rstd); o.w = pk2(f[6] * rstd, f[7] * rstd);
                    *(v4u*)(CQN + (size_t)m * 512 + lane * 8) = o; }
                  { const unsigned long long raw = *(const unsigned long long*)(PROJ + (size_t)m * NPROJ + PC_CKV + lane * 4); float f[4];
                    f[0] = bf2f((unsigned)raw & 0xffffu); f[1] = bf2f(((unsigned)raw) >> 16); f[2] = bf2f((unsigned)(raw >> 32) & 0xffffu); f[3] = bf2f((unsigned)(raw >> 48));
                    const float s = f[0] * f[0] + f[1] * f[1] + f[2] * f[2] + f[3] * f[3];
                    const float rstd = 1.f / sqrtf(wave_sum(s) * (1.f / 256.f) + NORM_EPS);
                    *(unsigned long long*)(CKVN + (size_t)m * 256 + lane * 4) = (unsigned long long)pk2(f[0] * rstd, f[1] * rstd) | ((unsigned long long)pk2(f[2] * rstd, f[3] * rstd) << 32); }
                  { const float vv = SPEC[(size_t)m * 256 + 128 + lane]; const float pt = __shfl_xor(vv, 1); const int i = lane >> 1;
                    const float cs_ = CS[((size_t)m * 32 + i) * 2], sn_ = CS[((size_t)m * 32 + i) * 2 + 1];
                    const float o = (lane & 1) ? (vv * cs_ + pt * sn_) : (vv * cs_ - pt * sn_);
                    KR[(size_t)m * 64 + lane] = (bf16_t)f2bf(o); } }
#pragma unroll
                for (int hh = 0; hh < 2; ++hh) { const int ch = c + hh * 512;
                    const float cw0 = conv_w[ch], cw1 = conv_w[1024 + ch], cw2 = conv_w[2048 + ch], cw3 = conv_w[3072 + ch], cb = conv_b[ch];
                    float x0 = 0.f, x1 = 0.f, x2 = 0.f;
                    if (t0 >= 3) { x0 = bf2f(PROJ[(size_t)(m0 - 3) * NPROJ + PC_MLQK + ch]); x1 = bf2f(PROJ[(size_t)(m0 - 2) * NPROJ + PC_MLQK + ch]); x2 = bf2f(PROJ[(size_t)(m0 - 1) * NPROJ + PC_MLQK + ch]); }
                    const float sc_ = hh == 0 ? 0.08838834764831845f : 1.f;
#pragma unroll
                    for (int i = 0; i < 8; ++i) { const float x3 = bf2f(PROJ[(size_t)(m0 + i) * NPROJ + PC_MLQK + ch]);
                        const float y = cb + cw0 * x0 + cw1 * x1 + cw2 * x2 + cw3 * x3;
                        QKC[(size_t)(m0 + i) * 1024 + ch] = (bf16_t)f2bf(siluf_(y) * sc_);
                        x0 = x1; x1 = x2; x2 = x3; } }
                if (tid < 64) { const int i = tid >> 3, gh = tid & 7; const float val = SPEC[(size_t)(m0 + i) * 256 + 192 + gh];
                    if (gh < 4) LI[(size_t)(m0 + i) * 4 + gh] = val + i_bias[gh];
                    else { const float xx = val + f_bias[gh - 4]; LF[(size_t)(m0 + i) * 4 + gh - 4] = -softplusf_(-xx); } }
                __syncthreads();
            }
#endif
        }
        SEAM(pb + 1);
        if (IN(pb + 2)) {
#ifndef NO_G23
            { pg8::Gemm g{CQN, WUQ + (size_t)l * NQ * 512, M, NQ, 512}; pg8::StaticOrder S; S.init(M, NQ, G, bid);
              pg8::EpiPlain E{Q, NQ};
              pg8::gemm_phase<pg8::EpiPlain, pg8::StaticOrder, true, true>((LAS unsigned char*)lds, g, S, E); }
            { pg8::Gemm g{CKVN, WUKV + (size_t)l * NKV * 256, M, NKV, 256}; pg8::StaticOrder S; S.init(M, NKV, G, bid);
              pg8::EpiPlain E{KV, NKV};
              pg8::gemm_phase<pg8::EpiPlain, pg8::StaticOrder, true, true>((LAS unsigned char*)lds, g, S, E); }
#endif
        }
        SEAM(pb + 2);
        if (IN(pb + 3)) {
#ifndef NO_SCANS
            if (bid < 32 && G >= 64) {
                const int b = bid >> 3, h = bid & 7, row = tid >> 3, kq = tid & 7;
                LAS float* tin = (LAS float*)lds;
                LAS float* ybuf = tin + 6 * 1024;
                const float* ln_g = args.in[24] + l * 512 + h * 64; const float* ln_b = args.in[25] + l * 512 + h * 64;
                float S8[8];
#pragma unroll
                for (int j = 0; j < 8; ++j) S8[j] = 0.f;
                for (int t0 = 0; t0 < T; t0 += 16) {
#pragma unroll
                    for (int i = 0; i < 12; ++i) { const int idx = tid + 512 * i, arr = idx >> 10, rem = idx & 1023, tt = rem >> 6, cc = rem & 63;
                        const size_t o = (size_t)(b * T + t0 + tt) * 512 + h * 64 + cc;
                        float val;
                        if (arr == 1) val = RWW[o]; else { const int ba = arr == 0 ? 0 : arr - 1; val = bf2f(RWB[(size_t)ba * RWS + o]); }
                        tin[idx] = val; }
                    __syncthreads();
                    for (int tt = 0; tt < 16; ++tt) {
                        const LAS float* base = tin + tt * 64 + kq * 8;
                        const f32x4 r0 = *(const LAS f32x4*)(base), r1 = *(const LAS f32x4*)(base + 4);
                        const f32x4 w0_ = *(const LAS f32x4*)(base + 1024), w1_ = *(const LAS f32x4*)(base + 1024 + 4);
                        const f32x4 k0_ = *(const LAS f32x4*)(base + 2048), k1_ = *(const LAS f32x4*)(base + 2048 + 4);
                        const f32x4 a0_ = *(const LAS f32x4*)(base + 4096), a1_ = *(const LAS f32x4*)(base + 4096 + 4);
                        const f32x4 b0_ = *(const LAS f32x4*)(base + 5120), b1_ = *(const LAS f32x4*)(base + 5120 + 4);
                        const float vv = tin[3072 + tt * 64 + row];
                        float sa = 0.f;
#pragma unroll
                        for (int j = 0; j < 4; ++j) sa += S8[j] * a0_[j] + S8[4 + j] * a1_[j];
                        sa += __shfl_xor(sa, 1); sa += __shfl_xor(sa, 2); sa += __shfl_xor(sa, 4);
                        float y = 0.f;
#pragma unroll
                        for (int j = 0; j < 4; ++j) { S8[j] = S8[j] * w0_[j] + sa * b0_[j] + vv * k0_[j]; S8[4 + j] = S8[4 + j] * w1_[j] + sa * b1_[j] + vv * k1_[j]; y += S8[j] * r0[j] + S8[4 + j] * r1[j]; }
                        y += __shfl_xor(y, 1); y += __shfl_xor(y, 2); y += __shfl_xor(y, 4);
                        if (kq == 0) ybuf[tt * 64 + row] = y;
                    }
                    __syncthreads();
#pragma unroll
                    for (int q = 0; q < 2; ++q) { const int tt = wave * 2 + q; const size_t m = (size_t)b * T + t0 + tt;
                        const float y = ybuf[tt * 64 + lane]; const float mean = wave_sum(y) * (1.f / 64.f); const float d = y - mean; const float var = wave_sum(d * d) * (1.f / 64.f);
                        float yn = d / sqrtf(var + RW_GN_EPS) * ln_g[lane] + ln_b[lane];
                        yn += BONUS[m * 8 + h] * tin[3072 + tt * 64 + lane];
                        const float z = bf2f(PROJ[m * NPROJ + PC_RWZ + h * 64 + lane]);
                        MIXED[m * DM + 1536 + h * 64 + lane] = (bf16_t)f2bf(siluf_(z) * yn); }
                    __syncthreads();
                }
            } else if (bid < 48 && G >= 64) {
                const int u = bid - 32;
                mlstm_unit(lds, u >> 2, u & 3, QKC, PROJ, LI, LF, args.in[8] + l * 512 + (u & 3) * 128, MIXED);
            } else
#endif
            {
#ifndef NO_ATT
                const int first = (G >= 64) ? bid - 48 : bid, stride = (G >= 64) ? G - 48 : G; constexpr int total = BATCH * 8 * 8;
                if (first < total) {
                    att::Seam S; int L = first, pass = 0;
#define mk(L_, pass_) mk_block(Q, KV, KR, MIXED, PROJ, CS, (L_), (pass_))
                    att::BlockRef cur = mk(L, 0);
                    att::attn_prime(cur, (char*)lds, S);
                    for (;;) {
                        const bool more_pass = pass == 0, more_item = L + stride < total, last = !more_pass && !more_item;
                        int Ln = L, passn = pass + 1; if (!more_pass) { passn = 0; Ln = more_item ? L + stride : L; }
                        const att::BlockRef nxt = last ? cur : mk(Ln, passn);
                        att::attn_block(cur, nxt, (char*)lds, S);
                        if (last) break;
                        cur = nxt; L = Ln; pass = passn;
                    }
#undef mk
                }
#endif
            }
        }
        SEAM(pb + 3);
        if (IN(pb + 4)) {
#ifndef NO_G4
            pg8::Gemm g{MIXED, WOUT + (size_t)l * DM * DM, M, DM, DM}; pg8::StaticOrder S; S.init(M, DM, G, bid);
            pg8::EpiResid E{l == 0 ? x_in : (const float*)X, X, DM};
            pg8::gemm_phase<pg8::EpiResid, pg8::StaticOrder, true, true>((LAS unsigned char*)lds, g, S, E);
#endif
        }
        SEAM(pb + 4);
        if (IN(pb + 5)) {
            const int gw = bid * 8 + wave, NGW = G * 8;
            if (l + 1 < DEPTH) { for (int m = gw; m < M; m += NGW) norm_row<0>(X + (size_t)m * DM, XN + (size_t)m * DM, nullptr, nullptr, lane); }
            else { for (int m = gw; m < M; m += NGW) norm_row<1>(X + (size_t)m * DM, nullptr, X + (size_t)m * DM, args.in[27], lane); }
        }
        SEAM(pb + 5);
    }
#undef IN
#undef SEAM
}

constexpr int N_PHASES = 1 + DEPTH * 6;
#ifndef MK_ONE_LAUNCH
#define MK_ONE_LAUNCH 1
#endif
extern "C" void kernel_launch(void* const* d_in, const int* in_sizes, int n_in, void* d_out, int out_size, void* d_ws, size_t ws_size, hipStream_t stream) {
    static int grid = 0;
    if (grid == 0) {
        if (n_in != 28 || out_size != M * DM || ws_size < WS_END) { fprintf(stderr, "kernel_launch: unexpected shapes (n_in %d, out %d, ws %zu < %zu)\n", n_in, out_size, ws_size, (size_t)WS_END); grid = -1; return; }
        int dev = 0, cus = 0;
        if (hipGetDevice(&dev) != hipSuccess || hipDeviceGetAttribute(&cus, hipDeviceAttributeMultiprocessorCount, dev) != hipSuccess) { grid = -1; return; }
        if (hipFuncSetAttribute((const void*)fwd, hipFuncAttributeMaxDynamicSharedMemorySize, LDS_BYTES) != hipSuccess) { fprintf(stderr, "kernel_launch: hipFuncSetAttribute failed\n"); grid = -1; return; }
        int per_cu = 0;
        if (hipOccupancyMaxActiveBlocksPerMultiprocessor(&per_cu, (const void*)fwd, 512, LDS_BYTES) != hipSuccess || per_cu < 1) fprintf(stderr, "kernel_launch: occupancy query says %d\n", per_cu);
        (void)hipGetLastError();
        grid = cus;
    }
    if (grid < 0) return;
    if (hipMemsetAsync((char*)d_ws + WS_CTL, 0, CTL_ZERO_BYTES, stream) != hipSuccess) return;
    Args a; memset(&a, 0, sizeof(a));
    for (int i = 0; i < 28; ++i) a.in[i] = (const float*)d_in[i];
    a.out = (float*)d_out; a.ws = (unsigned char*)d_ws;
#if MK_ONE_LAUNCH
    a.ph_lo = 0; a.ph_hi = N_PHASES;
    hipLaunchKernelGGL(fwd, dim3(grid), dim3(512), LDS_BYTES, stream, a);
#else
    for (int p = 0; p < N_PHASES; ++p) { a.ph_lo = p; a.ph_hi = p + 1; hipLaunchKernelGGL(fwd, dim3(grid), dim3(512), LDS_BYTES, stream, a); }
#endif
}
```

```cpp
#include <hip/hip_runtime.h>
#include <cstdio>
#include <cstdint>
#include <cstring>
namespace pg8 {
#define PG8_LAS __attribute__((address_space(3)))
typedef unsigned short bf16_t;
typedef short bf16x8 __attribute__((ext_vector_type(8)));
typedef float f32x4 __attribute__((ext_vector_type(4)));
typedef unsigned u32x4 __attribute__((ext_vector_type(4)));
constexpr int BM = 256, BK = 64, HALF = 128, HTB = HALF * BK * 2  , STAGE_BYTES = 8 * HTB, NXCD = 8, WGM = 8;

__host__ __device__ __forceinline__ int lds_byte(int r, int c) { const int st = (r >> 4) * 2 + (c >> 5), rr = r & 15, cc = c & 31, ob = rr * 64 + cc * 2; return st * 1024 + (ob ^ (((ob >> 9) & 1) << 5)); }
__host__ __device__ __forceinline__ void stage_rc(int b, int& R, int& C) { const int st = b / 1024, sb = b % 1024, swz = sb ^ (((sb >> 9) & 1) << 5); R = (st >> 1) * 16 + swz / 64; C = (st & 1) * 32 + (swz % 64) / 2; }
__host__ __device__ __forceinline__ int perm32(int rho) { const int n = rho >> 4, i = rho & 15; return 8 * (i >> 2) + 4 * n + (i & 3); }

struct Unit { int pm, pn; };
struct Gemm { const bf16_t* A; const bf16_t* Bt; int M, N, K; };

struct StaticOrder {
    int nM, nN, nwg, G, c;
    __host__ __device__ void init(int M, int N, int G_, int c_) { nM = M / BM; nN = N / BM; nwg = nM * nN; G = G_; c = c_; }
    __host__ __device__ bool next(int i, Unit& u) const {
        const long L = (long)i * G + c; if (L >= nwg) return false;
        int wgid = (int)L; { const int q = nwg / NXCD, r = nwg % NXCD, xcd = wgid % NXCD, off = wgid / NXCD; wgid = (xcd < r ? xcd * (q + 1) : r * (q + 1) + (xcd - r) * q) + off; }
        const int nig = WGM * nN, gid = wgid / nig, fm = gid * WGM, gsz = (nM - fm) < WGM ? (nM - fm) : WGM;
        u.pm = fm + ((wgid % nig) % gsz); u.pn = (wgid % nig) / gsz; return true;
    }
    __device__ __forceinline__ void a_ready(const Unit&) const {}
    __device__ __forceinline__ void done(const Unit&) const {}
};

__device__ __forceinline__ unsigned cvt_pk_bf16(float lo, float hi) { unsigned r; asm volatile("v_cvt_pk_bf16_f32 %0, %1, %2" : "=v"(r) : "v"(lo), "v"(hi)); return r; }
typedef float f32x2 __attribute__((ext_vector_type(2)));
typedef unsigned u32x2 __attribute__((ext_vector_type(2)));
struct EpiProj {
    static constexpr bool PERM = true, AFTER_DRAIN = false;
    bf16_t* O; int ldc; float* spec; int spec_tile;
    __device__ __forceinline__ void operator()(const f32x4 (&acc)[2][2][4][2], const Unit& u, int wr, int wc, int fr, int fq) const {
        const int row0 = u.pm * BM + wr * 64 + fr, col0 = u.pn * BM + wc * 32 + 8 * fq;
        if (u.pn == spec_tile) {
            float* sp0 = spec + (size_t)row0 * 256 + wc * 32 + 8 * fq;
#pragma unroll
            for (int ai = 0; ai < 2; ++ai)
#pragma unroll
                for (int m = 0; m < 4; ++m) { float* sp_p = sp0 + (size_t)(ai * HALF + m * 16) * 256;
#pragma unroll
                    for (int bj = 0; bj < 2; ++bj) { *(f32x4*)(sp_p + bj * HALF) = acc[ai][bj][m][0]; *(f32x4*)(sp_p + bj * HALF + 4) = acc[ai][bj][m][1]; } }
        }
        bf16_t* o0 = O + (size_t)row0 * ldc + col0;
#pragma unroll
        for (int ai = 0; ai < 2; ++ai)
#pragma unroll
            for (int m = 0; m < 4; ++m) { bf16_t* rowp = o0 + (size_t)(ai * HALF + m * 16) * ldc;
#pragma unroll
                for (int bj = 0; bj < 2; ++bj) { const f32x4 v0 = acc[ai][bj][m][0], v1 = acc[ai][bj][m][1];
                    u32x4 w; w.x = cvt_pk_bf16(v0[0], v0[1]); w.y = cvt_pk_bf16(v0[2], v0[3]); w.z = cvt_pk_bf16(v1[0], v1[1]); w.w = cvt_pk_bf16(v1[2], v1[3]);
                    *(u32x4*)(rowp + bj * HALF) = w; } }
    }
};
struct EpiQ {
    static constexpr bool PERM = true, AFTER_DRAIN = false;
    bf16_t* O; const float* cs;
    __device__ __forceinline__ void operator()(const f32x4 (&acc)[2][2][4][2], const Unit& u, int wr, int wc, int fr, int fq) const {
        const int row0 = u.pm * BM + wr * 64 + fr, col0 = u.pn * BM + wc * 32 + 8 * fq;
#pragma unroll
        for (int ai = 0; ai < 2; ++ai)
#pragma unroll
            for (int m = 0; m < 4; ++m) { const int row = row0 + ai * HALF + m * 16; bf16_t* rowp = O + (size_t)row * 1536 + col0;
#pragma unroll
                for (int bj = 0; bj < 2; ++bj) { f32x4 v0 = acc[ai][bj][m][0], v1 = acc[ai][bj][m][1];
                    const int d = (col0 + bj * HALF) % 192;
                    if (d >= 128) { const int i0 = (d - 128) >> 1; const f32x4* cp = (const f32x4*)(cs + (size_t)row * 64 + i0 * 2); const f32x4 c0 = cp[0], c1 = cp[1];
                        f32x4 r0, r1;
                        r0[0] = v0[0] * c0[0] - v0[1] * c0[1]; r0[1] = v0[1] * c0[0] + v0[0] * c0[1];
                        r0[2] = v0[2] * c0[2] - v0[3] * c0[3]; r0[3] = v0[3] * c0[2] + v0[2] * c0[3];
                        r1[0] = v1[0] * c1[0] - v1[1] * c1[1]; r1[1] = v1[1] * c1[0] + v1[0] * c1[1];
                        r1[2] = v1[2] * c1[2] - v1[3] * c1[3]; r1[3] = v1[3] * c1[2] + v1[2] * c1[3];
                        v0 = r0; v1 = r1; }
                    u32x4 w; w.x = cvt_pk_bf16(v0[0], v0[1]); w.y = cvt_pk_bf16(v0[2], v0[3]); w.z = cvt_pk_bf16(v1[0], v1[1]); w.w = cvt_pk_bf16(v1[2], v1[3]);
                    *(u32x4*)(rowp + bj * HALF) = w; } }
    }
};
struct EpiPlain {
    static constexpr bool PERM = true, AFTER_DRAIN = false;
    bf16_t* O; int ldc;
    __device__ __forceinline__ void operator()(const f32x4 (&acc)[2][2][4][2], const Unit& u, int wr, int wc, int fr, int fq) const {
        const int row0 = u.pm * BM + wr * 64 + fr, col0 = u.pn * BM + wc * 32 + 8 * fq;
#pragma unroll
        for (int ai = 0; ai < 2; ++ai)
#pragma unroll
            for (int m = 0; m < 4; ++m) { bf16_t* rowp = O + (size_t)(row0 + ai * HALF + m * 16) * ldc + col0;
#pragma unroll
                for (int bj = 0; bj < 2; ++bj) { const f32x4 v0 = acc[ai][bj][m][0], v1 = acc[ai][bj][m][1];
                    u32x4 w; w.x = cvt_pk_bf16(v0[0], v0[1]); w.y = cvt_pk_bf16(v0[2], v0[3]); w.z = cvt_pk_bf16(v1[0], v1[1]); w.w = cvt_pk_bf16(v1[2], v1[3]);
                    *(u32x4*)(rowp + bj * HALF) = w; } }
    }
};
struct EpiResid {
    static constexpr bool PERM = false, AFTER_DRAIN = false;
    const float* base; float* out; int ldc;
    __device__ __forceinline__ void operator()(const f32x4 (&acc)[2][2][4][2], const Unit& u, int wr, int wc, int fr, int fq) const {
        const int row0 = u.pm * BM + wr * 64 + fr, col0 = u.pn * BM + wc * 32 + 4 * fq;
#pragma unroll
        for (int ai = 0; ai < 2; ++ai)
#pragma unroll
            for (int m = 0; m < 4; ++m) { const size_t off = (size_t)(row0 + ai * HALF + m * 16) * ldc + col0;
#pragma unroll
                for (int bj = 0; bj < 2; ++bj)
#pragma unroll
                    for (int n = 0; n < 2; ++n) { const f32x4 bs = *(const f32x4*)(base + off + bj * HALF + n * 16); *(f32x4*)(out + off + bj * HALF + n * 16) = bs + acc[ai][bj][m][n]; } }
    }
};
template <class Epi, class Sched, bool ALIGN_EPI = false, bool SP2 = false>
__device__ __forceinline__ void gemm_phase(PG8_LAS unsigned char* lds, const Gemm g, const Sched& S, const Epi& E) {
    int tid_o = threadIdx.x; asm volatile("" : "+v"(tid_o));
    const int tid = tid_o, wid = __builtin_amdgcn_readfirstlane(tid >> 6), lane = tid & 63, wr = wid >> 2, wc = wid & 3, fr = lane & 15, fq = lane >> 4;
    const int K = g.K, nt = K / BK;
    unsigned voffA[2], voffB[2];
#pragma unroll
    for (int i = 0; i < 2; ++i) { int R, C; stage_rc(tid * 16 + i * 8192, R, C); const int Rb = Epi::PERM ? ((R & ~31) + perm32(R & 31)) : R;
        voffA[i] = (unsigned)(R * K + C) * 2u; voffB[i] = (unsigned)(Rb * K + C) * 2u; }
    const size_t kstep = (size_t)(BK * 2);
    const size_t hstep = (size_t)HALF * K * 2;
    const size_t tstep = 2 * hstep;
    const unsigned ldsw = (unsigned)wid * 1024u;
    const int aoff = lds_byte(wr * 64 + fr, fq * 8), boff = lds_byte(wc * 32 + fr, fq * 8);
#define PG8_SA(b, h) (((b) * 2 + (h)) * HTB)
#define PG8_SB(b, h) ((4 + (b) * 2 + (h)) * HTB)
#define PG8_STAGE(bufoff, gbase, voff) do { _Pragma("unroll") for (int _i = 0; _i < 2; ++_i) \
        __builtin_amdgcn_global_load_lds((const unsigned*)((const char*)(gbase) + (voff)[_i]), (PG8_LAS unsigned*)(lds + (bufoff) + ldsw + _i * 8192), 16, 0, 0); } while (0)
#define PG8_LDA(dst, b, h) do { _Pragma("unroll") for (int m = 0; m < 4; ++m) _Pragma("unroll") for (int k = 0; k < 2; ++k) dst[m][k] = *(const PG8_LAS bf16x8*)(lds + PG8_SA(b, h) + aoff + m * 2048 + k * 1024); } while (0)
#define PG8_LDB(dst, b, h) do { _Pragma("unroll") for (int n = 0; n < 2; ++n) _Pragma("unroll") for (int k = 0; k < 2; ++k) dst[n][k] = *(const PG8_LAS bf16x8*)(lds + PG8_SB(b, h) + boff + n * 2048 + k * 1024); } while (0)
#define PG8_MMA(ai, bj, At, Bt) do { __builtin_amdgcn_s_setprio(1); _Pragma("unroll") for (int m = 0; m < 4; ++m) _Pragma("unroll") for (int n = 0; n < 2; ++n) _Pragma("unroll") for (int k = 0; k < 2; ++k) \
        acc[ai][bj][m][n] = __builtin_amdgcn_mfma_f32_16x16x32_bf16(Bt[n][k], At[m][k], acc[ai][bj][m][n], 0, 0, 0); __builtin_amdgcn_s_setprio(0); } while (0)
#define PG8_WAIT_V(n) asm volatile("s_waitcnt vmcnt(" #n ")" ::: "memory")
#define PG8_WAIT_L(n) asm volatile("s_waitcnt lgkmcnt(" #n ")" ::: "memory")
#define PG8_BAR __builtin_amdgcn_s_barrier()
#define PG8_SCHED __builtin_amdgcn_sched_barrier(0)
    Unit cur, nxt; int ui = 0;
    if (!S.next(0, cur)) return;
    f32x4 acc[2][2][4][2];
#pragma unroll
    for (int a = 0; a < 2; ++a)
#pragma unroll
        for (int b = 0; b < 2; ++b)
#pragma unroll
            for (int m = 0; m < 4; ++m)
#pragma unroll
                for (int n = 0; n < 2; ++n) acc[a][b][m][n] = (f32x4){0.f, 0.f, 0.f, 0.f};
    bf16x8 At[4][2], B0[2][2], B1[2][2];
    const char* cA = (const char*)g.A + (size_t)cur.pm * tstep; const char* cB = (const char*)g.Bt + (size_t)cur.pn * tstep;
    S.a_ready(cur);
    if constexpr (SP2) {
        PG8_STAGE(PG8_SB(0, 0), cB, voffB); PG8_STAGE(PG8_SB(0, 1), cB + hstep, voffB); PG8_STAGE(PG8_SA(0, 0), cA, voffA); PG8_STAGE(PG8_SA(0, 1), cA + hstep, voffA);
        if (wr == 1) PG8_BAR;
        PG8_WAIT_V(2); PG8_BAR;
        PG8_STAGE(PG8_SB(1, 0), cB + kstep, voffB); PG8_STAGE(PG8_SA(1, 0), cA + kstep, voffA); PG8_STAGE(PG8_SB(1, 1), cB + hstep + kstep, voffB);
        PG8_WAIT_V(6); PG8_BAR;
    } else {
        PG8_STAGE(PG8_SB(0, 0), cB, voffB); PG8_STAGE(PG8_SA(0, 0), cA, voffA); PG8_STAGE(PG8_SB(0, 1), cB + hstep, voffB); PG8_STAGE(PG8_SA(0, 1), cA + hstep, voffA);
        if (wr == 1) PG8_BAR;
        PG8_WAIT_V(4); PG8_BAR;
        PG8_STAGE(PG8_SB(1, 0), cB + kstep, voffB); PG8_STAGE(PG8_SA(1, 0), cA + kstep, voffA); PG8_STAGE(PG8_SB(1, 1), cB + hstep + kstep, voffB);
        PG8_WAIT_V(6); PG8_BAR;
    }
    for (;;) {
        const bool has_next = S.next(ui + 1, nxt);
        const char* nA = has_next ? (const char*)g.A + (size_t)nxt.pm * tstep : cA; const char* nB = has_next ? (const char*)g.Bt + (size_t)nxt.pn * tstep : cB;
        for (int t = 0; t < nt; t += 2) {
            const bool last = (t == nt - 2);
            const char* a1 = cA + (size_t)(t + 1) * kstep;
            const char* a2 = last ? nA : cA + (size_t)(t + 2) * kstep; const char* b2 = last ? nB : cB + (size_t)(t + 2) * kstep;
            const char* a3 = a2 + kstep; const char* b3 = b2 + kstep;
            if (last && has_next) S.a_ready(nxt);
            if constexpr (SP2) {
            PG8_LDB(B0, 0, 0); PG8_LDB(B1, 0, 1); PG8_SCHED; PG8_LDA(At, 0, 0); PG8_STAGE(PG8_SA(1, 1), a1 + hstep, voffA);
            PG8_WAIT_V(8); PG8_WAIT_L(0); PG8_BAR; PG8_MMA(0, 0, At, B0); PG8_MMA(0, 1, At, B1); PG8_BAR; PG8_SCHED;
            PG8_LDA(At, 0, 1); PG8_STAGE(PG8_SB(0, 0), b2, voffB); PG8_STAGE(PG8_SB(0, 1), b2 + hstep, voffB); PG8_STAGE(PG8_SA(0, 0), a2, voffA);
            PG8_WAIT_V(8); PG8_WAIT_L(0); PG8_BAR; PG8_MMA(1, 0, At, B0); PG8_MMA(1, 1, At, B1); PG8_BAR; PG8_SCHED;
            PG8_LDB(B0, 1, 0); PG8_LDB(B1, 1, 1); PG8_SCHED; PG8_LDA(At, 1, 0); PG8_STAGE(PG8_SA(0, 1), a2 + hstep, voffA);
            PG8_WAIT_V(8); PG8_WAIT_L(0); PG8_BAR; PG8_MMA(0, 0, At, B0); PG8_MMA(0, 1, At, B1); PG8_BAR; PG8_SCHED;
            PG8_LDA(At, 1, 1); PG8_STAGE(PG8_SB(1, 0), b3, voffB); PG8_STAGE(PG8_SB(1, 1), b3 + hstep, voffB); PG8_STAGE(PG8_SA(1, 0), a3, voffA);
            PG8_WAIT_V(8); PG8_WAIT_L(0); PG8_BAR; PG8_MMA(1, 0, At, B0); PG8_MMA(1, 1, At, B1); PG8_BAR; PG8_SCHED;
            } else {
            PG8_LDB(B0, 0, 0); PG8_SCHED; PG8_LDA(At, 0, 0); PG8_STAGE(PG8_SA(1, 1), a1 + hstep, voffA);
            PG8_WAIT_L(8); PG8_BAR; PG8_WAIT_L(0); PG8_MMA(0, 0, At, B0); PG8_BAR; PG8_SCHED;
            PG8_LDB(B1, 0, 1); PG8_STAGE(PG8_SB(0, 0), b2, voffB);
            PG8_BAR; PG8_WAIT_L(0); PG8_MMA(0, 1, At, B1); PG8_BAR;
            PG8_LDA(At, 0, 1); PG8_STAGE(PG8_SA(0, 0), a2, voffA);
            PG8_BAR; PG8_WAIT_L(0); PG8_MMA(1, 0, At, B0); PG8_BAR; PG8_SCHED;
            PG8_STAGE(PG8_SB(0, 1), b2 + hstep, voffB);
            PG8_WAIT_V(6); PG8_BAR; PG8_MMA(1, 1, At, B1); PG8_BAR;
            PG8_LDB(B0, 1, 0); PG8_SCHED; PG8_LDA(At, 1, 0); PG8_STAGE(PG8_SA(0, 1), a2 + hstep, voffA);
            PG8_WAIT_L(8); PG8_BAR; PG8_WAIT_L(0); PG8_MMA(0, 0, At, B0); PG8_BAR; PG8_SCHED;
            PG8_LDB(B1, 1, 1); PG8_STAGE(PG8_SB(1, 0), b3, voffB);
            PG8_BAR; PG8_WAIT_L(0); PG8_MMA(0, 1, At, B1); PG8_BAR;
            PG8_LDA(At, 1, 1); PG8_STAGE(PG8_SA(1, 0), a3, voffA);
            PG8_BAR; PG8_WAIT_L(0); PG8_MMA(1, 0, At, B0); PG8_BAR; PG8_SCHED;
            PG8_STAGE(PG8_SB(1, 1), b3 + hstep, voffB);
            PG8_WAIT_V(6); PG8_BAR; PG8_MMA(1, 1, At, B1); PG8_BAR;
            }
        }
        if constexpr (ALIGN_EPI) { if (wr == 0) PG8_BAR; }
        if constexpr (!Epi::AFTER_DRAIN) { E(acc, cur, wr, wc, fr, fq); S.done(cur); }
        if (!has_next) break;
#pragma unroll
        for (int a = 0; a < 2; ++a)
#pragma unroll
            for (int b = 0; b < 2; ++b)
#pragma unroll
                for (int m = 0; m < 4; ++m)
#pragma unroll
                    for (int n = 0; n < 2; ++n) acc[a][b][m][n] = (f32x4){0.f, 0.f, 0.f, 0.f};
        cur = nxt; cA = nA; cB = nB; ++ui;
        if constexpr (ALIGN_EPI) { if (wr == 1) PG8_BAR; }
    }
    PG8_WAIT_V(0);
    if constexpr (!ALIGN_EPI) { if (wr == 0) PG8_BAR; }
    PG8_BAR;
    if constexpr (Epi::AFTER_DRAIN) { E.fused(acc, cur, wr, wc, fr, fq, lds, wid, lane); S.done(cur); }
#undef PG8_SA
#undef PG8_SB
#undef PG8_STAGE
#undef PG8_LDA
#undef PG8_LDB
#undef PG8_MMA
#undef PG8_WAIT_V
#undef PG8_WAIT_L
#undef PG8_BAR
#undef PG8_SCHED
}
}
#define GAS __attribute__((address_space(1)))
#define LAS __attribute__((address_space(3)))
typedef unsigned short bf16;
typedef unsigned v4u __attribute__((ext_vector_type(4)));
typedef float f32x4 __attribute__((ext_vector_type(4)));
typedef short bf16x8 __attribute__((ext_vector_type(8)));
typedef GAS unsigned gu32;
typedef GAS unsigned long long gu64;
#define RLX_AGENT __ATOMIC_RELAXED, __HIP_MEMORY_SCOPE_AGENT
#define LDS_WAIT() asm volatile("s_waitcnt lgkmcnt(0)" ::: "memory")
#define VM_WAIT() asm volatile("s_waitcnt vmcnt(0)" ::: "memory")
__device__ __forceinline__ unsigned long long rt() { return __builtin_amdgcn_s_memrealtime(); }
__device__ __forceinline__ unsigned f2bf(float f) { unsigned u = __builtin_bit_cast(unsigned, f); return (u + 0x7fffu + ((u >> 16) & 1u)) >> 16; }
__device__ __forceinline__ unsigned pk2(float lo, float hi) { return f2bf(lo) | (f2bf(hi) << 16); }

#define XB_TMO      128
#define XB_XCNT(j)  (256  + 64 * (j))
#define XB_XSUB(j)  (1280 + 64 * (j))
#define XB_XGEN(j)  (2304 + 64 * (j))
#define XB_TOP      3328
#define XB_TOPGEN   3392
#define XCD_BAR_WORDS 3456
#define XB_SPIN_CAP (1u << 18)

__device__ __forceinline__ unsigned xb_ld(unsigned* p)              { return __hip_atomic_load(p, __ATOMIC_RELAXED, __HIP_MEMORY_SCOPE_AGENT); }
__device__ __forceinline__ unsigned xb_add(unsigned* p, unsigned v) { return __hip_atomic_fetch_add(p, v, __ATOMIC_RELAXED, __HIP_MEMORY_SCOPE_AGENT); }
__device__ __forceinline__ unsigned xb_xcc_id() { return (unsigned)__builtin_amdgcn_s_getreg((3 << 11) | 20) & 0xFu; }
#define XB_SPIN(cond, bar) do { unsigned _sp = 0; while (cond) { __builtin_amdgcn_s_sleep(1); \
    if ((++_sp & 255u) == 0u) { if (xb_ld(&(bar)[XB_TMO])) break; if (_sp > XB_SPIN_CAP) { atomicAdd(&(bar)[XB_TMO], 1u); break; } } } } while (0)

struct XcdBarrier {
    unsigned* bar; unsigned x;
    volatile LAS unsigned* st;
};

__device__ __forceinline__ XcdBarrier xcd_barrier_post(unsigned* bar, volatile LAS unsigned* st) {
    XcdBarrier b; b.bar = bar; b.x = xb_xcc_id(); b.st = st;
    if (threadIdx.x == 0) (void)xb_add(&bar[XB_XCNT(b.x)], 1u);
    return b;
}
__device__ __forceinline__ void xcd_barrier_complete(unsigned* bar, unsigned x, unsigned& nloc, unsigned& nx) {
    const unsigned G = gridDim.x * gridDim.y * gridDim.z;
    unsigned sum, cnt, mine, sp = 0u;
    for (;;) {
        sum = 0u; cnt = 0u; mine = 0u;
#pragma unroll
        for (unsigned j = 0; j < 16; ++j) { const unsigned c = xb_ld(&bar[XB_XCNT(j)]); sum += c; cnt += (c > 0u) ? 1u : 0u; mine = (j == x) ? c : mine; }
        if (sum == G) break;
        __builtin_amdgcn_s_sleep(1);
        if ((++sp & 255u) == 0u) { if (xb_ld(&bar[XB_TMO])) break; if (sp > XB_SPIN_CAP) { atomicAdd(&bar[XB_TMO], 1u); break; } }
    }
    nloc = mine > 0u ? mine : 1u; nx = cnt > 0u ? cnt : 1u;
}

__device__ __forceinline__ void xcd_barrier(const XcdBarrier& b) {
    asm volatile("s_waitcnt vmcnt(0)" ::: "memory");
    __syncthreads();
    if (threadIdx.x == 0) {
        unsigned* bar = b.bar;
        __builtin_amdgcn_s_waitcnt(0);
        unsigned nloc = b.st[0], nx = b.st[1];
        if (nloc == 0u) { xcd_barrier_complete(bar, b.x, nloc, nx); b.st[0] = nloc; b.st[1] = nx; }
        const unsigned old = xb_add(&bar[XB_XSUB(b.x)], 1u);
        const unsigned gen = old / nloc;
        if (old + 1u == (gen + 1u) * nloc) {
            __builtin_amdgcn_fence(__ATOMIC_RELEASE, "agent");
            asm volatile("s_waitcnt vmcnt(0)" ::: "memory");
            const unsigned og = xb_add(&bar[XB_TOP], 1u);
            const unsigned tg = og / nx;
            if (og + 1u == (tg + 1u) * nx) xb_add(&bar[XB_TOPGEN], 1u);
            else XB_SPIN(xb_ld(&bar[XB_TOPGEN]) == tg, bar);
            __builtin_amdgcn_fence(__ATOMIC_ACQUIRE, "agent");
            xb_add(&bar[XB_XGEN(b.x)], 1u);
            asm volatile("s_waitcnt vmcnt(0)" ::: "memory");
        } else {
            XB_SPIN(xb_ld(&bar[XB_XGEN(b.x)]) == gen, bar);
            __builtin_amdgcn_fence(__ATOMIC_ACQUIRE, "agent");
            asm volatile("s_waitcnt vmcnt(0)" ::: "memory");
        }
    }
    __syncthreads();
}
constexpr int BATCH = 4, T = 4096, DM = 2048, DEPTH = 4, M = BATCH * T;
constexpr int D_IN = 6600, NPROJ = 6656;
constexpr int SC_MLQK = 0, SC_MLV = 1024, SC_MLI = 1536, SC_MLF = 1540, SC_MLO = 1544, SC_MLZ = 2056, SC_CQ = 2568, SC_CKV = 3080, SC_KR = 3336, SC_MLAZ = 3400, SC_RW = 4424, SC_RWZ = 6088;
constexpr int PC_MLQK = 0, PC_MLV = 1024, PC_MLO = 1536, PC_MLZ = 2048, PC_CQ = 2560, PC_CKV = 3072, PC_MLAZ = 3328, PC_RW = 4352, PC_SPEC = 5888, PC_RWZ = 6144;
constexpr int SPEC_TILE = PC_SPEC / 256;
constexpr int NQ = 1536, NKV = 2048;
constexpr float NORM_EPS = 1e-6f, RW_GN_EPS = 64e-5f;
typedef unsigned short bf16_t;
__device__ __forceinline__ float bf2f(unsigned v) { return __uint_as_float(v << 16); }
__device__ __forceinline__ float wave_sum(float v) {
#pragma unroll
    for (int o = 1; o < 64; o <<= 1) v += __shfl_xor(v, o);
    return v;
}
__device__ __forceinline__ float sigmoidf_(float x) { return 1.f / (1.f + __expf(-x)); }
__device__ __forceinline__ float siluf_(float x) { return x / (1.f + __expf(-x)); }
__device__ __forceinline__ float softplusf_(float x) { return fmaxf(x, 0.f) + log1pf(__expf(-fabsf(x))); }

namespace att {
typedef unsigned short bf16_t;
typedef short bf16x8 __attribute__((ext_vector_type(8)));
typedef short s16x4 __attribute__((ext_vector_type(4)));
typedef float f32x16 __attribute__((ext_vector_type(16)));
typedef float f32x4 __attribute__((ext_vector_type(4)));
typedef unsigned u32x4 __attribute__((ext_vector_type(4)));
constexpr int NW = 8, QBLK = 32, KVBLK = 64, QB = NW * QBLK;
constexpr int QP = 1536, KVP = 2048, KRP = 64, OP = 2048;
constexpr int SHM_V = KVBLK * 128 * 2, SHM_K = KVBLK * 128 * 2, SHM_R = KVBLK * 64 * 2;
constexpr int OFF_V = 0, OFF_K = 2 * SHM_V, OFF_R = OFF_K + SHM_K, OFF_WS = OFF_R + SHM_R, OFF_Q = OFF_WS + NW * 64 * 4, LDS_BYTES = OFF_Q + NW * 12288;
constexpr float SCALE = 0.07216878364870322f;
constexpr float THR = 8.f;
constexpr unsigned WBIG = 1u << 30;
#define KSWZ(row, colB) ((row) * 256 + ((colB) ^ (((row) & 7) << 4)))
#define RSWZ(row, colB) ((row) * 128 + ((colB) ^ (((row) & 7) << 4)))
#define SBAR() __builtin_amdgcn_sched_barrier(0)
__device__ __forceinline__ int v_st(int k, int c) { const int kk = (k & ~0xC) | ((k & 4) << 1) | ((k & 8) >> 1); return ((kk >> 3) * 4 + (c >> 5)) * 512 + ((kk & 7) * 32 + (c & 31)) * 2; }
__device__ __forceinline__ int v_rd_base(int lane) { return ((lane & 3) << 3) | (((lane >> 2) & 3) << 6) | (((lane >> 4) & 1) << 5) | (((lane >> 5) & 1) << 8); }
constexpr int v_rd_off(int d0, int ks, int half) { return d0 * 512 + ks * 4096 + half * 2048; }
__device__ __forceinline__ int crow(int r, int hi) { return (r & 3) + 8 * (r >> 2) + 4 * hi; }
__device__ __forceinline__ unsigned cvtpk(float lo, float hi) { unsigned r; asm volatile("v_cvt_pk_bf16_f32 %0, %1, %2" : "=v"(r) : "v"(lo), "v"(hi)); return r; }
__device__ __forceinline__ bf16x8 load8(const bf16_t* p) { return *reinterpret_cast<const bf16x8*>(p); }
__device__ __forceinline__ float bf2f(bf16_t v) { return __uint_as_float((unsigned)v << 16); }
__device__ __forceinline__ void mask_tile(f32x16& p0, f32x16& p1, int dq, unsigned W) {
    const float NEG = -__builtin_inff();
#pragma unroll
    for (int r = 0; r < 16; ++r) {
        const int c = (r & 3) + 8 * (r >> 2);
        if ((unsigned)(dq - c) >= W) p0[r] = NEG;
        if ((unsigned)(dq - c - 32) >= W) p1[r] = NEG;
    }
}
__device__ __forceinline__ void partialSM(f32x16& p0, f32x16& p1, float& m_reg, float& mn, float& alpha) {
    float pmax = p0[0]; for (int r = 1; r < 16; ++r) pmax = fmaxf(pmax, p0[r]); for (int r = 0; r < 16; ++r) pmax = fmaxf(pmax, p1[r]);
    { auto rr = __builtin_amdgcn_permlane32_swap(__float_as_uint(pmax), __float_as_uint(pmax), false, false);
      pmax = fmaxf(__uint_as_float(rr[0]), __uint_as_float(rr[1])); }
    constexpr float C2 = 1.4426950408889634f * SCALE;
    if (__builtin_expect(__all((pmax - m_reg) * SCALE <= THR), 1)) { mn = m_reg; alpha = 1.f; }
    else { mn = fmaxf(m_reg, pmax); alpha = __builtin_amdgcn_exp2f((m_reg - mn) * C2); m_reg = mn; }
    const float mnL = -mn * C2;
    for (int r = 0; r < 16; ++r) p0[r] = fmaf(p0[r], C2, mnL); for (int r = 0; r < 16; ++r) p1[r] = fmaf(p1[r], C2, mnL);
    for (int r = 0; r < 16; ++r) p0[r] = __builtin_amdgcn_exp2f(p0[r]);
}
__device__ __forceinline__ void finishSM(f32x16& p0, f32x16& p1, float alpha, float& l_reg, bf16x8& pa0, bf16x8& pa1, bf16x8& pa2, bf16x8& pa3) {
    for (int r = 0; r < 16; ++r) p1[r] = __builtin_amdgcn_exp2f(p1[r]);
    float ps = 0; for (int r = 0; r < 16; ++r) ps += p0[r]; for (int r = 0; r < 16; ++r) ps += p1[r];
    { auto rr = __builtin_amdgcn_permlane32_swap(__float_as_uint(ps), __float_as_uint(ps), false, false);
      ps = __uint_as_float(rr[0]) + __uint_as_float(rr[1]); }
    l_reg = l_reg * alpha + ps;
#define PK4(P, B_, OUT) do { unsigned a0 = cvtpk(P[B_+0], P[B_+1]), a1 = cvtpk(P[B_+2], P[B_+3]);                          \
        unsigned b0 = cvtpk(P[B_+4], P[B_+5]), b1 = cvtpk(P[B_+6], P[B_+7]);                                             \
        auto r0 = __builtin_amdgcn_permlane32_swap(a0, b0, false, false); auto r1 = __builtin_amdgcn_permlane32_swap(a1, b1, false, false); \
        u32x4 w = {r0[0], r1[0], r0[1], r1[1]}; OUT = *reinterpret_cast<bf16x8*>(&w); } while (0)
    PK4(p0, 0, pa0); PK4(p0, 8, pa1); PK4(p1, 0, pa2); PK4(p1, 8, pa3);
#undef PK4
}
__device__ __forceinline__ void qkt(f32x16& p0, f32x16& p1, const char* K_lds, const char* R_lds, const char* Qw, int r32, int hi) {
    p0 = f32x16{}; p1 = f32x16{};
    const char* kb[4]; const char* rb[4];
#pragma unroll
    for (int dd = 0; dd < 4; ++dd) { kb[dd] = K_lds + KSWZ(r32, (dd * 16 + hi * 8) * 2); rb[dd] = R_lds + RSWZ(r32, (dd * 16 + hi * 8) * 2); }
#pragma unroll
    for (int d0 = 0; d0 < 8; ++d0) { const char* a = kb[d0 & 3] + (d0 >> 2) * 128;
        bf16x8 b0 = *reinterpret_cast<const bf16x8*>(a);
        bf16x8 b1 = *reinterpret_cast<const bf16x8*>(a + 32 * 256);
        bf16x8 q = *reinterpret_cast<const bf16x8*>(Qw + d0 * 1024);
        p0 = __builtin_amdgcn_mfma_f32_32x32x16_bf16(b0, q, p0, 0, 0, 0);
        p1 = __builtin_amdgcn_mfma_f32_32x32x16_bf16(b1, q, p1, 0, 0, 0); }
#pragma unroll
    for (int e = 0; e < 4; ++e) { const char* a = rb[e];
        bf16x8 b0 = *reinterpret_cast<const bf16x8*>(a);
        bf16x8 b1 = *reinterpret_cast<const bf16x8*>(a + 32 * 128);
        bf16x8 q = *reinterpret_cast<const bf16x8*>(Qw + (8 + e) * 1024);
        p0 = __builtin_amdgcn_mfma_f32_32x32x16_bf16(b0, q, p0, 0, 0, 0);
        p1 = __builtin_amdgcn_mfma_f32_32x32x16_bf16(b1, q, p1, 0, 0, 0); }
}
template <int VB>
__device__ __forceinline__ void pv_tile(f32x16* o, int vb0, bf16x8 pa0, bf16x8 pa1, bf16x8 pa2, bf16x8 pa3) {
#define TRRD(dst, off) asm volatile("ds_read_b64_tr_b16 %0, %1 offset:%2" : "=&v"(dst) : "v"(vb0), "i"(off) : "memory")
#define PV_D0(d0) do { s16x4 l0, l1, l2, l3, h0, h1, h2, h3; constexpr int b_ = OFF_V + VB * SHM_V + v_rd_off(d0, 0, 0); \
        TRRD(l0, b_); TRRD(h0, b_ + 2048); TRRD(l1, b_ + 4096); TRRD(h1, b_ + 6144); TRRD(l2, b_ + 8192); TRRD(h2, b_ + 10240); TRRD(l3, b_ + 12288); TRRD(h3, b_ + 14336); \
        asm volatile("s_waitcnt lgkmcnt(0)" ::: "memory"); SBAR();   \
        o[d0] = __builtin_amdgcn_mfma_f32_32x32x16_bf16(pa0, (bf16x8){l0[0], l0[1], l0[2], l0[3], h0[0], h0[1], h0[2], h0[3]}, o[d0], 0, 0, 0);   \
        o[d0] = __builtin_amdgcn_mfma_f32_32x32x16_bf16(pa1, (bf16x8){l1[0], l1[1], l1[2], l1[3], h1[0], h1[1], h1[2], h1[3]}, o[d0], 0, 0, 0);   \
        o[d0] = __builtin_amdgcn_mfma_f32_32x32x16_bf16(pa2, (bf16x8){l2[0], l2[1], l2[2], l2[3], h2[0], h2[1], h2[2], h2[3]}, o[d0], 0, 0, 0);   \
        o[d0] = __builtin_amdgcn_mfma_f32_32x32x16_bf16(pa3, (bf16x8){l3[0], l3[1], l3[2], l3[3], h3[0], h3[1], h3[2], h3[3]}, o[d0], 0, 0, 0); } while (0)
    PV_D0(0); PV_D0(1); PV_D0(2); PV_D0(3);
#undef PV_D0
#undef TRRD
}
struct BlockRef { const bf16_t* Q; const bf16_t* K; const bf16_t* V; const bf16_t* KR; bf16_t* O; const bf16_t* Z; const float* CSq; int P0; };
struct Seam { bf16x8 qr[12]; bf16x8 st_v0, st_v1, st_k0, st_k1, st_r; };
#define ROWKV(p, k0, rr) ((p) + (size_t)((k0) + (rr)) * KVP + sc)
#define VMW() asm volatile("s_waitcnt vmcnt(0)" ::: "memory")
#define VMWN(n) asm volatile("s_waitcnt vmcnt(%0)" :: "i"(n) : "memory")
#define SLOAD_H(Kp, Vp, Rp, k0) do { S.st_v0 = load8(ROWKV(Vp, k0, sr)); S.st_v1 = load8(ROWKV(Vp, k0, 32 + sr));              \
                         S.st_k0 = load8(ROWKV(Kp, k0, sr)); S.st_k1 = load8(ROWKV(Kp, k0, 32 + sr)); S.st_r = load8((Rp) + (size_t)((k0) + rr_) * KRP + rc_); } while (0)
#define SWRITE_HK() do { *(bf16x8*)(K_lds + kws) = S.st_k0; *(bf16x8*)(K_lds + kws + 32 * 256) = S.st_k1; *(bf16x8*)(R_lds + rws) = S.st_r; } while (0)
#define SWRITE_HV(bf) do { *(bf16x8*)(V_lds + (bf) * SHM_V + vst0) = S.st_v0; *(bf16x8*)(V_lds + (bf) * SHM_V + vst1) = S.st_v1; } while (0)
#define SWRITE_H(bf) do { SWRITE_HV(bf); SWRITE_HK(); } while (0)
__device__ __forceinline__ void attn_prime(const BlockRef& cur, char* lds, Seam& S) {
    int tid_o = threadIdx.x; asm volatile("" : "+v"(tid_o));
    const int tid = tid_o, wid = __builtin_amdgcn_readfirstlane(tid >> 6), lane = tid & 63, r32 = lane & 31, hi = lane >> 5;
    const int sr = tid >> 4, sc = (tid & 15) * 8, kws = KSWZ(sr, sc * 2), rr_ = tid >> 3, rc_ = (tid & 7) * 8, rws = RSWZ(rr_, rc_ * 2);
    char* K_lds = lds + OFF_K; char* R_lds = lds + OFF_R;
#pragma unroll
    for (int d0 = 0; d0 < 12; ++d0) S.qr[d0] = load8(cur.Q + (size_t)(wid * QBLK + r32) * QP + d0 * 16 + hi * 8);
    SLOAD_H(cur.K, cur.V, cur.KR, 0); VMW(); SWRITE_HK();
    __syncthreads();
}
__device__ __forceinline__ void attn_block(const BlockRef& cur, const BlockRef& nxt, char* lds, Seam& S) {
    int tid_o = threadIdx.x; asm volatile("" : "+v"(tid_o));
    const int tid = tid_o, wid = __builtin_amdgcn_readfirstlane(tid >> 6), lane = tid & 63, r32 = lane & 31, hi = lane >> 5;
    const int NT = cur.P0 / KVBLK + 4;
    const int qlo = cur.P0 + wid * QBLK, qm = qlo + r32 - 4 * hi;
    char* V_lds = lds + OFF_V; char* K_lds = lds + OFF_K; char* R_lds = lds + OFF_R;
    float* ws = (float*)(lds + OFF_WS) + wid * 64; float* li_l = ws, * al_l = ws + 32;
    float m_reg = -1e30f, l_reg = 0; f32x16 o[4] = {};
    const int sr = tid >> 4, sc = (tid & 15) * 8, vst0 = v_st(sr, sc), vst1 = v_st(32 + sr, sc), kws = KSWZ(sr, sc * 2), rr_ = tid >> 3, rc_ = (tid & 7) * 8, rws = RSWZ(rr_, rc_ * 2);
    const int vb0 = (int)(uintptr_t)lds + v_rd_base(lane);
    char* Qw = lds + OFF_Q + wid * 12288 + lane * 16;
    const bf16_t* Kh = cur.K; const bf16_t* Vh = cur.V; const bf16_t* Rh = cur.KR;
#define RESC(a) do { if (__any((a) < 1.f)) { if (hi == 0) al_l[r32] = (a); asm volatile("s_waitcnt lgkmcnt(0)" ::: "memory");              \
                     for (int d_ = 0; d_ < 4; ++d_) for (int r = 0; r < 16; ++r) o[d_][r] *= al_l[crow(r, hi)]; } } while (0)
#define KBASE(t) ((t) * KVBLK)
#define MASKT(P0_, P1_, t) do { const int kb_ = KBASE(t); if (kb_ + KVBLK - 1 > qlo) mask_tile(P0_, P1_, qm - kb_, WBIG); } while (0)
    constexpr int NQL = 12;
#define SEAM_K0() do { VMWN(NQL); SWRITE_HK(); SBAR(); } while (0)
    f32x16 pA0, pA1, pB0, pB1; float mnA, mnB, alA, alB; bf16x8 pa0, pa1, pa2, pa3;
#pragma unroll
    for (int e = 0; e < 4; ++e) { const f32x4* cp = (const f32x4*)(cur.CSq + (size_t)(wid * QBLK + r32) * 64 + (e * 8 + hi * 4) * 2); const f32x4 c0 = cp[0], c1 = cp[1];
        const bf16x8 raw = S.qr[8 + e]; float x[8];
#pragma unroll
        for (int j = 0; j < 8; ++j) x[j] = __uint_as_float((unsigned)(unsigned short)raw[j] << 16);
        u32x4 w;
        w.x = cvtpk(x[0] * c0[0] - x[1] * c0[1], x[1] * c0[0] + x[0] * c0[1]); w.y = cvtpk(x[2] * c0[2] - x[3] * c0[3], x[3] * c0[2] + x[2] * c0[3]);
        w.z = cvtpk(x[4] * c1[0] - x[5] * c1[1], x[5] * c1[0] + x[4] * c1[1]); w.w = cvtpk(x[6] * c1[2] - x[7] * c1[3], x[7] * c1[2] + x[6] * c1[3]);
        S.qr[8 + e] = *reinterpret_cast<bf16x8*>(&w); }
#pragma unroll
    for (int d0 = 0; d0 < 12; ++d0) *(bf16x8*)(Qw + d0 * 1024) = S.qr[d0];
    SWRITE_HV(0); SBAR();
    SLOAD_H(Kh, Vh, Rh, KBASE(1));
    SBAR(); qkt(pA0, pA1, K_lds, R_lds, Qw, r32, hi);
    MASKT(pA0, pA1, 0); partialSM(pA0, pA1, m_reg, mnA, alA);
    __syncthreads();
    VMW(); SWRITE_H(1);
    __syncthreads();
#define HALF_STEP(PX0, PX1, mnX, alX, PY0, PY1, alY, t, VB, SB) do {                                                          \
        SBAR(); qkt(PX0, PX1, K_lds, R_lds, Qw, r32, hi);                                                                     \
        finishSM(PY0, PY1, alY, l_reg, pa0, pa1, pa2, pa3); SBAR();                                                           \
        if ((t) + 1 < NT) { SLOAD_H(Kh, Vh, Rh, KBASE((t) + 1)); SBAR(); }                                                    \
        pv_tile<VB>(o, vb0, pa0, pa1, pa2, pa3); MASKT(PX0, PX1, (t)); partialSM(PX0, PX1, m_reg, mnX, alX);                  \
        __syncthreads();                                                                                                      \
        if ((t) + 1 < NT) { VMW(); SWRITE_H(SB); }                                                                            \
        RESC(alX); __syncthreads(); } while (0)
    for (int t = 1; t + 1 < NT; t += 2) {
        HALF_STEP(pB0, pB1, mnB, alB, pA0, pA1, alA, t, 0, 0);
        HALF_STEP(pA0, pA1, mnA, alA, pB0, pB1, alB, t + 1, 1, 1);
    }
    SBAR(); qkt(pB0, pB1, K_lds, R_lds, Qw, r32, hi); SBAR();
    SLOAD_H(nxt.K, nxt.V, nxt.KR, 0); SBAR();
    finishSM(pA0, pA1, alA, l_reg, pa0, pa1, pa2, pa3); SBAR();
    pv_tile<0>(o, vb0, pa0, pa1, pa2, pa3);
    MASKT(pB0, pB1, NT - 1); partialSM(pB0, pB1, m_reg, mnB, alB); __syncthreads(); RESC(alB);
    finishSM(pB0, pB1, alB, l_reg, pa0, pa1, pa2, pa3); SBAR(); pv_tile<1>(o, vb0, pa0, pa1, pa2, pa3);
    SBAR();
#pragma unroll
    for (int d0 = 0; d0 < 12; ++d0) S.qr[d0] = load8(nxt.Q + (size_t)(wid * QBLK + r32) * QP + d0 * 16 + hi * 8);
    SBAR(); SEAM_K0();
    if (hi == 0) li_l[r32] = l_reg; asm volatile("s_waitcnt lgkmcnt(0)" ::: "memory");
    float rli[16];
#pragma unroll
    for (int r = 0; r < 16; ++r) rli[r] = __builtin_amdgcn_rcpf(li_l[crow(r, hi)]);
    bf16_t* Ow = cur.O + (size_t)(wid * QBLK) * OP; const bf16_t* Zw = cur.Z + (size_t)(wid * QBLK) * NPROJ;
#pragma unroll
    for (int r = 0; r < 16; ++r) { const int orow = crow(r, hi);
#pragma unroll
        for (int d0 = 0; d0 < 4; ++d0) { const float z = bf2f(Zw[(size_t)orow * NPROJ + d0 * 32 + r32]);
            const float v = o[d0][r] * rli[r] * (z / (1.f + __expf(-z)));
            const float vn = __shfl_xor(v, 1);
            if ((r32 & 1) == 0) *(unsigned*)(Ow + (size_t)orow * OP + d0 * 32 + r32) = cvtpk(v, vn); } }
    __syncthreads();
#undef RESC
#undef KBASE
#undef MASKT
#undef SEAM_K0
#undef HALF_STEP
}
#undef ROWKV
#undef VMW
#undef VMWN
#undef SLOAD_H
#undef SWRITE_HK
#undef SWRITE_HV
#undef SWRITE_H
#undef KSWZ
#undef RSWZ
#undef SBAR
}
namespace mm {
typedef short bf16x8 __attribute__((ext_vector_type(8)));
typedef float f32x4 __attribute__((ext_vector_type(4)));
typedef unsigned u32x2 __attribute__((ext_vector_type(2)));
#define MM_LAS __attribute__((address_space(3)))
typedef float f32x2_t __attribute__((ext_vector_type(2))); typedef __bf16 bf16x2_t __attribute__((ext_vector_type(2)));
__device__ __forceinline__ unsigned cvtpk(float lo, float hi) { const f32x2_t v = {lo, hi}; const bf16x2_t b = __builtin_convertvector(v, bf16x2_t); return __builtin_bit_cast(unsigned, b); }
template <int NK>
__device__ __forceinline__ void blk(f32x4& acc, const MM_LAS unsigned char* A, int apitch, const MM_LAS unsigned char* Bt, int bpitch, int lane) {
    const MM_LAS unsigned char* ap = A + (lane & 15) * apitch + (lane >> 4) * 16;
    const MM_LAS unsigned char* bp = Bt + (lane & 15) * bpitch + (lane >> 4) * 16;
#pragma unroll
    for (int ks = 0; ks < NK; ++ks) { const bf16x8 a = *(const MM_LAS bf16x8*)(ap + ks * 64), b = *(const MM_LAS bf16x8*)(bp + ks * 64); acc = __builtin_amdgcn_mfma_f32_16x16x32_bf16(a, b, acc, 0, 0, 0); }
}
__device__ __forceinline__ void store_T(const f32x4& acc, MM_LAS unsigned char* img, int pitch, int jbase, int ibase, int lane) {
    u32x2 w; w.x = cvtpk(acc[0], acc[1]); w.y = cvtpk(acc[2], acc[3]);
    *(MM_LAS u32x2*)(img + (jbase + (lane & 15)) * pitch + (ibase + 4 * (lane >> 4)) * 2) = w;
}
__device__ __forceinline__ float bfl(unsigned short v) { return __uint_as_float((unsigned)v << 16); }
__device__ __forceinline__ unsigned short f2b(float f) { return (unsigned short)(cvtpk(f, 0.f) & 0xffffu); }
}

namespace mlk {
constexpr int PQ = 272, PS = 144;
constexpr int O_QI = 0, O_KI = 17408, O_WKT = 34816, O_VT = 53248, O_CI = 73984, O_SI = 113152, O_TAB = 122368, LDS_END = 124416;
constexpr int HBP = 132;
}
__device__ __forceinline__ void mlstm_unit(unsigned char* lds_g, int b, int h, const bf16_t* QKC, const bf16_t* PROJ, const float* LI, const float* LF, const float* ng, bf16_t* MIXED) {
    using namespace mlk; using mm::f32x4; using mm::bf16x8;
    MM_LAS unsigned char* L = (MM_LAS unsigned char*)lds_g;
    int tid_o = threadIdx.x; asm volatile("" : "+v"(tid_o));
    const int tid = tid_o, lane = tid & 63, wave = __builtin_amdgcn_readfirstlane(tid >> 6);
    MM_LAS unsigned char *QI = L + O_QI, *KI = L + O_KI, *WKT = L + O_WKT, *VT = L + O_VT, *CI = L + O_CI, *SI = L + O_SI;
    MM_LAS float* TAB = (MM_LAS float*)(L + O_TAB);
    MM_LAS float* HB = (MM_LAS float*)L;
    for (int i = tid; i < 39168 / 4; i += 512) ((MM_LAS unsigned*)CI)[i] = 0u;
    for (int i = tid; i < 16 * PS / 4; i += 512) ((MM_LAS unsigned*)(VT + 128 * PS))[i] = (i < PS / 4) ? 0x3f803f80u : 0u;
    f32x4 cacc[9];
#pragma unroll
    for (int i = 0; i < 9; ++i) cacc[i] = (f32x4){0.f, 0.f, 0.f, 0.f};
    float m_run = 0.f;
    const int t = lane, cg = wave;
    const size_t mrow0 = (size_t)b * T;
    bf16x8 q0, q1, k0, k1, v0, v1; float li = 0.f, lf = 0.f;
#define ML_LOAD(c_) do { const size_t m_ = mrow0 + (size_t)(c_) * 64 + t; const bf16_t* qp = QKC + m_ * 1024 + h * 128 + 16 * cg; const bf16_t* vp = PROJ + m_ * NPROJ + PC_MLV + h * 128 + 16 * cg; \
        q0 = *(const bf16x8*)qp; q1 = *(const bf16x8*)(qp + 8); k0 = *(const bf16x8*)(qp + 512); k1 = *(const bf16x8*)(qp + 520); v0 = *(const bf16x8*)vp; v1 = *(const bf16x8*)(vp + 8); \
        if (wave == 0) { li = LI[m_ * 4 + h]; lf = LF[m_ * 4 + h]; } } while (0)
    ML_LOAD(0);
    for (int c = 0; c < 64; ++c) {
        if (wave == 0) {
            float bb = lf;
#pragma unroll
            for (int o = 1; o < 64; o <<= 1) { const float u = __shfl_up(bb, o); if (lane >= o) bb += u; }
            const float a = li - bb; float pm = a;
#pragma unroll
            for (int o = 1; o < 64; o <<= 1) { const float u = __shfl_up(pm, o); if (lane >= o) pm = fmaxf(pm, u); }
            const float mx = fmaxf(m_run, pm), mxL = __shfl(mx, 63), bL = __shfl(bb, 63);
            TAB[t] = a; TAB[64 + t] = mx; TAB[128 + t] = __expf(m_run - mx); TAB[192 + t] = __expf(-(bb + mx)); TAB[256 + t] = __expf(a - mxL);
            if (lane == 0) TAB[320] = __expf(m_run - mxL);
            m_run = bL + mxL;
        }
        __syncthreads();
        {
            *(MM_LAS bf16x8*)(QI + t * PQ + cg * 32) = q0; *(MM_LAS bf16x8*)(QI + t * PQ + cg * 32 + 16) = q1;
            *(MM_LAS bf16x8*)(KI + t * PQ + cg * 32) = k0; *(MM_LAS bf16x8*)(KI + t * PQ + cg * 32 + 16) = k1;
            const float wt = TAB[256 + t];
#pragma unroll
            for (int e = 0; e < 8; ++e) {
                *(MM_LAS unsigned short*)(WKT + (16 * cg + e) * PS + t * 2) = mm::f2b(wt * mm::bfl((unsigned short)k0[e]));
                *(MM_LAS unsigned short*)(WKT + (16 * cg + 8 + e) * PS + t * 2) = mm::f2b(wt * mm::bfl((unsigned short)k1[e]));
                *(MM_LAS unsigned short*)(VT + (16 * cg + e) * PS + t * 2) = (unsigned short)v0[e];
                *(MM_LAS unsigned short*)(VT + (16 * cg + 8 + e) * PS + t * 2) = (unsigned short)v1[e]; }
        }
        if (c + 1 < 64) ML_LOAD(c + 1);
        __syncthreads();
        {
            const int bi = wave >> 1;
#pragma unroll
            for (int jj = 0; jj < 2; ++jj) { const int bj = 2 * (wave & 1) + jj; f32x4 acc = (f32x4){0.f, 0.f, 0.f, 0.f};
                if (bi <= bj) { mm::blk<4>(acc, KI + bi * 16 * PQ, PQ, QI + bj * 16 * PQ, PQ, lane);
                    const int tt = 16 * bj + (lane & 15); const float mxt = TAB[64 + tt];
#pragma unroll
                    for (int r = 0; r < 4; ++r) { const int s = 16 * bi + 4 * (lane >> 4) + r; acc[r] = (s <= tt) ? acc[r] * __expf(TAB[s] - mxt) : 0.f; } }
                mm::store_T(acc, SI, PS, 16 * bj, 16 * bi, lane); }
        }
        __syncthreads();
        f32x4 res[5];
        {
#pragma unroll
            for (int n = 0; n < 5; ++n) { const int id = wave + 8 * n; res[n] = (f32x4){0.f, 0.f, 0.f, 0.f};
                if (id < 36) { const int vb = id >> 2, tb = id & 3; f32x4 ai = (f32x4){0.f, 0.f, 0.f, 0.f}, aa = (f32x4){0.f, 0.f, 0.f, 0.f};
                    mm::blk<4>(ai, QI + tb * 16 * PQ, PQ, CI + vb * 16 * PQ, PQ, lane);
                    mm::blk<2>(aa, SI + tb * 16 * PS, PS, VT + vb * 16 * PS, PS, lane);
#pragma unroll
                    for (int r = 0; r < 4; ++r) res[n][r] = TAB[128 + 16 * tb + 4 * (lane >> 4) + r] * ai[r] + aa[r]; } }
            const float decay = TAB[320];
#pragma unroll
            for (int vb = 0; vb < 9; ++vb) { cacc[vb] = cacc[vb] * decay; mm::blk<2>(cacc[vb], WKT + wave * 16 * PS, PS, VT + vb * 16 * PS, PS, lane); }
        }
        const float em_l = TAB[192 + 16 * (wave & 3) + 4 * (lane >> 4) + 0], em_1 = TAB[192 + 16 * (wave & 3) + 4 * (lane >> 4) + 1], em_2 = TAB[192 + 16 * (wave & 3) + 4 * (lane >> 4) + 2], em_3 = TAB[192 + 16 * (wave & 3) + 4 * (lane >> 4) + 3];
        __syncthreads();
        {
#pragma unroll
            for (int n = 0; n < 5; ++n) { const int id = wave + 8 * n;
                if (id < 36) { const int vb = id >> 2, tb = id & 3, j = lane & 15;
#pragma unroll
                    for (int r = 0; r < 4; ++r) { const int tt = 16 * tb + 4 * (lane >> 4) + r;
                        if (vb < 8 || j == 0) HB[tt * HBP + 16 * vb + j] = res[n][r];
                        else if (j == 1) HB[tt * HBP + 129] = (r == 0 ? em_l : r == 1 ? em_1 : r == 2 ? em_2 : em_3); } } }
#pragma unroll
            for (int vb = 0; vb < 9; ++vb) mm::store_T(cacc[vb], CI, PQ, 16 * vb, 16 * wave, lane);
        }
        __syncthreads();
        {
#pragma unroll
            for (int q = 0; q < 8; ++q) { const int tt = wave * 8 + q; const size_t m = mrow0 + (size_t)c * 64 + tt;
                const float dn = fmaxf(fabsf(HB[tt * HBP + 128]), HB[tt * HBP + 129]);
                const float h0 = HB[tt * HBP + lane] / dn, h1 = HB[tt * HBP + 64 + lane] / dn;
                const float mean = wave_sum(h0 + h1) * (1.f / 128.f); const float d0 = h0 - mean, d1 = h1 - mean;
                const float rstd = 1.f / sqrtf(wave_sum(d0 * d0 + d1 * d1) * (1.f / 128.f) + NORM_EPS);
#pragma unroll
                for (int e = 0; e < 2; ++e) { const int d = lane + 64 * e; const float hn = (e ? d1 : d0) * rstd * ng[d];
                    const float og = bf2f(PROJ[m * NPROJ + PC_MLO + h * 128 + d]), z = bf2f(PROJ[m * NPROJ + PC_MLZ + h * 128 + d]);
                    MIXED[m * DM + h * 128 + d] = (bf16_t)f2bf(siluf_(z) * sigmoidf_(og) * hn); } }
        }
    }
    __syncthreads();
#undef ML_LOAD
}
namespace rwk {
constexpr int PS = 144, SLOT = 9216;
constexpr int S_AT = 0, S_RT = 1, S_BTT = 2, S_KTT = 3, S_VTT = 4, S_AAK = 5, S_ARB = 6, S_ARK = 7, S_S0A = 8, S_S0B = 9, S_Z0 = 10, S_Z1 = 11, S_Z2 = 12, S_Z3 = 13, S_T0 = 14, S_T1 = 15;
constexpr int O_TAB = 16 * SLOT, O_PQ = O_TAB + 256, LDS_END = O_PQ + 4096, YP = 65, FP = 68;
}
__device__ __forceinline__ void rwkv_unit(unsigned char* lds_g, int b, int h, const float* RWW, const bf16_t* RWB, size_t RWS, const float* BONUS, const bf16_t* PROJ, const float* ln_g, const float* ln_b, bf16_t* MIXED) {
    using namespace rwk; using mm::f32x4; using mm::bf16x8;
    MM_LAS unsigned char* L = (MM_LAS unsigned char*)lds_g;
    int tid_o = threadIdx.x; asm volatile("" : "+v"(tid_o));
    const int tid = tid_o, lane = tid & 63, wave = __builtin_amdgcn_readfirstlane(tid >> 6);
#define SL(n) (L + (n) * SLOT)
    MM_LAS float* WLT = (MM_LAS float*)(L + O_TAB); MM_LAS float* YB = (MM_LAS float*)SL(S_Z0); MM_LAS float* TF = (MM_LAS float*)SL(S_Z0); MM_LAS float* AF = (MM_LAS float*)SL(S_T0); MM_LAS float* PQ = (MM_LAS float*)(L + O_PQ);
    for (int i = tid; i < 2 * SLOT / 4; i += 512) ((MM_LAS unsigned*)SL(S_S0A))[i] = 0u;
    const int t = lane, cg = wave, bi = wave >> 1, bj0 = 2 * (wave & 1), lj = lane & 15, lq = lane >> 4;
    f32x4 sacc[2]; sacc[0] = (f32x4){0.f, 0.f, 0.f, 0.f}; sacc[1] = sacc[0];
    const size_t mrow0 = (size_t)b * T;
    bf16x8 gr, gk, gv, ga, gb; f32x4 gw0, gw1;
#define RW_LOAD(c_) do { const size_t o_ = (mrow0 + (size_t)(c_) * 64 + t) * 512 + h * 64 + 8 * cg; \
        gr = *(const bf16x8*)(RWB + o_); gk = *(const bf16x8*)(RWB + RWS + o_); gv = *(const bf16x8*)(RWB + 2 * RWS + o_); ga = *(const bf16x8*)(RWB + 3 * RWS + o_); gb = *(const bf16x8*)(RWB + 4 * RWS + o_); \
        gw0 = *(const f32x4*)(RWW + o_); gw1 = *(const f32x4*)(RWW + o_ + 4); } while (0)
    RW_LOAD(0);
    for (int c = 0; c < 64; ++c) {
        MM_LAS unsigned char* S0 = SL((c & 1) ? S_S0B : S_S0A); MM_LAS unsigned char* S0n = SL((c & 1) ? S_S0A : S_S0B);
        __syncthreads();
        {
            float lw[8], cw[8];
#pragma unroll
            for (int e = 0; e < 4; ++e) { lw[e] = gw0[e]; lw[4 + e] = gw1[e]; }
#pragma unroll
            for (int e = 0; e < 8; ++e) { float s = lw[e];
#pragma unroll
                for (int o = 1; o < 64; o <<= 1) { const float u = __shfl_up(s, o); if (lane >= o) s += u; }
                cw[e] = s; }
            float av[8], bv[8], kv[8], rv[8];
#pragma unroll
            for (int e = 0; e < 8; ++e) { const float Wt = __expf(cw[e]), Wp = __expf(cw[e] - lw[e]), iW = __expf(-cw[e]);
                av[e] = mm::bfl((unsigned short)ga[e]) * Wp; bv[e] = mm::bfl((unsigned short)gb[e]) * iW; kv[e] = mm::bfl((unsigned short)gk[e]) * iW; rv[e] = mm::bfl((unsigned short)gr[e]) * Wt;
                if (lane == 63) WLT[8 * cg + e] = Wt; }
            typedef unsigned u32x4_ __attribute__((ext_vector_type(4)));
            u32x4_ pa, pb, pk, pr;
            pa.x = mm::cvtpk(av[0], av[1]); pa.y = mm::cvtpk(av[2], av[3]); pa.z = mm::cvtpk(av[4], av[5]); pa.w = mm::cvtpk(av[6], av[7]);
            pb.x = mm::cvtpk(bv[0], bv[1]); pb.y = mm::cvtpk(bv[2], bv[3]); pb.z = mm::cvtpk(bv[4], bv[5]); pb.w = mm::cvtpk(bv[6], bv[7]);
            pk.x = mm::cvtpk(kv[0], kv[1]); pk.y = mm::cvtpk(kv[2], kv[3]); pk.z = mm::cvtpk(kv[4], kv[5]); pk.w = mm::cvtpk(kv[6], kv[7]);
            pr.x = mm::cvtpk(rv[0], rv[1]); pr.y = mm::cvtpk(rv[2], rv[3]); pr.z = mm::cvtpk(rv[4], rv[5]); pr.w = mm::cvtpk(rv[6], rv[7]);
            *(MM_LAS u32x4_*)(SL(S_AT) + t * PS + cg * 16) = pa; *(MM_LAS u32x4_*)(SL(S_RT) + t * PS + cg * 16) = pr;
            *(MM_LAS u32x4_*)(SL(S_Z0) + t * PS + cg * 16) = pb; *(MM_LAS u32x4_*)(SL(S_Z1) + t * PS + cg * 16) = pk;
#pragma unroll
            for (int e = 0; e < 8; ++e) { const unsigned wb = (e & 1) ? (pb[e >> 1] >> 16) : (pb[e >> 1] & 0xffffu), wk = (e & 1) ? (pk[e >> 1] >> 16) : (pk[e >> 1] & 0xffffu);
                *(MM_LAS unsigned short*)(SL(S_BTT) + (8 * cg + e) * PS + t * 2) = (unsigned short)wb;
                *(MM_LAS unsigned short*)(SL(S_KTT) + (8 * cg + e) * PS + t * 2) = (unsigned short)wk;
                *(MM_LAS unsigned short*)(SL(S_VTT) + (8 * cg + e) * PS + t * 2) = (unsigned short)gv[e]; }
        }
        if (c + 1 < 64) RW_LOAD(c + 1);
        __syncthreads();
        {
#pragma unroll
            for (int jj = 0; jj < 2; ++jj) { const int bj = bj0 + jj; const int tt = 16 * bj + lj, s0 = 16 * bi + 4 * lq;
                f32x4 ab = (f32x4){0.f, 0.f, 0.f, 0.f}, ak = ab, rb = ab, rk = ab;
                if (bi <= bj) {
                    mm::blk<2>(ab, SL(S_Z0) + bi * 16 * PS, PS, SL(S_AT) + bj * 16 * PS, PS, lane);
                    mm::blk<2>(ak, SL(S_Z1) + bi * 16 * PS, PS, SL(S_AT) + bj * 16 * PS, PS, lane);
                    mm::blk<2>(rb, SL(S_Z0) + bi * 16 * PS, PS, SL(S_RT) + bj * 16 * PS, PS, lane);
                    mm::blk<2>(rk, SL(S_Z1) + bi * 16 * PS, PS, SL(S_RT) + bj * 16 * PS, PS, lane);
#pragma unroll
                    for (int r = 0; r < 4; ++r) { const int s = s0 + r; if (!(s < tt)) { ab[r] = 0.f; ak[r] = 0.f; } if (!(s <= tt)) { rb[r] = 0.f; rk[r] = 0.f; } } }
                mm::store_T(ak, SL(S_AAK), PS, 16 * bj, 16 * bi, lane); mm::store_T(rb, SL(S_ARB), PS, 16 * bj, 16 * bi, lane); mm::store_T(rk, SL(S_ARK), PS, 16 * bj, 16 * bi, lane);
                *(MM_LAS f32x4*)(AF + tt * FP + s0) = ab; }
        }
        __syncthreads();
        if (wave < 4) { if (lane < 16) {
                float Tc[16]; const MM_LAS float* ar = AF + (16 * wave) * FP + 16 * wave;
#pragma unroll
                for (int r = 0; r < 16; ++r) { float acc = (r == lane) ? 1.f : 0.f;
#pragma unroll
                    for (int q4 = 0; q4 < (r + 3) / 4; ++q4) { const f32x4 a4 = *(const MM_LAS f32x4*)(ar + r * FP + 4 * q4);
#pragma unroll
                        for (int e = 0; e < 4; ++e) if (4 * q4 + e < r) acc += a4[e] * Tc[4 * q4 + e]; }
                    Tc[r] = acc; TF[(16 * wave + r) * FP + 16 * wave + lane] = acc; } } }
        else { const int z = (wave - 4) * 64 + lane, zb = z >> 7, zi = (z >> 4) & 7, zj = z & 15;
#pragma unroll
            for (int hh = 0; hh < 2; ++hh) TF[(32 * zb + zi + 8 * hh) * FP + 32 * zb + 16 + zj] = 0.f; }
        __syncthreads();
        {
            const int pr_ = tid >> 8, i = (tid >> 4) & 15, j = tid & 15, rb = 32 * pr_ + 16, cb = 32 * pr_; float acc = 0.f;
#pragma unroll
            for (int k4 = 0; k4 < 4; ++k4) { const f32x4 a4 = *(const MM_LAS f32x4*)(AF + (rb + i) * FP + cb + 4 * k4);
#pragma unroll
                for (int e = 0; e < 4; ++e) acc += a4[e] * TF[(cb + 4 * k4 + e) * FP + cb + j]; }
            PQ[pr_ * 256 + i * 16 + j] = acc; }
        __syncthreads();
        {
            const int pr_ = tid >> 8, i = (tid >> 4) & 15, j = tid & 15, rb = 32 * pr_ + 16, cb = 32 * pr_; float acc = 0.f;
#pragma unroll
            for (int k4 = 0; k4 < 4; ++k4) { const f32x4 a4 = *(const MM_LAS f32x4*)(TF + (rb + i) * FP + rb + 4 * k4);
#pragma unroll
                for (int e = 0; e < 4; ++e) acc += a4[e] * PQ[pr_ * 256 + (4 * k4 + e) * 16 + j]; }
            TF[(rb + i) * FP + cb + j] = acc; }
        __syncthreads();
        {
            const int i = tid >> 4, jq = tid & 15; float acc0 = 0.f, acc1 = 0.f;
#pragma unroll
            for (int k4 = 0; k4 < 8; ++k4) { const f32x4 a4 = *(const MM_LAS f32x4*)(AF + (32 + i) * FP + 4 * k4);
#pragma unroll
                for (int e = 0; e < 4; ++e) { acc0 += a4[e] * TF[(4 * k4 + e) * FP + jq]; acc1 += a4[e] * TF[(4 * k4 + e) * FP + 16 + jq]; } }
            PQ[i * 32 + jq] = acc0; PQ[i * 32 + 16 + jq] = acc1; }
        __syncthreads();
        {
            const int i = tid >> 4, jq = tid & 15; float acc0 = 0.f, acc1 = 0.f;
#pragma unroll
            for (int k4 = 0; k4 < 8; ++k4) { const f32x4 a4 = *(const MM_LAS f32x4*)(TF + (32 + i) * FP + 32 + 4 * k4);
#pragma unroll
                for (int e = 0; e < 4; ++e) { acc0 += a4[e] * PQ[(4 * k4 + e) * 32 + jq]; acc1 += a4[e] * PQ[(4 * k4 + e) * 32 + 16 + jq]; } }
            TF[(32 + i) * FP + jq] = acc0; TF[(32 + i) * FP + 16 + jq] = acc1; }
        __syncthreads();
        {
            const int tr = tid >> 3, s8 = (tid & 7) * 8; const f32x4 x0 = *(const MM_LAS f32x4*)(TF + tr * FP + s8), x1 = *(const MM_LAS f32x4*)(TF + tr * FP + s8 + 4);
            float y[8];
#pragma unroll
            for (int e = 0; e < 4; ++e) { y[e] = (s8 + e <= tr) ? x0[e] : 0.f; y[4 + e] = (s8 + 4 + e <= tr) ? x1[e] : 0.f; }
            typedef unsigned u32x4_ __attribute__((ext_vector_type(4))); u32x4_ w;
            w.x = mm::cvtpk(y[0], y[1]); w.y = mm::cvtpk(y[2], y[3]); w.z = mm::cvtpk(y[4], y[5]); w.w = mm::cvtpk(y[6], y[7]);
            *(MM_LAS u32x4_*)(SL(S_T0) + tr * PS + s8 * 2) = w; }
        {
#pragma unroll
            for (int jj = 0; jj < 2; ++jj) { const int bj = bj0 + jj; f32x4 d = (f32x4){0.f, 0.f, 0.f, 0.f};
                mm::blk<2>(d, SL(S_AT) + bi * 16 * PS, PS, S0 + bj * 16 * PS, PS, lane); mm::blk<2>(d, SL(S_AAK) + bi * 16 * PS, PS, SL(S_VTT) + bj * 16 * PS, PS, lane);
                mm::store_T(d, SL(S_Z2), PS, 16 * bj, 16 * bi, lane); }
        }
        __syncthreads();
        {
#pragma unroll
            for (int jj = 0; jj < 2; ++jj) { const int bj = bj0 + jj; f32x4 d = (f32x4){0.f, 0.f, 0.f, 0.f};
                mm::blk<2>(d, SL(S_T0) + bi * 16 * PS, PS, SL(S_Z2) + bj * 16 * PS, PS, lane);
                mm::store_T(d, SL(S_Z3), PS, 16 * bj, 16 * bi, lane); }
        }
        __syncthreads();
        {
#pragma unroll
            for (int jj = 0; jj < 2; ++jj) { const int bj = bj0 + jj; f32x4 d = (f32x4){0.f, 0.f, 0.f, 0.f};
                mm::blk<2>(d, SL(S_RT) + bi * 16 * PS, PS, S0 + bj * 16 * PS, PS, lane); mm::blk<2>(d, SL(S_ARB) + bi * 16 * PS, PS, SL(S_Z3) + bj * 16 * PS, PS, lane); mm::blk<2>(d, SL(S_ARK) + bi * 16 * PS, PS, SL(S_VTT) + bj * 16 * PS, PS, lane);
#pragma unroll
                for (int r = 0; r < 4; ++r) YB[(16 * bi + 4 * lq + r) * YP + 16 * bj + lj] = d[r];
                mm::blk<2>(sacc[jj], SL(S_BTT) + bi * 16 * PS, PS, SL(S_Z3) + bj * 16 * PS, PS, lane); mm::blk<2>(sacc[jj], SL(S_KTT) + bi * 16 * PS, PS, SL(S_VTT) + bj * 16 * PS, PS, lane);
#pragma unroll
                for (int r = 0; r < 4; ++r) sacc[jj][r] *= WLT[16 * bi + 4 * lq + r];
                mm::store_T(sacc[jj], S0n, PS, 16 * bj, 16 * bi, lane); }
        }
        __syncthreads();
        {
#pragma unroll
            for (int q = 0; q < 8; ++q) { const int tt = wave * 8 + q; const size_t m = mrow0 + (size_t)c * 64 + tt;
                const float y = YB[tt * YP + lane]; const float mean = wave_sum(y) * (1.f / 64.f); const float d = y - mean; const float var = wave_sum(d * d) * (1.f / 64.f);
                float yn = d / sqrtf(var + RW_GN_EPS) * ln_g[lane] + ln_b[lane];
                yn += BONUS[m * 8 + h] * mm::bfl(*(const MM_LAS unsigned short*)(SL(S_VTT) + lane * PS + tt * 2));
                const float z = bf2f(PROJ[m * NPROJ + PC_RWZ + h * 64 + lane]);
                MIXED[m * DM + 1536 + h * 64 + lane] = (bf16_t)f2bf(siluf_(z) * yn); }
        }
    }
    __syncthreads();
#undef SL
#undef RW_LOAD
}
constexpr size_t MiB = 1u << 20;
constexpr size_t WS_CTL = 0, CTL_ZERO_BYTES = 1 * MiB;
constexpr size_t WS_WIN = 1 * MiB;
constexpr size_t WS_WUQ = WS_WIN + 104 * MiB;
constexpr size_t WS_WUKV = WS_WUQ + 6 * MiB;
constexpr size_t WS_WOUT = WS_WUKV + 4 * MiB;
constexpr size_t WS_CS = WS_WOUT + 32 * MiB;
constexpr size_t WS_XN = WS_CS + 4 * MiB;
constexpr size_t WS_PROJ = WS_XN + 64 * MiB;
constexpr size_t WS_SPEC = WS_PROJ + 208 * MiB;
constexpr size_t WS_CQN = WS_SPEC + 16 * MiB;
constexpr size_t WS_CKVN = WS_CQN + 16 * MiB;
constexpr size_t WS_KR = WS_CKVN + 8 * MiB;
constexpr size_t WS_Q = WS_KR + 2 * MiB;
constexpr size_t WS_KV = WS_Q + 48 * MiB;
constexpr size_t WS_QKC = WS_KV + 64 * MiB;
constexpr size_t WS_GATE = WS_QKC + 32 * MiB;
constexpr size_t WS_RWW = WS_GATE + 1 * MiB;
constexpr size_t WS_RWB = WS_RWW + 32 * MiB;
constexpr size_t WS_VFIRST = WS_RWB + 80 * MiB;
constexpr size_t WS_BONUS = WS_VFIRST + 16 * MiB;
constexpr size_t WS_END = WS_BONUS + 1 * MiB;
constexpr int CW_BAR = 4096;
constexpr int LDS_BYTES = 163840, RING_BYTES = 158720, MISC_OFF = RING_BYTES + 320;
static_assert(att::LDS_BYTES <= RING_BYTES, "attention LDS");

struct Args { const float* in[28]; float* out; unsigned char* ws; int ph_lo, ph_hi; };

struct MapWin { __device__ __forceinline__ int operator()(int n) const {
    if (n < 1536) return n;
    if (n < 2048) return SC_MLO + (n - 1536);
    if (n < 2560) return SC_MLZ + (n - 2048);
    if (n < 3072) return SC_CQ + (n - 2560);
    if (n < 3328) return SC_CKV + (n - 3072);
    if (n < 4352) return SC_MLAZ + (n - 3328);
    if (n < 5888) return SC_RW + (n - 4352);
    if (n < 6144) { const int j = n - 5888;
        if (j < 128) return SC_RW + 1536 + j;
        if (j < 192) { const int q = j - 128; return SC_KR + ((q & 1) ? 32 + (q >> 1) : (q >> 1)); }
        if (j < 196) return SC_MLI + (j - 192);
        if (j < 200) return SC_MLF + (j - 196);
        return -1; }
    return SC_RWZ + (n - 6144); } };
struct MapUq { __device__ __forceinline__ int operator()(int n) const { const int h = n / 192, d = n % 192; if (d < 128) return n; const int q = d - 128; return h * 192 + 128 + ((q & 1) ? 32 + (q >> 1) : (q >> 1)); } };
struct MapId { __device__ __forceinline__ int operator()(int n) const { return n; } };

template <class Map>
__device__ __forceinline__ void transpose_item(const float* W, int K, int Nsrc, bf16_t* WT, const float* gain, LAS float* scr, int kb, int nb, int lane, Map map) {
    const int k0 = 64 * kb, n0 = 32 * nb, sc = map(n0 + (lane & 31));
#pragma unroll 8
    for (int i = 0; i < 32; ++i) { const int kk = 2 * i + (lane >> 5); float v = 0.f;
        if (sc >= 0) { v = W[(size_t)(k0 + kk) * Nsrc + sc]; if (gain) v *= gain[k0 + kk]; }
        scr[kk * 33 + (lane & 31)] = v; }
    LDS_WAIT(); asm volatile("" ::: "memory");
    const int c = lane & 7;
#pragma unroll
    for (int j = 0; j < 4; ++j) { const int n = (lane >> 3) + 8 * j; const LAS float* s = scr + (8 * c) * 33 + n;
        v4u o; o.x = pk2(s[0 * 33], s[1 * 33]); o.y = pk2(s[2 * 33], s[3 * 33]); o.z = pk2(s[4 * 33], s[5 * 33]); o.w = pk2(s[6 * 33], s[7 * 33]);
        *(v4u*)(WT + (size_t)(n0 + n) * K + k0 + 8 * c) = o; }
    LDS_WAIT(); asm volatile("" ::: "memory");
}

template <int MODE>
__device__ __forceinline__ void norm_row(const float* xrow, bf16_t* orow, float* frow, const float* g, int lane) {
    const f32x4* xr = (const f32x4*)xrow + lane;
    f32x4 v[8]; float s = 0.f;
#pragma unroll
    for (int j = 0; j < 8; ++j) { v[j] = xr[64 * j]; s += (v[j].x * v[j].x + v[j].y * v[j].y) + (v[j].z * v[j].z + v[j].w * v[j].w); }
    const float rstd = 1.f / sqrtf(wave_sum(s) * (1.f / DM) + NORM_EPS);
    if (MODE == 0) { unsigned long long* o8 = (unsigned long long*)orow + lane;
#pragma unroll
        for (int j = 0; j < 8; ++j) o8[64 * j] = (unsigned long long)pk2(v[j].x * rstd, v[j].y * rstd) | ((unsigned long long)pk2(v[j].z * rstd, v[j].w * rstd) << 32);
    } else { f32x4* o = (f32x4*)frow + lane; const f32x4* gr = (const f32x4*)g + lane;
#pragma unroll
        for (int j = 0; j < 8; ++j) { const f32x4 gg = gr[64 * j]; o[64 * j] = v[j] * rstd * gg; } }
}

__device__ __forceinline__ att::BlockRef mk_block(const bf16_t* Q, const bf16_t* KV, const bf16_t* KR, bf16_t* MIXED, const bf16_t* PROJ, const float* CS, int L_, int pass_) {
    const int bh = L_ >> 3, x = L_ & 7, qb = pass_ ? 15 - x : x, b = bh >> 3, h = bh & 7; att::BlockRef r;
    const size_t rb = (size_t)b * T, rq = rb + (size_t)qb * 256;
    r.Q = Q + rq * NQ + h * 192; r.K = KV + rb * NKV + h * 256; r.V = r.K + 128; r.KR = KR + rb * 64; r.O = MIXED + rq * DM + 512 + h * 128; r.Z = PROJ + rq * NPROJ + PC_MLAZ + h * 128; r.CSq = CS + rq * 64; r.P0 = qb * 256; return r;
}
__global__ void __launch_bounds__(512, 2) fwd(Args args) {
    extern __shared__ __attribute__((aligned(16))) unsigned char lds[];
    const int tid = threadIdx.x, lane = tid & 63, wave = __builtin_amdgcn_readfirstlane(tid >> 6);
    const int G = gridDim.x, bid = blockIdx.x;
    unsigned char* ws = args.ws;
    volatile LAS unsigned* MISC = (volatile LAS unsigned*)((LAS unsigned char*)lds + MISC_OFF);
    for (int u = tid; u < (LDS_BYTES - RING_BYTES) / 4; u += 512) ((LAS unsigned*)((LAS unsigned char*)lds + RING_BYTES))[u] = 0u;
    __syncthreads();
    const bool one_launch = (args.ph_hi - args.ph_lo) > 1;
    XcdBarrier bar; bar.bar = (unsigned*)(ws + WS_CTL) + CW_BAR; bar.x = 0; bar.st = nullptr;
    if (one_launch) bar = xcd_barrier_post((unsigned*)(ws + WS_CTL) + CW_BAR, MISC + 8);
    const int lo = args.ph_lo, hi = args.ph_hi;
#define IN(k) (lo <= (k) && (k) < hi)
#define SEAM(k) do { if (IN(k) && IN((k) + 1)) xcd_barrier(bar); } while (0)

    const float* x_in = args.in[0]; const int* positions = (const int*)args.in[1];
    float* X = args.out;
    bf16_t* WIN = (bf16_t*)(ws + WS_WIN); bf16_t* WUQ = (bf16_t*)(ws + WS_WUQ); bf16_t* WUKV = (bf16_t*)(ws + WS_WUKV); bf16_t* WOUT = (bf16_t*)(ws + WS_WOUT);
    float* CS = (float*)(ws + WS_CS); bf16_t* XN = (bf16_t*)(ws + WS_XN); bf16_t* MIXED = XN; bf16_t* PROJ = (bf16_t*)(ws + WS_PROJ); float* SPEC = (float*)(ws + WS_SPEC);
    bf16_t* CQN = (bf16_t*)(ws + WS_CQN); bf16_t* CKVN = (bf16_t*)(ws + WS_CKVN); bf16_t* KR = (bf16_t*)(ws + WS_KR); bf16_t* Q = (bf16_t*)(ws + WS_Q); bf16_t* KV = (bf16_t*)(ws + WS_KV);
    bf16_t* QKC = (bf16_t*)(ws + WS_QKC); float* LI = (float*)(ws + WS_GATE); float* LF = LI + (size_t)M * 4;
    float* RWW = (float*)(ws + WS_RWW); bf16_t* RWB = (bf16_t*)(ws + WS_RWB); bf16_t* VFIRST = (bf16_t*)(ws + WS_VFIRST); float* BONUS = (float*)(ws + WS_BONUS);
    constexpr size_t RWS = (size_t)M * 512;

    if (IN(0)) {
#ifndef NO_PRO
        LAS float* scr = (LAS float*)((LAS unsigned char*)lds + wave * 16384);
        const int gw = bid * 8 + wave, NGW = G * 8;
        constexpr int I_IN = (DM / 64) * (NPROJ / 32), I_UQ = (512 / 64) * (NQ / 32), I_UKV = (256 / 64) * (NKV / 32), I_OUT = (DM / 64) * (DM / 32), I_L = I_IN + I_UQ + I_UKV + I_OUT;
        for (int it = gw; it < DEPTH * I_L; it += NGW) {
            const int l = it / I_L; int r = it % I_L;
            if (r < I_IN) { transpose_item(args.in[3] + (size_t)l * DM * D_IN, DM, D_IN, WIN + (size_t)l * NPROJ * DM, args.in[2] + l * DM, scr, r / (NPROJ / 32), r % (NPROJ / 32), lane, MapWin()); continue; } r -= I_IN;
            if (r < I_UQ) { transpose_item(args.in[10] + (size_t)l * 512 * NQ, 512, NQ, WUQ + (size_t)l * NQ * 512, args.in[9] + l * 512, scr, r / (NQ / 32), r % (NQ / 32), lane, MapUq()); continue; } r -= I_UQ;
            if (r < I_UKV) { transpose_item(args.in[12] + (size_t)l * 256 * NKV, 256, NKV, WUKV + (size_t)l * NKV * 256, args.in[11] + l * 256, scr, r / (NKV / 32), r % (NKV / 32), lane, MapId()); continue; } r -= I_UKV;
            transpose_item(args.in[26] + (size_t)l * DM * DM, DM, DM, WOUT + (size_t)l * DM * DM, (const float*)nullptr, scr, r / (DM / 32), r % (DM / 32), lane, MapId());
        }
        for (int i = bid * 512 + tid; i < M * 32; i += G * 512) { const int m = i >> 5, j = i & 31;
            const float inv_freq = powf(10000.f, -(float)(2 * j) / 64.f);
            const float ang = (float)positions[m] * inv_freq;
            const double a = (double)ang; const double n = rint(a * 0.15915494309189535); const float r = (float)(a - n * 6.283185307179586);
            CS[2 * i] = cosf(r); CS[2 * i + 1] = sinf(r); }
        for (int m = gw; m < M; m += NGW) norm_row<0>(x_in + (size_t)m * DM, XN + (size_t)m * DM, nullptr, nullptr, lane);
#endif
    }
    SEAM(0);

#ifdef FIXL
    for (int l = 0; l < 1; ++l) {
#else
    for (int l = 0; l < DEPTH; ++l) {
#endif
        const int pb = 1 + l * 6;
        int tid_o = threadIdx.x; asm volatile("" : "+v"(tid_o));
        const int tid = tid_o, lane = tid & 63, wave = __builtin_amdgcn_readfirstlane(tid >> 6);
        if (IN(pb + 0)) {
#ifndef NO_G1
            pg8::Gemm g{XN, WIN + (size_t)l * NPROJ * DM, M, NPROJ, DM}; pg8::StaticOrder S; S.init(M, NPROJ, G, bid);
            pg8::EpiProj E{PROJ, NPROJ, SPEC, SPEC_TILE};
            pg8::gemm_phase<pg8::EpiProj, pg8::StaticOrder, true, true>((LAS unsigned char*)lds, g, S, E);
#endif
        }
        SEAM(pb + 0);
        if (IN(pb + 1)) {
#ifndef NO_PREP
            LAS float* L = (LAS float*)lds;
            LAS float* xw_t = L;
            LAS float* xa_s = L + 512;
            LAS float* t1 = L + 1024;
            LAS float* vbuf = L + 1280;
            const float* mu = args.in[13] + l * 1664; const float* w0 = args.in[14] + l * 512; const float* w2 = args.in[15] + (size_t)l * 64 * 512;
            const float* a0 = args.in[16] + l * 512; const float* a2 = args.in[17] + (size_t)l * 64 * 512;
            const float* v0 = args.in[18] + (l > 0 ? (l - 1) * 512 : 0); const float* v1 = args.in[19] + (size_t)(l > 0 ? l - 1 : 0) * 512 * 32; const float* v2 = args.in[20] + (size_t)(l > 0 ? l - 1 : 0) * 32 * 512;
            const float* k_k = args.in[21] + l * 512; const float* k_a = args.in[22] + l * 512; const float* r_k = args.in[23] + l * 512;
            const float* conv_w = args.in[4] + (size_t)l * 4 * 1024; const float* conv_b = args.in[5] + l * 1024;
            const float* i_bias = args.in[6] + l * 4; const float* f_bias = args.in[7] + l * 4;
            const int c = tid;
            for (int g8 = bid; g8 < M / 8; g8 += G) {
                const int m0 = g8 * 8, t0 = m0 % T;
                float r_[8], k_[8], v_[8];
                { const float mur = mu[c], muk = mu[512 + c], muv = mu[1024 + c];
                  float pr = 0.f, pk = 0.f, pv = 0.f;
                  if (t0 > 0) { const bf16_t* pp = PROJ + (size_t)(m0 - 1) * NPROJ + PC_RW + c; pr = bf2f(pp[0]); pk = bf2f(pp[512]); pv = bf2f(pp[1024]); }
#pragma unroll
                  for (int i = 0; i < 8; ++i) { const bf16_t* pp = PROJ + (size_t)(m0 + i) * NPROJ + PC_RW + c; const float cr = bf2f(pp[0]), ck = bf2f(pp[512]), cv = bf2f(pp[1024]);
                      r_[i] = cr + mur * (pr - cr); k_[i] = ck + muk * (pk - ck); v_[i] = cv + muv * (pv - cv); pr = cr; pk = ck; pv = cv; } }
                if (tid < 128) { const int j = tid & 63, which = tid >> 6; const float mm = mu[1536 + which * 64 + j];
                    float pv = 0.f; if (t0 > 0) pv = SPEC[(size_t)(m0 - 1) * 256 + which * 64 + j];
                    for (int i = 0; i < 8; ++i) { const float cv = SPEC[(size_t)(m0 + i) * 256 + which * 64 + j]; const float xs = cv + mm * (pv - cv); pv = cv;
                        if (which == 0) xw_t[i * 64 + j] = tanhf(xs); else xa_s[i * 64 + j] = xs; } }
                if (l > 0) {
#pragma unroll
                    for (int i = 0; i < 8; ++i) vbuf[i * 512 + c] = v_[i]; }
                __syncthreads();
                float lw[8], la[8];
                { const float w0c = w0[c], a0c = a0[c];
#pragma unroll
                  for (int i = 0; i < 8; ++i) { lw[i] = w0c; la[i] = a0c; }
                  for (int j = 0; j < 64; ++j) { const float w2v = w2[j * 512 + c], a2v = a2[j * 512 + c];
#pragma unroll
                      for (int i = 0; i < 8; ++i) { lw[i] += xw_t[i * 64 + j] * w2v; la[i] += xa_s[i * 64 + j] * a2v; } } }
                if (l > 0) {
                    if (tid < 256) { const int i = tid >> 5, j = tid & 31; float s = 0.f;
                        for (int cc = 0; cc < 512; ++cc) s += vbuf[i * 512 + cc] * v1[cc * 32 + j];
                        t1[i * 32 + j] = s; }
                    __syncthreads();
                    float gsum[8]; const float v0c = v0[c];
#pragma unroll
                    for (int i = 0; i < 8; ++i) gsum[i] = v0c;
                    for (int j = 0; j < 32; ++j) { const float v2v = v2[j * 512 + c];
#pragma unroll
                        for (int i = 0; i < 8; ++i) gsum[i] += t1[i * 32 + j] * v2v; }
#pragma unroll
                    for (int i = 0; i < 8; ++i) { const float vf = bf2f(VFIRST[(size_t)(m0 + i) * 512 + c]); v_[i] = v_[i] + (vf - v_[i]) * sigmoidf_(gsum[i]); }
                } else {
#pragma unroll
                    for (int i = 0; i < 8; ++i) VFIRST[(size_t)(m0 + i) * 512 + c] = (bf16_t)f2bf(v_[i]);
                }
                { const float kkc = k_k[c], kac = k_a[c], rkc = r_k[c];
#pragma unroll
                  for (int i = 0; i < 8; ++i) { const size_t o = (size_t)(m0 + i) * 512 + c;
                      const float logw = -softplusf_(-lw[i]) - 0.5f; const float dec = -__expf(logw); const float a = sigmoidf_(la[i]);
                      float kk = k_[i] * kkc; const float ss = wave_sum(kk * kk); kk = kk / fmaxf(sqrtf(ss), 1e-12f);
                      const float kh = k_[i] * (1.f + (a - 1.f) * kac);
                      const float bon = wave_sum(r_[i] * kh * rkc);
                      RWW[o] = dec; RWB[o] = (bf16_t)f2bf(r_[i]); RWB[RWS + o] = (bf16_t)f2bf(kh); RWB[2 * RWS + o] = (bf16_t)f2bf(v_[i]); RWB[3 * RWS + o] = (bf16_t)f2bf(-kk); RWB[4 * RWS + o] = (bf16_t)f2bf(kk * a);
                      if (lane == 0) BONUS[(size_t)(m0 + i) * 8 + wave] = bon; } }
                { const int m = m0 + wave;
                  { const v4u raw = *(const v4u*)(PROJ + (size_t)m * NPROJ + PC_CQ + lane * 8); float f[8];
                    f[0] = bf2f(raw.x & 0xffffu); f[1] = bf2f(raw.x >> 16); f[2] = bf2f(raw.y & 0xffffu); f[3] = bf2f(raw.y >> 16); f[4] = bf2f(raw.z & 0xffffu); f[5] = bf2f(raw.z >> 16); f[6] = bf2f(raw.w & 0xffffu); f[7] = bf2f(raw.w >> 16);
                    float s = 0.f;
#pragma unroll
                    for (int e = 0; e < 8; ++e) s += f[e] * f[e];
                    const float rstd = 1.f / sqrtf(wave_sum(s) * (1.f / 512.f) + NORM_EPS);
                    v4u o; o.x = pk2(f[0] * rstd, f[1] * rstd); o.y = pk2(f[2] * rstd, f[3] * rstd); o.z = pk2(f[4] * rstd, f[5] * rstd); o.w = pk2(f[6] * rstd, f[7] * rstd);
                    *(v4u*)(CQN + (size_t)m * 512 + lane * 8) = o; }
                  { const unsigned long long raw = *(const unsigned long long*)(PROJ + (size_t)m * NPROJ + PC_CKV + lane * 4); float f[4];
                    f[0] = bf2f((unsigned)raw & 0xffffu); f[1] = bf2f(((unsigned)raw) >> 16); f[2] = bf2f((unsigned)(raw >> 32) & 0xffffu); f[3] = bf2f((unsigned)(raw >> 48));
                    const float s = f[0] * f[0] + f[1] * f[1] + f[2] * f[2] + f[3] * f[3];
                    const float rstd = 1.f / sqrtf(wave_sum(s) * (1.f / 256.f) + NORM_EPS);
                    *(unsigned long long*)(CKVN + (size_t)m * 256 + lane * 4) = (unsigned long long)pk2(f[0] * rstd, f[1] * rstd) | ((unsigned long long)pk2(f[2] * rstd, f[3] * rstd) << 32); }
                  { const float vv = SPEC[(size_t)m * 256 + 128 + lane]; const float pt = __shfl_xor(vv, 1); const int i = lane >> 1;
                    const float cs_ = CS[((size_t)m * 32 + i) * 2], sn_ = CS[((size_t)m * 32 + i) * 2 + 1];
                    const float o = (lane & 1) ? (vv * cs_ + pt * sn_) : (vv * cs_ - pt * sn_);
                    KR[(size_t)m * 64 + lane] = (bf16_t)f2bf(o); } }
#pragma unroll
                for (int hh = 0; hh < 2; ++hh) { const int ch = c + hh * 512;
                    const float cw0 = conv_w[ch], cw1 = conv_w[1024 + ch], cw2 = conv_w[2048 + ch], cw3 = conv_w[3072 + ch], cb = conv_b[ch];
                    float x0 = 0.f, x1 = 0.f, x2 = 0.f;
                    if (t0 >= 3) { x0 = bf2f(PROJ[(size_t)(m0 - 3) * NPROJ + PC_MLQK + ch]); x1 = bf2f(PROJ[(size_t)(m0 - 2) * NPROJ + PC_MLQK + ch]); x2 = bf2f(PROJ[(size_t)(m0 - 1) * NPROJ + PC_MLQK + ch]); }
                    const float sc_ = hh == 0 ? 0.08838834764831845f : 1.f;
#pragma unroll
                    for (int i = 0; i < 8; ++i) { const float x3 = bf2f(PROJ[(size_t)(m0 + i) * NPROJ + PC_MLQK + ch]);
                        const float y = cb + cw0 * x0 + cw1 * x1 + cw2 * x2 + cw3 * x3;
                        QKC[(size_t)(m0 + i) * 1024 + ch] = (bf16_t)f2bf(siluf_(y) * sc_);
                        x0 = x1; x1 = x2; x2 = x3; } }
                if (tid < 64) { const int i = tid >> 3, gh = tid & 7; const float val = SPEC[(size_t)(m0 + i) * 256 + 192 + gh];
                    if (gh < 4) LI[(size_t)(m0 + i) * 4 + gh] = val + i_bias[gh];
                    else { const float xx = val + f_bias[gh - 4]; LF[(size_t)(m0 + i) * 4 + gh - 4] = -softplusf_(-xx); } }
                __syncthreads();
            }
#endif
        }
        SEAM(pb + 1);
        if (IN(pb + 2)) {
#ifndef NO_G23
            { pg8::Gemm g{CQN, WUQ + (size_t)l * NQ * 512, M, NQ, 512}; pg8::StaticOrder S; S.init(M, NQ, G, bid);
              pg8::EpiPlain E{Q, NQ};
              pg8::gemm_phase<pg8::EpiPlain, pg8::StaticOrder, true, true>((LAS unsigned char*)lds, g, S, E); }
            { pg8::Gemm g{CKVN, WUKV + (size_t)l * NKV * 256, M, NKV, 256}; pg8::StaticOrder S; S.init(M, NKV, G, bid);
              pg8::EpiPlain E{KV, NKV};
              pg8::gemm_phase<pg8::EpiPlain, pg8::StaticOrder, true, true>((LAS unsigned char*)lds, g, S, E); }
#endif
        }
        SEAM(pb + 2);
        if (IN(pb + 3)) {
#ifndef NO_SCANS
            if (bid < 32 && G >= 64) {
                rwkv_unit(lds, bid >> 3, bid & 7, RWW, RWB, RWS, BONUS, PROJ, args.in[24] + l * 512 + (bid & 7) * 64, args.in[25] + l * 512 + (bid & 7) * 64, MIXED);
            } else if (bid < 48 && G >= 64) {
                const int u = bid - 32;
                mlstm_unit(lds, u >> 2, u & 3, QKC, PROJ, LI, LF, args.in[8] + l * 512 + (u & 3) * 128, MIXED);
            } else
#endif
            {
#ifndef NO_ATT
                const int first = (G >= 64) ? bid - 48 : bid, stride = (G >= 64) ? G - 48 : G; constexpr int total = BATCH * 8 * 8;
                if (first < total) {
                    att::Seam S; int L = first, pass = 0;
#define mk(L_, pass_) mk_block(Q, KV, KR, MIXED, PROJ, CS, (L_), (pass_))
                    att::BlockRef cur = mk(L, 0);
                    att::attn_prime(cur, (char*)lds, S);
                    for (;;) {
                        const bool more_pass = pass == 0, more_item = L + stride < total, last = !more_pass && !more_item;
                        int Ln = L, passn = pass + 1; if (!more_pass) { passn = 0; Ln = more_item ? L + stride : L; }
                        const att::BlockRef nxt = last ? cur : mk(Ln, passn);
                        att::attn_block(cur, nxt, (char*)lds, S);
                        if (last) break;
                        cur = nxt; L = Ln; pass = passn;
                    }
#undef mk
                }
#endif
            }
        }
        SEAM(pb + 3);
        if (IN(pb + 4)) {
#ifndef NO_G4
            pg8::Gemm g{MIXED, WOUT + (size_t)l * DM * DM, M, DM, DM}; pg8::StaticOrder S; S.init(M, DM, G, bid);
            pg8::EpiResid E{l == 0 ? x_in : (const float*)X, X, DM};
            pg8::gemm_phase<pg8::EpiResid, pg8::StaticOrder, true, true>((LAS unsigned char*)lds, g, S, E);
#endif
        }
        SEAM(pb + 4);
        if (IN(pb + 5)) {
            const int gw = bid * 8 + wave, NGW = G * 8;
            if (l + 1 < DEPTH) { for (int m = gw; m < M; m += NGW) norm_row<0>(X + (size_t)m * DM, XN + (size_t)m * DM, nullptr, nullptr, lane); }
            else { for (int m = gw; m < M; m += NGW) norm_row<1>(X + (size_t)m * DM, nullptr, X + (size_t)m * DM, args.in[27], lane); }
        }
        SEAM(pb + 5);
    }
#undef IN
#undef SEAM
}

constexpr int N_PHASES = 1 + DEPTH * 6;
#ifndef MK_ONE_LAUNCH
#define MK_ONE_LAUNCH 1
#endif
extern "C" void kernel_launch(void* const* d_in, const int* in_sizes, int n_in, void* d_out, int out_size, void* d_ws, size_t ws_size, hipStream_t stream) {
    static int grid = 0;
    if (grid == 0) {
        if (n_in != 28 || out_size != M * DM || ws_size < WS_END) { fprintf(stderr, "kernel_launch: unexpected shapes (n_in %d, out %d, ws %zu < %zu)\n", n_in, out_size, ws_size, (size_t)WS_END); grid = -1; return; }
        int dev = 0, cus = 0;
        if (hipGetDevice(&dev) != hipSuccess || hipDeviceGetAttribute(&cus, hipDeviceAttributeMultiprocessorCount, dev) != hipSuccess) { grid = -1; return; }
        if (hipFuncSetAttribute((const void*)fwd, hipFuncAttributeMaxDynamicSharedMemorySize, LDS_BYTES) != hipSuccess) { fprintf(stderr, "kernel_launch: hipFuncSetAttribute failed\n"); grid = -1; return; }
        int per_cu = 0;
        if (hipOccupancyMaxActiveBlocksPerMultiprocessor(&per_cu, (const void*)fwd, 512, LDS_BYTES) != hipSuccess || per_cu < 1) fprintf(stderr, "kernel_launch: occupancy query says %d\n", per_cu);
        (void)hipGetLastError();
        grid = cus;
    }
    if (grid < 0) return;
    if (hipMemsetAsync((char*)d_ws + WS_CTL, 0, CTL_ZERO_BYTES, stream) != hipSuccess) return;
    Args a; memset(&a, 0, sizeof(a));
    for (int i = 0; i < 28; ++i) a.in[i] = (const float*)d_in[i];
    a.out = (float*)d_out; a.ws = (unsigned char*)d_ws;
#if MK_ONE_LAUNCH
    a.ph_lo = 0; a.ph_hi = N_PHASES;
    hipLaunchKernelGGL(fwd, dim3(grid), dim3(512), LDS_BYTES, stream, a);
#else
    for (int p = 0; p < N_PHASES; ++p) { a.ph_lo = p; a.ph_hi = p + 1; hipLaunchKernelGGL(fwd, dim3(grid), dim3(512), LDS_BYTES, stream, a); }
#endif
}
```

```cpp
#include <hip/hip_runtime.h>
#include <cstdio>
#include <cstdint>
#include <cstring>
namespace pg8 {
#define PG8_LAS __attribute__((address_space(3)))
typedef unsigned short bf16_t;
typedef short bf16x8 __attribute__((ext_vector_type(8)));
typedef float f32x4 __attribute__((ext_vector_type(4)));
typedef unsigned u32x4 __attribute__((ext_vector_type(4)));
constexpr int BM = 256, BK = 64, HALF = 128, HTB = HALF * BK * 2  , STAGE_BYTES = 8 * HTB, NXCD = 8, WGM = 8;

__host__ __device__ __forceinline__ int lds_byte(int r, int c) { const int st = (r >> 4) * 2 + (c >> 5), rr = r & 15, cc = c & 31, ob = rr * 64 + cc * 2; return st * 1024 + (ob ^ (((ob >> 9) & 1) << 5)); }
__host__ __device__ __forceinline__ void stage_rc(int b, int& R, int& C) { const int st = b / 1024, sb = b % 1024, swz = sb ^ (((sb >> 9) & 1) << 5); R = (st >> 1) * 16 + swz / 64; C = (st & 1) * 32 + (swz % 64) / 2; }
__host__ __device__ __forceinline__ int perm32(int rho) { const int n = rho >> 4, i = rho & 15; return 8 * (i >> 2) + 4 * n + (i & 3); }

struct Unit { int pm, pn; };
struct Gemm { const bf16_t* A; const bf16_t* Bt; int M, N, K; };

struct StaticOrder {
    int nM, nN, nwg, G, c;
    __host__ __device__ void init(int M, int N, int G_, int c_) { nM = M / BM; nN = N / BM; nwg = nM * nN; G = G_; c = c_; }
    __host__ __device__ bool next(int i, Unit& u) const {
        const long L = (long)i * G + c; if (L >= nwg) return false;
        int wgid = (int)L; { const int q = nwg / NXCD, r = nwg % NXCD, xcd = wgid % NXCD, off = wgid / NXCD; wgid = (xcd < r ? xcd * (q + 1) : r * (q + 1) + (xcd - r) * q) + off; }
        const int nig = WGM * nN, gid = wgid / nig, fm = gid * WGM, gsz = (nM - fm) < WGM ? (nM - fm) : WGM;
        u.pm = fm + ((wgid % nig) % gsz); u.pn = (wgid % nig) / gsz; return true;
    }
    __device__ __forceinline__ void a_ready(const Unit&) const {}
    __device__ __forceinline__ void done(const Unit&) const {}
};

__device__ __forceinline__ unsigned cvt_pk_bf16(float lo, float hi) { unsigned r; asm volatile("v_cvt_pk_bf16_f32 %0, %1, %2" : "=v"(r) : "v"(lo), "v"(hi)); return r; }
typedef float f32x2 __attribute__((ext_vector_type(2)));
typedef unsigned u32x2 __attribute__((ext_vector_type(2)));
struct EpiProj {
    static constexpr bool PERM = true, AFTER_DRAIN = false;
    bf16_t* O; int ldc; float* spec; int spec_tile;
    __device__ __forceinline__ void operator()(const f32x4 (&acc)[2][2][4][2], const Unit& u, int wr, int wc, int fr, int fq) const {
        const int row0 = u.pm * BM + wr * 64 + fr, col0 = u.pn * BM + wc * 32 + 8 * fq;
        if (u.pn == spec_tile) {
            float* sp0 = spec + (size_t)row0 * 256 + wc * 32 + 8 * fq;
#pragma unroll
            for (int ai = 0; ai < 2; ++ai)
#pragma unroll
                for (int m = 0; m < 4; ++m) { float* sp_p = sp0 + (size_t)(ai * HALF + m * 16) * 256;
#pragma unroll
                    for (int bj = 0; bj < 2; ++bj) { *(f32x4*)(sp_p + bj * HALF) = acc[ai][bj][m][0]; *(f32x4*)(sp_p + bj * HALF + 4) = acc[ai][bj][m][1]; } }
        }
        bf16_t* o0 = O + (size_t)row0 * ldc + col0;
#pragma unroll
        for (int ai = 0; ai < 2; ++ai)
#pragma unroll
            for (int m = 0; m < 4; ++m) { bf16_t* rowp = o0 + (size_t)(ai * HALF + m * 16) * ldc;
#pragma unroll
                for (int bj = 0; bj < 2; ++bj) { const f32x4 v0 = acc[ai][bj][m][0], v1 = acc[ai][bj][m][1];
                    u32x4 w; w.x = cvt_pk_bf16(v0[0], v0[1]); w.y = cvt_pk_bf16(v0[2], v0[3]); w.z = cvt_pk_bf16(v1[0], v1[1]); w.w = cvt_pk_bf16(v1[2], v1[3]);
                    *(u32x4*)(rowp + bj * HALF) = w; } }
    }
};
struct EpiQ {
    static constexpr bool PERM = true, AFTER_DRAIN = false;
    bf16_t* O; const float* cs;
    __device__ __forceinline__ void operator()(const f32x4 (&acc)[2][2][4][2], const Unit& u, int wr, int wc, int fr, int fq) const {
        const int row0 = u.pm * BM + wr * 64 + fr, col0 = u.pn * BM + wc * 32 + 8 * fq;
#pragma unroll
        for (int ai = 0; ai < 2; ++ai)
#pragma unroll
            for (int m = 0; m < 4; ++m) { const int row = row0 + ai * HALF + m * 16; bf16_t* rowp = O + (size_t)row * 1536 + col0;
#pragma unroll
                for (int bj = 0; bj < 2; ++bj) { f32x4 v0 = acc[ai][bj][m][0], v1 = acc[ai][bj][m][1];
                    const int d = (col0 + bj * HALF) % 192;
                    if (d >= 128) { const int i0 = (d - 128) >> 1; const f32x4* cp = (const f32x4*)(cs + (size_t)row * 64 + i0 * 2); const f32x4 c0 = cp[0], c1 = cp[1];
                        f32x4 r0, r1;
                        r0[0] = v0[0] * c0[0] - v0[1] * c0[1]; r0[1] = v0[1] * c0[0] + v0[0] * c0[1];
                        r0[2] = v0[2] * c0[2] - v0[3] * c0[3]; r0[3] = v0[3] * c0[2] + v0[2] * c0[3];
                        r1[0] = v1[0] * c1[0] - v1[1] * c1[1]; r1[1] = v1[1] * c1[0] + v1[0] * c1[1];
                        r1[2] = v1[2] * c1[2] - v1[3] * c1[3]; r1[3] = v1[3] * c1[2] + v1[2] * c1[3];
                        v0 = r0; v1 = r1; }
                    u32x4 w; w.x = cvt_pk_bf16(v0[0], v0[1]); w.y = cvt_pk_bf16(v0[2], v0[3]); w.z = cvt_pk_bf16(v1[0], v1[1]); w.w = cvt_pk_bf16(v1[2], v1[3]);
                    *(u32x4*)(rowp + bj * HALF) = w; } }
    }
};
struct EpiPlain {
    static constexpr bool PERM = true, AFTER_DRAIN = false;
    bf16_t* O; int ldc;
    __device__ __forceinline__ void operator()(const f32x4 (&acc)[2][2][4][2], const Unit& u, int wr, int wc, int fr, int fq) const {
        const int row0 = u.pm * BM + wr * 64 + fr, col0 = u.pn * BM + wc * 32 + 8 * fq;
#pragma unroll
        for (int ai = 0; ai < 2; ++ai)
#pragma unroll
            for (int m = 0; m < 4; ++m) { bf16_t* rowp = O + (size_t)(row0 + ai * HALF + m * 16) * ldc + col0;
#pragma unroll
                for (int bj = 0; bj < 2; ++bj) { const f32x4 v0 = acc[ai][bj][m][0], v1 = acc[ai][bj][m][1];
                    u32x4 w; w.x = cvt_pk_bf16(v0[0], v0[1]); w.y = cvt_pk_bf16(v0[2], v0[3]); w.z = cvt_pk_bf16(v1[0], v1[1]); w.w = cvt_pk_bf16(v1[2], v1[3]);
                    *(u32x4*)(rowp + bj * HALF) = w; } }
    }
};
struct EpiResid {
    static constexpr bool PERM = false, AFTER_DRAIN = false;
    const float* base; float* out; int ldc;
    __device__ __forceinline__ void operator()(const f32x4 (&acc)[2][2][4][2], const Unit& u, int wr, int wc, int fr, int fq) const {
        const int row0 = u.pm * BM + wr * 64 + fr, col0 = u.pn * BM + wc * 32 + 4 * fq;
#pragma unroll
        for (int ai = 0; ai < 2; ++ai)
#pragma unroll
            for (int m = 0; m < 4; ++m) { const size_t off = (size_t)(row0 + ai * HALF + m * 16) * ldc + col0;
#pragma unroll
                for (int bj = 0; bj < 2; ++bj)
#pragma unroll
                    for (int n = 0; n < 2; ++n) { const f32x4 bs = *(const f32x4*)(base + off + bj * HALF + n * 16); *(f32x4*)(out + off + bj * HALF + n * 16) = bs + acc[ai][bj][m][n]; } }
    }
};
template <class Epi, class Sched, bool ALIGN_EPI = false, bool SP2 = false>
__device__ __forceinline__ void gemm_phase(PG8_LAS unsigned char* lds, const Gemm g, const Sched& S, const Epi& E) {
    int tid_o = threadIdx.x; asm volatile("" : "+v"(tid_o));
    const int tid = tid_o, wid = __builtin_amdgcn_readfirstlane(tid >> 6), lane = tid & 63, wr = wid >> 2, wc = wid & 3, fr = lane & 15, fq = lane >> 4;
    const int K = g.K, nt = K / BK;
    unsigned voffA[2], voffB[2];
#pragma unroll
    for (int i = 0; i < 2; ++i) { int R, C; stage_rc(tid * 16 + i * 8192, R, C); const int Rb = Epi::PERM ? ((R & ~31) + perm32(R & 31)) : R;
        voffA[i] = (unsigned)(R * K + C) * 2u; voffB[i] = (unsigned)(Rb * K + C) * 2u; }
    const size_t kstep = (size_t)(BK * 2);
    const size_t hstep = (size_t)HALF * K * 2;
    const size_t tstep = 2 * hstep;
    const unsigned ldsw = (unsigned)wid * 1024u;
    const int aoff = lds_byte(wr * 64 + fr, fq * 8), boff = lds_byte(wc * 32 + fr, fq * 8);
#define PG8_SA(b, h) (((b) * 2 + (h)) * HTB)
#define PG8_SB(b, h) ((4 + (b) * 2 + (h)) * HTB)
#define PG8_STAGE(bufoff, gbase, voff) do { _Pragma("unroll") for (int _i = 0; _i < 2; ++_i) \
        __builtin_amdgcn_global_load_lds((const unsigned*)((const char*)(gbase) + (voff)[_i]), (PG8_LAS unsigned*)(lds + (bufoff) + ldsw + _i * 8192), 16, 0, 0); } while (0)
#define PG8_LDA(dst, b, h) do { _Pragma("unroll") for (int m = 0; m < 4; ++m) _Pragma("unroll") for (int k = 0; k < 2; ++k) dst[m][k] = *(const PG8_LAS bf16x8*)(lds + PG8_SA(b, h) + aoff + m * 2048 + k * 1024); } while (0)
#define PG8_LDB(dst, b, h) do { _Pragma("unroll") for (int n = 0; n < 2; ++n) _Pragma("unroll") for (int k = 0; k < 2; ++k) dst[n][k] = *(const PG8_LAS bf16x8*)(lds + PG8_SB(b, h) + boff + n * 2048 + k * 1024); } while (0)
#define PG8_MMA(ai, bj, At, Bt) do { __builtin_amdgcn_s_setprio(1); _Pragma("unroll") for (int m = 0; m < 4; ++m) _Pragma("unroll") for (int n = 0; n < 2; ++n) _Pragma("unroll") for (int k = 0; k < 2; ++k) \
        acc[ai][bj][m][n] = __builtin_amdgcn_mfma_f32_16x16x32_bf16(Bt[n][k], At[m][k], acc[ai][bj][m][n], 0, 0, 0); __builtin_amdgcn_s_setprio(0); } while (0)
#define PG8_WAIT_V(n) asm volatile("s_waitcnt vmcnt(" #n ")" ::: "memory")
#define PG8_WAIT_L(n) asm volatile("s_waitcnt lgkmcnt(" #n ")" ::: "memory")
#define PG8_BAR __builtin_amdgcn_s_barrier()
#define PG8_SCHED __builtin_amdgcn_sched_barrier(0)
    Unit cur, nxt; int ui = 0;
    if (!S.next(0, cur)) return;
    f32x4 acc[2][2][4][2];
#pragma unroll
    for (int a = 0; a < 2; ++a)
#pragma unroll
        for (int b = 0; b < 2; ++b)
#pragma unroll
            for (int m = 0; m < 4; ++m)
#pragma unroll
                for (int n = 0; n < 2; ++n) acc[a][b][m][n] = (f32x4){0.f, 0.f, 0.f, 0.f};
    bf16x8 At[4][2], B0[2][2], B1[2][2];
    const char* cA = (const char*)g.A + (size_t)cur.pm * tstep; const char* cB = (const char*)g.Bt + (size_t)cur.pn * tstep;
    S.a_ready(cur);
    if constexpr (SP2) {
        PG8_STAGE(PG8_SB(0, 0), cB, voffB); PG8_STAGE(PG8_SB(0, 1), cB + hstep, voffB); PG8_STAGE(PG8_SA(0, 0), cA, voffA); PG8_STAGE(PG8_SA(0, 1), cA + hstep, voffA);
        if (wr == 1) PG8_BAR;
        PG8_WAIT_V(2); PG8_BAR;
        PG8_STAGE(PG8_SB(1, 0), cB + kstep, voffB); PG8_STAGE(PG8_SA(1, 0), cA + kstep, voffA); PG8_STAGE(PG8_SB(1, 1), cB + hstep + kstep, voffB);
        PG8_WAIT_V(6); PG8_BAR;
    } else {
        PG8_STAGE(PG8_SB(0, 0), cB, voffB); PG8_STAGE(PG8_SA(0, 0), cA, voffA); PG8_STAGE(PG8_SB(0, 1), cB + hstep, voffB); PG8_STAGE(PG8_SA(0, 1), cA + hstep, voffA);
        if (wr == 1) PG8_BAR;
        PG8_WAIT_V(4); PG8_BAR;
        PG8_STAGE(PG8_SB(1, 0), cB + kstep, voffB); PG8_STAGE(PG8_SA(1, 0), cA + kstep, voffA); PG8_STAGE(PG8_SB(1, 1), cB + hstep + kstep, voffB);
        PG8_WAIT_V(6); PG8_BAR;
    }
    for (;;) {
        const bool has_next = S.next(ui + 1, nxt);
        const char* nA = has_next ? (const char*)g.A + (size_t)nxt.pm * tstep : cA; const char* nB = has_next ? (const char*)g.Bt + (size_t)nxt.pn * tstep : cB;
        for (int t = 0; t < nt; t += 2) {
            const bool last = (t == nt - 2);
            const char* a1 = cA + (size_t)(t + 1) * kstep;
            const char* a2 = last ? nA : cA + (size_t)(t + 2) * kstep; const char* b2 = last ? nB : cB + (size_t)(t + 2) * kstep;
            const char* a3 = a2 + kstep; const char* b3 = b2 + kstep;
            if (last && has_next) S.a_ready(nxt);
            if constexpr (SP2) {
            PG8_LDB(B0, 0, 0); PG8_LDB(B1, 0, 1); PG8_SCHED; PG8_LDA(At, 0, 0); PG8_STAGE(PG8_SA(1, 1), a1 + hstep, voffA);
            PG8_WAIT_V(8); PG8_WAIT_L(0); PG8_BAR; PG8_MMA(0, 0, At, B0); PG8_MMA(0, 1, At, B1); PG8_BAR; PG8_SCHED;
            PG8_LDA(At, 0, 1); PG8_STAGE(PG8_SB(0, 0), b2, voffB); PG8_STAGE(PG8_SB(0, 1), b2 + hstep, voffB); PG8_STAGE(PG8_SA(0, 0), a2, voffA);
            PG8_WAIT_V(8); PG8_WAIT_L(0); PG8_BAR; PG8_MMA(1, 0, At, B0); PG8_MMA(1, 1, At, B1); PG8_BAR; PG8_SCHED;
            PG8_LDB(B0, 1, 0); PG8_LDB(B1, 1, 1); PG8_SCHED; PG8_LDA(At, 1, 0); PG8_STAGE(PG8_SA(0, 1), a2 + hstep, voffA);
            PG8_WAIT_V(8); PG8_WAIT_L(0); PG8_BAR; PG8_MMA(0, 0, At, B0); PG8_MMA(0, 1, At, B1); PG8_BAR; PG8_SCHED;
            PG8_LDA(At, 1, 1); PG8_STAGE(PG8_SB(1, 0), b3, voffB); PG8_STAGE(PG8_SB(1, 1), b3 + hstep, voffB); PG8_STAGE(PG8_SA(1, 0), a3, voffA);
            PG8_WAIT_V(8); PG8_WAIT_L(0); PG8_BAR; PG8_MMA(1, 0, At, B0); PG8_MMA(1, 1, At, B1); PG8_BAR; PG8_SCHED;
            } else {
            PG8_LDB(B0, 0, 0); PG8_SCHED; PG8_LDA(At, 0, 0); PG8_STAGE(PG8_SA(1, 1), a1 + hstep, voffA);
            PG8_WAIT_L(8); PG8_BAR; PG8_WAIT_L(0); PG8_MMA(0, 0, At, B0); PG8_BAR; PG8_SCHED;
            PG8_LDB(B1, 0, 1); PG8_STAGE(PG8_SB(0, 0), b2, voffB);
            PG8_BAR; PG8_WAIT_L(0); PG8_MMA(0, 1, At, B1); PG8_BAR;
            PG8_LDA(At, 0, 1); PG8_STAGE(PG8_SA(0, 0), a2, voffA);
            PG8_BAR; PG8_WAIT_L(0); PG8_MMA(1, 0, At, B0); PG8_BAR; PG8_SCHED;
            PG8_STAGE(PG8_SB(0, 1), b2 + hstep, voffB);
            PG8_WAIT_V(6); PG8_BAR; PG8_MMA(1, 1, At, B1); PG8_BAR;
            PG8_LDB(B0, 1, 0); PG8_SCHED; PG8_LDA(At, 1, 0); PG8_STAGE(PG8_SA(0, 1), a2 + hstep, voffA);
            PG8_WAIT_L(8); PG8_BAR; PG8_WAIT_L(0); PG8_MMA(0, 0, At, B0); PG8_BAR; PG8_SCHED;
            PG8_LDB(B1, 1, 1); PG8_STAGE(PG8_SB(1, 0), b3, voffB);
            PG8_BAR; PG8_WAIT_L(0); PG8_MMA(0, 1, At, B1); PG8_BAR;
            PG8_LDA(At, 1, 1); PG8_STAGE(PG8_SA(1, 0), a3, voffA);
            PG8_BAR; PG8_WAIT_L(0); PG8_MMA(1, 0, At, B0); PG8_BAR; PG8_SCHED;
            PG8_STAGE(PG8_SB(1, 1), b3 + hstep, voffB);
            PG8_WAIT_V(6); PG8_BAR; PG8_MMA(1, 1, At, B1); PG8_BAR;
            }
        }
        if constexpr (ALIGN_EPI) { if (wr == 0) PG8_BAR; }
        if constexpr (!Epi::AFTER_DRAIN) { E(acc, cur, wr, wc, fr, fq); S.done(cur); }
        if (!has_next) break;
#pragma unroll
        for (int a = 0; a < 2; ++a)
#pragma unroll
            for (int b = 0; b < 2; ++b)
#pragma unroll
                for (int m = 0; m < 4; ++m)
#pragma unroll
                    for (int n = 0; n < 2; ++n) acc[a][b][m][n] = (f32x4){0.f, 0.f, 0.f, 0.f};
        cur = nxt; cA = nA; cB = nB; ++ui;
        if constexpr (ALIGN_EPI) { if (wr == 1) PG8_BAR; }
    }
    PG8_WAIT_V(0);
    if constexpr (!ALIGN_EPI) { if (wr == 0) PG8_BAR; }
    PG8_BAR;
    if constexpr (Epi::AFTER_DRAIN) { E.fused(acc, cur, wr, wc, fr, fq, lds, wid, lane); S.done(cur); }
#undef PG8_SA
#undef PG8_SB
#undef PG8_STAGE
#undef PG8_LDA
#undef PG8_LDB
#undef PG8_MMA
#undef PG8_WAIT_V
#undef PG8_WAIT_L
#undef PG8_BAR
#undef PG8_SCHED
}
}
#define GAS __attribute__((address_space(1)))
#define LAS __attribute__((address_space(3)))
typedef unsigned short bf16;
typedef unsigned v4u __attribute__((ext_vector_type(4)));
typedef float f32x4 __attribute__((ext_vector_type(4)));
typedef short bf16x8 __attribute__((ext_vector_type(8)));
typedef GAS unsigned gu32;
typedef GAS unsigned long long gu64;
#define RLX_AGENT __ATOMIC_RELAXED, __HIP_MEMORY_SCOPE_AGENT
#define LDS_WAIT() asm volatile("s_waitcnt lgkmcnt(0)" ::: "memory")
#define VM_WAIT() asm volatile("s_waitcnt vmcnt(0)" ::: "memory")
__device__ __forceinline__ unsigned long long rt() { return __builtin_amdgcn_s_memrealtime(); }
__device__ __forceinline__ unsigned f2bf(float f) { unsigned u = __builtin_bit_cast(unsigned, f); return (u + 0x7fffu + ((u >> 16) & 1u)) >> 16; }
__device__ __forceinline__ unsigned pk2(float lo, float hi) { return f2bf(lo) | (f2bf(hi) << 16); }

#define XB_TMO      128
#define XB_XCNT(j)  (256  + 64 * (j))
#define XB_XSUB(j)  (1280 + 64 * (j))
#define XB_XGEN(j)  (2304 + 64 * (j))
#define XB_TOP      3328
#define XB_TOPGEN   3392
#define XCD_BAR_WORDS 3456
#define XB_SPIN_CAP (1u << 18)

__device__ __forceinline__ unsigned xb_ld(unsigned* p)              { return __hip_atomic_load(p, __ATOMIC_RELAXED, __HIP_MEMORY_SCOPE_AGENT); }
__device__ __forceinline__ unsigned xb_add(unsigned* p, unsigned v) { return __hip_atomic_fetch_add(p, v, __ATOMIC_RELAXED, __HIP_MEMORY_SCOPE_AGENT); }
__device__ __forceinline__ unsigned xb_xcc_id() { return (unsigned)__builtin_amdgcn_s_getreg((3 << 11) | 20) & 0xFu; }
#define XB_SPIN(cond, bar) do { unsigned _sp = 0; while (cond) { __builtin_amdgcn_s_sleep(1); \
    if ((++_sp & 255u) == 0u) { if (xb_ld(&(bar)[XB_TMO])) break; if (_sp > XB_SPIN_CAP) { atomicAdd(&(bar)[XB_TMO], 1u); break; } } } } while (0)

struct XcdBarrier {
    unsigned* bar; unsigned x;
    volatile LAS unsigned* st;
};

__device__ __forceinline__ XcdBarrier xcd_barrier_post(unsigned* bar, volatile LAS unsigned* st) {
    XcdBarrier b; b.bar = bar; b.x = xb_xcc_id(); b.st = st;
    if (threadIdx.x == 0) (void)xb_add(&bar[XB_XCNT(b.x)], 1u);
    return b;
}
__device__ __forceinline__ void xcd_barrier_complete(unsigned* bar, unsigned x, unsigned& nloc, unsigned& nx) {
    const unsigned G = gridDim.x * gridDim.y * gridDim.z;
    unsigned sum, cnt, mine, sp = 0u;
    for (;;) {
        sum = 0u; cnt = 0u; mine = 0u;
#pragma unroll
        for (unsigned j = 0; j < 16; ++j) { const unsigned c = xb_ld(&bar[XB_XCNT(j)]); sum += c; cnt += (c > 0u) ? 1u : 0u; mine = (j == x) ? c : mine; }
        if (sum == G) break;
        __builtin_amdgcn_s_sleep(1);
        if ((++sp & 255u) == 0u) { if (xb_ld(&bar[XB_TMO])) break; if (sp > XB_SPIN_CAP) { atomicAdd(&bar[XB_TMO], 1u); break; } }
    }
    nloc = mine > 0u ? mine : 1u; nx = cnt > 0u ? cnt : 1u;
}

__device__ __forceinline__ void xcd_barrier(const XcdBarrier& b) {
    asm volatile("s_waitcnt vmcnt(0)" ::: "memory");
    __syncthreads();
    if (threadIdx.x == 0) {
        unsigned* bar = b.bar;
        __builtin_amdgcn_s_waitcnt(0);
        unsigned nloc = b.st[0], nx = b.st[1];
        if (nloc == 0u) { xcd_barrier_complete(bar, b.x, nloc, nx); b.st[0] = nloc; b.st[1] = nx; }
        const unsigned old = xb_add(&bar[XB_XSUB(b.x)], 1u);
        const unsigned gen = old / nloc;
        if (old + 1u == (gen + 1u) * nloc) {
            __builtin_amdgcn_fence(__ATOMIC_RELEASE, "agent");
            asm volatile("s_waitcnt vmcnt(0)" ::: "memory");
            const unsigned og = xb_add(&bar[XB_TOP], 1u);
            const unsigned tg = og / nx;
            if (og + 1u == (tg + 1u) * nx) xb_add(&bar[XB_TOPGEN], 1u);
            else XB_SPIN(xb_ld(&bar[XB_TOPGEN]) == tg, bar);
            __builtin_amdgcn_fence(__ATOMIC_ACQUIRE, "agent");
            xb_add(&bar[XB_XGEN(b.x)], 1u);
            asm volatile("s_waitcnt vmcnt(0)" ::: "memory");
        } else {
            XB_SPIN(xb_ld(&bar[XB_XGEN(b.x)]) == gen, bar);
            __builtin_amdgcn_fence(__ATOMIC_ACQUIRE, "agent");
            asm volatile("s_waitcnt vmcnt(0)" ::: "memory");
        }
    }
    __syncthreads();
}
constexpr int BATCH = 4, T = 4096, DM = 2048, DEPTH = 4, M = BATCH * T;
constexpr int D_IN = 6600, NPROJ = 6656;
constexpr int SC_MLQK = 0, SC_MLV = 1024, SC_MLI = 1536, SC_MLF = 1540, SC_MLO = 1544, SC_MLZ = 2056, SC_CQ = 2568, SC_CKV = 3080, SC_KR = 3336, SC_MLAZ = 3400, SC_RW = 4424, SC_RWZ = 6088;
constexpr int PC_MLQK = 0, PC_MLV = 1024, PC_MLO = 1536, PC_MLZ = 2048, PC_CQ = 2560, PC_CKV = 3072, PC_MLAZ = 3328, PC_RW = 4352, PC_SPEC = 5888, PC_RWZ = 6144;
constexpr int SPEC_TILE = PC_SPEC / 256;
constexpr int NQ = 1536, NKV = 2048;
constexpr float NORM_EPS = 1e-6f, RW_GN_EPS = 64e-5f;
typedef unsigned short bf16_t;
__device__ __forceinline__ float bf2f(unsigned v) { return __uint_as_float(v << 16); }
__device__ __forceinline__ float wave_sum(float v) {
#pragma unroll
    for (int o = 1; o < 64; o <<= 1) v += __shfl_xor(v, o);
    return v;
}
__device__ __forceinline__ float sigmoidf_(float x) { return 1.f / (1.f + __expf(-x)); }
__device__ __forceinline__ float siluf_(float x) { return x / (1.f + __expf(-x)); }
__device__ __forceinline__ float softplusf_(float x) { return fmaxf(x, 0.f) + log1pf(__expf(-fabsf(x))); }

namespace att {
typedef unsigned short bf16_t;
typedef short bf16x8 __attribute__((ext_vector_type(8)));
typedef short s16x4 __attribute__((ext_vector_type(4)));
typedef float f32x16 __attribute__((ext_vector_type(16)));
typedef float f32x4 __attribute__((ext_vector_type(4)));
typedef unsigned u32x4 __attribute__((ext_vector_type(4)));
constexpr int NW = 8, QBLK = 32, KVBLK = 64, QB = NW * QBLK;
constexpr int QP = 1536, KVP = 2048, KRP = 64, OP = 2048;
constexpr int SHM_V = KVBLK * 128 * 2, SHM_K = KVBLK * 128 * 2, SHM_R = KVBLK * 64 * 2;
constexpr int OFF_V = 0, OFF_K = 2 * SHM_V, OFF_R = OFF_K + SHM_K, OFF_WS = OFF_R + SHM_R, OFF_Q = OFF_WS + NW * 64 * 4, LDS_BYTES = OFF_Q + NW * 12288;
constexpr float SCALE = 0.07216878364870322f;
constexpr float THR = 8.f;
constexpr unsigned WBIG = 1u << 30;
#define KSWZ(row, colB) ((row) * 256 + ((colB) ^ (((row) & 7) << 4)))
#define RSWZ(row, colB) ((row) * 128 + ((colB) ^ (((row) & 7) << 4)))
#define SBAR() __builtin_amdgcn_sched_barrier(0)
__device__ __forceinline__ int v_st(int k, int c) { const int kk = (k & ~0xC) | ((k & 4) << 1) | ((k & 8) >> 1); return ((kk >> 3) * 4 + (c >> 5)) * 512 + ((kk & 7) * 32 + (c & 31)) * 2; }
__device__ __forceinline__ int v_rd_base(int lane) { return ((lane & 3) << 3) | (((lane >> 2) & 3) << 6) | (((lane >> 4) & 1) << 5) | (((lane >> 5) & 1) << 8); }
constexpr int v_rd_off(int d0, int ks, int half) { return d0 * 512 + ks * 4096 + half * 2048; }
__device__ __forceinline__ int crow(int r, int hi) { return (r & 3) + 8 * (r >> 2) + 4 * hi; }
__device__ __forceinline__ unsigned cvtpk(float lo, float hi) { unsigned r; asm volatile("v_cvt_pk_bf16_f32 %0, %1, %2" : "=v"(r) : "v"(lo), "v"(hi)); return r; }
__device__ __forceinline__ bf16x8 load8(const bf16_t* p) { return *reinterpret_cast<const bf16x8*>(p); }
__device__ __forceinline__ float bf2f(bf16_t v) { return __uint_as_float((unsigned)v << 16); }
__device__ __forceinline__ void mask_tile(f32x16& p0, f32x16& p1, int dq, unsigned W) {
    const float NEG = -__builtin_inff();
#pragma unroll
    for (int r = 0; r < 16; ++r) {
        const int c = (r & 3) + 8 * (r >> 2);
        if ((unsigned)(dq - c) >= W) p0[r] = NEG;
        if ((unsigned)(dq - c - 32) >= W) p1[r] = NEG;
    }
}
__device__ __forceinline__ void partialSM(f32x16& p0, f32x16& p1, float& m_reg, float& mn, float& alpha) {
    float pmax = p0[0]; for (int r = 1; r < 16; ++r) pmax = fmaxf(pmax, p0[r]); for (int r = 0; r < 16; ++r) pmax = fmaxf(pmax, p1[r]);
    { auto rr = __builtin_amdgcn_permlane32_swap(__float_as_uint(pmax), __float_as_uint(pmax), false, false);
      pmax = fmaxf(__uint_as_float(rr[0]), __uint_as_float(rr[1])); }
    constexpr float C2 = 1.4426950408889634f * SCALE;
    if (__builtin_expect(__all((pmax - m_reg) * SCALE <= THR), 1)) { mn = m_reg; alpha = 1.f; }
    else { mn = fmaxf(m_reg, pmax); alpha = __builtin_amdgcn_exp2f((m_reg - mn) * C2); m_reg = mn; }
    const float mnL = -mn * C2;
    for (int r = 0; r < 16; ++r) p0[r] = fmaf(p0[r], C2, mnL); for (int r = 0; r < 16; ++r) p1[r] = fmaf(p1[r], C2, mnL);
    for (int r = 0; r < 16; ++r) p0[r] = __builtin_amdgcn_exp2f(p0[r]);
}
__device__ __forceinline__ void finishSM(f32x16& p0, f32x16& p1, float alpha, float& l_reg, bf16x8& pa0, bf16x8& pa1, bf16x8& pa2, bf16x8& pa3) {
    for (int r = 0; r < 16; ++r) p1[r] = __builtin_amdgcn_exp2f(p1[r]);
    float ps = 0; for (int r = 0; r < 16; ++r) ps += p0[r]; for (int r = 0; r < 16; ++r) ps += p1[r];
    { auto rr = __builtin_amdgcn_permlane32_swap(__float_as_uint(ps), __float_as_uint(ps), false, false);
      ps = __uint_as_float(rr[0]) + __uint_as_float(rr[1]); }
    l_reg = l_reg * alpha + ps;
#define PK4(P, B_, OUT) do { unsigned a0 = cvtpk(P[B_+0], P[B_+1]), a1 = cvtpk(P[B_+2], P[B_+3]);                          \
        unsigned b0 = cvtpk(P[B_+4], P[B_+5]), b1 = cvtpk(P[B_+6], P[B_+7]);                                             \
        auto r0 = __builtin_amdgcn_permlane32_swap(a0, b0, false, false); auto r1 = __builtin_amdgcn_permlane32_swap(a1, b1, false, false); \
        u32x4 w = {r0[0], r1[0], r0[1], r1[1]}; OUT = *reinterpret_cast<bf16x8*>(&w); } while (0)
    PK4(p0, 0, pa0); PK4(p0, 8, pa1); PK4(p1, 0, pa2); PK4(p1, 8, pa3);
#undef PK4
}
__device__ __forceinline__ void qkt(f32x16& p0, f32x16& p1, const char* K_lds, const char* R_lds, const char* Qw, int r32, int hi) {
    p0 = f32x16{}; p1 = f32x16{};
    const char* kb[4]; const char* rb[4];
#pragma unroll
    for (int dd = 0; dd < 4; ++dd) { kb[dd] = K_lds + KSWZ(r32, (dd * 16 + hi * 8) * 2); rb[dd] = R_lds + RSWZ(r32, (dd * 16 + hi * 8) * 2); }
#pragma unroll
    for (int d0 = 0; d0 < 8; ++d0) { const char* a = kb[d0 & 3] + (d0 >> 2) * 128;
        bf16x8 b0 = *reinterpret_cast<const bf16x8*>(a);
        bf16x8 b1 = *reinterpret_cast<const bf16x8*>(a + 32 * 256);
        bf16x8 q = *reinterpret_cast<const bf16x8*>(Qw + d0 * 1024);
        p0 = __builtin_amdgcn_mfma_f32_32x32x16_bf16(b0, q, p0, 0, 0, 0);
        p1 = __builtin_amdgcn_mfma_f32_32x32x16_bf16(b1, q, p1, 0, 0, 0); }
#pragma unroll
    for (int e = 0; e < 4; ++e) { const char* a = rb[e];
        bf16x8 b0 = *reinterpret_cast<const bf16x8*>(a);
        bf16x8 b1 = *reinterpret_cast<const bf16x8*>(a + 32 * 128);
        bf16x8 q = *reinterpret_cast<const bf16x8*>(Qw + (8 + e) * 1024);
        p0 = __builtin_amdgcn_mfma_f32_32x32x16_bf16(b0, q, p0, 0, 0, 0);
        p1 = __builtin_amdgcn_mfma_f32_32x32x16_bf16(b1, q, p1, 0, 0, 0); }
}
template <int VB>
__device__ __forceinline__ void pv_tile(f32x16* o, int vb0, bf16x8 pa0, bf16x8 pa1, bf16x8 pa2, bf16x8 pa3) {
#define TRRD(dst, off) asm volatile("ds_read_b64_tr_b16 %0, %1 offset:%2" : "=&v"(dst) : "v"(vb0), "i"(off) : "memory")
#define PV_D0(d0) do { s16x4 l0, l1, l2, l3, h0, h1, h2, h3; constexpr int b_ = OFF_V + VB * SHM_V + v_rd_off(d0, 0, 0); \
        TRRD(l0, b_); TRRD(h0, b_ + 2048); TRRD(l1, b_ + 4096); TRRD(h1, b_ + 6144); TRRD(l2, b_ + 8192); TRRD(h2, b_ + 10240); TRRD(l3, b_ + 12288); TRRD(h3, b_ + 14336); \
        asm volatile("s_waitcnt lgkmcnt(0)" ::: "memory"); SBAR();   \
        o[d0] = __builtin_amdgcn_mfma_f32_32x32x16_bf16(pa0, (bf16x8){l0[0], l0[1], l0[2], l0[3], h0[0], h0[1], h0[2], h0[3]}, o[d0], 0, 0, 0);   \
        o[d0] = __builtin_amdgcn_mfma_f32_32x32x16_bf16(pa1, (bf16x8){l1[0], l1[1], l1[2], l1[3], h1[0], h1[1], h1[2], h1[3]}, o[d0], 0, 0, 0);   \
        o[d0] = __builtin_amdgcn_mfma_f32_32x32x16_bf16(pa2, (bf16x8){l2[0], l2[1], l2[2], l2[3], h2[0], h2[1], h2[2], h2[3]}, o[d0], 0, 0, 0);   \
        o[d0] = __builtin_amdgcn_mfma_f32_32x32x16_bf16(pa3, (bf16x8){l3[0], l3[1], l3[2], l3[3], h3[0], h3[1], h3[2], h3[3]}, o[d0], 0, 0, 0); } while (0)
    PV_D0(0); PV_D0(1); PV_D0(2); PV_D0(3);
#undef PV_D0
#undef TRRD
}
struct BlockRef { const bf16_t* Q; const bf16_t* K; const bf16_t* V; const bf16_t* KR; bf16_t* O; const bf16_t* Z; const float* CSq; int P0; };
struct Seam { bf16x8 qr[12]; bf16x8 st_v0, st_v1, st_k0, st_k1, st_r; };
#define ROWKV(p, k0, rr) ((p) + (size_t)((k0) + (rr)) * KVP + sc)
#define VMW() asm volatile("s_waitcnt vmcnt(0)" ::: "memory")
#define VMWN(n) asm volatile("s_waitcnt vmcnt(%0)" :: "i"(n) : "memory")
#define SLOAD_H(Kp, Vp, Rp, k0) do { S.st_v0 = load8(ROWKV(Vp, k0, sr)); S.st_v1 = load8(ROWKV(Vp, k0, 32 + sr));              \
                         S.st_k0 = load8(ROWKV(Kp, k0, sr)); S.st_k1 = load8(ROWKV(Kp, k0, 32 + sr)); S.st_r = load8((Rp) + (size_t)((k0) + rr_) * KRP + rc_); } while (0)
#define SWRITE_HK() do { *(bf16x8*)(K_lds + kws) = S.st_k0; *(bf16x8*)(K_lds + kws + 32 * 256) = S.st_k1; *(bf16x8*)(R_lds + rws) = S.st_r; } while (0)
#define SWRITE_HV(bf) do { *(bf16x8*)(V_lds + (bf) * SHM_V + vst0) = S.st_v0; *(bf16x8*)(V_lds + (bf) * SHM_V + vst1) = S.st_v1; } while (0)
#define SWRITE_H(bf) do { SWRITE_HV(bf); SWRITE_HK(); } while (0)
__device__ __forceinline__ void attn_prime(const BlockRef& cur, char* lds, Seam& S) {
    int tid_o = threadIdx.x; asm volatile("" : "+v"(tid_o));
    const int tid = tid_o, wid = __builtin_amdgcn_readfirstlane(tid >> 6), lane = tid & 63, r32 = lane & 31, hi = lane >> 5;
    const int sr = tid >> 4, sc = (tid & 15) * 8, kws = KSWZ(sr, sc * 2), rr_ = tid >> 3, rc_ = (tid & 7) * 8, rws = RSWZ(rr_, rc_ * 2);
    char* K_lds = lds + OFF_K; char* R_lds = lds + OFF_R;
#pragma unroll
    for (int d0 = 0; d0 < 12; ++d0) S.qr[d0] = load8(cur.Q + (size_t)(wid * QBLK + r32) * QP + d0 * 16 + hi * 8);
    SLOAD_H(cur.K, cur.V, cur.KR, 0); VMW(); SWRITE_HK();
    __syncthreads();
}
__device__ __forceinline__ void attn_block(const BlockRef& cur, const BlockRef& nxt, char* lds, Seam& S) {
    int tid_o = threadIdx.x; asm volatile("" : "+v"(tid_o));
    const int tid = tid_o, wid = __builtin_amdgcn_readfirstlane(tid >> 6), lane = tid & 63, r32 = lane & 31, hi = lane >> 5;
    const int NT = cur.P0 / KVBLK + 4;
    const int qlo = cur.P0 + wid * QBLK, qm = qlo + r32 - 4 * hi;
    char* V_lds = lds + OFF_V; char* K_lds = lds + OFF_K; char* R_lds = lds + OFF_R;
    float* ws = (float*)(lds + OFF_WS) + wid * 64; float* li_l = ws, * al_l = ws + 32;
    float m_reg = -1e30f, l_reg = 0; f32x16 o[4] = {};
    const int sr = tid >> 4, sc = (tid & 15) * 8, vst0 = v_st(sr, sc), vst1 = v_st(32 + sr, sc), kws = KSWZ(sr, sc * 2), rr_ = tid >> 3, rc_ = (tid & 7) * 8, rws = RSWZ(rr_, rc_ * 2);
    const int vb0 = (int)(uintptr_t)lds + v_rd_base(lane);
    char* Qw = lds + OFF_Q + wid * 12288 + lane * 16;
    const bf16_t* Kh = cur.K; const bf16_t* Vh = cur.V; const bf16_t* Rh = cur.KR;
#define RESC(a) do { if (__any((a) < 1.f)) { if (hi == 0) al_l[r32] = (a); asm volatile("s_waitcnt lgkmcnt(0)" ::: "memory");              \
                     for (int d_ = 0; d_ < 4; ++d_) for (int r = 0; r < 16; ++r) o[d_][r] *= al_l[crow(r, hi)]; } } while (0)
#define KBASE(t) ((t) * KVBLK)
#define MASKT(P0_, P1_, t) do { const int kb_ = KBASE(t); if (kb_ + KVBLK - 1 > qlo) mask_tile(P0_, P1_, qm - kb_, WBIG); } while (0)
    constexpr int NQL = 12;
#define SEAM_K0() do { VMWN(NQL); SWRITE_HK(); SBAR(); } while (0)
    f32x16 pA0, pA1, pB0, pB1; float mnA, mnB, alA, alB; bf16x8 pa0, pa1, pa2, pa3;
#pragma unroll
    for (int e = 0; e < 4; ++e) { const f32x4* cp = (const f32x4*)(cur.CSq + (size_t)(wid * QBLK + r32) * 64 + (e * 8 + hi * 4) * 2); const f32x4 c0 = cp[0], c1 = cp[1];
        const bf16x8 raw = S.qr[8 + e]; float x[8];
#pragma unroll
        for (int j = 0; j < 8; ++j) x[j] = __uint_as_float((unsigned)(unsigned short)raw[j] << 16);
        u32x4 w;
        w.x = cvtpk(x[0] * c0[0] - x[1] * c0[1], x[1] * c0[0] + x[0] * c0[1]); w.y = cvtpk(x[2] * c0[2] - x[3] * c0[3], x[3] * c0[2] + x[2] * c0[3]);
        w.z = cvtpk(x[4] * c1[0] - x[5] * c1[1], x[5] * c1[0] + x[4] * c1[1]); w.w = cvtpk(x[6] * c1[2] - x[7] * c1[3], x[7] * c1[2] + x[6] * c1[3]);
        S.qr[8 + e] = *reinterpret_cast<bf16x8*>(&w); }
#pragma unroll
    for (int d0 = 0; d0 < 12; ++d0) *(bf16x8*)(Qw + d0 * 1024) = S.qr[d0];
    SWRITE_HV(0); SBAR();
    SLOAD_H(Kh, Vh, Rh, KBASE(1));
    SBAR(); qkt(pA0, pA1, K_lds, R_lds, Qw, r32, hi);
    MASKT(pA0, pA1, 0); partialSM(pA0, pA1, m_reg, mnA, alA);
    __syncthreads();
    VMW(); SWRITE_H(1);
    __syncthreads();
#define HALF_STEP(PX0, PX1, mnX, alX, PY0, PY1, alY, t, VB, SB) do {                                                          \
        SBAR(); qkt(PX0, PX1, K_lds, R_lds, Qw, r32, hi);                                                                     \
        finishSM(PY0, PY1, alY, l_reg, pa0, pa1, pa2, pa3); SBAR();                                                           \
        if ((t) + 1 < NT) { SLOAD_H(Kh, Vh, Rh, KBASE((t) + 1)); SBAR(); }                                                    \
        pv_tile<VB>(o, vb0, pa0, pa1, pa2, pa3); MASKT(PX0, PX1, (t)); partialSM(PX0, PX1, m_reg, mnX, alX);                  \
        __syncthreads();                                                                                                      \
        if ((t) + 1 < NT) { VMW(); SWRITE_H(SB); }                                                                            \
        RESC(alX); __syncthreads(); } while (0)
    for (int t = 1; t + 1 < NT; t += 2) {
        HALF_STEP(pB0, pB1, mnB, alB, pA0, pA1, alA, t, 0, 0);
        HALF_STEP(pA0, pA1, mnA, alA, pB0, pB1, alB, t + 1, 1, 1);
    }
    SBAR(); qkt(pB0, pB1, K_lds, R_lds, Qw, r32, hi); SBAR();
    SLOAD_H(nxt.K, nxt.V, nxt.KR, 0); SBAR();
    finishSM(pA0, pA1, alA, l_reg, pa0, pa1, pa2, pa3); SBAR();
    pv_tile<0>(o, vb0, pa0, pa1, pa2, pa3);
    MASKT(pB0, pB1, NT - 1); partialSM(pB0, pB1, m_reg, mnB, alB); __syncthreads(); RESC(alB);
    finishSM(pB0, pB1, alB, l_reg, pa0, pa1, pa2, pa3); SBAR(); pv_tile<1>(o, vb0, pa0, pa1, pa2, pa3);
    SBAR();
#pragma unroll
    for (int d0 = 0; d0 < 12; ++d0) S.qr[d0] = load8(nxt.Q + (size_t)(wid * QBLK + r32) * QP + d0 * 16 + hi * 8);
    SBAR(); SEAM_K0();
    if (hi == 0) li_l[r32] = l_reg; asm volatile("s_waitcnt lgkmcnt(0)" ::: "memory");
    float rli[16];
#pragma unroll
    for (int r = 0; r < 16; ++r) rli[r] = __builtin_amdgcn_rcpf(li_l[crow(r, hi)]);
    bf16_t* Ow = cur.O + (size_t)(wid * QBLK) * OP; const bf16_t* Zw = cur.Z + (size_t)(wid * QBLK) * NPROJ;
#pragma unroll
    for (int r = 0; r < 16; ++r) { const int orow = crow(r, hi);
#pragma unroll
        for (int d0 = 0; d0 < 4; ++d0) { const float z = bf2f(Zw[(size_t)orow * NPROJ + d0 * 32 + r32]);
            const float v = o[d0][r] * rli[r] * (z / (1.f + __expf(-z)));
            const float vn = __shfl_xor(v, 1);
            if ((r32 & 1) == 0) *(unsigned*)(Ow + (size_t)orow * OP + d0 * 32 + r32) = cvtpk(v, vn); } }
    __syncthreads();
#undef RESC
#undef KBASE
#undef MASKT
#undef SEAM_K0
#undef HALF_STEP
}
#undef ROWKV
#undef VMW
#undef VMWN
#undef SLOAD_H
#undef SWRITE_HK
#undef SWRITE_HV
#undef SWRITE_H
#undef KSWZ
#undef RSWZ
#undef SBAR
}
namespace mm {
typedef short bf16x8 __attribute__((ext_vector_type(8)));
typedef float f32x4 __attribute__((ext_vector_type(4)));
typedef unsigned u32x2 __attribute__((ext_vector_type(2)));
#define MM_LAS __attribute__((address_space(3)))
typedef float f32x2_t __attribute__((ext_vector_type(2))); typedef __bf16 bf16x2_t __attribute__((ext_vector_type(2)));
__device__ __forceinline__ unsigned cvtpk(float lo, float hi) { const f32x2_t v = {lo, hi}; const bf16x2_t b = __builtin_convertvector(v, bf16x2_t); return __builtin_bit_cast(unsigned, b); }
template <int NK>
__device__ __forceinline__ void blk(f32x4& acc, const MM_LAS unsigned char* A, int apitch, const MM_LAS unsigned char* Bt, int bpitch, int lane) {
    const MM_LAS unsigned char* ap = A + (lane & 15) * apitch + (lane >> 4) * 16;
    const MM_LAS unsigned char* bp = Bt + (lane & 15) * bpitch + (lane >> 4) * 16;
#pragma unroll
    for (int ks = 0; ks < NK; ++ks) { const bf16x8 a = *(const MM_LAS bf16x8*)(ap + ks * 64), b = *(const MM_LAS bf16x8*)(bp + ks * 64); acc = __builtin_amdgcn_mfma_f32_16x16x32_bf16(a, b, acc, 0, 0, 0); }
}
__device__ __forceinline__ void store_T(const f32x4& acc, MM_LAS unsigned char* img, int pitch, int jbase, int ibase, int lane) {
    u32x2 w; w.x = cvtpk(acc[0], acc[1]); w.y = cvtpk(acc[2], acc[3]);
    *(MM_LAS u32x2*)(img + (jbase + (lane & 15)) * pitch + (ibase + 4 * (lane >> 4)) * 2) = w;
}
__device__ __forceinline__ float bfl(unsigned short v) { return __uint_as_float((unsigned)v << 16); }
__device__ __forceinline__ unsigned short f2b(float f) { return (unsigned short)(cvtpk(f, 0.f) & 0xffffu); }
}

namespace mlk {
constexpr int PQ = 272, PS = 144;
constexpr int O_QI = 0, O_KI = 17408, O_WKT = 34816, O_VT = 53248, O_CI = 73984, O_SI = 113152, O_TAB = 122368, LDS_END = 124416;
constexpr int HBP = 132;
}
__device__ __forceinline__ void mlstm_unit(unsigned char* lds_g, int b, int h, const bf16_t* QKC, const bf16_t* PROJ, const float* LI, const float* LF, const float* ng, bf16_t* MIXED) {
    using namespace mlk; using mm::f32x4; using mm::bf16x8;
    MM_LAS unsigned char* L = (MM_LAS unsigned char*)lds_g;
    int tid_o = threadIdx.x; asm volatile("" : "+v"(tid_o));
    const int tid = tid_o, lane = tid & 63, wave = __builtin_amdgcn_readfirstlane(tid >> 6);
    MM_LAS unsigned char *QI = L + O_QI, *KI = L + O_KI, *WKT = L + O_WKT, *VT = L + O_VT, *CI = L + O_CI, *SI = L + O_SI;
    MM_LAS float* TAB = (MM_LAS float*)(L + O_TAB);
    MM_LAS float* HB = (MM_LAS float*)L;
    for (int i = tid; i < 39168 / 4; i += 512) ((MM_LAS unsigned*)CI)[i] = 0u;
    for (int i = tid; i < 16 * PS / 4; i += 512) ((MM_LAS unsigned*)(VT + 128 * PS))[i] = (i < PS / 4) ? 0x3f803f80u : 0u;
    f32x4 cacc[9];
#pragma unroll
    for (int i = 0; i < 9; ++i) cacc[i] = (f32x4){0.f, 0.f, 0.f, 0.f};
    float m_run = 0.f;
    const int t = lane, cg = wave;
    const size_t mrow0 = (size_t)b * T;
    bf16x8 q0, q1, k0, k1, v0, v1; float li = 0.f, lf = 0.f;
#define ML_LOAD(c_) do { const size_t m_ = mrow0 + (size_t)(c_) * 64 + t; const bf16_t* qp = QKC + m_ * 1024 + h * 128 + 16 * cg; const bf16_t* vp = PROJ + m_ * NPROJ + PC_MLV + h * 128 + 16 * cg; \
        q0 = *(const bf16x8*)qp; q1 = *(const bf16x8*)(qp + 8); k0 = *(const bf16x8*)(qp + 512); k1 = *(const bf16x8*)(qp + 520); v0 = *(const bf16x8*)vp; v1 = *(const bf16x8*)(vp + 8); \
        if (wave == 0) { li = LI[m_ * 4 + h]; lf = LF[m_ * 4 + h]; } } while (0)
    ML_LOAD(0);
    const int et = tid >> 3, ep = tid & 7;
    f32x4 ngr[4];
#pragma unroll
    for (int i = 0; i < 4; ++i) ngr[i] = *(const f32x4*)(ng + 16 * ep + 4 * i);
    typedef unsigned u32x4_ __attribute__((ext_vector_type(4)));
    for (int c = 0; c < 64; ++c) {
        const size_t em_ = mrow0 + (size_t)c * 64 + et;
        const u32x4_ eo0 = *(const u32x4_*)(PROJ + em_ * NPROJ + PC_MLO + h * 128 + 16 * ep), eo1 = *(const u32x4_*)(PROJ + em_ * NPROJ + PC_MLO + h * 128 + 16 * ep + 8);
        const u32x4_ ez0 = *(const u32x4_*)(PROJ + em_ * NPROJ + PC_MLZ + h * 128 + 16 * ep), ez1 = *(const u32x4_*)(PROJ + em_ * NPROJ + PC_MLZ + h * 128 + 16 * ep + 8);
        if (wave == 0) {
            float bb = lf;
#pragma unroll
            for (int o = 1; o < 64; o <<= 1) { const float u = __shfl_up(bb, o); if (lane >= o) bb += u; }
            const float a = li - bb; float pm = a;
#pragma unroll
            for (int o = 1; o < 64; o <<= 1) { const float u = __shfl_up(pm, o); if (lane >= o) pm = fmaxf(pm, u); }
            const float mx = fmaxf(m_run, pm), mxL = __shfl(mx, 63), bL = __shfl(bb, 63);
            TAB[t] = a; TAB[64 + t] = mx; TAB[128 + t] = __expf(m_run - mx); TAB[192 + t] = __expf(-(bb + mx)); TAB[256 + t] = __expf(a - mxL);
            if (lane == 0) TAB[320] = __expf(m_run - mxL);
            m_run = bL + mxL;
        }
        __syncthreads();
        {
            *(MM_LAS bf16x8*)(QI + t * PQ + cg * 32) = q0; *(MM_LAS bf16x8*)(QI + t * PQ + cg * 32 + 16) = q1;
            *(MM_LAS bf16x8*)(KI + t * PQ + cg * 32) = k0; *(MM_LAS bf16x8*)(KI + t * PQ + cg * 32 + 16) = k1;
            const float wt = TAB[256 + t];
#pragma unroll
            for (int e = 0; e < 8; ++e) {
                *(MM_LAS unsigned short*)(WKT + (16 * cg + e) * PS + t * 2) = mm::f2b(wt * mm::bfl((unsigned short)k0[e]));
                *(MM_LAS unsigned short*)(WKT + (16 * cg + 8 + e) * PS + t * 2) = mm::f2b(wt * mm::bfl((unsigned short)k1[e]));
                *(MM_LAS unsigned short*)(VT + (16 * cg + e) * PS + t * 2) = (unsigned short)v0[e];
                *(MM_LAS unsigned short*)(VT + (16 * cg + 8 + e) * PS + t * 2) = (unsigned short)v1[e]; }
        }
        if (c + 1 < 64) ML_LOAD(c + 1);
        __syncthreads();
        {
            const int bi = wave >> 1;
#pragma unroll
            for (int jj = 0; jj < 2; ++jj) { const int bj = 2 * (wave & 1) + jj; f32x4 acc = (f32x4){0.f, 0.f, 0.f, 0.f};
                if (bi <= bj) { mm::blk<4>(acc, KI + bi * 16 * PQ, PQ, QI + bj * 16 * PQ, PQ, lane);
                    const int tt = 16 * bj + (lane & 15); const float mxt = TAB[64 + tt];
#pragma unroll
                    for (int r = 0; r < 4; ++r) { const int s = 16 * bi + 4 * (lane >> 4) + r; acc[r] = (s <= tt) ? acc[r] * __expf(TAB[s] - mxt) : 0.f; } }
                mm::store_T(acc, SI, PS, 16 * bj, 16 * bi, lane); }
        }
        __syncthreads();
        f32x4 res[5];
        {
#pragma unroll
            for (int n = 0; n < 5; ++n) { const int id = wave + 8 * n; res[n] = (f32x4){0.f, 0.f, 0.f, 0.f};
                if (id < 36) { const int vb = id >> 2, tb = id & 3; f32x4 ai = (f32x4){0.f, 0.f, 0.f, 0.f}, aa = (f32x4){0.f, 0.f, 0.f, 0.f};
                    mm::blk<4>(ai, QI + tb * 16 * PQ, PQ, CI + vb * 16 * PQ, PQ, lane);
                    mm::blk<2>(aa, SI + tb * 16 * PS, PS, VT + vb * 16 * PS, PS, lane);
#pragma unroll
                    for (int r = 0; r < 4; ++r) res[n][r] = TAB[128 + 16 * tb + 4 * (lane >> 4) + r] * ai[r] + aa[r]; } }
            const float decay = TAB[320];
#pragma unroll
            for (int vb = 0; vb < 9; ++vb) { cacc[vb] = cacc[vb] * decay; mm::blk<2>(cacc[vb], WKT + wave * 16 * PS, PS, VT + vb * 16 * PS, PS, lane); }
        }
        const float em_l = TAB[192 + 16 * (wave & 3) + 4 * (lane >> 4) + 0], em_1 = TAB[192 + 16 * (wave & 3) + 4 * (lane >> 4) + 1], em_2 = TAB[192 + 16 * (wave & 3) + 4 * (lane >> 4) + 2], em_3 = TAB[192 + 16 * (wave & 3) + 4 * (lane >> 4) + 3];
        __syncthreads();
        {
#pragma unroll
            for (int n = 0; n < 5; ++n) { const int id = wave + 8 * n;
                if (id < 36) { const int vb = id >> 2, tb = id & 3, j = lane & 15;
#pragma unroll
                    for (int r = 0; r < 4; ++r) { const int tt = 16 * tb + 4 * (lane >> 4) + r;
                        if (vb < 8 || j == 0) HB[tt * HBP + 16 * vb + j] = res[n][r];
                        else if (j == 1) HB[tt * HBP + 129] = (r == 0 ? em_l : r == 1 ? em_1 : r == 2 ? em_2 : em_3); } } }
#pragma unroll
            for (int vb = 0; vb < 9; ++vb) mm::store_T(cacc[vb], CI, PQ, 16 * vb, 16 * wave, lane);
        }
        __syncthreads();
        {
            const MM_LAS float* hr = HB + et * HBP; const float rdn = 1.f / fmaxf(fabsf(hr[128]), hr[129]);
            f32x4 hv[4]; float sm = 0.f;
#pragma unroll
            for (int i = 0; i < 4; ++i) { hv[i] = *(const MM_LAS f32x4*)(hr + 16 * ep + 4 * i) * rdn; sm += (hv[i][0] + hv[i][1]) + (hv[i][2] + hv[i][3]); }
            sm += __shfl_xor(sm, 1); sm += __shfl_xor(sm, 2); sm += __shfl_xor(sm, 4);
            const float mean = sm * (1.f / 128.f); float sq = 0.f;
#pragma unroll
            for (int i = 0; i < 4; ++i) { hv[i] = hv[i] - mean; sq += (hv[i][0] * hv[i][0] + hv[i][1] * hv[i][1]) + (hv[i][2] * hv[i][2] + hv[i][3] * hv[i][3]); }
            sq += __shfl_xor(sq, 1); sq += __shfl_xor(sq, 2); sq += __shfl_xor(sq, 4);
            const float rstd = 1.f / sqrtf(sq * (1.f / 128.f) + NORM_EPS);
            u32x4_ o0, o1;
#pragma unroll
            for (int i = 0; i < 4; ++i) { const unsigned go0 = (i < 2 ? eo0 : eo1)[(2 * i) & 3], go1 = (i < 2 ? eo0 : eo1)[(2 * i + 1) & 3], gz0 = (i < 2 ? ez0 : ez1)[(2 * i) & 3], gz1 = (i < 2 ? ez0 : ez1)[(2 * i + 1) & 3];
                const float g0 = siluf_(bf2f(gz0 & 0xffffu)) * sigmoidf_(bf2f(go0 & 0xffffu)), g1 = siluf_(bf2f(gz0 >> 16)) * sigmoidf_(bf2f(go0 >> 16));
                const float g2 = siluf_(bf2f(gz1 & 0xffffu)) * sigmoidf_(bf2f(go1 & 0xffffu)), g3 = siluf_(bf2f(gz1 >> 16)) * sigmoidf_(bf2f(go1 >> 16));
                const unsigned w0 = mm::cvtpk(g0 * hv[i][0] * rstd * ngr[i][0], g1 * hv[i][1] * rstd * ngr[i][1]), w1 = mm::cvtpk(g2 * hv[i][2] * rstd * ngr[i][2], g3 * hv[i][3] * rstd * ngr[i][3]);
                if (i < 2) { o0[2 * i] = w0; o0[2 * i + 1] = w1; } else { o1[2 * i - 4] = w0; o1[2 * i - 3] = w1; } }
            *(u32x4_*)(MIXED + em_ * DM + h * 128 + 16 * ep) = o0; *(u32x4_*)(MIXED + em_ * DM + h * 128 + 16 * ep + 8) = o1;
        }
    }
    __syncthreads();
#undef ML_LOAD
}
namespace rwk {
constexpr int PS = 144, SLOT = 9216;
constexpr int S_AT = 0, S_RT = 1, S_BTT = 2, S_KTT = 3, S_VTT = 4, S_AAK = 5, S_ARB = 6, S_ARK = 7, S_S0A = 8, S_S0B = 9, S_Z0 = 10, S_Z1 = 11, S_Z2 = 12, S_Z3 = 13, S_T0 = 14, S_T1 = 15;
constexpr int O_TAB = 16 * SLOT, O_PQ = O_TAB + 256, O_LN = O_PQ + 4096, LDS_END = O_LN + 512, YP = 68, FP = 68;
}
__device__ __forceinline__ void rwkv_unit(unsigned char* lds_g, int b, int h, const float* RWW, const bf16_t* RWB, size_t RWS, const float* BONUS, const bf16_t* PROJ, const float* ln_g, const float* ln_b, bf16_t* MIXED) {
    using namespace rwk; using mm::f32x4; using mm::bf16x8;
    MM_LAS unsigned char* L = (MM_LAS unsigned char*)lds_g;
    int tid_o = threadIdx.x; asm volatile("" : "+v"(tid_o));
    const int tid = tid_o, lane = tid & 63, wave = __builtin_amdgcn_readfirstlane(tid >> 6);
#define SL(n) (L + (n) * SLOT)
    MM_LAS float* WLT = (MM_LAS float*)(L + O_TAB); MM_LAS float* YB = (MM_LAS float*)SL(S_Z0); MM_LAS float* TF = (MM_LAS float*)SL(S_Z0); MM_LAS float* AF = (MM_LAS float*)SL(S_T0); MM_LAS float* PQ = (MM_LAS float*)(L + O_PQ);
    for (int i = tid; i < 2 * SLOT / 4; i += 512) ((MM_LAS unsigned*)SL(S_S0A))[i] = 0u;
    const int t = lane, cg = wave, bi = wave >> 1, bj0 = 2 * (wave & 1), lj = lane & 15, lq = lane >> 4;
    f32x4 sacc[2]; sacc[0] = (f32x4){0.f, 0.f, 0.f, 0.f}; sacc[1] = sacc[0];
    const size_t mrow0 = (size_t)b * T;
    bf16x8 gr, gk, gv, ga, gb; f32x4 gw0, gw1;
#define RW_LOAD(c_) do { const size_t o_ = (mrow0 + (size_t)(c_) * 64 + t) * 512 + h * 64 + 8 * cg; \
        gr = *(const bf16x8*)(RWB + o_); gk = *(const bf16x8*)(RWB + RWS + o_); gv = *(const bf16x8*)(RWB + 2 * RWS + o_); ga = *(const bf16x8*)(RWB + 3 * RWS + o_); gb = *(const bf16x8*)(RWB + 4 * RWS + o_); \
        gw0 = *(const f32x4*)(RWW + o_); gw1 = *(const f32x4*)(RWW + o_ + 4); } while (0)
    RW_LOAD(0);
    const int et = tid >> 3, ep = tid & 7;
    MM_LAS float* LNT = (MM_LAS float*)(L + O_LN);
    if (tid < 128) LNT[tid] = tid < 64 ? ln_g[tid] : ln_b[tid - 64];
    typedef unsigned u32x4e __attribute__((ext_vector_type(4)));
    for (int c = 0; c < 64; ++c) {
        const size_t em_ = mrow0 + (size_t)c * 64 + et;
        const u32x4e ez = *(const u32x4e*)(PROJ + em_ * NPROJ + PC_RWZ + h * 64 + 8 * ep), ev = *(const u32x4e*)(RWB + 2 * RWS + em_ * 512 + h * 64 + 8 * ep);
        const float ebon = BONUS[em_ * 8 + h];
        MM_LAS unsigned char* S0 = SL((c & 1) ? S_S0B : S_S0A); MM_LAS unsigned char* S0n = SL((c & 1) ? S_S0A : S_S0B);
        __syncthreads();
        {
            float lw[8], cw[8];
#pragma unroll
            for (int e = 0; e < 4; ++e) { lw[e] = gw0[e]; lw[4 + e] = gw1[e]; }
#pragma unroll
            for (int e = 0; e < 8; ++e) { float s = lw[e];
#pragma unroll
                for (int o = 1; o < 64; o <<= 1) { const float u = __shfl_up(s, o); if (lane >= o) s += u; }
                cw[e] = s; }
            float av[8], bv[8], kv[8], rv[8];
#pragma unroll
            for (int e = 0; e < 8; ++e) { const float Wt = __expf(cw[e]), Wp = __expf(cw[e] - lw[e]), iW = __expf(-cw[e]);
                av[e] = mm::bfl((unsigned short)ga[e]) * Wp; bv[e] = mm::bfl((unsigned short)gb[e]) * iW; kv[e] = mm::bfl((unsigned short)gk[e]) * iW; rv[e] = mm::bfl((unsigned short)gr[e]) * Wt;
                if (lane == 63) WLT[8 * cg + e] = Wt; }
            typedef unsigned u32x4_ __attribute__((ext_vector_type(4)));
            u32x4_ pa, pb, pk, pr;
            pa.x = mm::cvtpk(av[0], av[1]); pa.y = mm::cvtpk(av[2], av[3]); pa.z = mm::cvtpk(av[4], av[5]); pa.w = mm::cvtpk(av[6], av[7]);
            pb.x = mm::cvtpk(bv[0], bv[1]); pb.y = mm::cvtpk(bv[2], bv[3]); pb.z = mm::cvtpk(bv[4], bv[5]); pb.w = mm::cvtpk(bv[6], bv[7]);
            pk.x = mm::cvtpk(kv[0], kv[1]); pk.y = mm::cvtpk(kv[2], kv[3]); pk.z = mm::cvtpk(kv[4], kv[5]); pk.w = mm::cvtpk(kv[6], kv[7]);
            pr.x = mm::cvtpk(rv[0], rv[1]); pr.y = mm::cvtpk(rv[2], rv[3]); pr.z = mm::cvtpk(rv[4], rv[5]); pr.w = mm::cvtpk(rv[6], rv[7]);
            *(MM_LAS u32x4_*)(SL(S_AT) + t * PS + cg * 16) = pa; *(MM_LAS u32x4_*)(SL(S_RT) + t * PS + cg * 16) = pr;
            *(MM_LAS u32x4_*)(SL(S_Z0) + t * PS + cg * 16) = pb; *(MM_LAS u32x4_*)(SL(S_Z1) + t * PS + cg * 16) = pk;
#pragma unroll
            for (int e = 0; e < 8; ++e) { const unsigned wb = (e & 1) ? (pb[e >> 1] >> 16) : (pb[e >> 1] & 0xffffu), wk = (e & 1) ? (pk[e >> 1] >> 16) : (pk[e >> 1] & 0xffffu);
                *(MM_LAS unsigned short*)(SL(S_BTT) + (8 * cg + e) * PS + t * 2) = (unsigned short)wb;
                *(MM_LAS unsigned short*)(SL(S_KTT) + (8 * cg + e) * PS + t * 2) = (unsigned short)wk;
                *(MM_LAS unsigned short*)(SL(S_VTT) + (8 * cg + e) * PS + t * 2) = (unsigned short)gv[e]; }
        }
        if (c + 1 < 64) RW_LOAD(c + 1);
        __syncthreads();
        {
#pragma unroll
            for (int jj = 0; jj < 2; ++jj) { const int bj = bj0 + jj; const int tt = 16 * bj + lj, s0 = 16 * bi + 4 * lq;
                f32x4 ab = (f32x4){0.f, 0.f, 0.f, 0.f}, ak = ab, rb = ab, rk = ab;
                if (bi <= bj) {
                    mm::blk<2>(ab, SL(S_Z0) + bi * 16 * PS, PS, SL(S_AT) + bj * 16 * PS, PS, lane);
                    mm::blk<2>(ak, SL(S_Z1) + bi * 16 * PS, PS, SL(S_AT) + bj * 16 * PS, PS, lane);
                    mm::blk<2>(rb, SL(S_Z0) + bi * 16 * PS, PS, SL(S_RT) + bj * 16 * PS, PS, lane);
                    mm::blk<2>(rk, SL(S_Z1) + bi * 16 * PS, PS, SL(S_RT) + bj * 16 * PS, PS, lane);
#pragma unroll
                    for (int r = 0; r < 4; ++r) { const int s = s0 + r; if (!(s < tt)) { ab[r] = 0.f; ak[r] = 0.f; } if (!(s <= tt)) { rb[r] = 0.f; rk[r] = 0.f; } } }
                mm::store_T(ak, SL(S_AAK), PS, 16 * bj, 16 * bi, lane); mm::store_T(rb, SL(S_ARB), PS, 16 * bj, 16 * bi, lane); mm::store_T(rk, SL(S_ARK), PS, 16 * bj, 16 * bi, lane);
                *(MM_LAS f32x4*)(AF + tt * FP + s0) = ab; }
        }
        __syncthreads();
        if (wave < 4) { if (lane < 16) {
                float Tc[16]; const MM_LAS float* ar = AF + (16 * wave) * FP + 16 * wave;
#pragma unroll
                for (int r = 0; r < 16; ++r) { float acc = (r == lane) ? 1.f : 0.f;
#pragma unroll
                    for (int q4 = 0; q4 < (r + 3) / 4; ++q4) { const f32x4 a4 = *(const MM_LAS f32x4*)(ar + r * FP + 4 * q4);
#pragma unroll
                        for (int e = 0; e < 4; ++e) if (4 * q4 + e < r) acc += a4[e] * Tc[4 * q4 + e]; }
                    Tc[r] = acc; TF[(16 * wave + r) * FP + 16 * wave + lane] = acc; } } }
        else { const int z = (wave - 4) * 64 + lane, zb = z >> 7, zi = (z >> 4) & 7, zj = z & 15;
#pragma unroll
            for (int hh = 0; hh < 2; ++hh) TF[(32 * zb + zi + 8 * hh) * FP + 32 * zb + 16 + zj] = 0.f; }
        __syncthreads();
        {
            const int pr_ = tid >> 8, i = (tid >> 4) & 15, j = tid & 15, rb = 32 * pr_ + 16, cb = 32 * pr_; float acc = 0.f;
#pragma unroll
            for (int k4 = 0; k4 < 4; ++k4) { const f32x4 a4 = *(const MM_LAS f32x4*)(AF + (rb + i) * FP + cb + 4 * k4);
#pragma unroll
                for (int e = 0; e < 4; ++e) acc += a4[e] * TF[(cb + 4 * k4 + e) * FP + cb + j]; }
            PQ[pr_ * 256 + i * 16 + j] = acc; }
        __syncthreads();
        {
            const int pr_ = tid >> 8, i = (tid >> 4) & 15, j = tid & 15, rb = 32 * pr_ + 16, cb = 32 * pr_; float acc = 0.f;
#pragma unroll
            for (int k4 = 0; k4 < 4; ++k4) { const f32x4 a4 = *(const MM_LAS f32x4*)(TF + (rb + i) * FP + rb + 4 * k4);
#pragma unroll
                for (int e = 0; e < 4; ++e) acc += a4[e] * PQ[pr_ * 256 + (4 * k4 + e) * 16 + j]; }
            TF[(rb + i) * FP + cb + j] = acc; }
        __syncthreads();
        {
            const int i = tid >> 4, jq = tid & 15; float acc0 = 0.f, acc1 = 0.f;
#pragma unroll
            for (int k4 = 0; k4 < 8; ++k4) { const f32x4 a4 = *(const MM_LAS f32x4*)(AF + (32 + i) * FP + 4 * k4);
#pragma unroll
                for (int e = 0; e < 4; ++e) { acc0 += a4[e] * TF[(4 * k4 + e) * FP + jq]; acc1 += a4[e] * TF[(4 * k4 + e) * FP + 16 + jq]; } }
            PQ[i * 32 + jq] = acc0; PQ[i * 32 + 16 + jq] = acc1; }
        __syncthreads();
        {
            const int i = tid >> 4, jq = tid & 15; float acc0 = 0.f, acc1 = 0.f;
#pragma unroll
            for (int k4 = 0; k4 < 8; ++k4) { const f32x4 a4 = *(const MM_LAS f32x4*)(TF + (32 + i) * FP + 32 + 4 * k4);
#pragma unroll
                for (int e = 0; e < 4; ++e) { acc0 += a4[e] * PQ[(4 * k4 + e) * 32 + jq]; acc1 += a4[e] * PQ[(4 * k4 + e) * 32 + 16 + jq]; } }
            TF[(32 + i) * FP + jq] = acc0; TF[(32 + i) * FP + 16 + jq] = acc1; }
        __syncthreads();
        {
            const int tr = tid >> 3, s8 = (tid & 7) * 8; const f32x4 x0 = *(const MM_LAS f32x4*)(TF + tr * FP + s8), x1 = *(const MM_LAS f32x4*)(TF + tr * FP + s8 + 4);
            float y[8];
#pragma unroll
            for (int e = 0; e < 4; ++e) { y[e] = (s8 + e <= tr) ? x0[e] : 0.f; y[4 + e] = (s8 + 4 + e <= tr) ? x1[e] : 0.f; }
            typedef unsigned u32x4_ __attribute__((ext_vector_type(4))); u32x4_ w;
            w.x = mm::cvtpk(y[0], y[1]); w.y = mm::cvtpk(y[2], y[3]); w.z = mm::cvtpk(y[4], y[5]); w.w = mm::cvtpk(y[6], y[7]);
            *(MM_LAS u32x4_*)(SL(S_T0) + tr * PS + s8 * 2) = w; }
        {
#pragma unroll
            for (int jj = 0; jj < 2; ++jj) { const int bj = bj0 + jj; f32x4 d = (f32x4){0.f, 0.f, 0.f, 0.f};
                mm::blk<2>(d, SL(S_AT) + bi * 16 * PS, PS, S0 + bj * 16 * PS, PS, lane); mm::blk<2>(d, SL(S_AAK) + bi * 16 * PS, PS, SL(S_VTT) + bj * 16 * PS, PS, lane);
                mm::store_T(d, SL(S_Z2), PS, 16 * bj, 16 * bi, lane); }
        }
        __syncthreads();
        {
#pragma unroll
            for (int jj = 0; jj < 2; ++jj) { const int bj = bj0 + jj; f32x4 d = (f32x4){0.f, 0.f, 0.f, 0.f};
                mm::blk<2>(d, SL(S_T0) + bi * 16 * PS, PS, SL(S_Z2) + bj * 16 * PS, PS, lane);
                mm::store_T(d, SL(S_Z3), PS, 16 * bj, 16 * bi, lane); }
        }
        __syncthreads();
        {
#pragma unroll
            for (int jj = 0; jj < 2; ++jj) { const int bj = bj0 + jj; f32x4 d = (f32x4){0.f, 0.f, 0.f, 0.f};
                mm::blk<2>(d, SL(S_RT) + bi * 16 * PS, PS, S0 + bj * 16 * PS, PS, lane); mm::blk<2>(d, SL(S_ARB) + bi * 16 * PS, PS, SL(S_Z3) + bj * 16 * PS, PS, lane); mm::blk<2>(d, SL(S_ARK) + bi * 16 * PS, PS, SL(S_VTT) + bj * 16 * PS, PS, lane);
#pragma unroll
                for (int r = 0; r < 4; ++r) YB[(16 * bi + 4 * lq + r) * YP + 16 * bj + lj] = d[r];
                mm::blk<2>(sacc[jj], SL(S_BTT) + bi * 16 * PS, PS, SL(S_Z3) + bj * 16 * PS, PS, lane); mm::blk<2>(sacc[jj], SL(S_KTT) + bi * 16 * PS, PS, SL(S_VTT) + bj * 16 * PS, PS, lane);
#pragma unroll
                for (int r = 0; r < 4; ++r) sacc[jj][r] *= WLT[16 * bi + 4 * lq + r];
                mm::store_T(sacc[jj], S0n, PS, 16 * bj, 16 * bi, lane); }
        }
        __syncthreads();
        {
            f32x4 y0 = *(const MM_LAS f32x4*)(YB + et * YP + 8 * ep), y1 = *(const MM_LAS f32x4*)(YB + et * YP + 8 * ep + 4);
            float sm = ((y0[0] + y0[1]) + (y0[2] + y0[3])) + ((y1[0] + y1[1]) + (y1[2] + y1[3]));
            sm += __shfl_xor(sm, 1); sm += __shfl_xor(sm, 2); sm += __shfl_xor(sm, 4);
            const float mean = sm * (1.f / 64.f); y0 = y0 - mean; y1 = y1 - mean;
            float sq = ((y0[0] * y0[0] + y0[1] * y0[1]) + (y0[2] * y0[2] + y0[3] * y0[3])) + ((y1[0] * y1[0] + y1[1] * y1[1]) + (y1[2] * y1[2] + y1[3] * y1[3]));
            sq += __shfl_xor(sq, 1); sq += __shfl_xor(sq, 2); sq += __shfl_xor(sq, 4);
            const float rstd = 1.f / sqrtf(sq * (1.f / 64.f) + RW_GN_EPS);
            const f32x4 lg0 = *(const MM_LAS f32x4*)(LNT + 8 * ep), lg1 = *(const MM_LAS f32x4*)(LNT + 8 * ep + 4), lb0 = *(const MM_LAS f32x4*)(LNT + 64 + 8 * ep), lb1 = *(const MM_LAS f32x4*)(LNT + 64 + 8 * ep + 4);
            u32x4e o;
#pragma unroll
            for (int i = 0; i < 4; ++i) { const float ya = (i < 2 ? y0 : y1)[(2 * i) & 3], yb = (i < 2 ? y0 : y1)[(2 * i + 1) & 3], ga = (i < 2 ? lg0 : lg1)[(2 * i) & 3], gb_ = (i < 2 ? lg0 : lg1)[(2 * i + 1) & 3], ba = (i < 2 ? lb0 : lb1)[(2 * i) & 3], bb_ = (i < 2 ? lb0 : lb1)[(2 * i + 1) & 3];
                const float na = ya * rstd * ga + ba + ebon * bf2f(ev[i] & 0xffffu), nb = yb * rstd * gb_ + bb_ + ebon * bf2f(ev[i] >> 16);
                o[i] = mm::cvtpk(siluf_(bf2f(ez[i] & 0xffffu)) * na, siluf_(bf2f(ez[i] >> 16)) * nb); }
            *(u32x4e*)(MIXED + em_ * DM + 1536 + h * 64 + 8 * ep) = o;
        }
    }
    __syncthreads();
#undef SL
#undef RW_LOAD
}
constexpr size_t MiB = 1u << 20;
constexpr size_t WS_CTL = 0, CTL_ZERO_BYTES = 1 * MiB;
constexpr size_t WS_WIN = 1 * MiB;
constexpr size_t WS_WUQ = WS_WIN + 104 * MiB;
constexpr size_t WS_WUKV = WS_WUQ + 6 * MiB;
constexpr size_t WS_WOUT = WS_WUKV + 4 * MiB;
constexpr size_t WS_CS = WS_WOUT + 32 * MiB;
constexpr size_t WS_XN = WS_CS + 4 * MiB;
constexpr size_t WS_PROJ = WS_XN + 64 * MiB;
constexpr size_t WS_SPEC = WS_PROJ + 208 * MiB;
constexpr size_t WS_CQN = WS_SPEC + 16 * MiB;
constexpr size_t WS_CKVN = WS_CQN + 16 * MiB;
constexpr size_t WS_KR = WS_CKVN + 8 * MiB;
constexpr size_t WS_Q = WS_KR + 2 * MiB;
constexpr size_t WS_KV = WS_Q + 48 * MiB;
constexpr size_t WS_QKC = WS_KV + 64 * MiB;
constexpr size_t WS_GATE = WS_QKC + 32 * MiB;
constexpr size_t WS_RWW = WS_GATE + 1 * MiB;
constexpr size_t WS_RWB = WS_RWW + 32 * MiB;
constexpr size_t WS_VFIRST = WS_RWB + 80 * MiB;
constexpr size_t WS_BONUS = WS_VFIRST + 16 * MiB;
constexpr size_t WS_END = WS_BONUS + 1 * MiB;
constexpr int CW_BAR = 4096;
constexpr int LDS_BYTES = 163840, RING_BYTES = 158720, MISC_OFF = RING_BYTES + 320;
static_assert(att::LDS_BYTES <= RING_BYTES, "attention LDS");

struct Args { const float* in[28]; float* out; unsigned char* ws; int ph_lo, ph_hi; };

struct MapWin { __device__ __forceinline__ int operator()(int n) const {
    if (n < 1536) return n;
    if (n < 2048) return SC_MLO + (n - 1536);
    if (n < 2560) return SC_MLZ + (n - 2048);
    if (n < 3072) return SC_CQ + (n - 2560);
    if (n < 3328) return SC_CKV + (n - 3072);
    if (n < 4352) return SC_MLAZ + (n - 3328);
    if (n < 5888) return SC_RW + (n - 4352);
    if (n < 6144) { const int j = n - 5888;
        if (j < 128) return SC_RW + 1536 + j;
        if (j < 192) { const int q = j - 128; return SC_KR + ((q & 1) ? 32 + (q >> 1) : (q >> 1)); }
        if (j < 196) return SC_MLI + (j - 192);
        if (j < 200) return SC_MLF + (j - 196);
        return -1; }
    return SC_RWZ + (n - 6144); } };
struct MapUq { __device__ __forceinline__ int operator()(int n) const { const int h = n / 192, d = n % 192; if (d < 128) return n; const int q = d - 128; return h * 192 + 128 + ((q & 1) ? 32 + (q >> 1) : (q >> 1)); } };
struct MapId { __device__ __forceinline__ int operator()(int n) const { return n; } };

template <class Map>
__device__ __forceinline__ void transpose_item(const float* W, int K, int Nsrc, bf16_t* WT, const float* gain, LAS float* scr, int kb, int nb, int lane, Map map) {
    const int k0 = 64 * kb, n0 = 32 * nb, sc = map(n0 + (lane & 31));
#pragma unroll 8
    for (int i = 0; i < 32; ++i) { const int kk = 2 * i + (lane >> 5); float v = 0.f;
        if (sc >= 0) { v = W[(size_t)(k0 + kk) * Nsrc + sc]; if (gain) v *= gain[k0 + kk]; }
        scr[kk * 33 + (lane & 31)] = v; }
    LDS_WAIT(); asm volatile("" ::: "memory");
    const int c = lane & 7;
#pragma unroll
    for (int j = 0; j < 4; ++j) { const int n = (lane >> 3) + 8 * j; const LAS float* s = scr + (8 * c) * 33 + n;
        v4u o; o.x = pk2(s[0 * 33], s[1 * 33]); o.y = pk2(s[2 * 33], s[3 * 33]); o.z = pk2(s[4 * 33], s[5 * 33]); o.w = pk2(s[6 * 33], s[7 * 33]);
        *(v4u*)(WT + (size_t)(n0 + n) * K + k0 + 8 * c) = o; }
    LDS_WAIT(); asm volatile("" ::: "memory");
}

template <int MODE>
__device__ __forceinline__ void norm_row(const float* xrow, bf16_t* orow, float* frow, const float* g, int lane) {
    const f32x4* xr = (const f32x4*)xrow + lane;
    f32x4 v[8]; float s = 0.f;
#pragma unroll
    for (int j = 0; j < 8; ++j) { v[j] = xr[64 * j]; s += (v[j].x * v[j].x + v[j].y * v[j].y) + (v[j].z * v[j].z + v[j].w * v[j].w); }
    const float rstd = 1.f / sqrtf(wave_sum(s) * (1.f / DM) + NORM_EPS);
    if (MODE == 0) { unsigned long long* o8 = (unsigned long long*)orow + lane;
#pragma unroll
        for (int j = 0; j < 8; ++j) o8[64 * j] = (unsigned long long)pk2(v[j].x * rstd, v[j].y * rstd) | ((unsigned long long)pk2(v[j].z * rstd, v[j].w * rstd) << 32);
    } else { f32x4* o = (f32x4*)frow + lane; const f32x4* gr = (const f32x4*)g + lane;
#pragma unroll
        for (int j = 0; j < 8; ++j) { const f32x4 gg = gr[64 * j]; o[64 * j] = v[j] * rstd * gg; } }
}

__device__ __forceinline__ att::BlockRef mk_block(const bf16_t* Q, const bf16_t* KV, const bf16_t* KR, bf16_t* MIXED, const bf16_t* PROJ, const float* CS, int L_, int pass_) {
    const int bh = L_ >> 3, x = L_ & 7, qb = pass_ ? 15 - x : x, b = bh >> 3, h = bh & 7; att::BlockRef r;
    const size_t rb = (size_t)b * T, rq = rb + (size_t)qb * 256;
    r.Q = Q + rq * NQ + h * 192; r.K = KV + rb * NKV + h * 256; r.V = r.K + 128; r.KR = KR + rb * 64; r.O = MIXED + rq * DM + 512 + h * 128; r.Z = PROJ + rq * NPROJ + PC_MLAZ + h * 128; r.CSq = CS + rq * 64; r.P0 = qb * 256; return r;
}
#ifndef REP_PREP
#define REP_PREP 1
#endif
#ifndef REP_MIX
#define REP_MIX 1
#endif
#ifndef REP_RW
#define REP_RW 1
#endif
#ifndef REP_ML
#define REP_ML 1
#endif
__global__ void __launch_bounds__(512, 2) fwd(Args args) {
    extern __shared__ __attribute__((aligned(16))) unsigned char lds[];
    const int tid = threadIdx.x, lane = tid & 63, wave = __builtin_amdgcn_readfirstlane(tid >> 6);
    const int G = gridDim.x, bid = blockIdx.x;
    unsigned char* ws = args.ws;
    volatile LAS unsigned* MISC = (volatile LAS unsigned*)((LAS unsigned char*)lds + MISC_OFF);
    for (int u = tid; u < (LDS_BYTES - RING_BYTES) / 4; u += 512) ((LAS unsigned*)((LAS unsigned char*)lds + RING_BYTES))[u] = 0u;
    __syncthreads();
    const bool one_launch = (args.ph_hi - args.ph_lo) > 1;
    XcdBarrier bar; bar.bar = (unsigned*)(ws + WS_CTL) + CW_BAR; bar.x = 0; bar.st = nullptr;
    if (one_launch) bar = xcd_barrier_post((unsigned*)(ws + WS_CTL) + CW_BAR, MISC + 8);
    const int lo = args.ph_lo, hi = args.ph_hi;
#define IN(k) (lo <= (k) && (k) < hi)
#define SEAM(k) do { if (IN(k) && IN((k) + 1)) xcd_barrier(bar); } while (0)

    const float* x_in = args.in[0]; const int* positions = (const int*)args.in[1];
    float* X = args.out;
    bf16_t* WIN = (bf16_t*)(ws + WS_WIN); bf16_t* WUQ = (bf16_t*)(ws + WS_WUQ); bf16_t* WUKV = (bf16_t*)(ws + WS_WUKV); bf16_t* WOUT = (bf16_t*)(ws + WS_WOUT);
    float* CS = (float*)(ws + WS_CS); bf16_t* XN = (bf16_t*)(ws + WS_XN); bf16_t* MIXED = XN; bf16_t* PROJ = (bf16_t*)(ws + WS_PROJ); float* SPEC = (float*)(ws + WS_SPEC);
    bf16_t* CQN = (bf16_t*)(ws + WS_CQN); bf16_t* CKVN = (bf16_t*)(ws + WS_CKVN); bf16_t* KR = (bf16_t*)(ws + WS_KR); bf16_t* Q = (bf16_t*)(ws + WS_Q); bf16_t* KV = (bf16_t*)(ws + WS_KV);
    bf16_t* QKC = (bf16_t*)(ws + WS_QKC); float* LI = (float*)(ws + WS_GATE); float* LF = LI + (size_t)M * 4;
    float* RWW = (float*)(ws + WS_RWW); bf16_t* RWB = (bf16_t*)(ws + WS_RWB); bf16_t* VFIRST = (bf16_t*)(ws + WS_VFIRST); float* BONUS = (float*)(ws + WS_BONUS);
    constexpr size_t RWS = (size_t)M * 512;

    if (IN(0)) {
#ifndef NO_PRO
        LAS float* scr = (LAS float*)((LAS unsigned char*)lds + wave * 16384);
        const int gw = bid * 8 + wave, NGW = G * 8;
        constexpr int I_IN = (DM / 64) * (NPROJ / 32), I_UQ = (512 / 64) * (NQ / 32), I_UKV = (256 / 64) * (NKV / 32), I_OUT = (DM / 64) * (DM / 32), I_L = I_IN + I_UQ + I_UKV + I_OUT;
        for (int it = gw; it < DEPTH * I_L; it += NGW) {
            const int l = it / I_L; int r = it % I_L;
            if (r < I_IN) { transpose_item(args.in[3] + (size_t)l * DM * D_IN, DM, D_IN, WIN + (size_t)l * NPROJ * DM, args.in[2] + l * DM, scr, r / (NPROJ / 32), r % (NPROJ / 32), lane, MapWin()); continue; } r -= I_IN;
            if (r < I_UQ) { transpose_item(args.in[10] + (size_t)l * 512 * NQ, 512, NQ, WUQ + (size_t)l * NQ * 512, args.in[9] + l * 512, scr, r / (NQ / 32), r % (NQ / 32), lane, MapUq()); continue; } r -= I_UQ;
            if (r < I_UKV) { transpose_item(args.in[12] + (size_t)l * 256 * NKV, 256, NKV, WUKV + (size_t)l * NKV * 256, args.in[11] + l * 256, scr, r / (NKV / 32), r % (NKV / 32), lane, MapId()); continue; } r -= I_UKV;
            transpose_item(args.in[26] + (size_t)l * DM * DM, DM, DM, WOUT + (size_t)l * DM * DM, (const float*)nullptr, scr, r / (DM / 32), r % (DM / 32), lane, MapId());
        }
        for (int i = bid * 512 + tid; i < M * 32; i += G * 512) { const int m = i >> 5, j = i & 31;
            const float inv_freq = powf(10000.f, -(float)(2 * j) / 64.f);
            const float ang = (float)positions[m] * inv_freq;
            const double a = (double)ang; const double n = rint(a * 0.15915494309189535); const float r = (float)(a - n * 6.283185307179586);
            CS[2 * i] = cosf(r); CS[2 * i + 1] = sinf(r); }
        for (int m = gw; m < M; m += NGW) norm_row<0>(x_in + (size_t)m * DM, XN + (size_t)m * DM, nullptr, nullptr, lane);
#endif
    }
    SEAM(0);

#ifdef FIXL
    for (int l = 0; l < 1; ++l) {
#else
    for (int l = 0; l < DEPTH; ++l) {
#endif
        const int pb = 1 + l * 6;
        int tid_o = threadIdx.x; asm volatile("" : "+v"(tid_o));
        const int tid = tid_o, lane = tid & 63, wave = __builtin_amdgcn_readfirstlane(tid >> 6);
        if (IN(pb + 0)) {
#ifndef NO_G1
            pg8::Gemm g{XN, WIN + (size_t)l * NPROJ * DM, M, NPROJ, DM}; pg8::StaticOrder S; S.init(M, NPROJ, G, bid);
            pg8::EpiProj E{PROJ, NPROJ, SPEC, SPEC_TILE};
            pg8::gemm_phase<pg8::EpiProj, pg8::StaticOrder, true, true>((LAS unsigned char*)lds, g, S, E);
#endif
        }
        SEAM(pb + 0);
        if (IN(pb + 1)) {
#ifndef NO_PREP
            LAS float* L = (LAS float*)lds;
            LAS float* xw_t = L;
            LAS float* xa_s = L + 512;
            LAS float* t1 = L + 1024;
            LAS float* vbuf = L + 1280;
            const float* mu = args.in[13] + l * 1664; const float* w0 = args.in[14] + l * 512; const float* w2 = args.in[15] + (size_t)l * 64 * 512;
            const float* a0 = args.in[16] + l * 512; const float* a2 = args.in[17] + (size_t)l * 64 * 512;
            const float* v0 = args.in[18] + (l > 0 ? (l - 1) * 512 : 0); const float* v1 = args.in[19] + (size_t)(l > 0 ? l - 1 : 0) * 512 * 32; const float* v2 = args.in[20] + (size_t)(l > 0 ? l - 1 : 0) * 32 * 512;
            const float* k_k = args.in[21] + l * 512; const float* k_a = args.in[22] + l * 512; const float* r_k = args.in[23] + l * 512;
            const float* conv_w = args.in[4] + (size_t)l * 4 * 1024; const float* conv_b = args.in[5] + l * 1024;
            const float* i_bias = args.in[6] + l * 4; const float* f_bias = args.in[7] + l * 4;
            const int c = tid;
            for (int rep_ = 0; rep_ < REP_PREP; ++rep_)
            for (int g8 = bid; g8 < M / 8; g8 += G) {
                const int m0 = g8 * 8, t0 = m0 % T;
                float r_[8], k_[8], v_[8];
                { const float mur = mu[c], muk = mu[512 + c], muv = mu[1024 + c];
                  float pr = 0.f, pk = 0.f, pv = 0.f;
                  if (t0 > 0) { const bf16_t* pp = PROJ + (size_t)(m0 - 1) * NPROJ + PC_RW + c; pr = bf2f(pp[0]); pk = bf2f(pp[512]); pv = bf2f(pp[1024]); }
#pragma unroll
                  for (int i = 0; i < 8; ++i) { const bf16_t* pp = PROJ + (size_t)(m0 + i) * NPROJ + PC_RW + c; const float cr = bf2f(pp[0]), ck = bf2f(pp[512]), cv = bf2f(pp[1024]);
                      r_[i] = cr + mur * (pr - cr); k_[i] = ck + muk * (pk - ck); v_[i] = cv + muv * (pv - cv); pr = cr; pk = ck; pv = cv; } }
                if (tid < 128) { const int j = tid & 63, which = tid >> 6; const float mm = mu[1536 + which * 64 + j];
                    float pv = 0.f; if (t0 > 0) pv = SPEC[(size_t)(m0 - 1) * 256 + which * 64 + j];
                    for (int i = 0; i < 8; ++i) { const float cv = SPEC[(size_t)(m0 + i) * 256 + which * 64 + j]; const float xs = cv + mm * (pv - cv); pv = cv;
                        if (which == 0) xw_t[i * 64 + j] = tanhf(xs); else xa_s[i * 64 + j] = xs; } }
                if (l > 0) {
#pragma unroll
                    for (int i = 0; i < 8; ++i) vbuf[i * 512 + c] = v_[i]; }
                __syncthreads();
                float lw[8], la[8];
                { const float w0c = w0[c], a0c = a0[c];
#pragma unroll
                  for (int i = 0; i < 8; ++i) { lw[i] = w0c; la[i] = a0c; }
                  for (int j = 0; j < 64; ++j) { const float w2v = w2[j * 512 + c], a2v = a2[j * 512 + c];
#pragma unroll
                      for (int i = 0; i < 8; ++i) { lw[i] += xw_t[i * 64 + j] * w2v; la[i] += xa_s[i * 64 + j] * a2v; } } }
                if (l > 0) {
                    if (tid < 256) { const int i = tid >> 5, j = tid & 31; float s = 0.f;
                        for (int cc = 0; cc < 512; ++cc) s += vbuf[i * 512 + cc] * v1[cc * 32 + j];
                        t1[i * 32 + j] = s; }
                    __syncthreads();
                    float gsum[8]; const float v0c = v0[c];
#pragma unroll
                    for (int i = 0; i < 8; ++i) gsum[i] = v0c;
                    for (int j = 0; j < 32; ++j) { const float v2v = v2[j * 512 + c];
#pragma unroll
                        for (int i = 0; i < 8; ++i) gsum[i] += t1[i * 32 + j] * v2v; }
#pragma unroll
                    for (int i = 0; i < 8; ++i) { const float vf = bf2f(VFIRST[(size_t)(m0 + i) * 512 + c]); v_[i] = v_[i] + (vf - v_[i]) * sigmoidf_(gsum[i]); }
                } else {
#pragma unroll
                    for (int i = 0; i < 8; ++i) VFIRST[(size_t)(m0 + i) * 512 + c] = (bf16_t)f2bf(v_[i]);
                }
                { const float kkc = k_k[c], kac = k_a[c], rkc = r_k[c];
#pragma unroll
                  for (int i = 0; i < 8; ++i) { const size_t o = (size_t)(m0 + i) * 512 + c;
                      const float logw = -softplusf_(-lw[i]) - 0.5f; const float dec = -__expf(logw); const float a = sigmoidf_(la[i]);
                      float kk = k_[i] * kkc; const float ss = wave_sum(kk * kk); kk = kk / fmaxf(sqrtf(ss), 1e-12f);
                      const float kh = k_[i] * (1.f + (a - 1.f) * kac);
                      const float bon = wave_sum(r_[i] * kh * rkc);
                      RWW[o] = dec; RWB[o] = (bf16_t)f2bf(r_[i]); RWB[RWS + o] = (bf16_t)f2bf(kh); RWB[2 * RWS + o] = (bf16_t)f2bf(v_[i]); RWB[3 * RWS + o] = (bf16_t)f2bf(-kk); RWB[4 * RWS + o] = (bf16_t)f2bf(kk * a);
                      if (lane == 0) BONUS[(size_t)(m0 + i) * 8 + wave] = bon; } }
                { const int m = m0 + wave;
                  { const v4u raw = *(const v4u*)(PROJ + (size_t)m * NPROJ + PC_CQ + lane * 8); float f[8];
                    f[0] = bf2f(raw.x & 0xffffu); f[1] = bf2f(raw.x >> 16); f[2] = bf2f(raw.y & 0xffffu); f[3] = bf2f(raw.y >> 16); f[4] = bf2f(raw.z & 0xffffu); f[5] = bf2f(raw.z >> 16); f[6] = bf2f(raw.w & 0xffffu); f[7] = bf2f(raw.w >> 16);
                    float s = 0.f;
#pragma unroll
                    for (int e = 0; e < 8; ++e) s += f[e] * f[e];
                    const float rstd = 1.f / sqrtf(wave_sum(s) * (1.f / 512.f) + NORM_EPS);
                    v4u o; o.x = pk2(f[0] * rstd, f[1] * rstd); o.y = pk2(f[2] * rstd, f[3] * rstd); o.z = pk2(f[4] * rstd, f[5] * rstd); o.w = pk2(f[6] * rstd, f[7] * rstd);
                    *(v4u*)(CQN + (size_t)m * 512 + lane * 8) = o; }
                  { const unsigned long long raw = *(const unsigned long long*)(PROJ + (size_t)m * NPROJ + PC_CKV + lane * 4); float f[4];
                    f[0] = bf2f((unsigned)raw & 0xffffu); f[1] = bf2f(((unsigned)raw) >> 16); f[2] = bf2f((unsigned)(raw >> 32) & 0xffffu); f[3] = bf2f((unsigned)(raw >> 48));
                    const float s = f[0] * f[0] + f[1] * f[1] + f[2] * f[2] + f[3] * f[3];
                    const float rstd = 1.f / sqrtf(wave_sum(s) * (1.f / 256.f) + NORM_EPS);
                    *(unsigned long long*)(CKVN + (size_t)m * 256 + lane * 4) = (unsigned long long)pk2(f[0] * rstd, f[1] * rstd) | ((unsigned long long)pk2(f[2] * rstd, f[3] * rstd) << 32); }
                  { const float vv = SPEC[(size_t)m * 256 + 128 + lane]; const float pt = __shfl_xor(vv, 1); const int i = lane >> 1;
                    const float cs_ = CS[((size_t)m * 32 + i) * 2], sn_ = CS[((size_t)m * 32 + i) * 2 + 1];
                    const float o = (lane & 1) ? (vv * cs_ + pt * sn_) : (vv * cs_ - pt * sn_);
                    KR[(size_t)m * 64 + lane] = (bf16_t)f2bf(o); } }
#pragma unroll
                for (int hh = 0; hh < 2; ++hh) { const int ch = c + hh * 512;
                    const float cw0 = conv_w[ch], cw1 = conv_w[1024 + ch], cw2 = conv_w[2048 + ch], cw3 = conv_w[3072 + ch], cb = conv_b[ch];
                    float x0 = 0.f, x1 = 0.f, x2 = 0.f;
                    if (t0 >= 3) { x0 = bf2f(PROJ[(size_t)(m0 - 3) * NPROJ + PC_MLQK + ch]); x1 = bf2f(PROJ[(size_t)(m0 - 2) * NPROJ + PC_MLQK + ch]); x2 = bf2f(PROJ[(size_t)(m0 - 1) * NPROJ + PC_MLQK + ch]); }
                    const float sc_ = hh == 0 ? 0.08838834764831845f : 1.f;
#pragma unroll
                    for (int i = 0; i < 8; ++i) { const float x3 = bf2f(PROJ[(size_t)(m0 + i) * NPROJ + PC_MLQK + ch]);
                        const float y = cb + cw0 * x0 + cw1 * x1 + cw2 * x2 + cw3 * x3;
                        QKC[(size_t)(m0 + i) * 1024 + ch] = (bf16_t)f2bf(siluf_(y) * sc_);
                        x0 = x1; x1 = x2; x2 = x3; } }
                if (tid < 64) { const int i = tid >> 3, gh = tid & 7; const float val = SPEC[(size_t)(m0 + i) * 256 + 192 + gh];
                    if (gh < 4) LI[(size_t)(m0 + i) * 4 + gh] = val + i_bias[gh];
                    else { const float xx = val + f_bias[gh - 4]; LF[(size_t)(m0 + i) * 4 + gh - 4] = -softplusf_(-xx); } }
                __syncthreads();
            }
#endif
        }
        SEAM(pb + 1);
        if (IN(pb + 2)) {
#ifndef NO_G23
            { pg8::Gemm g{CQN, WUQ + (size_t)l * NQ * 512, M, NQ, 512}; pg8::StaticOrder S; S.init(M, NQ, G, bid);
              pg8::EpiPlain E{Q, NQ};
              pg8::gemm_phase<pg8::EpiPlain, pg8::StaticOrder, true, true>((LAS unsigned char*)lds, g, S, E); }
            { pg8::Gemm g{CKVN, WUKV + (size_t)l * NKV * 256, M, NKV, 256}; pg8::StaticOrder S; S.init(M, NKV, G, bid);
              pg8::EpiPlain E{KV, NKV};
              pg8::gemm_phase<pg8::EpiPlain, pg8::StaticOrder, true, true>((LAS unsigned char*)lds, g, S, E); }
#endif
        }
        SEAM(pb + 2);
        if (IN(pb + 3)) for (int rep_ = 0; rep_ < REP_MIX; ++rep_) {
#ifndef NO_SCANS
            if (bid < 32 && G >= 64) {
                for (int rr_ = 0; rr_ < REP_RW; ++rr_) rwkv_unit(lds, bid >> 3, bid & 7, RWW, RWB, RWS, BONUS, PROJ, args.in[24] + l * 512 + (bid & 7) * 64, args.in[25] + l * 512 + (bid & 7) * 64, MIXED);
            } else if (bid < 48 && G >= 64) {
                const int u = bid - 32;
                for (int rr_ = 0; rr_ < REP_ML; ++rr_) mlstm_unit(lds, u >> 2, u & 3, QKC, PROJ, LI, LF, args.in[8] + l * 512 + (u & 3) * 128, MIXED);
            } else
#endif
            {
#ifndef NO_ATT
                const int first = (G >= 64) ? bid - 48 : bid, stride = (G >= 64) ? G - 48 : G; constexpr int total = BATCH * 8 * 8;
                if (first < total) {
                    att::Seam S; int L = first, pass = 0;
#define mk(L_, pass_) mk_block(Q, KV, KR, MIXED, PROJ, CS, (L_), (pass_))
                    att::BlockRef cur = mk(L, 0);
                    att::attn_prime(cur, (char*)lds, S);
                    for (;;) {
                        const bool more_pass = pass == 0, more_item = L + stride < total, last = !more_pass && !more_item;
                        int Ln = L, passn = pass + 1; if (!more_pass) { passn = 0; Ln = more_item ? L + stride : L; }
                        const att::BlockRef nxt = last ? cur : mk(Ln, passn);
                        att::attn_block(cur, nxt, (char*)lds, S);
                        if (last) break;
                        cur = nxt; L = Ln; pass = passn;
                    }
#undef mk
                }
#endif
            }
        }
        SEAM(pb + 3);
        if (IN(pb + 4)) {
#ifndef NO_G4
            pg8::Gemm g{MIXED, WOUT + (size_t)l * DM * DM, M, DM, DM}; pg8::StaticOrder S; S.init(M, DM, G, bid);
            pg8::EpiResid E{l == 0 ? x_in : (const float*)X, X, DM};
            pg8::gemm_phase<pg8::EpiResid, pg8::StaticOrder, true, true>((LAS unsigned char*)lds, g, S, E);
#endif
        }
        SEAM(pb + 4);
        if (IN(pb + 5)) {
            const int gw = bid * 8 + wave, NGW = G * 8;
            if (l + 1 < DEPTH) { for (int m = gw; m < M; m += NGW) norm_row<0>(X + (size_t)m * DM, XN + (size_t)m * DM, nullptr, nullptr, lane); }
            else { for (int m = gw; m < M; m += NGW) norm_row<1>(X + (size_t)m * DM, nullptr, X + (size_t)m * DM, args.in[27], lane); }
        }
        SEAM(pb + 5);
    }
#undef IN
#undef SEAM
}

constexpr int N_PHASES = 1 + DEPTH * 6;
#ifndef MK_ONE_LAUNCH
#define MK_ONE_LAUNCH 1
#endif
extern "C" void kernel_launch(void* const* d_in, const int* in_sizes, int n_in, void* d_out, int out_size, void* d_ws, size_t ws_size, hipStream_t stream) {
    static int grid = 0;
    if (grid == 0) {
        if (n_in != 28 || out_size != M * DM || ws_size < WS_END) { fprintf(stderr, "kernel_launch: unexpected shapes (n_in %d, out %d, ws %zu < %zu)\n", n_in, out_size, ws_size, (size_t)WS_END); grid = -1; return; }
        int dev = 0, cus = 0;
        if (hipGetDevice(&dev) != hipSuccess || hipDeviceGetAttribute(&cus, hipDeviceAttributeMultiprocessorCount, dev) != hipSuccess) { grid = -1; return; }
        if (hipFuncSetAttribute((const void*)fwd, hipFuncAttributeMaxDynamicSharedMemorySize, LDS_BYTES) != hipSuccess) { fprintf(stderr, "kernel_launch: hipFuncSetAttribute failed\n"); grid = -1; return; }
        int per_cu = 0;
        if (hipOccupancyMaxActiveBlocksPerMultiprocessor(&per_cu, (const void*)fwd, 512, LDS_BYTES) != hipSuccess || per_cu < 1) fprintf(stderr, "kernel_launch: occupancy query says %d\n", per_cu);
        (void)hipGetLastError();
        grid = cus;
    }
    if (grid < 0) return;
    if (hipMemsetAsync((char*)d_ws + WS_CTL, 0, CTL_ZERO_BYTES, stream) != hipSuccess) return;
    Args a; memset(&a, 0, sizeof(a));
    for (int i = 0; i < 28; ++i) a.in[i] = (const float*)d_in[i];
    a.out = (float*)d_out; a.ws = (unsigned char*)d_ws;
#if MK_ONE_LAUNCH
    a.ph_lo = 0; a.ph_hi = N_PHASES;
    hipLaunchKernelGGL(fwd, dim3(grid), dim3(512), LDS_BYTES, stream, a);
#else
    for (int p = 0; p < N_PHASES; ++p) { a.ph_lo = p; a.ph_hi = p + 1; hipLaunchKernelGGL(fwd, dim3(grid), dim3(512), LDS_BYTES, stream, a); }
#endif
}
```

```cpp
#include <hip/hip_runtime.h>
#include <cstdio>
#include <cstdint>
#include <cstring>
namespace pg8 {
#define PG8_LAS __attribute__((address_space(3)))
typedef unsigned short bf16_t;
typedef short bf16x8 __attribute__((ext_vector_type(8)));
typedef float f32x4 __attribute__((ext_vector_type(4)));
typedef unsigned u32x4 __attribute__((ext_vector_type(4)));
constexpr int BM = 256, BK = 64, HALF = 128, HTB = HALF * BK * 2  , STAGE_BYTES = 8 * HTB, NXCD = 8, WGM = 8;

__host__ __device__ __forceinline__ int lds_byte(int r, int c) { const int st = (r >> 4) * 2 + (c >> 5), rr = r & 15, cc = c & 31, ob = rr * 64 + cc * 2; return st * 1024 + (ob ^ (((ob >> 9) & 1) << 5)); }
__host__ __device__ __forceinline__ void stage_rc(int b, int& R, int& C) { const int st = b / 1024, sb = b % 1024, swz = sb ^ (((sb >> 9) & 1) << 5); R = (st >> 1) * 16 + swz / 64; C = (st & 1) * 32 + (swz % 64) / 2; }
__host__ __device__ __forceinline__ int perm32(int rho) { const int n = rho >> 4, i = rho & 15; return 8 * (i >> 2) + 4 * n + (i & 3); }

struct Unit { int pm, pn; };
struct Gemm { const bf16_t* A; const bf16_t* Bt; int M, N, K; };

struct StaticOrder {
    int nM, nN, nwg, G, c;
    __host__ __device__ void init(int M, int N, int G_, int c_) { nM = M / BM; nN = N / BM; nwg = nM * nN; G = G_; c = c_; }
    __host__ __device__ bool next(int i, Unit& u) const {
        const long L = (long)i * G + c; if (L >= nwg) return false;
        int wgid = (int)L; { const int q = nwg / NXCD, r = nwg % NXCD, xcd = wgid % NXCD, off = wgid / NXCD; wgid = (xcd < r ? xcd * (q + 1) : r * (q + 1) + (xcd - r) * q) + off; }
        const int nig = WGM * nN, gid = wgid / nig, fm = gid * WGM, gsz = (nM - fm) < WGM ? (nM - fm) : WGM;
        u.pm = fm + ((wgid % nig) % gsz); u.pn = (wgid % nig) / gsz; return true;
    }
    __device__ __forceinline__ void a_ready(const Unit&) const {}
    __device__ __forceinline__ void done(const Unit&) const {}
};

__device__ __forceinline__ unsigned cvt_pk_bf16(float lo, float hi) { unsigned r; asm volatile("v_cvt_pk_bf16_f32 %0, %1, %2" : "=v"(r) : "v"(lo), "v"(hi)); return r; }
typedef float f32x2 __attribute__((ext_vector_type(2)));
typedef unsigned u32x2 __attribute__((ext_vector_type(2)));
struct EpiProj {
    static constexpr bool PERM = true, AFTER_DRAIN = false;
    bf16_t* O; int ldc; float* spec; int spec_tile;
    __device__ __forceinline__ void operator()(const f32x4 (&acc)[2][2][4][2], const Unit& u, int wr, int wc, int fr, int fq) const {
        const int row0 = u.pm * BM + wr * 64 + fr, col0 = u.pn * BM + wc * 32 + 8 * fq;
        if (u.pn == spec_tile) {
            float* sp0 = spec + (size_t)row0 * 256 + wc * 32 + 8 * fq;
#pragma unroll
            for (int ai = 0; ai < 2; ++ai)
#pragma unroll
                for (int m = 0; m < 4; ++m) { float* sp_p = sp0 + (size_t)(ai * HALF + m * 16) * 256;
#pragma unroll
                    for (int bj = 0; bj < 2; ++bj) { *(f32x4*)(sp_p + bj * HALF) = acc[ai][bj][m][0]; *(f32x4*)(sp_p + bj * HALF + 4) = acc[ai][bj][m][1]; } }
        }
        bf16_t* o0 = O + (size_t)row0 * ldc + col0;
#pragma unroll
        for (int ai = 0; ai < 2; ++ai)
#pragma unroll
            for (int m = 0; m < 4; ++m) { bf16_t* rowp = o0 + (size_t)(ai * HALF + m * 16) * ldc;
#pragma unroll
                for (int bj = 0; bj < 2; ++bj) { const f32x4 v0 = acc[ai][bj][m][0], v1 = acc[ai][bj][m][1];
                    u32x4 w; w.x = cvt_pk_bf16(v0[0], v0[1]); w.y = cvt_pk_bf16(v0[2], v0[3]); w.z = cvt_pk_bf16(v1[0], v1[1]); w.w = cvt_pk_bf16(v1[2], v1[3]);
                    *(u32x4*)(rowp + bj * HALF) = w; } }
    }
};
struct EpiQ {
    static constexpr bool PERM = true, AFTER_DRAIN = false;
    bf16_t* O; const float* cs;
    __device__ __forceinline__ void operator()(const f32x4 (&acc)[2][2][4][2], const Unit& u, int wr, int wc, int fr, int fq) const {
        const int row0 = u.pm * BM + wr * 64 + fr, col0 = u.pn * BM + wc * 32 + 8 * fq;
#pragma unroll
        for (int ai = 0; ai < 2; ++ai)
#pragma unroll
            for (int m = 0; m < 4; ++m) { const int row = row0 + ai * HALF + m * 16; bf16_t* rowp = O + (size_t)row * 1536 + col0;
#pragma unroll
                for (int bj = 0; bj < 2; ++bj) { f32x4 v0 = acc[ai][bj][m][0], v1 = acc[ai][bj][m][1];
                    const int d = (col0 + bj * HALF) % 192;
                    if (d >= 128) { const int i0 = (d - 128) >> 1; const f32x4* cp = (const f32x4*)(cs + (size_t)row * 64 + i0 * 2); const f32x4 c0 = cp[0], c1 = cp[1];
                        f32x4 r0, r1;
                        r0[0] = v0[0] * c0[0] - v0[1] * c0[1]; r0[1] = v0[1] * c0[0] + v0[0] * c0[1];
                        r0[2] = v0[2] * c0[2] - v0[3] * c0[3]; r0[3] = v0[3] * c0[2] + v0[2] * c0[3];
                        r1[0] = v1[0] * c1[0] - v1[1] * c1[1]; r1[1] = v1[1] * c1[0] + v1[0] * c1[1];
                        r1[2] = v1[2] * c1[2] - v1[3] * c1[3]; r1[3] = v1[3] * c1[2] + v1[2] * c1[3];
                        v0 = r0; v1 = r1; }
                    u32x4 w; w.x = cvt_pk_bf16(v0[0], v0[1]); w.y = cvt_pk_bf16(v0[2], v0[3]); w.z = cvt_pk_bf16(v1[0], v1[1]); w.w = cvt_pk_bf16(v1[2], v1[3]);
                    *(u32x4*)(rowp + bj * HALF) = w; } }
    }
};
struct EpiPlain {
    static constexpr bool PERM = true, AFTER_DRAIN = false;
    bf16_t* O; int ldc;
    __device__ __forceinline__ void operator()(const f32x4 (&acc)[2][2][4][2], const Unit& u, int wr, int wc, int fr, int fq) const {
        const int row0 = u.pm * BM + wr * 64 + fr, col0 = u.pn * BM + wc * 32 + 8 * fq;
#pragma unroll
        for (int ai = 0; ai < 2; ++ai)
#pragma unroll
            for (int m = 0; m < 4; ++m) { bf16_t* rowp = O + (size_t)(row0 + ai * HALF + m * 16) * ldc + col0;
#pragma unroll
                for (int bj = 0; bj < 2; ++bj) { const f32x4 v0 = acc[ai][bj][m][0], v1 = acc[ai][bj][m][1];
                    u32x4 w; w.x = cvt_pk_bf16(v0[0], v0[1]); w.y = cvt_pk_bf16(v0[2], v0[3]); w.z = cvt_pk_bf16(v1[0], v1[1]); w.w = cvt_pk_bf16(v1[2], v1[3]);
                    *(u32x4*)(rowp + bj * HALF) = w; } }
    }
};
struct EpiResid {
    static constexpr bool PERM = false, AFTER_DRAIN = false;
    const float* base; float* out; int ldc;
    __device__ __forceinline__ void operator()(const f32x4 (&acc)[2][2][4][2], const Unit& u, int wr, int wc, int fr, int fq) const {
        const int row0 = u.pm * BM + wr * 64 + fr, col0 = u.pn * BM + wc * 32 + 4 * fq;
#pragma unroll
        for (int ai = 0; ai < 2; ++ai)
#pragma unroll
            for (int m = 0; m < 4; ++m) { const size_t off = (size_t)(row0 + ai * HALF + m * 16) * ldc + col0;
#pragma unroll
                for (int bj = 0; bj < 2; ++bj)
#pragma unroll
                    for (int n = 0; n < 2; ++n) { const f32x4 bs = *(const f32x4*)(base + off + bj * HALF + n * 16); *(f32x4*)(out + off + bj * HALF + n * 16) = bs + acc[ai][bj][m][n]; } }
    }
};
template <class Epi, class Sched, bool ALIGN_EPI = false, bool SP2 = false>
__device__ __forceinline__ void gemm_phase(PG8_LAS unsigned char* lds, const Gemm g, const Sched& S, const Epi& E) {
    int tid_o = threadIdx.x; asm volatile("" : "+v"(tid_o));
    const int tid = tid_o, wid = __builtin_amdgcn_readfirstlane(tid >> 6), lane = tid & 63, wr = wid >> 2, wc = wid & 3, fr = lane & 15, fq = lane >> 4;
    const int K = g.K, nt = K / BK;
    unsigned voffA[2], voffB[2];
#pragma unroll
    for (int i = 0; i < 2; ++i) { int R, C; stage_rc(tid * 16 + i * 8192, R, C); const int Rb = Epi::PERM ? ((R & ~31) + perm32(R & 31)) : R;
        voffA[i] = (unsigned)(R * K + C) * 2u; voffB[i] = (unsigned)(Rb * K + C) * 2u; }
    const size_t kstep = (size_t)(BK * 2);
    const size_t hstep = (size_t)HALF * K * 2;
    const size_t tstep = 2 * hstep;
    const unsigned ldsw = (unsigned)wid * 1024u;
    const int aoff = lds_byte(wr * 64 + fr, fq * 8), boff = lds_byte(wc * 32 + fr, fq * 8);
#define PG8_SA(b, h) (((b) * 2 + (h)) * HTB)
#define PG8_SB(b, h) ((4 + (b) * 2 + (h)) * HTB)
#define PG8_STAGE(bufoff, gbase, voff) do { _Pragma("unroll") for (int _i = 0; _i < 2; ++_i) \
        __builtin_amdgcn_global_load_lds((const unsigned*)((const char*)(gbase) + (voff)[_i]), (PG8_LAS unsigned*)(lds + (bufoff) + ldsw + _i * 8192), 16, 0, 0); } while (0)
#define PG8_LDA(dst, b, h) do { _Pragma("unroll") for (int m = 0; m < 4; ++m) _Pragma("unroll") for (int k = 0; k < 2; ++k) dst[m][k] = *(const PG8_LAS bf16x8*)(lds + PG8_SA(b, h) + aoff + m * 2048 + k * 1024); } while (0)
#define PG8_LDB(dst, b, h) do { _Pragma("unroll") for (int n = 0; n < 2; ++n) _Pragma("unroll") for (int k = 0; k < 2; ++k) dst[n][k] = *(const PG8_LAS bf16x8*)(lds + PG8_SB(b, h) + boff + n * 2048 + k * 1024); } while (0)
#define PG8_MMA(ai, bj, At, Bt) do { __builtin_amdgcn_s_setprio(1); _Pragma("unroll") for (int m = 0; m < 4; ++m) _Pragma("unroll") for (int n = 0; n < 2; ++n) _Pragma("unroll") for (int k = 0; k < 2; ++k) \
        acc[ai][bj][m][n] = __builtin_amdgcn_mfma_f32_16x16x32_bf16(Bt[n][k], At[m][k], acc[ai][bj][m][n], 0, 0, 0); __builtin_amdgcn_s_setprio(0); } while (0)
#define PG8_WAIT_V(n) asm volatile("s_waitcnt vmcnt(" #n ")" ::: "memory")
#define PG8_WAIT_L(n) asm volatile("s_waitcnt lgkmcnt(" #n ")" ::: "memory")
#define PG8_BAR __builtin_amdgcn_s_barrier()
#define PG8_SCHED __builtin_amdgcn_sched_barrier(0)
    Unit cur, nxt; int ui = 0;
    if (!S.next(0, cur)) return;
    f32x4 acc[2][2][4][2];
#pragma unroll
    for (int a = 0; a < 2; ++a)
#pragma unroll
        for (int b = 0; b < 2; ++b)
#pragma unroll
            for (int m = 0; m < 4; ++m)
#pragma unroll
                for (int n = 0; n < 2; ++n) acc[a][b][m][n] = (f32x4){0.f, 0.f, 0.f, 0.f};
    bf16x8 At[4][2], B0[2][2], B1[2][2];
    const char* cA = (const char*)g.A + (size_t)cur.pm * tstep; const char* cB = (const char*)g.Bt + (size_t)cur.pn * tstep;
    S.a_ready(cur);
    if constexpr (SP2) {
        PG8_STAGE(PG8_SB(0, 0), cB, voffB); PG8_STAGE(PG8_SB(0, 1), cB + hstep, voffB); PG8_STAGE(PG8_SA(0, 0), cA, voffA); PG8_STAGE(PG8_SA(0, 1), cA + hstep, voffA);
        if (wr == 1) PG8_BAR;
        PG8_WAIT_V(2); PG8_BAR;
        PG8_STAGE(PG8_SB(1, 0), cB + kstep, voffB); PG8_STAGE(PG8_SA(1, 0), cA + kstep, voffA); PG8_STAGE(PG8_SB(1, 1), cB + hstep + kstep, voffB);
        PG8_WAIT_V(6); PG8_BAR;
    } else {
        PG8_STAGE(PG8_SB(0, 0), cB, voffB); PG8_STAGE(PG8_SA(0, 0), cA, voffA); PG8_STAGE(PG8_SB(0, 1), cB + hstep, voffB); PG8_STAGE(PG8_SA(0, 1), cA + hstep, voffA);
        if (wr == 1) PG8_BAR;
        PG8_WAIT_V(4); PG8_BAR;
        PG8_STAGE(PG8_SB(1, 0), cB + kstep, voffB); PG8_STAGE(PG8_SA(1, 0), cA + kstep, voffA); PG8_STAGE(PG8_SB(1, 1), cB + hstep + kstep, voffB);
        PG8_WAIT_V(6); PG8_BAR;
    }
    for (;;) {
        const bool has_next = S.next(ui + 1, nxt);
        const char* nA = has_next ? (const char*)g.A + (size_t)nxt.pm * tstep : cA; const char* nB = has_next ? (const char*)g.Bt + (size_t)nxt.pn * tstep : cB;
        for (int t = 0; t < nt; t += 2) {
            const bool last = (t == nt - 2);
            const char* a1 = cA + (size_t)(t + 1) * kstep;
            const char* a2 = last ? nA : cA + (size_t)(t + 2) * kstep; const char* b2 = last ? nB : cB + (size_t)(t + 2) * kstep;
            const char* a3 = a2 + kstep; const char* b3 = b2 + kstep;
            if (last && has_next) S.a_ready(nxt);
            if constexpr (SP2) {
            PG8_LDB(B0, 0, 0); PG8_LDB(B1, 0, 1); PG8_SCHED; PG8_LDA(At, 0, 0); PG8_STAGE(PG8_SA(1, 1), a1 + hstep, voffA);
            PG8_WAIT_V(8); PG8_WAIT_L(0); PG8_BAR; PG8_MMA(0, 0, At, B0); PG8_MMA(0, 1, At, B1); PG8_BAR; PG8_SCHED;
            PG8_LDA(At, 0, 1); PG8_STAGE(PG8_SB(0, 0), b2, voffB); PG8_STAGE(PG8_SB(0, 1), b2 + hstep, voffB); PG8_STAGE(PG8_SA(0, 0), a2, voffA);
            PG8_WAIT_V(8); PG8_WAIT_L(0); PG8_BAR; PG8_MMA(1, 0, At, B0); PG8_MMA(1, 1, At, B1); PG8_BAR; PG8_SCHED;
            PG8_LDB(B0, 1, 0); PG8_LDB(B1, 1, 1); PG8_SCHED; PG8_LDA(At, 1, 0); PG8_STAGE(PG8_SA(0, 1), a2 + hstep, voffA);
            PG8_WAIT_V(8); PG8_WAIT_L(0); PG8_BAR; PG8_MMA(0, 0, At, B0); PG8_MMA(0, 1, At, B1); PG8_BAR; PG8_SCHED;
            PG8_LDA(At, 1, 1); PG8_STAGE(PG8_SB(1, 0), b3, voffB); PG8_STAGE(PG8_SB(1, 1), b3 + hstep, voffB); PG8_STAGE(PG8_SA(1, 0), a3, voffA);
            PG8_WAIT_V(8); PG8_WAIT_L(0); PG8_BAR; PG8_MMA(1, 0, At, B0); PG8_MMA(1, 1, At, B1); PG8_BAR; PG8_SCHED;
            } else {
            PG8_LDB(B0, 0, 0); PG8_SCHED; PG8_LDA(At, 0, 0); PG8_STAGE(PG8_SA(1, 1), a1 + hstep, voffA);
            PG8_WAIT_L(8); PG8_BAR; PG8_WAIT_L(0); PG8_MMA(0, 0, At, B0); PG8_BAR; PG8_SCHED;
            PG8_LDB(B1, 0, 1); PG8_STAGE(PG8_SB(0, 0), b2, voffB);
            PG8_BAR; PG8_WAIT_L(0); PG8_MMA(0, 1, At, B1); PG8_BAR;
            PG8_LDA(At, 0, 1); PG8_STAGE(PG8_SA(0, 0), a2, voffA);
            PG8_BAR; PG8_WAIT_L(0); PG8_MMA(1, 0, At, B0); PG8_BAR; PG8_SCHED;
            PG8_STAGE(PG8_SB(0, 1), b2 + hstep, voffB);
            PG8_WAIT_V(6); PG8_BAR; PG8_MMA(1, 1, At, B1); PG8_BAR;
            PG8_LDB(B0, 1, 0); PG8_SCHED; PG8_LDA(At, 1, 0); PG8_STAGE(PG8_SA(0, 1), a2 + hstep, voffA);
            PG8_WAIT_L(8); PG8_BAR; PG8_WAIT_L(0); PG8_MMA(0, 0, At, B0); PG8_BAR; PG8_SCHED;
            PG8_LDB(B1, 1, 1); PG8_STAGE(PG8_SB(1, 0), b3, voffB);
            PG8_BAR; PG8_WAIT_L(0); PG8_MMA(0, 1, At, B1); PG8_BAR;
            PG8_LDA(At, 1, 1); PG8_STAGE(PG8_SA(1, 0), a3, voffA);
            PG8_BAR; PG8_WAIT_L(0); PG8_MMA(1, 0, At, B0); PG8_BAR; PG8_SCHED;
            PG8_STAGE(PG8_SB(1, 1), b3 + hstep, voffB);
            PG8_WAIT_V(6); PG8_BAR; PG8_MMA(1, 1, At, B1); PG8_BAR;
            }
        }
        if constexpr (ALIGN_EPI) { if (wr == 0) PG8_BAR; }
        if constexpr (!Epi::AFTER_DRAIN) { E(acc, cur, wr, wc, fr, fq); S.done(cur); }
        if (!has_next) break;
#pragma unroll
        for (int a = 0; a < 2; ++a)
#pragma unroll
            for (int b = 0; b < 2; ++b)
#pragma unroll
                for (int m = 0; m < 4; ++m)
#pragma unroll
                    for (int n = 0; n < 2; ++n) acc[a][b][m][n] = (f32x4){0.f, 0.f, 0.f, 0.f};
        cur = nxt; cA = nA; cB = nB; ++ui;
        if constexpr (ALIGN_EPI) { if (wr == 1) PG8_BAR; }
    }
    PG8_WAIT_V(0);
    if constexpr (!ALIGN_EPI) { if (wr == 0) PG8_BAR; }
    PG8_BAR;
    if constexpr (Epi::AFTER_DRAIN) { E.fused(acc, cur, wr, wc, fr, fq, lds, wid, lane); S.done(cur); }
#undef PG8_SA
#undef PG8_SB
#undef PG8_STAGE
#undef PG8_LDA
#undef PG8_LDB
#undef PG8_MMA
#undef PG8_WAIT_V
#undef PG8_WAIT_L
#undef PG8_BAR
#undef PG8_SCHED
}
}
#define GAS __attribute__((address_space(1)))
#define LAS __attribute__((address_space(3)))
typedef unsigned short bf16;
typedef unsigned v4u __attribute__((ext_vector_type(4)));
typedef float f32x4 __attribute__((ext_vector_type(4)));
typedef short bf16x8 __attribute__((ext_vector_type(8)));
typedef GAS unsigned gu32;
typedef GAS unsigned long long gu64;
#define RLX_AGENT __ATOMIC_RELAXED, __HIP_MEMORY_SCOPE_AGENT
#define LDS_WAIT() asm volatile("s_waitcnt lgkmcnt(0)" ::: "memory")
#define VM_WAIT() asm volatile("s_waitcnt vmcnt(0)" ::: "memory")
__device__ __forceinline__ unsigned long long rt() { return __builtin_amdgcn_s_memrealtime(); }
__device__ __forceinline__ unsigned f2bf(float f) { unsigned u = __builtin_bit_cast(unsigned, f); return (u + 0x7fffu + ((u >> 16) & 1u)) >> 16; }
__device__ __forceinline__ unsigned pk2(float lo, float hi) { return f2bf(lo) | (f2bf(hi) << 16); }

#define XB_TMO      128
#define XB_XCNT(j)  (256  + 64 * (j))
#define XB_XSUB(j)  (1280 + 64 * (j))
#define XB_XGEN(j)  (2304 + 64 * (j))
#define XB_TOP      3328
#define XB_TOPGEN   3392
#define XCD_BAR_WORDS 3456
#define XB_SPIN_CAP (1u << 18)

__device__ __forceinline__ unsigned xb_ld(unsigned* p)              { return __hip_atomic_load(p, __ATOMIC_RELAXED, __HIP_MEMORY_SCOPE_AGENT); }
__device__ __forceinline__ unsigned xb_add(unsigned* p, unsigned v) { return __hip_atomic_fetch_add(p, v, __ATOMIC_RELAXED, __HIP_MEMORY_SCOPE_AGENT); }
__device__ __forceinline__ unsigned xb_xcc_id() { return (unsigned)__builtin_amdgcn_s_getreg((3 << 11) | 20) & 0xFu; }
#define XB_SPIN(cond, bar) do { unsigned _sp = 0; while (cond) { __builtin_amdgcn_s_sleep(1); \
    if ((++_sp & 255u) == 0u) { if (xb_ld(&(bar)[XB_TMO])) break; if (_sp > XB_SPIN_CAP) { atomicAdd(&(bar)[XB_TMO], 1u); break; } } } } while (0)

struct XcdBarrier {
    unsigned* bar; unsigned x;
    volatile LAS unsigned* st;
};

__device__ __forceinline__ XcdBarrier xcd_barrier_post(unsigned* bar, volatile LAS unsigned* st) {
    XcdBarrier b; b.bar = bar; b.x = xb_xcc_id(); b.st = st;
    if (threadIdx.x == 0) (void)xb_add(&bar[XB_XCNT(b.x)], 1u);
    return b;
}
__device__ __forceinline__ void xcd_barrier_complete(unsigned* bar, unsigned x, unsigned& nloc, unsigned& nx) {
    const unsigned G = gridDim.x * gridDim.y * gridDim.z;
    unsigned sum, cnt, mine, sp = 0u;
    for (;;) {
        sum = 0u; cnt = 0u; mine = 0u;
#pragma unroll
        for (unsigned j = 0; j < 16; ++j) { const unsigned c = xb_ld(&bar[XB_XCNT(j)]); sum += c; cnt += (c > 0u) ? 1u : 0u; mine = (j == x) ? c : mine; }
        if (sum == G) break;
        __builtin_amdgcn_s_sleep(1);
        if ((++sp & 255u) == 0u) { if (xb_ld(&bar[XB_TMO])) break; if (sp > XB_SPIN_CAP) { atomicAdd(&bar[XB_TMO], 1u); break; } }
    }
    nloc = mine > 0u ? mine : 1u; nx = cnt > 0u ? cnt : 1u;
}

__device__ __forceinline__ void xcd_barrier(const XcdBarrier& b) {
    asm volatile("s_waitcnt vmcnt(0)" ::: "memory");
    __syncthreads();
    if (threadIdx.x == 0) {
        unsigned* bar = b.bar;
        __builtin_amdgcn_s_waitcnt(0);
        unsigned nloc = b.st[0], nx = b.st[1];
        if (nloc == 0u) { xcd_barrier_complete(bar, b.x, nloc, nx); b.st[0] = nloc; b.st[1] = nx; }
        const unsigned old = xb_add(&bar[XB_XSUB(b.x)], 1u);
        const unsigned gen = old / nloc;
        if (old + 1u == (gen + 1u) * nloc) {
            __builtin_amdgcn_fence(__ATOMIC_RELEASE, "agent");
            asm volatile("s_waitcnt vmcnt(0)" ::: "memory");
            const unsigned og = xb_add(&bar[XB_TOP], 1u);
            const unsigned tg = og / nx;
            if (og + 1u == (tg + 1u) * nx) xb_add(&bar[XB_TOPGEN], 1u);
            else XB_SPIN(xb_ld(&bar[XB_TOPGEN]) == tg, bar);
            __builtin_amdgcn_fence(__ATOMIC_ACQUIRE, "agent");
            xb_add(&bar[XB_XGEN(b.x)], 1u);
            asm volatile("s_waitcnt vmcnt(0)" ::: "memory");
        } else {
            XB_SPIN(xb_ld(&bar[XB_XGEN(b.x)]) == gen, bar);
            __builtin_amdgcn_fence(__ATOMIC_ACQUIRE, "agent");
            asm volatile("s_waitcnt vmcnt(0)" ::: "memory");
        }
    }
    __syncthreads();
}
constexpr int BATCH = 4, T = 4096, DM = 2048, DEPTH = 4, M = BATCH * T;
constexpr int D_IN = 6600, NPROJ = 6656;
constexpr int SC_MLQK = 0, SC_MLV = 1024, SC_MLI = 1536, SC_MLF = 1540, SC_MLO = 1544, SC_MLZ = 2056, SC_CQ = 2568, SC_CKV = 3080, SC_KR = 3336, SC_MLAZ = 3400, SC_RW = 4424, SC_RWZ = 6088;
constexpr int PC_MLQK = 0, PC_MLV = 1024, PC_MLO = 1536, PC_MLZ = 2048, PC_CQ = 2560, PC_CKV = 3072, PC_MLAZ = 3328, PC_RW = 4352, PC_SPEC = 5888, PC_RWZ = 6144;
constexpr int SPEC_TILE = PC_SPEC / 256;
constexpr int NQ = 1536, NKV = 2048;
constexpr float NORM_EPS = 1e-6f, RW_GN_EPS = 64e-5f;
typedef unsigned short bf16_t;
__device__ __forceinline__ float bf2f(unsigned v) { return __uint_as_float(v << 16); }
__device__ __forceinline__ float wave_sum(float v) {
#pragma unroll
    for (int o = 1; o < 64; o <<= 1) v += __shfl_xor(v, o);
    return v;
}
__device__ __forceinline__ float sigmoidf_(float x) { return 1.f / (1.f + __expf(-x)); }
__device__ __forceinline__ float siluf_(float x) { return x / (1.f + __expf(-x)); }
__device__ __forceinline__ float softplusf_(float x) { return fmaxf(x, 0.f) + log1pf(__expf(-fabsf(x))); }

namespace att {
typedef unsigned short bf16_t;
typedef short bf16x8 __attribute__((ext_vector_type(8)));
typedef short s16x4 __attribute__((ext_vector_type(4)));
typedef float f32x16 __attribute__((ext_vector_type(16)));
typedef float f32x4 __attribute__((ext_vector_type(4)));
typedef unsigned u32x4 __attribute__((ext_vector_type(4)));
constexpr int NW = 8, QBLK = 32, KVBLK = 64, QB = NW * QBLK;
constexpr int QP = 1536, KVP = 2048, KRP = 64, OP = 2048;
constexpr int SHM_V = KVBLK * 128 * 2, SHM_K = KVBLK * 128 * 2, SHM_R = KVBLK * 64 * 2;
constexpr int OFF_V = 0, OFF_K = 2 * SHM_V, OFF_R = OFF_K + SHM_K, OFF_WS = OFF_R + SHM_R, OFF_Q = OFF_WS + NW * 64 * 4, LDS_BYTES = OFF_Q + NW * 12288;
constexpr float SCALE = 0.07216878364870322f;
constexpr float THR = 8.f;
constexpr unsigned WBIG = 1u << 30;
#define KSWZ(row, colB) ((row) * 256 + ((colB) ^ (((row) & 7) << 4)))
#define RSWZ(row, colB) ((row) * 128 + ((colB) ^ (((row) & 7) << 4)))
#define SBAR() __builtin_amdgcn_sched_barrier(0)
__device__ __forceinline__ int v_st(int k, int c) { const int kk = (k & ~0xC) | ((k & 4) << 1) | ((k & 8) >> 1); return ((kk >> 3) * 4 + (c >> 5)) * 512 + ((kk & 7) * 32 + (c & 31)) * 2; }
__device__ __forceinline__ int v_rd_base(int lane) { return ((lane & 3) << 3) | (((lane >> 2) & 3) << 6) | (((lane >> 4) & 1) << 5) | (((lane >> 5) & 1) << 8); }
constexpr int v_rd_off(int d0, int ks, int half) { return d0 * 512 + ks * 4096 + half * 2048; }
__device__ __forceinline__ int crow(int r, int hi) { return (r & 3) + 8 * (r >> 2) + 4 * hi; }
__device__ __forceinline__ unsigned cvtpk(float lo, float hi) { unsigned r; asm volatile("v_cvt_pk_bf16_f32 %0, %1, %2" : "=v"(r) : "v"(lo), "v"(hi)); return r; }
__device__ __forceinline__ bf16x8 load8(const bf16_t* p) { return *reinterpret_cast<const bf16x8*>(p); }
__device__ __forceinline__ float bf2f(bf16_t v) { return __uint_as_float((unsigned)v << 16); }
__device__ __forceinline__ void mask_tile(f32x16& p0, f32x16& p1, int dq, unsigned W) {
    const float NEG = -__builtin_inff();
#pragma unroll
    for (int r = 0; r < 16; ++r) {
        const int c = (r & 3) + 8 * (r >> 2);
        if ((unsigned)(dq - c) >= W) p0[r] = NEG;
        if ((unsigned)(dq - c - 32) >= W) p1[r] = NEG;
    }
}
__device__ __forceinline__ void partialSM(f32x16& p0, f32x16& p1, float& m_reg, float& mn, float& alpha) {
    float pmax = p0[0]; for (int r = 1; r < 16; ++r) pmax = fmaxf(pmax, p0[r]); for (int r = 0; r < 16; ++r) pmax = fmaxf(pmax, p1[r]);
    { auto rr = __builtin_amdgcn_permlane32_swap(__float_as_uint(pmax), __float_as_uint(pmax), false, false);
      pmax = fmaxf(__uint_as_float(rr[0]), __uint_as_float(rr[1])); }
    constexpr float C2 = 1.4426950408889634f * SCALE;
    if (__builtin_expect(__all((pmax - m_reg) * SCALE <= THR), 1)) { mn = m_reg; alpha = 1.f; }
    else { mn = fmaxf(m_reg, pmax); alpha = __builtin_amdgcn_exp2f((m_reg - mn) * C2); m_reg = mn; }
    const float mnL = -mn * C2;
    for (int r = 0; r < 16; ++r) p0[r] = fmaf(p0[r], C2, mnL); for (int r = 0; r < 16; ++r) p1[r] = fmaf(p1[r], C2, mnL);
    for (int r = 0; r < 16; ++r) p0[r] = __builtin_amdgcn_exp2f(p0[r]);
}
__device__ __forceinline__ void finishSM(f32x16& p0, f32x16& p1, float alpha, float& l_reg, bf16x8& pa0, bf16x8& pa1, bf16x8& pa2, bf16x8& pa3) {
    for (int r = 0; r < 16; ++r) p1[r] = __builtin_amdgcn_exp2f(p1[r]);
    float ps = 0; for (int r = 0; r < 16; ++r) ps += p0[r]; for (int r = 0; r < 16; ++r) ps += p1[r];
    { auto rr = __builtin_amdgcn_permlane32_swap(__float_as_uint(ps), __float_as_uint(ps), false, false);
      ps = __uint_as_float(rr[0]) + __uint_as_float(rr[1]); }
    l_reg = l_reg * alpha + ps;
#define PK4(P, B_, OUT) do { unsigned a0 = cvtpk(P[B_+0], P[B_+1]), a1 = cvtpk(P[B_+2], P[B_+3]);                          \
        unsigned b0 = cvtpk(P[B_+4], P[B_+5]), b1 = cvtpk(P[B_+6], P[B_+7]);                                             \
        auto r0 = __builtin_amdgcn_permlane32_swap(a0, b0, false, false); auto r1 = __builtin_amdgcn_permlane32_swap(a1, b1, false, false); \
        u32x4 w = {r0[0], r1[0], r0[1], r1[1]}; OUT = *reinterpret_cast<bf16x8*>(&w); } while (0)
    PK4(p0, 0, pa0); PK4(p0, 8, pa1); PK4(p1, 0, pa2); PK4(p1, 8, pa3);
#undef PK4
}
__device__ __forceinline__ void qkt(f32x16& p0, f32x16& p1, const char* K_lds, const char* R_lds, const char* Qw, int r32, int hi) {
    p0 = f32x16{}; p1 = f32x16{};
    const char* kb[4]; const char* rb[4];
#pragma unroll
    for (int dd = 0; dd < 4; ++dd) { kb[dd] = K_lds + KSWZ(r32, (dd * 16 + hi * 8) * 2); rb[dd] = R_lds + RSWZ(r32, (dd * 16 + hi * 8) * 2); }
#pragma unroll
    for (int d0 = 0; d0 < 8; ++d0) { const char* a = kb[d0 & 3] + (d0 >> 2) * 128;
        bf16x8 b0 = *reinterpret_cast<const bf16x8*>(a);
        bf16x8 b1 = *reinterpret_cast<const bf16x8*>(a + 32 * 256);
        bf16x8 q = *reinterpret_cast<const bf16x8*>(Qw + d0 * 1024);
        p0 = __builtin_amdgcn_mfma_f32_32x32x16_bf16(b0, q, p0, 0, 0, 0);
        p1 = __builtin_amdgcn_mfma_f32_32x32x16_bf16(b1, q, p1, 0, 0, 0); }
#pragma unroll
    for (int e = 0; e < 4; ++e) { const char* a = rb[e];
        bf16x8 b0 = *reinterpret_cast<const bf16x8*>(a);
        bf16x8 b1 = *reinterpret_cast<const bf16x8*>(a + 32 * 128);
        bf16x8 q = *reinterpret_cast<const bf16x8*>(Qw + (8 + e) * 1024);
        p0 = __builtin_amdgcn_mfma_f32_32x32x16_bf16(b0, q, p0, 0, 0, 0);
        p1 = __builtin_amdgcn_mfma_f32_32x32x16_bf16(b1, q, p1, 0, 0, 0); }
}
template <int VB>
__device__ __forceinline__ void pv_tile(f32x16* o, int vb0, bf16x8 pa0, bf16x8 pa1, bf16x8 pa2, bf16x8 pa3) {
#define TRRD(dst, off) asm volatile("ds_read_b64_tr_b16 %0, %1 offset:%2" : "=&v"(dst) : "v"(vb0), "i"(off) : "memory")
#define PV_D0(d0) do { s16x4 l0, l1, l2, l3, h0, h1, h2, h3; constexpr int b_ = OFF_V + VB * SHM_V + v_rd_off(d0, 0, 0); \
        TRRD(l0, b_); TRRD(h0, b_ + 2048); TRRD(l1, b_ + 4096); TRRD(h1, b_ + 6144); TRRD(l2, b_ + 8192); TRRD(h2, b_ + 10240); TRRD(l3, b_ + 12288); TRRD(h3, b_ + 14336); \
        asm volatile("s_waitcnt lgkmcnt(0)" ::: "memory"); SBAR();   \
        o[d0] = __builtin_amdgcn_mfma_f32_32x32x16_bf16(pa0, (bf16x8){l0[0], l0[1], l0[2], l0[3], h0[0], h0[1], h0[2], h0[3]}, o[d0], 0, 0, 0);   \
        o[d0] = __builtin_amdgcn_mfma_f32_32x32x16_bf16(pa1, (bf16x8){l1[0], l1[1], l1[2], l1[3], h1[0], h1[1], h1[2], h1[3]}, o[d0], 0, 0, 0);   \
        o[d0] = __builtin_amdgcn_mfma_f32_32x32x16_bf16(pa2, (bf16x8){l2[0], l2[1], l2[2], l2[3], h2[0], h2[1], h2[2], h2[3]}, o[d0], 0, 0, 0);   \
        o[d0] = __builtin_amdgcn_mfma_f32_32x32x16_bf16(pa3, (bf16x8){l3[0], l3[1], l3[2], l3[3], h3[0], h3[1], h3[2], h3[3]}, o[d0], 0, 0, 0); } while (0)
    PV_D0(0); PV_D0(1); PV_D0(2); PV_D0(3);
#undef PV_D0
#undef TRRD
}
struct BlockRef { const bf16_t* Q; const bf16_t* K; const bf16_t* V; const bf16_t* KR; bf16_t* O; const bf16_t* Z; const float* CSq; int P0; };
struct Seam { bf16x8 qr[12]; bf16x8 st_v0, st_v1, st_k0, st_k1, st_r; };
#define ROWKV(p, k0, rr) ((p) + (size_t)((k0) + (rr)) * KVP + sc)
#define VMW() asm volatile("s_waitcnt vmcnt(0)" ::: "memory")
#define VMWN(n) asm volatile("s_waitcnt vmcnt(%0)" :: "i"(n) : "memory")
#define SLOAD_H(Kp, Vp, Rp, k0) do { S.st_v0 = load8(ROWKV(Vp, k0, sr)); S.st_v1 = load8(ROWKV(Vp, k0, 32 + sr));              \
                         S.st_k0 = load8(ROWKV(Kp, k0, sr)); S.st_k1 = load8(ROWKV(Kp, k0, 32 + sr)); S.st_r = load8((Rp) + (size_t)((k0) + rr_) * KRP + rc_); } while (0)
#define SWRITE_HK() do { *(bf16x8*)(K_lds + kws) = S.st_k0; *(bf16x8*)(K_lds + kws + 32 * 256) = S.st_k1; *(bf16x8*)(R_lds + rws) = S.st_r; } while (0)
#define SWRITE_HV(bf) do { *(bf16x8*)(V_lds + (bf) * SHM_V + vst0) = S.st_v0; *(bf16x8*)(V_lds + (bf) * SHM_V + vst1) = S.st_v1; } while (0)
#define SWRITE_H(bf) do { SWRITE_HV(bf); SWRITE_HK(); } while (0)
__device__ __forceinline__ void attn_prime(const BlockRef& cur, char* lds, Seam& S) {
    int tid_o = threadIdx.x; asm volatile("" : "+v"(tid_o));
    const int tid = tid_o, wid = __builtin_amdgcn_readfirstlane(tid >> 6), lane = tid & 63, r32 = lane & 31, hi = lane >> 5;
    const int sr = tid >> 4, sc = (tid & 15) * 8, kws = KSWZ(sr, sc * 2), rr_ = tid >> 3, rc_ = (tid & 7) * 8, rws = RSWZ(rr_, rc_ * 2);
    char* K_lds = lds + OFF_K; char* R_lds = lds + OFF_R;
#pragma unroll
    for (int d0 = 0; d0 < 12; ++d0) S.qr[d0] = load8(cur.Q + (size_t)(wid * QBLK + r32) * QP + d0 * 16 + hi * 8);
    SLOAD_H(cur.K, cur.V, cur.KR, 0); VMW(); SWRITE_HK();
    __syncthreads();
}
__device__ __forceinline__ void attn_block(const BlockRef& cur, const BlockRef& nxt, char* lds, Seam& S) {
    int tid_o = threadIdx.x; asm volatile("" : "+v"(tid_o));
    const int tid = tid_o, wid = __builtin_amdgcn_readfirstlane(tid >> 6), lane = tid & 63, r32 = lane & 31, hi = lane >> 5;
    const int NT = cur.P0 / KVBLK + 4;
    const int qlo = cur.P0 + wid * QBLK, qm = qlo + r32 - 4 * hi;
    char* V_lds = lds + OFF_V; char* K_lds = lds + OFF_K; char* R_lds = lds + OFF_R;
    float* ws = (float*)(lds + OFF_WS) + wid * 64; float* li_l = ws, * al_l = ws + 32;
    float m_reg = -1e30f, l_reg = 0; f32x16 o[4] = {};
    const int sr = tid >> 4, sc = (tid & 15) * 8, vst0 = v_st(sr, sc), vst1 = v_st(32 + sr, sc), kws = KSWZ(sr, sc * 2), rr_ = tid >> 3, rc_ = (tid & 7) * 8, rws = RSWZ(rr_, rc_ * 2);
    const int vb0 = (int)(uintptr_t)lds + v_rd_base(lane);
    char* Qw = lds + OFF_Q + wid * 12288 + lane * 16;
    const bf16_t* Kh = cur.K; const bf16_t* Vh = cur.V; const bf16_t* Rh = cur.KR;
#define RESC(a) do { if (__any((a) < 1.f)) { if (hi == 0) al_l[r32] = (a); asm volatile("s_waitcnt lgkmcnt(0)" ::: "memory");              \
                     for (int d_ = 0; d_ < 4; ++d_) for (int r = 0; r < 16; ++r) o[d_][r] *= al_l[crow(r, hi)]; } } while (0)
#define KBASE(t) ((t) * KVBLK)
#define MASKT(P0_, P1_, t) do { const int kb_ = KBASE(t); if (kb_ + KVBLK - 1 > qlo) mask_tile(P0_, P1_, qm - kb_, WBIG); } while (0)
    constexpr int NQL = 12;
#define SEAM_K0() do { VMWN(NQL); SWRITE_HK(); SBAR(); } while (0)
    f32x16 pA0, pA1, pB0, pB1; float mnA, mnB, alA, alB; bf16x8 pa0, pa1, pa2, pa3;
#pragma unroll
    for (int e = 0; e < 4; ++e) { const f32x4* cp = (const f32x4*)(cur.CSq + (size_t)(wid * QBLK + r32) * 64 + (e * 8 + hi * 4) * 2); const f32x4 c0 = cp[0], c1 = cp[1];
        const bf16x8 raw = S.qr[8 + e]; float x[8];
#pragma unroll
        for (int j = 0; j < 8; ++j) x[j] = __uint_as_float((unsigned)(unsigned short)raw[j] << 16);
        u32x4 w;
        w.x = cvtpk(x[0] * c0[0] - x[1] * c0[1], x[1] * c0[0] + x[0] * c0[1]); w.y = cvtpk(x[2] * c0[2] - x[3] * c0[3], x[3] * c0[2] + x[2] * c0[3]);
        w.z = cvtpk(x[4] * c1[0] - x[5] * c1[1], x[5] * c1[0] + x[4] * c1[1]); w.w = cvtpk(x[6] * c1[2] - x[7] * c1[3], x[7] * c1[2] + x[6] * c1[3]);
        S.qr[8 + e] = *reinterpret_cast<bf16x8*>(&w); }
#pragma unroll
    for (int d0 = 0; d0 < 12; ++d0) *(bf16x8*)(Qw + d0 * 1024) = S.qr[d0];
    SWRITE_HV(0); SBAR();
    SLOAD_H(Kh, Vh, Rh, KBASE(1));
    SBAR(); qkt(pA0, pA1, K_lds, R_lds, Qw, r32, hi);
    MASKT(pA0, pA1, 0); partialSM(pA0, pA1, m_reg, mnA, alA);
    __syncthreads();
    VMW(); SWRITE_H(1);
    __syncthreads();
#define HALF_STEP(PX0, PX1, mnX, alX, PY0, PY1, alY, t, VB, SB) do {                                                          \
        SBAR(); qkt(PX0, PX1, K_lds, R_lds, Qw, r32, hi);                                                                     \
        finishSM(PY0, PY1, alY, l_reg, pa0, pa1, pa2, pa3); SBAR();                                                           \
        if ((t) + 1 < NT) { SLOAD_H(Kh, Vh, Rh, KBASE((t) + 1)); SBAR(); }                                                    \
        pv_tile<VB>(o, vb0, pa0, pa1, pa2, pa3); MASKT(PX0, PX1, (t)); partialSM(PX0, PX1, m_reg, mnX, alX);                  \
        __syncthreads();                                                                                                      \
        if ((t) + 1 < NT) { VMW(); SWRITE_H(SB); }                                                                            \
        RESC(alX); __syncthreads(); } while (0)
    for (int t = 1; t + 1 < NT; t += 2) {
        HALF_STEP(pB0, pB1, mnB, alB, pA0, pA1, alA, t, 0, 0);
        HALF_STEP(pA0, pA1, mnA, alA, pB0, pB1, alB, t + 1, 1, 1);
    }
    SBAR(); qkt(pB0, pB1, K_lds, R_lds, Qw, r32, hi); SBAR();
    SLOAD_H(nxt.K, nxt.V, nxt.KR, 0); SBAR();
    finishSM(pA0, pA1, alA, l_reg, pa0, pa1, pa2, pa3); SBAR();
    pv_tile<0>(o, vb0, pa0, pa1, pa2, pa3);
    MASKT(pB0, pB1, NT - 1); partialSM(pB0, pB1, m_reg, mnB, alB); __syncthreads(); RESC(alB);
    finishSM(pB0, pB1, alB, l_reg, pa0, pa1, pa2, pa3); SBAR(); pv_tile<1>(o, vb0, pa0, pa1, pa2, pa3);
    SBAR();
#pragma unroll
    for (int d0 = 0; d0 < 12; ++d0) S.qr[d0] = load8(nxt.Q + (size_t)(wid * QBLK + r32) * QP + d0 * 16 + hi * 8);
    SBAR(); SEAM_K0();
    if (hi == 0) li_l[r32] = l_reg; asm volatile("s_waitcnt lgkmcnt(0)" ::: "memory");
    float rli[16];
#pragma unroll
    for (int r = 0; r < 16; ++r) rli[r] = __builtin_amdgcn_rcpf(li_l[crow(r, hi)]);
    bf16_t* Ow = cur.O + (size_t)(wid * QBLK) * OP; const bf16_t* Zw = cur.Z + (size_t)(wid * QBLK) * NPROJ;
#pragma unroll
    for (int r = 0; r < 16; ++r) { const int orow = crow(r, hi);
#pragma unroll
        for (int d0 = 0; d0 < 4; ++d0) { const float z = bf2f(Zw[(size_t)orow * NPROJ + d0 * 32 + r32]);
            const float v = o[d0][r] * rli[r] * (z / (1.f + __expf(-z)));
            const float vn = __shfl_xor(v, 1);
            if ((r32 & 1) == 0) *(unsigned*)(Ow + (size_t)orow * OP + d0 * 32 + r32) = cvtpk(v, vn); } }
    __syncthreads();
#undef RESC
#undef KBASE
#undef MASKT
#undef SEAM_K0
#undef HALF_STEP
}
#undef ROWKV
#undef VMW
#undef VMWN
#undef SLOAD_H
#undef SWRITE_HK
#undef SWRITE_HV
#undef SWRITE_H
#undef KSWZ
#undef RSWZ
#undef SBAR
}
namespace mm {
typedef short bf16x8 __attribute__((ext_vector_type(8)));
typedef float f32x4 __attribute__((ext_vector_type(4)));
typedef unsigned u32x2 __attribute__((ext_vector_type(2)));
#define MM_LAS __attribute__((address_space(3)))
typedef float f32x2_t __attribute__((ext_vector_type(2))); typedef __bf16 bf16x2_t __attribute__((ext_vector_type(2)));
__device__ __forceinline__ unsigned cvtpk(float lo, float hi) { const f32x2_t v = {lo, hi}; const bf16x2_t b = __builtin_convertvector(v, bf16x2_t); return __builtin_bit_cast(unsigned, b); }
template <int NK>
__device__ __forceinline__ void blk(f32x4& acc, const MM_LAS unsigned char* A, int apitch, const MM_LAS unsigned char* Bt, int bpitch, int lane) {
    const MM_LAS unsigned char* ap = A + (lane & 15) * apitch + (lane >> 4) * 16;
    const MM_LAS unsigned char* bp = Bt + (lane & 15) * bpitch + (lane >> 4) * 16;
#pragma unroll
    for (int ks = 0; ks < NK; ++ks) { const bf16x8 a = *(const MM_LAS bf16x8*)(ap + ks * 64), b = *(const MM_LAS bf16x8*)(bp + ks * 64); acc = __builtin_amdgcn_mfma_f32_16x16x32_bf16(a, b, acc, 0, 0, 0); }
}
__device__ __forceinline__ void store_T(const f32x4& acc, MM_LAS unsigned char* img, int pitch, int jbase, int ibase, int lane) {
    u32x2 w; w.x = cvtpk(acc[0], acc[1]); w.y = cvtpk(acc[2], acc[3]);
    *(MM_LAS u32x2*)(img + (jbase + (lane & 15)) * pitch + (ibase + 4 * (lane >> 4)) * 2) = w;
}
__device__ __forceinline__ float bfl(unsigned short v) { return __uint_as_float((unsigned)v << 16); }
__device__ __forceinline__ unsigned short f2b(float f) { return (unsigned short)(cvtpk(f, 0.f) & 0xffffu); }
}

namespace mlk {
constexpr int PQ = 272, PS = 144;
constexpr int O_QI = 0, O_KI = 17408, O_WKT = 34816, O_VT = 53248, O_CI = 73984, O_SI = 113152, O_TAB = 122368, LDS_END = 124416;
constexpr int HBP = 132;
}
__device__ __forceinline__ void mlstm_unit(unsigned char* lds_g, int b, int h, const bf16_t* QKC, const bf16_t* PROJ, const float* LI, const float* LF, const float* ng, bf16_t* MIXED) {
    using namespace mlk; using mm::f32x4; using mm::bf16x8;
    MM_LAS unsigned char* L = (MM_LAS unsigned char*)lds_g;
    int tid_o = threadIdx.x; asm volatile("" : "+v"(tid_o));
    const int tid = tid_o, lane = tid & 63, wave = __builtin_amdgcn_readfirstlane(tid >> 6);
    MM_LAS unsigned char *QI = L + O_QI, *KI = L + O_KI, *WKT = L + O_WKT, *VT = L + O_VT, *CI = L + O_CI, *SI = L + O_SI;
    MM_LAS float* TAB = (MM_LAS float*)(L + O_TAB);
    MM_LAS float* HB = (MM_LAS float*)L;
    for (int i = tid; i < 39168 / 4; i += 512) ((MM_LAS unsigned*)CI)[i] = 0u;
    for (int i = tid; i < 16 * PS / 4; i += 512) ((MM_LAS unsigned*)(VT + 128 * PS))[i] = (i < PS / 4) ? 0x3f803f80u : 0u;
    f32x4 cacc[9];
#pragma unroll
    for (int i = 0; i < 9; ++i) cacc[i] = (f32x4){0.f, 0.f, 0.f, 0.f};
    float m_run = 0.f;
    const int t = lane, cg = wave;
    const size_t mrow0 = (size_t)b * T;
    bf16x8 q0, q1, k0, k1, v0, v1; float li = 0.f, lf = 0.f;
#define ML_LOAD(c_) do { const size_t m_ = mrow0 + (size_t)(c_) * 64 + t; const bf16_t* qp = QKC + m_ * 1024 + h * 128 + 16 * cg; const bf16_t* vp = PROJ + m_ * NPROJ + PC_MLV + h * 128 + 16 * cg; \
        q0 = *(const bf16x8*)qp; q1 = *(const bf16x8*)(qp + 8); k0 = *(const bf16x8*)(qp + 512); k1 = *(const bf16x8*)(qp + 520); v0 = *(const bf16x8*)vp; v1 = *(const bf16x8*)(vp + 8); \
        if (wave == 0) { li = LI[m_ * 4 + h]; lf = LF[m_ * 4 + h]; } } while (0)
    ML_LOAD(0);
    const int et = tid >> 3, ep = tid & 7;
    f32x4 ngr[4];
#pragma unroll
    for (int i = 0; i < 4; ++i) ngr[i] = *(const f32x4*)(ng + 16 * ep + 4 * i);
    typedef unsigned u32x4_ __attribute__((ext_vector_type(4)));
    for (int c = 0; c < 64; ++c) {
        const size_t em_ = mrow0 + (size_t)c * 64 + et;
        const u32x4_ eo0 = *(const u32x4_*)(PROJ + em_ * NPROJ + PC_MLO + h * 128 + 16 * ep), eo1 = *(const u32x4_*)(PROJ + em_ * NPROJ + PC_MLO + h * 128 + 16 * ep + 8);
        const u32x4_ ez0 = *(const u32x4_*)(PROJ + em_ * NPROJ + PC_MLZ + h * 128 + 16 * ep), ez1 = *(const u32x4_*)(PROJ + em_ * NPROJ + PC_MLZ + h * 128 + 16 * ep + 8);
        if (wave == 0) {
            float bb = lf;
#pragma unroll
            for (int o = 1; o < 64; o <<= 1) { const float u = __shfl_up(bb, o); if (lane >= o) bb += u; }
            const float a = li - bb; float pm = a;
#pragma unroll
            for (int o = 1; o < 64; o <<= 1) { const float u = __shfl_up(pm, o); if (lane >= o) pm = fmaxf(pm, u); }
            const float mx = fmaxf(m_run, pm), mxL = __shfl(mx, 63), bL = __shfl(bb, 63);
            TAB[t] = a; TAB[64 + t] = mx; TAB[128 + t] = __expf(m_run - mx); TAB[192 + t] = __expf(-(bb + mx)); TAB[256 + t] = __expf(a - mxL);
            if (lane == 0) TAB[320] = __expf(m_run - mxL);
            m_run = bL + mxL;
        }
        __syncthreads();
        {
            *(MM_LAS bf16x8*)(QI + t * PQ + cg * 32) = q0; *(MM_LAS bf16x8*)(QI + t * PQ + cg * 32 + 16) = q1;
            *(MM_LAS bf16x8*)(KI + t * PQ + cg * 32) = k0; *(MM_LAS bf16x8*)(KI + t * PQ + cg * 32 + 16) = k1;
            const float wt = TAB[256 + t];
#pragma unroll
            for (int e = 0; e < 8; ++e) {
                *(MM_LAS unsigned short*)(WKT + (16 * cg + e) * PS + t * 2) = mm::f2b(wt * mm::bfl((unsigned short)k0[e]));
                *(MM_LAS unsigned short*)(WKT + (16 * cg + 8 + e) * PS + t * 2) = mm::f2b(wt * mm::bfl((unsigned short)k1[e]));
                *(MM_LAS unsigned short*)(VT + (16 * cg + e) * PS + t * 2) = (unsigned short)v0[e];
                *(MM_LAS unsigned short*)(VT + (16 * cg + 8 + e) * PS + t * 2) = (unsigned short)v1[e]; }
        }
        if (c + 1 < 64) ML_LOAD(c + 1);
        __syncthreads();
        {
            const int bi = wave >> 1;
#pragma unroll
            for (int jj = 0; jj < 2; ++jj) { const int bj = 2 * (wave & 1) + jj; f32x4 acc = (f32x4){0.f, 0.f, 0.f, 0.f};
                if (bi <= bj) { mm::blk<4>(acc, KI + bi * 16 * PQ, PQ, QI + bj * 16 * PQ, PQ, lane);
                    const int tt = 16 * bj + (lane & 15); const float mxt = TAB[64 + tt];
#pragma unroll
                    for (int r = 0; r < 4; ++r) { const int s = 16 * bi + 4 * (lane >> 4) + r; acc[r] = (s <= tt) ? acc[r] * __expf(TAB[s] - mxt) : 0.f; } }
                mm::store_T(acc, SI, PS, 16 * bj, 16 * bi, lane); }
        }
        __syncthreads();
        f32x4 res[5];
        {
#pragma unroll
            for (int n = 0; n < 5; ++n) { const int id = wave + 8 * n; res[n] = (f32x4){0.f, 0.f, 0.f, 0.f};
                if (id < 36) { const int vb = id >> 2, tb = id & 3; f32x4 ai = (f32x4){0.f, 0.f, 0.f, 0.f}, aa = (f32x4){0.f, 0.f, 0.f, 0.f};
                    mm::blk<4>(ai, QI + tb * 16 * PQ, PQ, CI + vb * 16 * PQ, PQ, lane);
                    mm::blk<2>(aa, SI + tb * 16 * PS, PS, VT + vb * 16 * PS, PS, lane);
#pragma unroll
                    for (int r = 0; r < 4; ++r) res[n][r] = TAB[128 + 16 * tb + 4 * (lane >> 4) + r] * ai[r] + aa[r]; } }
            const float decay = TAB[320];
#pragma unroll
            for (int vb = 0; vb < 9; ++vb) { cacc[vb] = cacc[vb] * decay; mm::blk<2>(cacc[vb], WKT + wave * 16 * PS, PS, VT + vb * 16 * PS, PS, lane); }
        }
        const float em_l = TAB[192 + 16 * (wave & 3) + 4 * (lane >> 4) + 0], em_1 = TAB[192 + 16 * (wave & 3) + 4 * (lane >> 4) + 1], em_2 = TAB[192 + 16 * (wave & 3) + 4 * (lane >> 4) + 2], em_3 = TAB[192 + 16 * (wave & 3) + 4 * (lane >> 4) + 3];
        __syncthreads();
        {
#pragma unroll
            for (int n = 0; n < 5; ++n) { const int id = wave + 8 * n;
                if (id < 36) { const int vb = id >> 2, tb = id & 3, j = lane & 15;
#pragma unroll
                    for (int r = 0; r < 4; ++r) { const int tt = 16 * tb + 4 * (lane >> 4) + r;
                        if (vb < 8 || j == 0) HB[tt * HBP + 16 * vb + j] = res[n][r];
                        else if (j == 1) HB[tt * HBP + 129] = (r == 0 ? em_l : r == 1 ? em_1 : r == 2 ? em_2 : em_3); } } }
#pragma unroll
            for (int vb = 0; vb < 9; ++vb) mm::store_T(cacc[vb], CI, PQ, 16 * vb, 16 * wave, lane);
        }
        __syncthreads();
        {
            const MM_LAS float* hr = HB + et * HBP; const float rdn = 1.f / fmaxf(fabsf(hr[128]), hr[129]);
            f32x4 hv[4]; float sm = 0.f;
#pragma unroll
            for (int i = 0; i < 4; ++i) { hv[i] = *(const MM_LAS f32x4*)(hr + 16 * ep + 4 * i) * rdn; sm += (hv[i][0] + hv[i][1]) + (hv[i][2] + hv[i][3]); }
            sm += __shfl_xor(sm, 1); sm += __shfl_xor(sm, 2); sm += __shfl_xor(sm, 4);
            const float mean = sm * (1.f / 128.f); float sq = 0.f;
#pragma unroll
            for (int i = 0; i < 4; ++i) { hv[i] = hv[i] - mean; sq += (hv[i][0] * hv[i][0] + hv[i][1] * hv[i][1]) + (hv[i][2] * hv[i][2] + hv[i][3] * hv[i][3]); }
            sq += __shfl_xor(sq, 1); sq += __shfl_xor(sq, 2); sq += __shfl_xor(sq, 4);
            const float rstd = 1.f / sqrtf(sq * (1.f / 128.f) + NORM_EPS);
            u32x4_ o0, o1;
#pragma unroll
            for (int i = 0; i < 4; ++i) { const unsigned go0 = (i < 2 ? eo0 : eo1)[(2 * i) & 3], go1 = (i < 2 ? eo0 : eo1)[(2 * i + 1) & 3], gz0 = (i < 2 ? ez0 : ez1)[(2 * i) & 3], gz1 = (i < 2 ? ez0 : ez1)[(2 * i + 1) & 3];
                const float g0 = siluf_(bf2f(gz0 & 0xffffu)) * sigmoidf_(bf2f(go0 & 0xffffu)), g1 = siluf_(bf2f(gz0 >> 16)) * sigmoidf_(bf2f(go0 >> 16));
                const float g2 = siluf_(bf2f(gz1 & 0xffffu)) * sigmoidf_(bf2f(go1 & 0xffffu)), g3 = siluf_(bf2f(gz1 >> 16)) * sigmoidf_(bf2f(go1 >> 16));
                const unsigned w0 = mm::cvtpk(g0 * hv[i][0] * rstd * ngr[i][0], g1 * hv[i][1] * rstd * ngr[i][1]), w1 = mm::cvtpk(g2 * hv[i][2] * rstd * ngr[i][2], g3 * hv[i][3] * rstd * ngr[i][3]);
                if (i < 2) { o0[2 * i] = w0; o0[2 * i + 1] = w1; } else { o1[2 * i - 4] = w0; o1[2 * i - 3] = w1; } }
            *(u32x4_*)(MIXED + em_ * DM + h * 128 + 16 * ep) = o0; *(u32x4_*)(MIXED + em_ * DM + h * 128 + 16 * ep + 8) = o1;
        }
    }
    __syncthreads();
#undef ML_LOAD
}
namespace rwk {
constexpr int PS = 144, SLOT = 9216;
constexpr int S_AT = 0, S_RT = 1, S_BTT = 2, S_KTT = 3, S_VTT = 4, S_AAK = 5, S_ARB = 6, S_ARK = 7, S_S0A = 8, S_S0B = 9, S_Z0 = 10, S_Z1 = 11, S_Z2 = 12, S_Z3 = 13, S_T0 = 14, S_T1 = 15;
constexpr int O_TAB = 16 * SLOT, O_PQ = O_TAB + 256, O_LN = O_PQ + 4096, LDS_END = O_LN + 512, YP = 68, FP = 68;
}
__device__ __forceinline__ void rwkv_unit(unsigned char* lds_g, int b, int h, const float* RWW, const bf16_t* RWB, size_t RWS, const float* BONUS, const bf16_t* PROJ, const float* ln_g, const float* ln_b, bf16_t* MIXED) {
    using namespace rwk; using mm::f32x4; using mm::bf16x8;
    MM_LAS unsigned char* L = (MM_LAS unsigned char*)lds_g;
    int tid_o = threadIdx.x; asm volatile("" : "+v"(tid_o));
    const int tid = tid_o, lane = tid & 63, wave = __builtin_amdgcn_readfirstlane(tid >> 6);
#define SL(n) (L + (n) * SLOT)
    MM_LAS float* WLT = (MM_LAS float*)(L + O_TAB); MM_LAS float* YB = (MM_LAS float*)SL(S_Z0); MM_LAS float* TF = (MM_LAS float*)SL(S_Z0); MM_LAS float* AF = (MM_LAS float*)SL(S_T0); MM_LAS float* PQ = (MM_LAS float*)(L + O_PQ);
    for (int i = tid; i < 2 * SLOT / 4; i += 512) ((MM_LAS unsigned*)SL(S_S0A))[i] = 0u;
    const int t = lane, cg = wave, bi = wave >> 1, bj0 = 2 * (wave & 1), lj = lane & 15, lq = lane >> 4;
    f32x4 sacc[2]; sacc[0] = (f32x4){0.f, 0.f, 0.f, 0.f}; sacc[1] = sacc[0];
    const size_t mrow0 = (size_t)b * T;
    bf16x8 gr, gk, gv, ga, gb; f32x4 gw0, gw1;
#define RW_LOAD(c_) do { const size_t o_ = (mrow0 + (size_t)(c_) * 64 + t) * 512 + h * 64 + 8 * cg; \
        gr = *(const bf16x8*)(RWB + o_); gk = *(const bf16x8*)(RWB + RWS + o_); gv = *(const bf16x8*)(RWB + 2 * RWS + o_); ga = *(const bf16x8*)(RWB + 3 * RWS + o_); gb = *(const bf16x8*)(RWB + 4 * RWS + o_); \
        gw0 = *(const f32x4*)(RWW + o_); gw1 = *(const f32x4*)(RWW + o_ + 4); } while (0)
    RW_LOAD(0);
    const int et = tid >> 3, ep = tid & 7;
    MM_LAS float* LNT = (MM_LAS float*)(L + O_LN);
    if (tid < 128) LNT[tid] = tid < 64 ? ln_g[tid] : ln_b[tid - 64];
    typedef unsigned u32x4e __attribute__((ext_vector_type(4)));
    for (int c = 0; c < 64; ++c) {
        const size_t em_ = mrow0 + (size_t)c * 64 + et;
        const u32x4e ez = *(const u32x4e*)(PROJ + em_ * NPROJ + PC_RWZ + h * 64 + 8 * ep), ev = *(const u32x4e*)(RWB + 2 * RWS + em_ * 512 + h * 64 + 8 * ep);
        const float ebon = BONUS[em_ * 8 + h];
        MM_LAS unsigned char* S0 = SL((c & 1) ? S_S0B : S_S0A); MM_LAS unsigned char* S0n = SL((c & 1) ? S_S0A : S_S0B);
        __syncthreads();
        {
            float lw[8], cw[8];
#pragma unroll
            for (int e = 0; e < 4; ++e) { lw[e] = gw0[e]; lw[4 + e] = gw1[e]; }
#pragma unroll
            for (int e = 0; e < 8; ++e) { float s = lw[e];
#pragma unroll
                for (int o = 1; o < 64; o <<= 1) { const float u = __shfl_up(s, o); if (lane >= o) s += u; }
                cw[e] = s; }
            float av[8], bv[8], kv[8], rv[8];
#pragma unroll
            for (int e = 0; e < 8; ++e) { const float Wt = __expf(cw[e]), Wp = __expf(cw[e] - lw[e]), iW = __expf(-cw[e]);
                av[e] = mm::bfl((unsigned short)ga[e]) * Wp; bv[e] = mm::bfl((unsigned short)gb[e]) * iW; kv[e] = mm::bfl((unsigned short)gk[e]) * iW; rv[e] = mm::bfl((unsigned short)gr[e]) * Wt;
                if (lane == 63) WLT[8 * cg + e] = Wt; }
            typedef unsigned u32x4_ __attribute__((ext_vector_type(4)));
            u32x4_ pa, pb, pk, pr;
            pa.x = mm::cvtpk(av[0], av[1]); pa.y = mm::cvtpk(av[2], av[3]); pa.z = mm::cvtpk(av[4], av[5]); pa.w = mm::cvtpk(av[6], av[7]);
            pb.x = mm::cvtpk(bv[0], bv[1]); pb.y = mm::cvtpk(bv[2], bv[3]); pb.z = mm::cvtpk(bv[4], bv[5]); pb.w = mm::cvtpk(bv[6], bv[7]);
            pk.x = mm::cvtpk(kv[0], kv[1]); pk.y = mm::cvtpk(kv[2], kv[3]); pk.z = mm::cvtpk(kv[4], kv[5]); pk.w = mm::cvtpk(kv[6], kv[7]);
            pr.x = mm::cvtpk(rv[0], rv[1]); pr.y = mm::cvtpk(rv[2], rv[3]); pr.z = mm::cvtpk(rv[4], rv[5]); pr.w = mm::cvtpk(rv[6], rv[7]);
            *(MM_LAS u32x4_*)(SL(S_AT) + t * PS + cg * 16) = pa; *(MM_LAS u32x4_*)(SL(S_RT) + t * PS + cg * 16) = pr;
            *(MM_LAS u32x4_*)(SL(S_Z0) + t * PS + cg * 16) = pb; *(MM_LAS u32x4_*)(SL(S_Z1) + t * PS + cg * 16) = pk;
#pragma unroll
            for (int e = 0; e < 8; ++e) { const unsigned wb = (e & 1) ? (pb[e >> 1] >> 16) : (pb[e >> 1] & 0xffffu), wk = (e & 1) ? (pk[e >> 1] >> 16) : (pk[e >> 1] & 0xffffu);
                *(MM_LAS unsigned short*)(SL(S_BTT) + (8 * cg + e) * PS + t * 2) = (unsigned short)wb;
                *(MM_LAS unsigned short*)(SL(S_KTT) + (8 * cg + e) * PS + t * 2) = (unsigned short)wk;
                *(MM_LAS unsigned short*)(SL(S_VTT) + (8 * cg + e) * PS + t * 2) = (unsigned short)gv[e]; }
        }
        if (c + 1 < 64) RW_LOAD(c + 1);
        __syncthreads();
        {
#pragma unroll
            for (int jj = 0; jj < 2; ++jj) { const int bj = bj0 + jj; const int tt = 16 * bj + lj, s0 = 16 * bi + 4 * lq;
                f32x4 ab = (f32x4){0.f, 0.f, 0.f, 0.f}, ak = ab, rb = ab, rk = ab;
                if (bi <= bj) {
                    mm::blk<2>(ab, SL(S_Z0) + bi * 16 * PS, PS, SL(S_AT) + bj * 16 * PS, PS, lane);
                    mm::blk<2>(ak, SL(S_Z1) + bi * 16 * PS, PS, SL(S_AT) + bj * 16 * PS, PS, lane);
                    mm::blk<2>(rb, SL(S_Z0) + bi * 16 * PS, PS, SL(S_RT) + bj * 16 * PS, PS, lane);
                    mm::blk<2>(rk, SL(S_Z1) + bi * 16 * PS, PS, SL(S_RT) + bj * 16 * PS, PS, lane);
#pragma unroll
                    for (int r = 0; r < 4; ++r) { const int s = s0 + r; if (!(s < tt)) { ab[r] = 0.f; ak[r] = 0.f; } if (!(s <= tt)) { rb[r] = 0.f; rk[r] = 0.f; } } }
                mm::store_T(ak, SL(S_AAK), PS, 16 * bj, 16 * bi, lane); mm::store_T(rb, SL(S_ARB), PS, 16 * bj, 16 * bi, lane); mm::store_T(rk, SL(S_ARK), PS, 16 * bj, 16 * bi, lane);
                *(MM_LAS f32x4*)(AF + tt * FP + s0) = ab; }
        }
        __syncthreads();
        if (wave < 4) { if (lane < 16) {
                float Tc[16]; const MM_LAS float* ar = AF + (16 * wave) * FP + 16 * wave;
#pragma unroll
                for (int r = 0; r < 16; ++r) { float acc = (r == lane) ? 1.f : 0.f;
#pragma unroll
                    for (int q4 = 0; q4 < (r + 3) / 4; ++q4) { const f32x4 a4 = *(const MM_LAS f32x4*)(ar + r * FP + 4 * q4);
#pragma unroll
                        for (int e = 0; e < 4; ++e) if (4 * q4 + e < r) acc += a4[e] * Tc[4 * q4 + e]; }
                    Tc[r] = acc; TF[(16 * wave + r) * FP + 16 * wave + lane] = acc; } } }
        else { const int z = (wave - 4) * 64 + lane, zb = z >> 7, zi = (z >> 4) & 7, zj = z & 15;
#pragma unroll
            for (int hh = 0; hh < 2; ++hh) TF[(32 * zb + zi + 8 * hh) * FP + 32 * zb + 16 + zj] = 0.f; }
        __syncthreads();
        {
            const int pr_ = tid >> 8, i = (tid >> 4) & 15, j = tid & 15, rb = 32 * pr_ + 16, cb = 32 * pr_; float acc = 0.f;
#pragma unroll
            for (int k4 = 0; k4 < 4; ++k4) { const f32x4 a4 = *(const MM_LAS f32x4*)(AF + (rb + i) * FP + cb + 4 * k4);
#pragma unroll
                for (int e = 0; e < 4; ++e) acc += a4[e] * TF[(cb + 4 * k4 + e) * FP + cb + j]; }
            PQ[pr_ * 256 + i * 16 + j] = acc; }
        __syncthreads();
        {
            const int pr_ = tid >> 8, i = (tid >> 4) & 15, j = tid & 15, rb = 32 * pr_ + 16, cb = 32 * pr_; float acc = 0.f;
#pragma unroll
            for (int k4 = 0; k4 < 4; ++k4) { const f32x4 a4 = *(const MM_LAS f32x4*)(TF + (rb + i) * FP + rb + 4 * k4);
#pragma unroll
                for (int e = 0; e < 4; ++e) acc += a4[e] * PQ[pr_ * 256 + (4 * k4 + e) * 16 + j]; }
            TF[(rb + i) * FP + cb + j] = acc; }
        __syncthreads();
        {
            const int i = tid >> 4, jq = tid & 15; float acc0 = 0.f, acc1 = 0.f;
#pragma unroll
            for (int k4 = 0; k4 < 8; ++k4) { const f32x4 a4 = *(const MM_LAS f32x4*)(AF + (32 + i) * FP + 4 * k4);
#pragma unroll
                for (int e = 0; e < 4; ++e) { acc0 += a4[e] * TF[(4 * k4 + e) * FP + jq]; acc1 += a4[e] * TF[(4 * k4 + e) * FP + 16 + jq]; } }
            PQ[i * 32 + jq] = acc0; PQ[i * 32 + 16 + jq] = acc1; }
        __syncthreads();
        {
            const int i = tid >> 4, jq = tid & 15; float acc0 = 0.f, acc1 = 0.f;
#pragma unroll
            for (int k4 = 0; k4 < 8; ++k4) { const f32x4 a4 = *(const MM_LAS f32x4*)(TF + (32 + i) * FP + 32 + 4 * k4);
#pragma unroll
                for (int e = 0; e < 4; ++e) { acc0 += a4[e] * PQ[(4 * k4 + e) * 32 + jq]; acc1 += a4[e] * PQ[(4 * k4 + e) * 32 + 16 + jq]; } }
            TF[(32 + i) * FP + jq] = acc0; TF[(32 + i) * FP + 16 + jq] = acc1; }
        __syncthreads();
        {
            const int tr = tid >> 3, s8 = (tid & 7) * 8; const f32x4 x0 = *(const MM_LAS f32x4*)(TF + tr * FP + s8), x1 = *(const MM_LAS f32x4*)(TF + tr * FP + s8 + 4);
            float y[8];
#pragma unroll
            for (int e = 0; e < 4; ++e) { y[e] = (s8 + e <= tr) ? x0[e] : 0.f; y[4 + e] = (s8 + 4 + e <= tr) ? x1[e] : 0.f; }
            typedef unsigned u32x4_ __attribute__((ext_vector_type(4))); u32x4_ w;
            w.x = mm::cvtpk(y[0], y[1]); w.y = mm::cvtpk(y[2], y[3]); w.z = mm::cvtpk(y[4], y[5]); w.w = mm::cvtpk(y[6], y[7]);
            *(MM_LAS u32x4_*)(SL(S_T0) + tr * PS + s8 * 2) = w; }
        {
#pragma unroll
            for (int jj = 0; jj < 2; ++jj) { const int bj = bj0 + jj; f32x4 d = (f32x4){0.f, 0.f, 0.f, 0.f};
                mm::blk<2>(d, SL(S_AT) + bi * 16 * PS, PS, S0 + bj * 16 * PS, PS, lane); mm::blk<2>(d, SL(S_AAK) + bi * 16 * PS, PS, SL(S_VTT) + bj * 16 * PS, PS, lane);
                mm::store_T(d, SL(S_Z2), PS, 16 * bj, 16 * bi, lane); }
        }
        __syncthreads();
        {
#pragma unroll
            for (int jj = 0; jj < 2; ++jj) { const int bj = bj0 + jj; f32x4 d = (f32x4){0.f, 0.f, 0.f, 0.f};
                mm::blk<2>(d, SL(S_T0) + bi * 16 * PS, PS, SL(S_Z2) + bj * 16 * PS, PS, lane);
                mm::store_T(d, SL(S_Z3), PS, 16 * bj, 16 * bi, lane); }
        }
        __syncthreads();
        {
#pragma unroll
            for (int jj = 0; jj < 2; ++jj) { const int bj = bj0 + jj; f32x4 d = (f32x4){0.f, 0.f, 0.f, 0.f};
                mm::blk<2>(d, SL(S_RT) + bi * 16 * PS, PS, S0 + bj * 16 * PS, PS, lane); mm::blk<2>(d, SL(S_ARB) + bi * 16 * PS, PS, SL(S_Z3) + bj * 16 * PS, PS, lane); mm::blk<2>(d, SL(S_ARK) + bi * 16 * PS, PS, SL(S_VTT) + bj * 16 * PS, PS, lane);
#pragma unroll
                for (int r = 0; r < 4; ++r) YB[(16 * bi + 4 * lq + r) * YP + 16 * bj + lj] = d[r];
                mm::blk<2>(sacc[jj], SL(S_BTT) + bi * 16 * PS, PS, SL(S_Z3) + bj * 16 * PS, PS, lane); mm::blk<2>(sacc[jj], SL(S_KTT) + bi * 16 * PS, PS, SL(S_VTT) + bj * 16 * PS, PS, lane);
#pragma unroll
                for (int r = 0; r < 4; ++r) sacc[jj][r] *= WLT[16 * bi + 4 * lq + r];
                mm::store_T(sacc[jj], S0n, PS, 16 * bj, 16 * bi, lane); }
        }
        __syncthreads();
        {
            f32x4 y0 = *(const MM_LAS f32x4*)(YB + et * YP + 8 * ep), y1 = *(const MM_LAS f32x4*)(YB + et * YP + 8 * ep + 4);
            float sm = ((y0[0] + y0[1]) + (y0[2] + y0[3])) + ((y1[0] + y1[1]) + (y1[2] + y1[3]));
            sm += __shfl_xor(sm, 1); sm += __shfl_xor(sm, 2); sm += __shfl_xor(sm, 4);
            const float mean = sm * (1.f / 64.f); y0 = y0 - mean; y1 = y1 - mean;
            float sq = ((y0[0] * y0[0] + y0[1] * y0[1]) + (y0[2] * y0[2] + y0[3] * y0[3])) + ((y1[0] * y1[0] + y1[1] * y1[1]) + (y1[2] * y1[2] + y1[3] * y1[3]));
            sq += __shfl_xor(sq, 1); sq += __shfl_xor(sq, 2); sq += __shfl_xor(sq, 4);
            const float rstd = 1.f / sqrtf(sq * (1.f / 64.f) + RW_GN_EPS);
            const f32x4 lg0 = *(const MM_LAS f32x4*)(LNT + 8 * ep), lg1 = *(const MM_LAS f32x4*)(LNT + 8 * ep + 4), lb0 = *(const MM_LAS f32x4*)(LNT + 64 + 8 * ep), lb1 = *(const MM_LAS f32x4*)(LNT + 64 + 8 * ep + 4);
            u32x4e o;
#pragma unroll
            for (int i = 0; i < 4; ++i) { const float ya = (i < 2 ? y0 : y1)[(2 * i) & 3], yb = (i < 2 ? y0 : y1)[(2 * i + 1) & 3], ga = (i < 2 ? lg0 : lg1)[(2 * i) & 3], gb_ = (i < 2 ? lg0 : lg1)[(2 * i + 1) & 3], ba = (i < 2 ? lb0 : lb1)[(2 * i) & 3], bb_ = (i < 2 ? lb0 : lb1)[(2 * i + 1) & 3];
                const float na = ya * rstd * ga + ba + ebon * bf2f(ev[i] & 0xffffu), nb = yb * rstd * gb_ + bb_ + ebon * bf2f(ev[i] >> 16);
                o[i] = mm::cvtpk(siluf_(bf2f(ez[i] & 0xffffu)) * na, siluf_(bf2f(ez[i] >> 16)) * nb); }
            *(u32x4e*)(MIXED + em_ * DM + 1536 + h * 64 + 8 * ep) = o;
        }
    }
    __syncthreads();
#undef SL
#undef RW_LOAD
}
namespace prp {
constexpr int PS = 144, PW = 1040, PT = 80;
constexpr int O_X = 0, O_A = 9216, O_AIM = 18432, O_VIM = 84992, O_T1 = 151552, LDS_END = 156672;
typedef unsigned u32x4 __attribute__((ext_vector_type(4)));
template <int NK>
__device__ __forceinline__ void blk_g(mm::f32x4& acc, const MM_LAS unsigned char* A, int apitch, const bf16_t* Bt, int bpitch, int lane) {
    const MM_LAS unsigned char* ap = A + (lane & 15) * apitch + (lane >> 4) * 16; const bf16_t* bp = Bt + (size_t)(lane & 15) * bpitch + (lane >> 4) * 8;
#pragma unroll
    for (int ks = 0; ks < NK; ++ks) { const mm::bf16x8 a = *(const MM_LAS mm::bf16x8*)(ap + ks * 64), b = *(const mm::bf16x8*)(bp + ks * 32); acc = __builtin_amdgcn_mfma_f32_16x16x32_bf16(a, b, acc, 0, 0, 0); }
}
__device__ __forceinline__ void unpack8(const u32x4 w, float (&f)[8]) {
#pragma unroll
    for (int i = 0; i < 4; ++i) { f[2 * i] = __uint_as_float(w[i] << 16); f[2 * i + 1] = __uint_as_float(w[i] & 0xffff0000u); } }
__device__ __forceinline__ u32x4 pack8(const float (&f)[8]) { u32x4 w; w.x = mm::cvtpk(f[0], f[1]); w.y = mm::cvtpk(f[2], f[3]); w.z = mm::cvtpk(f[4], f[5]); w.w = mm::cvtpk(f[6], f[7]); return w; }
}
struct PrepP {
    const float *mu, *w0, *a0, *v0, *k_k, *k_a, *r_k, *conv_w, *conv_b, *i_bias, *f_bias; const bf16_t *W2T, *A2T, *V1T, *V2T; int layer;
    const bf16_t* PROJ; const float* SPEC; const float* CS; float* RWW; bf16_t* RWB; bf16_t* VFIRST; float* BONUS; bf16_t* CQN; bf16_t* CKVN; bf16_t* KR; bf16_t* QKC; float* LI; float* LF;
};
__device__ __forceinline__ void prep_tile(unsigned char* lds_g, int tile, const PrepP& P) {
    using namespace prp; using mm::f32x4; using mm::bf16x8;
    MM_LAS unsigned char* L = (MM_LAS unsigned char*)lds_g;
    int tid_o = threadIdx.x; asm volatile("" : "+v"(tid_o));
    const int tid = tid_o, lane = tid & 63, wave = __builtin_amdgcn_readfirstlane(tid >> 6);
    const int m0 = tile * 64, t0 = m0 % T;
    constexpr size_t RWS = (size_t)M * 512;
    const bool resid = P.layer > 0;
    { const int t = tid >> 3, p = tid & 7; const size_t m = (size_t)m0 + t; const bool has_prev = (t0 + t) > 0;
#pragma unroll
      for (int which = 0; which < 2; ++which) { const float* cp = P.SPEC + m * 256 + which * 64 + 8 * p; const f32x4 c0 = *(const f32x4*)cp, c1 = *(const f32x4*)(cp + 4);
          f32x4 p0 = (f32x4){0.f, 0.f, 0.f, 0.f}, p1 = p0; if (has_prev) { p0 = *(const f32x4*)(cp - 256); p1 = *(const f32x4*)(cp - 252); }
          const f32x4 mu0 = *(const f32x4*)(P.mu + 1536 + which * 64 + 8 * p), mu1 = *(const f32x4*)(P.mu + 1536 + which * 64 + 8 * p + 4);
          float f[8];
#pragma unroll
          for (int e = 0; e < 4; ++e) { f[e] = c0[e] + mu0[e] * (p0[e] - c0[e]); f[4 + e] = c1[e] + mu1[e] * (p1[e] - c1[e]); }
          if (which == 0) {
#pragma unroll
              for (int e = 0; e < 8; ++e) f[e] = tanhf(f[e]); }
          *(MM_LAS u32x4*)(L + (which ? O_A : O_X) + t * PS + p * 16) = pack8(f); } }
    if (resid) { const int t = lane, hh = wave; const size_t m = (size_t)m0 + t; const bool has_prev = (t0 + t) > 0;
        const bf16_t* cp = P.PROJ + m * NPROJ + PC_RW + 1024 + hh * 64;
#pragma unroll
        for (int g = 0; g < 8; ++g) { float c[8], pv[8], mu_[8], o[8]; unpack8(*(const u32x4*)(cp + 8 * g), c);
            if (has_prev) unpack8(*(const u32x4*)(cp - NPROJ + 8 * g), pv); else {
#pragma unroll
                for (int e = 0; e < 8; ++e) pv[e] = 0.f; }
            const f32x4 m0_ = *(const f32x4*)(P.mu + 1024 + hh * 64 + 8 * g), m1_ = *(const f32x4*)(P.mu + 1024 + hh * 64 + 8 * g + 4);
#pragma unroll
            for (int e = 0; e < 4; ++e) { mu_[e] = m0_[e]; mu_[4 + e] = m1_[e]; }
#pragma unroll
            for (int e = 0; e < 8; ++e) o[e] = c[e] + mu_[e] * (pv[e] - c[e]);
            *(MM_LAS u32x4*)(L + O_VIM + t * PW + hh * 128 + g * 16) = pack8(o); } }
    __syncthreads();
    { bf16x8 fx[4][2], fa[4][2];
#pragma unroll
      for (int bi = 0; bi < 4; ++bi)
#pragma unroll
          for (int ks = 0; ks < 2; ++ks) { fx[bi][ks] = *(const MM_LAS bf16x8*)(L + O_X + (16 * bi + (lane & 15)) * PS + (lane >> 4) * 16 + ks * 64); fa[bi][ks] = *(const MM_LAS bf16x8*)(L + O_A + (16 * bi + (lane & 15)) * PS + (lane >> 4) * 16 + ks * 64); }
#pragma unroll
      for (int bjl = 0; bjl < 4; ++bjl) { const int c = 64 * wave + 16 * bjl + (lane & 15);
          const bf16_t* wp = P.W2T + (size_t)c * 64 + (lane >> 4) * 8; const bf16_t* ap = P.A2T + (size_t)c * 64 + (lane >> 4) * 8;
          const bf16x8 bw0 = *(const bf16x8*)wp, bw1 = *(const bf16x8*)(wp + 32), ba0 = *(const bf16x8*)ap, ba1 = *(const bf16x8*)(ap + 32);
          const float w0c = P.w0[c], a0c = P.a0[c];
#pragma unroll
          for (int bi = 0; bi < 4; ++bi) { f32x4 aw = (f32x4){0.f, 0.f, 0.f, 0.f}, aa = aw;
              aw = __builtin_amdgcn_mfma_f32_16x16x32_bf16(fx[bi][0], bw0, aw, 0, 0, 0); aw = __builtin_amdgcn_mfma_f32_16x16x32_bf16(fx[bi][1], bw1, aw, 0, 0, 0);
              aa = __builtin_amdgcn_mfma_f32_16x16x32_bf16(fa[bi][0], ba0, aa, 0, 0, 0); aa = __builtin_amdgcn_mfma_f32_16x16x32_bf16(fa[bi][1], ba1, aa, 0, 0, 0);
#pragma unroll
              for (int r = 0; r < 4; ++r) { const int t = 16 * bi + 4 * (lane >> 4) + r;
                  const float logw = -softplusf_(-(aw[r] + w0c)) - 0.5f;
                  P.RWW[((size_t)m0 + t) * 512 + c] = -__expf(logw);
                  *(MM_LAS unsigned short*)(L + O_AIM + t * PW + c * 2) = mm::f2b(sigmoidf_(aa[r] + a0c)); } } }
      if (resid) { const int bi = wave >> 1, bj = wave & 1; f32x4 d = (f32x4){0.f, 0.f, 0.f, 0.f};
          blk_g<16>(d, L + O_VIM + bi * 16 * PW, PW, P.V1T + (size_t)bj * 16 * 512, 512, lane);
#pragma unroll
          for (int r = 0; r < 4; ++r) *(MM_LAS unsigned short*)(L + O_T1 + (16 * bi + 4 * (lane >> 4) + r) * PT + (16 * bj + (lane & 15)) * 2) = mm::f2b(d[r]); } }
    __syncthreads();
    { MM_LAS float* PT_ = (MM_LAS float*)(L + O_X);
      PT_[tid] = P.mu[tid]; PT_[512 + tid] = P.mu[512 + tid]; PT_[1024 + tid] = P.mu[1024 + tid]; PT_[1536 + tid] = P.k_k[tid]; PT_[2048 + tid] = P.k_a[tid]; PT_[2560 + tid] = P.r_k[tid]; }
    if (resid) { bf16x8 ft[4];
#pragma unroll
        for (int bi = 0; bi < 4; ++bi) ft[bi] = *(const MM_LAS bf16x8*)(L + O_T1 + (16 * bi + (lane & 15)) * PT + (lane >> 4) * 16);
#pragma unroll
        for (int bjl = 0; bjl < 4; ++bjl) { const int c = 64 * wave + 16 * bjl + (lane & 15); const bf16x8 b = *(const bf16x8*)(P.V2T + (size_t)c * 32 + (lane >> 4) * 8); const float v0c = P.v0[c];
#pragma unroll
            for (int bi = 0; bi < 4; ++bi) { f32x4 d = (f32x4){0.f, 0.f, 0.f, 0.f}; d = __builtin_amdgcn_mfma_f32_16x16x32_bf16(ft[bi], b, d, 0, 0, 0);
#pragma unroll
                for (int r = 0; r < 4; ++r) *(MM_LAS unsigned short*)(L + O_VIM + (16 * bi + 4 * (lane >> 4) + r) * PW + c * 2) = mm::f2b(sigmoidf_(d[r] + v0c)); } } }
    __syncthreads();
    { const int t = lane, hh = wave; const size_t m = (size_t)m0 + t; const bool has_prev = (t0 + t) > 0; const int cb = hh * 64;
      const bf16_t* cp = P.PROJ + m * NPROJ + PC_RW + cb; const size_t ob = m * 512 + cb;
      const MM_LAS float* PT_ = (const MM_LAS float*)(L + O_X) + cb;
#define PRM(arr, g, e) (PT_[(arr) * 512 + 8 * (g) + (e)])
      float ss = 0.f, bon = 0.f;
      u32x4 ksp[8];
      const u32x4 zero4 = (u32x4){0u, 0u, 0u, 0u};
#define LDC(off, g) (*(const u32x4*)(cp + (off) + 8 * (g)))
#define LDP(off, g) (has_prev ? *(const u32x4*)(cp + (off) - NPROJ + 8 * (g)) : zero4)
      { u32x4 nc = LDC(512, 0), np = LDP(512, 0);
#pragma unroll
        for (int g = 0; g < 8; ++g) { const u32x4 rc = nc, rp = np; if (g < 7) { nc = LDC(512, g + 1); np = LDP(512, g + 1); }
          float c[8], pv[8], o[8]; unpack8(rc, c); unpack8(rp, pv);
#pragma unroll
          for (int e = 0; e < 8; ++e) { o[e] = c[e] + PRM(1, g, e) * (pv[e] - c[e]); const float q = o[e] * PRM(3, g, e); ss += q * q; }
          ksp[g] = pack8(o); asm volatile("" ::: "memory"); } }
      const float rn = 1.f / fmaxf(sqrtf(ss), 1e-12f);
      { u32x4 nc = LDC(0, 0), np = LDP(0, 0);
#pragma unroll
        for (int g = 0; g < 8; ++g) { const u32x4 rc = nc, rp = np; if (g < 7) { nc = LDC(0, g + 1); np = LDP(0, g + 1); }
          float ks_[8], a_[8], c[8], pv[8], rr[8], okh[8], oa[8], ob_[8]; unpack8(ksp[g], ks_); unpack8(*(const MM_LAS u32x4*)(L + O_AIM + t * PW + cb * 2 + g * 16), a_); unpack8(rc, c); unpack8(rp, pv);
#pragma unroll
          for (int e = 0; e < 8; ++e) { rr[e] = c[e] + PRM(0, g, e) * (pv[e] - c[e]); const float kkn = ks_[e] * PRM(3, g, e) * rn; okh[e] = ks_[e] * (1.f + (a_[e] - 1.f) * PRM(4, g, e)); oa[e] = -kkn; ob_[e] = kkn * a_[e]; bon += rr[e] * okh[e] * PRM(5, g, e); }
          *(u32x4*)(P.RWB + ob + 8 * g) = pack8(rr); *(u32x4*)(P.RWB + RWS + ob + 8 * g) = pack8(okh); *(u32x4*)(P.RWB + 3 * RWS + ob + 8 * g) = pack8(oa); *(u32x4*)(P.RWB + 4 * RWS + ob + 8 * g) = pack8(ob_);
          asm volatile("" ::: "memory"); } }
      P.BONUS[m * 8 + hh] = bon;
      { u32x4 nc = LDC(1024, 0), np = LDP(1024, 0), nf = resid ? *(const u32x4*)(P.VFIRST + ob) : zero4;
#pragma unroll
        for (int g = 0; g < 8; ++g) { const u32x4 rc = nc, rp = np, rf = nf; if (g < 7) { nc = LDC(1024, g + 1); np = LDP(1024, g + 1); if (resid) nf = *(const u32x4*)(P.VFIRST + ob + 8 * (g + 1)); }
          float c[8], pv[8], o[8]; unpack8(rc, c); unpack8(rp, pv);
#pragma unroll
          for (int e = 0; e < 8; ++e) o[e] = c[e] + PRM(2, g, e) * (pv[e] - c[e]);
          if (resid) { float gg[8], vf[8]; unpack8(*(const MM_LAS u32x4*)(L + O_VIM + t * PW + cb * 2 + g * 16), gg); unpack8(rf, vf);
#pragma unroll
              for (int e = 0; e < 8; ++e) o[e] = o[e] + (vf[e] - o[e]) * gg[e]; }
          else *(u32x4*)(P.VFIRST + ob + 8 * g) = pack8(o);
          *(u32x4*)(P.RWB + 2 * RWS + ob + 8 * g) = pack8(o); asm volatile("" ::: "memory"); } }
#undef LDC
#undef LDP
#undef PRM
    }
    { const int t = tid >> 3, p = tid & 7; const size_t m = (size_t)m0 + t;
      { const bf16_t* cp = P.PROJ + m * NPROJ + PC_CQ + 64 * p; u32x4 w[8]; float s = 0.f;
#pragma unroll
        for (int g = 0; g < 8; ++g) { w[g] = *(const u32x4*)(cp + 8 * g); float f[8]; unpack8(w[g], f);
#pragma unroll
            for (int e = 0; e < 8; ++e) s += f[e] * f[e]; }
        s += __shfl_xor(s, 1); s += __shfl_xor(s, 2); s += __shfl_xor(s, 4);
        const float rstd = 1.f / sqrtf(s * (1.f / 512.f) + NORM_EPS);
#pragma unroll
        for (int g = 0; g < 8; ++g) { float f[8]; unpack8(w[g], f);
#pragma unroll
            for (int e = 0; e < 8; ++e) f[e] *= rstd;
            *(u32x4*)(P.CQN + m * 512 + 64 * p + 8 * g) = pack8(f); } }
      { const bf16_t* cp = P.PROJ + m * NPROJ + PC_CKV + 32 * p; u32x4 w[4]; float s = 0.f;
#pragma unroll
        for (int g = 0; g < 4; ++g) { w[g] = *(const u32x4*)(cp + 8 * g); float f[8]; unpack8(w[g], f);
#pragma unroll
            for (int e = 0; e < 8; ++e) s += f[e] * f[e]; }
        s += __shfl_xor(s, 1); s += __shfl_xor(s, 2); s += __shfl_xor(s, 4);
        const float rstd = 1.f / sqrtf(s * (1.f / 256.f) + NORM_EPS);
#pragma unroll
        for (int g = 0; g < 4; ++g) { float f[8]; unpack8(w[g], f);
#pragma unroll
            for (int e = 0; e < 8; ++e) f[e] *= rstd;
            *(u32x4*)(P.CKVN + m * 256 + 32 * p + 8 * g) = pack8(f); } }
      { const float* sp = P.SPEC + m * 256 + 128 + 8 * p; const f32x4 x0 = *(const f32x4*)sp, x1 = *(const f32x4*)(sp + 4);
        const float* cs = P.CS + (m * 32 + 4 * p) * 2; const f32x4 c0 = *(const f32x4*)cs, c1 = *(const f32x4*)(cs + 4);
        float o[8];
        o[0] = x0[0] * c0[0] - x0[1] * c0[1]; o[1] = x0[1] * c0[0] + x0[0] * c0[1]; o[2] = x0[2] * c0[2] - x0[3] * c0[3]; o[3] = x0[3] * c0[2] + x0[2] * c0[3];
        o[4] = x1[0] * c1[0] - x1[1] * c1[1]; o[5] = x1[1] * c1[0] + x1[0] * c1[1]; o[6] = x1[2] * c1[2] - x1[3] * c1[3]; o[7] = x1[3] * c1[2] + x1[2] * c1[3];
        *(u32x4*)(P.KR + m * 64 + 8 * p) = pack8(o); }
      { const int gh = p; const float val = P.SPEC[m * 256 + 192 + gh];
        if (gh < 4) P.LI[m * 4 + gh] = val + P.i_bias[gh]; else P.LF[m * 4 + gh - 4] = -softplusf_(-(val + P.f_bias[gh - 4])); } }
    { const int cgp = tid & 127, tq = tid >> 7, ch = 8 * cgp; const float sc_ = ch < 512 ? 0.08838834764831845f : 1.f;
      float cw[4][8], cbv[8];
#pragma unroll
      for (int j = 0; j < 4; ++j) { const f32x4 a = *(const f32x4*)(P.conv_w + j * 1024 + ch), b = *(const f32x4*)(P.conv_w + j * 1024 + ch + 4);
#pragma unroll
          for (int e = 0; e < 4; ++e) { cw[j][e] = a[e]; cw[j][4 + e] = b[e]; } }
      { const f32x4 a = *(const f32x4*)(P.conv_b + ch), b = *(const f32x4*)(P.conv_b + ch + 4);
#pragma unroll
        for (int e = 0; e < 4; ++e) { cbv[e] = a[e]; cbv[4 + e] = b[e]; } }
      float x0[8], x1[8], x2[8];
      const int tb = 16 * tq;
#pragma unroll
      for (int e = 0; e < 8; ++e) { x0[e] = 0.f; x1[e] = 0.f; x2[e] = 0.f; }
      if (t0 + tb >= 3) { unpack8(*(const u32x4*)(P.PROJ + ((size_t)m0 + tb - 3) * NPROJ + PC_MLQK + ch), x0); unpack8(*(const u32x4*)(P.PROJ + ((size_t)m0 + tb - 2) * NPROJ + PC_MLQK + ch), x1); unpack8(*(const u32x4*)(P.PROJ + ((size_t)m0 + tb - 1) * NPROJ + PC_MLQK + ch), x2); }
#pragma unroll 4
      for (int i = 0; i < 16; ++i) { float x3[8], y[8]; unpack8(*(const u32x4*)(P.PROJ + ((size_t)m0 + tb + i) * NPROJ + PC_MLQK + ch), x3);
#pragma unroll
          for (int e = 0; e < 8; ++e) { const float v = cbv[e] + cw[0][e] * x0[e] + cw[1][e] * x1[e] + cw[2][e] * x2[e] + cw[3][e] * x3[e]; y[e] = siluf_(v) * sc_; x0[e] = x1[e]; x1[e] = x2[e]; x2[e] = x3[e]; }
          *(u32x4*)(P.QKC + ((size_t)m0 + tb + i) * 1024 + ch) = pack8(y); } }
    __syncthreads();
}
constexpr size_t MiB = 1u << 20;
constexpr size_t WS_CTL = 0, CTL_ZERO_BYTES = 1 * MiB;
constexpr size_t WS_WIN = 1 * MiB;
constexpr size_t WS_WUQ = WS_WIN + 104 * MiB;
constexpr size_t WS_WUKV = WS_WUQ + 6 * MiB;
constexpr size_t WS_WOUT = WS_WUKV + 4 * MiB;
constexpr size_t WS_CS = WS_WOUT + 32 * MiB;
constexpr size_t WS_XN = WS_CS + 4 * MiB;
constexpr size_t WS_PROJ = WS_XN + 64 * MiB;
constexpr size_t WS_SPEC = WS_PROJ + 208 * MiB;
constexpr size_t WS_CQN = WS_SPEC + 16 * MiB;
constexpr size_t WS_CKVN = WS_CQN + 16 * MiB;
constexpr size_t WS_KR = WS_CKVN + 8 * MiB;
constexpr size_t WS_Q = WS_KR + 2 * MiB;
constexpr size_t WS_KV = WS_Q + 48 * MiB;
constexpr size_t WS_QKC = WS_KV + 64 * MiB;
constexpr size_t WS_GATE = WS_QKC + 32 * MiB;
constexpr size_t WS_RWW = WS_GATE + 1 * MiB;
constexpr size_t WS_RWB = WS_RWW + 32 * MiB;
constexpr size_t WS_VFIRST = WS_RWB + 80 * MiB;
constexpr size_t WS_BONUS = WS_VFIRST + 16 * MiB;
constexpr size_t WS_LR = WS_BONUS + 1 * MiB;
constexpr size_t LR_STRIDE = 196608, LR_W2T = 0, LR_A2T = 65536, LR_V1T = 131072, LR_V2T = 163840;
constexpr size_t WS_END = WS_LR + 1 * MiB;
constexpr int CW_BAR = 4096;
constexpr int LDS_BYTES = 163840, RING_BYTES = 158720, MISC_OFF = RING_BYTES + 320;
static_assert(att::LDS_BYTES <= RING_BYTES, "attention LDS");

struct Args { const float* in[28]; float* out; unsigned char* ws; int ph_lo, ph_hi; };

struct MapWin { __device__ __forceinline__ int operator()(int n) const {
    if (n < 1536) return n;
    if (n < 2048) return SC_MLO + (n - 1536);
    if (n < 2560) return SC_MLZ + (n - 2048);
    if (n < 3072) return SC_CQ + (n - 2560);
    if (n < 3328) return SC_CKV + (n - 3072);
    if (n < 4352) return SC_MLAZ + (n - 3328);
    if (n < 5888) return SC_RW + (n - 4352);
    if (n < 6144) { const int j = n - 5888;
        if (j < 128) return SC_RW + 1536 + j;
        if (j < 192) { const int q = j - 128; return SC_KR + ((q & 1) ? 32 + (q >> 1) : (q >> 1)); }
        if (j < 196) return SC_MLI + (j - 192);
        if (j < 200) return SC_MLF + (j - 196);
        return -1; }
    return SC_RWZ + (n - 6144); } };
struct MapUq { __device__ __forceinline__ int operator()(int n) const { const int h = n / 192, d = n % 192; if (d < 128) return n; const int q = d - 128; return h * 192 + 128 + ((q & 1) ? 32 + (q >> 1) : (q >> 1)); } };
struct MapId { __device__ __forceinline__ int operator()(int n) const { return n; } };

template <class Map>
__device__ __forceinline__ void transpose_item(const float* W, int K, int Nsrc, bf16_t* WT, const float* gain, LAS float* scr, int kb, int nb, int lane, Map map) {
    const int k0 = 64 * kb, n0 = 32 * nb, sc = map(n0 + (lane & 31));
#pragma unroll 8
    for (int i = 0; i < 32; ++i) { const int kk = 2 * i + (lane >> 5); float v = 0.f;
        if (sc >= 0) { v = W[(size_t)(k0 + kk) * Nsrc + sc]; if (gain) v *= gain[k0 + kk]; }
        scr[kk * 33 + (lane & 31)] = v; }
    LDS_WAIT(); asm volatile("" ::: "memory");
    const int c = lane & 7;
#pragma unroll
    for (int j = 0; j < 4; ++j) { const int n = (lane >> 3) + 8 * j; const LAS float* s = scr + (8 * c) * 33 + n;
        v4u o; o.x = pk2(s[0 * 33], s[1 * 33]); o.y = pk2(s[2 * 33], s[3 * 33]); o.z = pk2(s[4 * 33], s[5 * 33]); o.w = pk2(s[6 * 33], s[7 * 33]);
        *(v4u*)(WT + (size_t)(n0 + n) * K + k0 + 8 * c) = o; }
    LDS_WAIT(); asm volatile("" ::: "memory");
}

template <int MODE>
__device__ __forceinline__ void norm_row(const float* xrow, bf16_t* orow, float* frow, const float* g, int lane) {
    const f32x4* xr = (const f32x4*)xrow + lane;
    f32x4 v[8]; float s = 0.f;
#pragma unroll
    for (int j = 0; j < 8; ++j) { v[j] = xr[64 * j]; s += (v[j].x * v[j].x + v[j].y * v[j].y) + (v[j].z * v[j].z + v[j].w * v[j].w); }
    const float rstd = 1.f / sqrtf(wave_sum(s) * (1.f / DM) + NORM_EPS);
    if (MODE == 0) { unsigned long long* o8 = (unsigned long long*)orow + lane;
#pragma unroll
        for (int j = 0; j < 8; ++j) o8[64 * j] = (unsigned long long)pk2(v[j].x * rstd, v[j].y * rstd) | ((unsigned long long)pk2(v[j].z * rstd, v[j].w * rstd) << 32);
    } else { f32x4* o = (f32x4*)frow + lane; const f32x4* gr = (const f32x4*)g + lane;
#pragma unroll
        for (int j = 0; j < 8; ++j) { const f32x4 gg = gr[64 * j]; o[64 * j] = v[j] * rstd * gg; } }
}

__device__ __forceinline__ att::BlockRef mk_block(const bf16_t* Q, const bf16_t* KV, const bf16_t* KR, bf16_t* MIXED, const bf16_t* PROJ, const float* CS, int L_, int pass_) {
    const int bh = L_ >> 3, x = L_ & 7, qb = pass_ ? 15 - x : x, b = bh >> 3, h = bh & 7; att::BlockRef r;
    const size_t rb = (size_t)b * T, rq = rb + (size_t)qb * 256;
    r.Q = Q + rq * NQ + h * 192; r.K = KV + rb * NKV + h * 256; r.V = r.K + 128; r.KR = KR + rb * 64; r.O = MIXED + rq * DM + 512 + h * 128; r.Z = PROJ + rq * NPROJ + PC_MLAZ + h * 128; r.CSq = CS + rq * 64; r.P0 = qb * 256; return r;
}
#ifndef REP_PREP
#define REP_PREP 1
#endif
#ifndef REP_MIX
#define REP_MIX 1
#endif
#ifndef REP_RW
#define REP_RW 1
#endif
#ifndef REP_ML
#define REP_ML 1
#endif
__global__ void __launch_bounds__(512, 2) fwd(Args args) {
    extern __shared__ __attribute__((aligned(16))) unsigned char lds[];
    const int tid = threadIdx.x, lane = tid & 63, wave = __builtin_amdgcn_readfirstlane(tid >> 6);
    const int G = gridDim.x, bid = blockIdx.x;
    unsigned char* ws = args.ws;
    volatile LAS unsigned* MISC = (volatile LAS unsigned*)((LAS unsigned char*)lds + MISC_OFF);
    for (int u = tid; u < (LDS_BYTES - RING_BYTES) / 4; u += 512) ((LAS unsigned*)((LAS unsigned char*)lds + RING_BYTES))[u] = 0u;
    __syncthreads();
    const bool one_launch = (args.ph_hi - args.ph_lo) > 1;
    XcdBarrier bar; bar.bar = (unsigned*)(ws + WS_CTL) + CW_BAR; bar.x = 0; bar.st = nullptr;
    if (one_launch) bar = xcd_barrier_post((unsigned*)(ws + WS_CTL) + CW_BAR, MISC + 8);
    const int lo = args.ph_lo, hi = args.ph_hi;
#define IN(k) (lo <= (k) && (k) < hi)
#define SEAM(k) do { if (IN(k) && IN((k) + 1)) xcd_barrier(bar); } while (0)

    const float* x_in = args.in[0]; const int* positions = (const int*)args.in[1];
    float* X = args.out;
    bf16_t* WIN = (bf16_t*)(ws + WS_WIN); bf16_t* WUQ = (bf16_t*)(ws + WS_WUQ); bf16_t* WUKV = (bf16_t*)(ws + WS_WUKV); bf16_t* WOUT = (bf16_t*)(ws + WS_WOUT);
    float* CS = (float*)(ws + WS_CS); bf16_t* XN = (bf16_t*)(ws + WS_XN); bf16_t* MIXED = XN; bf16_t* PROJ = (bf16_t*)(ws + WS_PROJ); float* SPEC = (float*)(ws + WS_SPEC);
    bf16_t* CQN = (bf16_t*)(ws + WS_CQN); bf16_t* CKVN = (bf16_t*)(ws + WS_CKVN); bf16_t* KR = (bf16_t*)(ws + WS_KR); bf16_t* Q = (bf16_t*)(ws + WS_Q); bf16_t* KV = (bf16_t*)(ws + WS_KV);
    bf16_t* QKC = (bf16_t*)(ws + WS_QKC); float* LI = (float*)(ws + WS_GATE); float* LF = LI + (size_t)M * 4;
    float* RWW = (float*)(ws + WS_RWW); bf16_t* RWB = (bf16_t*)(ws + WS_RWB); bf16_t* VFIRST = (bf16_t*)(ws + WS_VFIRST); float* BONUS = (float*)(ws + WS_BONUS);
    constexpr size_t RWS = (size_t)M * 512;

    if (IN(0)) {
#ifndef NO_PRO
        LAS float* scr = (LAS float*)((LAS unsigned char*)lds + wave * 16384);
        const int gw = bid * 8 + wave, NGW = G * 8;
        constexpr int I_IN = (DM / 64) * (NPROJ / 32), I_UQ = (512 / 64) * (NQ / 32), I_UKV = (256 / 64) * (NKV / 32), I_OUT = (DM / 64) * (DM / 32), I_L = I_IN + I_UQ + I_UKV + I_OUT;
        for (int it = gw; it < DEPTH * I_L; it += NGW) {
            const int l = it / I_L; int r = it % I_L;
            if (r < I_IN) { transpose_item(args.in[3] + (size_t)l * DM * D_IN, DM, D_IN, WIN + (size_t)l * NPROJ * DM, args.in[2] + l * DM, scr, r / (NPROJ / 32), r % (NPROJ / 32), lane, MapWin()); continue; } r -= I_IN;
            if (r < I_UQ) { transpose_item(args.in[10] + (size_t)l * 512 * NQ, 512, NQ, WUQ + (size_t)l * NQ * 512, args.in[9] + l * 512, scr, r / (NQ / 32), r % (NQ / 32), lane, MapUq()); continue; } r -= I_UQ;
            if (r < I_UKV) { transpose_item(args.in[12] + (size_t)l * 256 * NKV, 256, NKV, WUKV + (size_t)l * NKV * 256, args.in[11] + l * 256, scr, r / (NKV / 32), r % (NKV / 32), lane, MapId()); continue; } r -= I_UKV;
            transpose_item(args.in[26] + (size_t)l * DM * DM, DM, DM, WOUT + (size_t)l * DM * DM, (const float*)nullptr, scr, r / (DM / 32), r % (DM / 32), lane, MapId());
        }
        for (int it = gw; it < DEPTH * 40; it += NGW) {
            const int l = it / 40, r = it % 40; unsigned char* lr = ws + WS_LR + (size_t)l * LR_STRIDE;
            if (r < 16) transpose_item(args.in[15] + (size_t)l * 64 * 512, 64, 512, (bf16_t*)(lr + LR_W2T), (const float*)nullptr, scr, 0, r, lane, MapId());
            else if (r < 32) transpose_item(args.in[17] + (size_t)l * 64 * 512, 64, 512, (bf16_t*)(lr + LR_A2T), (const float*)nullptr, scr, 0, r - 16, lane, MapId());
            else if (l > 0) transpose_item(args.in[19] + (size_t)(l - 1) * 512 * 32, 512, 32, (bf16_t*)(lr + LR_V1T), (const float*)nullptr, scr, r - 32, 0, lane, MapId());
        }
        for (int i = bid * 512 + tid; i < (DEPTH - 1) * 512 * 32; i += G * 512) { const int l = 1 + i / 16384, e = i % 16384, c = e >> 5, j = e & 31;
            ((bf16_t*)(ws + WS_LR + (size_t)l * LR_STRIDE + LR_V2T))[c * 32 + j] = (bf16_t)f2bf(args.in[20][(size_t)(l - 1) * 32 * 512 + j * 512 + c]); }
        for (int i = bid * 512 + tid; i < M * 32; i += G * 512) { const int m = i >> 5, j = i & 31;
            const float inv_freq = powf(10000.f, -(float)(2 * j) / 64.f);
            const float ang = (float)positions[m] * inv_freq;
            const double a = (double)ang; const double n = rint(a * 0.15915494309189535); const float r = (float)(a - n * 6.283185307179586);
            CS[2 * i] = cosf(r); CS[2 * i + 1] = sinf(r); }
        for (int m = gw; m < M; m += NGW) norm_row<0>(x_in + (size_t)m * DM, XN + (size_t)m * DM, nullptr, nullptr, lane);
#endif
    }
    SEAM(0);

#ifdef FIXL
    for (int l = 0; l < 1; ++l) {
#else
    for (int l = 0; l < DEPTH; ++l) {
#endif
        const int pb = 1 + l * 6;
        int tid_o = threadIdx.x; asm volatile("" : "+v"(tid_o));
        const int tid = tid_o, lane = tid & 63, wave = __builtin_amdgcn_readfirstlane(tid >> 6);
        if (IN(pb + 0)) {
#ifndef NO_G1
            pg8::Gemm g{XN, WIN + (size_t)l * NPROJ * DM, M, NPROJ, DM}; pg8::StaticOrder S; S.init(M, NPROJ, G, bid);
            pg8::EpiProj E{PROJ, NPROJ, SPEC, SPEC_TILE};
            pg8::gemm_phase<pg8::EpiProj, pg8::StaticOrder, true, true>((LAS unsigned char*)lds, g, S, E);
#endif
        }
        SEAM(pb + 0);
        if (IN(pb + 1)) {
#ifndef NO_PREP
            PrepP P;
            P.mu = args.in[13] + l * 1664; P.w0 = args.in[14] + l * 512; P.a0 = args.in[16] + l * 512; P.v0 = args.in[18] + (l > 0 ? (l - 1) * 512 : 0);
            P.k_k = args.in[21] + l * 512; P.k_a = args.in[22] + l * 512; P.r_k = args.in[23] + l * 512;
            P.conv_w = args.in[4] + (size_t)l * 4 * 1024; P.conv_b = args.in[5] + l * 1024; P.i_bias = args.in[6] + l * 4; P.f_bias = args.in[7] + l * 4;
            const unsigned char* lr = ws + WS_LR + (size_t)l * LR_STRIDE;
            P.W2T = (const bf16_t*)(lr + LR_W2T); P.A2T = (const bf16_t*)(lr + LR_A2T); P.V1T = (const bf16_t*)(lr + LR_V1T); P.V2T = (const bf16_t*)(lr + LR_V2T); P.layer = l;
            P.PROJ = PROJ; P.SPEC = SPEC; P.CS = CS; P.RWW = RWW; P.RWB = RWB; P.VFIRST = VFIRST; P.BONUS = BONUS; P.CQN = CQN; P.CKVN = CKVN; P.KR = KR; P.QKC = QKC; P.LI = LI; P.LF = LF;
            for (int rep_ = 0; rep_ < REP_PREP; ++rep_)
            for (int tile = bid; tile < M / 64; tile += G) prep_tile(lds, tile, P);
#endif
        }
        SEAM(pb + 1);
        if (IN(pb + 2)) {
#ifndef NO_G23
            { pg8::Gemm g{CQN, WUQ + (size_t)l * NQ * 512, M, NQ, 512}; pg8::StaticOrder S; S.init(M, NQ, G, bid);
              pg8::EpiPlain E{Q, NQ};
              pg8::gemm_phase<pg8::EpiPlain, pg8::StaticOrder, true, true>((LAS unsigned char*)lds, g, S, E); }
            { pg8::Gemm g{CKVN, WUKV + (size_t)l * NKV * 256, M, NKV, 256}; pg8::StaticOrder S; S.init(M, NKV, G, bid);
              pg8::EpiPlain E{KV, NKV};
              pg8::gemm_phase<pg8::EpiPlain, pg8::StaticOrder, true, true>((LAS unsigned char*)lds, g, S, E); }
#endif
        }
        SEAM(pb + 2);
        if (IN(pb + 3)) for (int rep_ = 0; rep_ < REP_MIX; ++rep_) {
#ifndef NO_SCANS
            if (bid < 32 && G >= 64) {
                for (int rr_ = 0; rr_ < REP_RW; ++rr_) rwkv_unit(lds, bid >> 3, bid & 7, RWW, RWB, RWS, BONUS, PROJ, args.in[24] + l * 512 + (bid & 7) * 64, args.in[25] + l * 512 + (bid & 7) * 64, MIXED);
            } else if (bid < 48 && G >= 64) {
                const int u = bid - 32;
                for (int rr_ = 0; rr_ < REP_ML; ++rr_) mlstm_unit(lds, u >> 2, u & 3, QKC, PROJ, LI, LF, args.in[8] + l * 512 + (u & 3) * 128, MIXED);
            } else
#endif
            {
#ifndef NO_ATT
                const int first = (G >= 64) ? bid - 48 : bid, stride = (G >= 64) ? G - 48 : G; constexpr int total = BATCH * 8 * 8;
                if (first < total) {
                    att::Seam S; int L = first, pass = 0;
#define mk(L_, pass_) mk_block(Q, KV, KR, MIXED, PROJ, CS, (L_), (pass_))
                    att::BlockRef cur = mk(L, 0);
                    att::attn_prime(cur, (char*)lds, S);
                    for (;;) {
                        const bool more_pass = pass == 0, more_item = L + stride < total, last = !more_pass && !more_item;
                        int Ln = L, passn = pass + 1; if (!more_pass) { passn = 0; Ln = more_item ? L + stride : L; }
                        const att::BlockRef nxt = last ? cur : mk(Ln, passn);
                        att::attn_block(cur, nxt, (char*)lds, S);
                        if (last) break;
                        cur = nxt; L = Ln; pass = passn;
                    }
#undef mk
                }
#endif
            }
        }
        SEAM(pb + 3);
        if (IN(pb + 4)) {
#ifndef NO_G4
            pg8::Gemm g{MIXED, WOUT + (size_t)l * DM * DM, M, DM, DM}; pg8::StaticOrder S; S.init(M, DM, G, bid);
            pg8::EpiResid E{l == 0 ? x_in : (const float*)X, X, DM};
            pg8::gemm_phase<pg8::EpiResid, pg8::StaticOrder, true, true>((LAS unsigned char*)lds, g, S, E);
#endif
        }
        SEAM(pb + 4);
        if (IN(pb + 5)) {
            const int gw = bid * 8 + wave, NGW = G * 8;
            if (l + 1 < DEPTH) { for (int m = gw; m < M; m += NGW) norm_row<0>(X + (size_t)m * DM, XN + (size_t)m * DM, nullptr, nullptr, lane); }
            else { for (int m = gw; m < M; m += NGW) norm_row<1>(X + (size_t)m * DM, nullptr, X + (size_t)m * DM, args.in[27], lane); }
        }
        SEAM(pb + 5);
    }
#undef IN
#undef SEAM
}

constexpr int N_PHASES = 1 + DEPTH * 6;
#ifndef MK_ONE_LAUNCH
#define MK_ONE_LAUNCH 1
#endif
extern "C" void kernel_launch(void* const* d_in, const int* in_sizes, int n_in, void* d_out, int out_size, void* d_ws, size_t ws_size, hipStream_t stream) {
    static int grid = 0;
    if (grid == 0) {
        if (n_in != 28 || out_size != M * DM || ws_size < WS_END) { fprintf(stderr, "kernel_launch: unexpected shapes (n_in %d, out %d, ws %zu < %zu)\n", n_in, out_size, ws_size, (size_t)WS_END); grid = -1; return; }
        int dev = 0, cus = 0;
        if (hipGetDevice(&dev) != hipSuccess || hipDeviceGetAttribute(&cus, hipDeviceAttributeMultiprocessorCount, dev) != hipSuccess) { grid = -1; return; }
        if (hipFuncSetAttribute((const void*)fwd, hipFuncAttributeMaxDynamicSharedMemorySize, LDS_BYTES) != hipSuccess) { fprintf(stderr, "kernel_launch: hipFuncSetAttribute failed\n"); grid = -1; return; }
        int per_cu = 0;
        if (hipOccupancyMaxActiveBlocksPerMultiprocessor(&per_cu, (const void*)fwd, 512, LDS_BYTES) != hipSuccess || per_cu < 1) fprintf(stderr, "kernel_launch: occupancy query says %d\n", per_cu);
        (void)hipGetLastError();
        grid = cus;
    }
    if (grid < 0) return;
    if (hipMemsetAsync((char*)d_ws + WS_CTL, 0, CTL_ZERO_BYTES, stream) != hipSuccess) return;
    Args a; memset(&a, 0, sizeof(a));
    for (int i = 0; i < 28; ++i) a.in[i] = (const float*)d_in[i];
    a.out = (float*)d_out; a.ws = (unsigned char*)d_ws;
#if MK_ONE_LAUNCH
    a.ph_lo = 0; a.ph_hi = N_PHASES;
    hipLaunchKernelGGL(fwd, dim3(grid), dim3(512), LDS_BYTES, stream, a);
#else
    for (int p = 0; p < N_PHASES; ++p) { a.ph_lo = p; a.ph_hi = p + 1; hipLaunchKernelGGL(fwd, dim3(grid), dim3(512), LDS_BYTES, stream, a); }
#endif
}
```

```cpp
#include <hip/hip_runtime.h>
#include <cstdio>
#include <cstdint>
#include <cstring>
namespace pg8 {
#define PG8_LAS __attribute__((address_space(3)))
typedef unsigned short bf16_t;
typedef short bf16x8 __attribute__((ext_vector_type(8)));
typedef float f32x4 __attribute__((ext_vector_type(4)));
typedef unsigned u32x4 __attribute__((ext_vector_type(4)));
constexpr int BM = 256, BK = 64, HALF = 128, HTB = HALF * BK * 2  , STAGE_BYTES = 8 * HTB, NXCD = 8, WGM = 8;

__host__ __device__ __forceinline__ int lds_byte(int r, int c) { const int st = (r >> 4) * 2 + (c >> 5), rr = r & 15, cc = c & 31, ob = rr * 64 + cc * 2; return st * 1024 + (ob ^ (((ob >> 9) & 1) << 5)); }
__host__ __device__ __forceinline__ void stage_rc(int b, int& R, int& C) { const int st = b / 1024, sb = b % 1024, swz = sb ^ (((sb >> 9) & 1) << 5); R = (st >> 1) * 16 + swz / 64; C = (st & 1) * 32 + (swz % 64) / 2; }
__host__ __device__ __forceinline__ int perm32(int rho) { const int n = rho >> 4, i = rho & 15; return 8 * (i >> 2) + 4 * n + (i & 3); }

struct Unit { int pm, pn; };
struct Gemm { const bf16_t* A; const bf16_t* Bt; int M, N, K; };

struct StaticOrder {
    int nM, nN, nwg, G, c;
    __host__ __device__ void init(int M, int N, int G_, int c_) { nM = M / BM; nN = N / BM; nwg = nM * nN; G = G_; c = c_; }
    __host__ __device__ bool next(int i, Unit& u) const {
        const long L = (long)i * G + c; if (L >= nwg) return false;
        int wgid = (int)L; { const int q = nwg / NXCD, r = nwg % NXCD, xcd = wgid % NXCD, off = wgid / NXCD; wgid = (xcd < r ? xcd * (q + 1) : r * (q + 1) + (xcd - r) * q) + off; }
        const int nig = WGM * nN, gid = wgid / nig, fm = gid * WGM, gsz = (nM - fm) < WGM ? (nM - fm) : WGM;
        u.pm = fm + ((wgid % nig) % gsz); u.pn = (wgid % nig) / gsz; return true;
    }
    __device__ __forceinline__ void a_ready(const Unit&) const {}
    __device__ __forceinline__ void done(const Unit&) const {}
};

__device__ __forceinline__ unsigned cvt_pk_bf16(float lo, float hi) { unsigned r; asm volatile("v_cvt_pk_bf16_f32 %0, %1, %2" : "=v"(r) : "v"(lo), "v"(hi)); return r; }
typedef float f32x2 __attribute__((ext_vector_type(2)));
typedef unsigned u32x2 __attribute__((ext_vector_type(2)));
struct EpiProj {
    static constexpr bool PERM = true, AFTER_DRAIN = false;
    bf16_t* O; int ldc; float* spec; int spec_tile;
    __device__ __forceinline__ void operator()(const f32x4 (&acc)[2][2][4][2], const Unit& u, int wr, int wc, int fr, int fq) const {
        const int row0 = u.pm * BM + wr * 64 + fr, col0 = u.pn * BM + wc * 32 + 8 * fq;
        if (u.pn == spec_tile) {
            float* sp0 = spec + (size_t)row0 * 256 + wc * 32 + 8 * fq;
#pragma unroll
            for (int ai = 0; ai < 2; ++ai)
#pragma unroll
                for (int m = 0; m < 4; ++m) { float* sp_p = sp0 + (size_t)(ai * HALF + m * 16) * 256;
#pragma unroll
                    for (int bj = 0; bj < 2; ++bj) { *(f32x4*)(sp_p + bj * HALF) = acc[ai][bj][m][0]; *(f32x4*)(sp_p + bj * HALF + 4) = acc[ai][bj][m][1]; } }
        }
        bf16_t* o0 = O + (size_t)row0 * ldc + col0;
#pragma unroll
        for (int ai = 0; ai < 2; ++ai)
#pragma unroll
            for (int m = 0; m < 4; ++m) { bf16_t* rowp = o0 + (size_t)(ai * HALF + m * 16) * ldc;
#pragma unroll
                for (int bj = 0; bj < 2; ++bj) { const f32x4 v0 = acc[ai][bj][m][0], v1 = acc[ai][bj][m][1];
                    u32x4 w; w.x = cvt_pk_bf16(v0[0], v0[1]); w.y = cvt_pk_bf16(v0[2], v0[3]); w.z = cvt_pk_bf16(v1[0], v1[1]); w.w = cvt_pk_bf16(v1[2], v1[3]);
                    *(u32x4*)(rowp + bj * HALF) = w; } }
    }
};
struct EpiQ {
    static constexpr bool PERM = true, AFTER_DRAIN = false;
    bf16_t* O; const float* cs;
    __device__ __forceinline__ void operator()(const f32x4 (&acc)[2][2][4][2], const Unit& u, int wr, int wc, int fr, int fq) const {
        const int row0 = u.pm * BM + wr * 64 + fr, col0 = u.pn * BM + wc * 32 + 8 * fq;
#pragma unroll
        for (int ai = 0; ai < 2; ++ai)
#pragma unroll
            for (int m = 0; m < 4; ++m) { const int row = row0 + ai * HALF + m * 16; bf16_t* rowp = O + (size_t)row * 1536 + col0;
#pragma unroll
                for (int bj = 0; bj < 2; ++bj) { f32x4 v0 = acc[ai][bj][m][0], v1 = acc[ai][bj][m][1];
                    const int d = (col0 + bj * HALF) % 192;
                    if (d >= 128) { const int i0 = (d - 128) >> 1; const f32x4* cp = (const f32x4*)(cs + (size_t)row * 64 + i0 * 2); const f32x4 c0 = cp[0], c1 = cp[1];
                        f32x4 r0, r1;
                        r0[0] = v0[0] * c0[0] - v0[1] * c0[1]; r0[1] = v0[1] * c0[0] + v0[0] * c0[1];
                        r0[2] = v0[2] * c0[2] - v0[3] * c0[3]; r0[3] = v0[3] * c0[2] + v0[2] * c0[3];
                        r1[0] = v1[0] * c1[0] - v1[1] * c1[1]; r1[1] = v1[1] * c1[0] + v1[0] * c1[1];
                        r1[2] = v1[2] * c1[2] - v1[3] * c1[3]; r1[3] = v1[3] * c1[2] + v1[2] * c1[3];
                        v0 = r0; v1 = r1; }
                    u32x4 w; w.x = cvt_pk_bf16(v0[0], v0[1]); w.y = cvt_pk_bf16(v0[2], v0[3]); w.z = cvt_pk_bf16(v1[0], v1[1]); w.w = cvt_pk_bf16(v1[2], v1[3]);
                    *(u32x4*)(rowp + bj * HALF) = w; } }
    }
};
struct EpiPlain {
    static constexpr bool PERM = true, AFTER_DRAIN = false;
    bf16_t* O; int ldc;
    __device__ __forceinline__ void operator()(const f32x4 (&acc)[2][2][4][2], const Unit& u, int wr, int wc, int fr, int fq) const {
        const int row0 = u.pm * BM + wr * 64 + fr, col0 = u.pn * BM + wc * 32 + 8 * fq;
#pragma unroll
        for (int ai = 0; ai < 2; ++ai)
#pragma unroll
            for (int m = 0; m < 4; ++m) { bf16_t* rowp = O + (size_t)(row0 + ai * HALF + m * 16) * ldc + col0;
#pragma unroll
                for (int bj = 0; bj < 2; ++bj) { const f32x4 v0 = acc[ai][bj][m][0], v1 = acc[ai][bj][m][1];
                    u32x4 w; w.x = cvt_pk_bf16(v0[0], v0[1]); w.y = cvt_pk_bf16(v0[2], v0[3]); w.z = cvt_pk_bf16(v1[0], v1[1]); w.w = cvt_pk_bf16(v1[2], v1[3]);
                    *(u32x4*)(rowp + bj * HALF) = w; } }
    }
};
struct EpiResid {
    static constexpr bool PERM = false, AFTER_DRAIN = false;
    const float* base; float* out; int ldc;
    __device__ __forceinline__ void operator()(const f32x4 (&acc)[2][2][4][2], const Unit& u, int wr, int wc, int fr, int fq) const {
        const int row0 = u.pm * BM + wr * 64 + fr, col0 = u.pn * BM + wc * 32 + 4 * fq;
#pragma unroll
        for (int ai = 0; ai < 2; ++ai)
#pragma unroll
            for (int m = 0; m < 4; ++m) { const size_t off = (size_t)(row0 + ai * HALF + m * 16) * ldc + col0;
#pragma unroll
                for (int bj = 0; bj < 2; ++bj)
#pragma unroll
                    for (int n = 0; n < 2; ++n) { const f32x4 bs = *(const f32x4*)(base + off + bj * HALF + n * 16); *(f32x4*)(out + off + bj * HALF + n * 16) = bs + acc[ai][bj][m][n]; } }
    }
};
template <class Epi, class Sched, bool ALIGN_EPI = false, bool SP2 = false>
__device__ __forceinline__ void gemm_phase(PG8_LAS unsigned char* lds, const Gemm g, const Sched& S, const Epi& E) {
    int tid_o = threadIdx.x; asm volatile("" : "+v"(tid_o));
    const int tid = tid_o, wid = __builtin_amdgcn_readfirstlane(tid >> 6), lane = tid & 63, wr = wid >> 2, wc = wid & 3, fr = lane & 15, fq = lane >> 4;
    const int K = g.K, nt = K / BK;
    unsigned voffA[2], voffB[2];
#pragma unroll
    for (int i = 0; i < 2; ++i) { int R, C; stage_rc(tid * 16 + i * 8192, R, C); const int Rb = Epi::PERM ? ((R & ~31) + perm32(R & 31)) : R;
        voffA[i] = (unsigned)(R * K + C) * 2u; voffB[i] = (unsigned)(Rb * K + C) * 2u; }
    const size_t kstep = (size_t)(BK * 2);
    const size_t hstep = (size_t)HALF * K * 2;
    const size_t tstep = 2 * hstep;
    const unsigned ldsw = (unsigned)wid * 1024u;
    const int aoff = lds_byte(wr * 64 + fr, fq * 8), boff = lds_byte(wc * 32 + fr, fq * 8);
#define PG8_SA(b, h) (((b) * 2 + (h)) * HTB)
#define PG8_SB(b, h) ((4 + (b) * 2 + (h)) * HTB)
#define PG8_STAGE(bufoff, gbase, voff) do { _Pragma("unroll") for (int _i = 0; _i < 2; ++_i) \
        __builtin_amdgcn_global_load_lds((const unsigned*)((const char*)(gbase) + (voff)[_i]), (PG8_LAS unsigned*)(lds + (bufoff) + ldsw + _i * 8192), 16, 0, 0); } while (0)
#define PG8_LDA(dst, b, h) do { _Pragma("unroll") for (int m = 0; m < 4; ++m) _Pragma("unroll") for (int k = 0; k < 2; ++k) dst[m][k] = *(const PG8_LAS bf16x8*)(lds + PG8_SA(b, h) + aoff + m * 2048 + k * 1024); } while (0)
#define PG8_LDB(dst, b, h) do { _Pragma("unroll") for (int n = 0; n < 2; ++n) _Pragma("unroll") for (int k = 0; k < 2; ++k) dst[n][k] = *(const PG8_LAS bf16x8*)(lds + PG8_SB(b, h) + boff + n * 2048 + k * 1024); } while (0)
#define PG8_MMA(ai, bj, At, Bt) do { __builtin_amdgcn_s_setprio(1); _Pragma("unroll") for (int m = 0; m < 4; ++m) _Pragma("unroll") for (int n = 0; n < 2; ++n) _Pragma("unroll") for (int k = 0; k < 2; ++k) \
        acc[ai][bj][m][n] = __builtin_amdgcn_mfma_f32_16x16x32_bf16(Bt[n][k], At[m][k], acc[ai][bj][m][n], 0, 0, 0); __builtin_amdgcn_s_setprio(0); } while (0)
#define PG8_WAIT_V(n) asm volatile("s_waitcnt vmcnt(" #n ")" ::: "memory")
#define PG8_WAIT_L(n) asm volatile("s_waitcnt lgkmcnt(" #n ")" ::: "memory")
#define PG8_BAR __builtin_amdgcn_s_barrier()
#define PG8_SCHED __builtin_amdgcn_sched_barrier(0)
    Unit cur, nxt; int ui = 0;
    if (!S.next(0, cur)) return;
    f32x4 acc[2][2][4][2];
#pragma unroll
    for (int a = 0; a < 2; ++a)
#pragma unroll
        for (int b = 0; b < 2; ++b)
#pragma unroll
            for (int m = 0; m < 4; ++m)
#pragma unroll
                for (int n = 0; n < 2; ++n) acc[a][b][m][n] = (f32x4){0.f, 0.f, 0.f, 0.f};
    bf16x8 At[4][2], B0[2][2], B1[2][2];
    const char* cA = (const char*)g.A + (size_t)cur.pm * tstep; const char* cB = (const char*)g.Bt + (size_t)cur.pn * tstep;
    S.a_ready(cur);
    if constexpr (SP2) {
        PG8_STAGE(PG8_SB(0, 0), cB, voffB); PG8_STAGE(PG8_SB(0, 1), cB + hstep, voffB); PG8_STAGE(PG8_SA(0, 0), cA, voffA); PG8_STAGE(PG8_SA(0, 1), cA + hstep, voffA);
        if (wr == 1) PG8_BAR;
        PG8_WAIT_V(2); PG8_BAR;
        PG8_STAGE(PG8_SB(1, 0), cB + kstep, voffB); PG8_STAGE(PG8_SA(1, 0), cA + kstep, voffA); PG8_STAGE(PG8_SB(1, 1), cB + hstep + kstep, voffB);
        PG8_WAIT_V(6); PG8_BAR;
    } else {
        PG8_STAGE(PG8_SB(0, 0), cB, voffB); PG8_STAGE(PG8_SA(0, 0), cA, voffA); PG8_STAGE(PG8_SB(0, 1), cB + hstep, voffB); PG8_STAGE(PG8_SA(0, 1), cA + hstep, voffA);
        if (wr == 1) PG8_BAR;
        PG8_WAIT_V(4); PG8_BAR;
        PG8_STAGE(PG8_SB(1, 0), cB + kstep, voffB); PG8_STAGE(PG8_SA(1, 0), cA + kstep, voffA); PG8_STAGE(PG8_SB(1, 1), cB + hstep + kstep, voffB);
        PG8_WAIT_V(6); PG8_BAR;
    }
    for (;;) {
        const bool has_next = S.next(ui + 1, nxt);
        const char* nA = has_next ? (const char*)g.A + (size_t)nxt.pm * tstep : cA; const char* nB = has_next ? (const char*)g.Bt + (size_t)nxt.pn * tstep : cB;
        for (int t = 0; t < nt; t += 2) {
            const bool last = (t == nt - 2);
            const char* a1 = cA + (size_t)(t + 1) * kstep;
            const char* a2 = last ? nA : cA + (size_t)(t + 2) * kstep; const char* b2 = last ? nB : cB + (size_t)(t + 2) * kstep;
            const char* a3 = a2 + kstep; const char* b3 = b2 + kstep;
            if (last && has_next) S.a_ready(nxt);
            if constexpr (SP2) {
            PG8_LDB(B0, 0, 0); PG8_LDB(B1, 0, 1); PG8_SCHED; PG8_LDA(At, 0, 0); PG8_STAGE(PG8_SA(1, 1), a1 + hstep, voffA);
            PG8_WAIT_V(8); PG8_WAIT_L(0); PG8_BAR; PG8_MMA(0, 0, At, B0); PG8_MMA(0, 1, At, B1); PG8_BAR; PG8_SCHED;
            PG8_LDA(At, 0, 1); PG8_STAGE(PG8_SB(0, 0), b2, voffB); PG8_STAGE(PG8_SB(0, 1), b2 + hstep, voffB); PG8_STAGE(PG8_SA(0, 0), a2, voffA);
            PG8_WAIT_V(8); PG8_WAIT_L(0); PG8_BAR; PG8_MMA(1, 0, At, B0); PG8_MMA(1, 1, At, B1); PG8_BAR; PG8_SCHED;
            PG8_LDB(B0, 1, 0); PG8_LDB(B1, 1, 1); PG8_SCHED; PG8_LDA(At, 1, 0); PG8_STAGE(PG8_SA(0, 1), a2 + hstep, voffA);
            PG8_WAIT_V(8); PG8_WAIT_L(0); PG8_BAR; PG8_MMA(0, 0, At, B0); PG8_MMA(0, 1, At, B1); PG8_BAR; PG8_SCHED;
            PG8_LDA(At, 1, 1); PG8_STAGE(PG8_SB(1, 0), b3, voffB); PG8_STAGE(PG8_SB(1, 1), b3 + hstep, voffB); PG8_STAGE(PG8_SA(1, 0), a3, voffA);
            PG8_WAIT_V(8); PG8_WAIT_L(0); PG8_BAR; PG8_MMA(1, 0, At, B0); PG8_MMA(1, 1, At, B1); PG8_BAR; PG8_SCHED;
            } else {
            PG8_LDB(B0, 0, 0); PG8_SCHED; PG8_LDA(At, 0, 0); PG8_STAGE(PG8_SA(1, 1), a1 + hstep, voffA);
            PG8_WAIT_L(8); PG8_BAR; PG8_WAIT_L(0); PG8_MMA(0, 0, At, B0); PG8_BAR; PG8_SCHED;
            PG8_LDB(B1, 0, 1); PG8_STAGE(PG8_SB(0, 0), b2, voffB);
            PG8_BAR; PG8_WAIT_L(0); PG8_MMA(0, 1, At, B1); PG8_BAR;
            PG8_LDA(At, 0, 1); PG8_STAGE(PG8_SA(0, 0), a2, voffA);
            PG8_BAR; PG8_WAIT_L(0); PG8_MMA(1, 0, At, B0); PG8_BAR; PG8_SCHED;
            PG8_STAGE(PG8_SB(0, 1), b2 + hstep, voffB);
            PG8_WAIT_V(6); PG8_BAR; PG8_MMA(1, 1, At, B1); PG8_BAR;
            PG8_LDB(B0, 1, 0); PG8_SCHED; PG8_LDA(At, 1, 0); PG8_STAGE(PG8_SA(0, 1), a2 + hstep, voffA);
            PG8_WAIT_L(8); PG8_BAR; PG8_WAIT_L(0); PG8_MMA(0, 0, At, B0); PG8_BAR; PG8_SCHED;
            PG8_LDB(B1, 1, 1); PG8_STAGE(PG8_SB(1, 0), b3, voffB);
            PG8_BAR; PG8_WAIT_L(0); PG8_MMA(0, 1, At, B1); PG8_BAR;
            PG8_LDA(At, 1, 1); PG8_STAGE(PG8_SA(1, 0), a3, voffA);
            PG8_BAR; PG8_WAIT_L(0); PG8_MMA(1, 0, At, B0); PG8_BAR; PG8_SCHED;
            PG8_STAGE(PG8_SB(1, 1), b3 + hstep, voffB);
            PG8_WAIT_V(6); PG8_BAR; PG8_MMA(1, 1, At, B1); PG8_BAR;
            }
        }
        if constexpr (ALIGN_EPI) { if (wr == 0) PG8_BAR; }
        if constexpr (!Epi::AFTER_DRAIN) { E(acc, cur, wr, wc, fr, fq); S.done(cur); }
        if (!has_next) break;
#pragma unroll
        for (int a = 0; a < 2; ++a)
#pragma unroll
            for (int b = 0; b < 2; ++b)
#pragma unroll
                for (int m = 0; m < 4; ++m)
#pragma unroll
                    for (int n = 0; n < 2; ++n) acc[a][b][m][n] = (f32x4){0.f, 0.f, 0.f, 0.f};
        cur = nxt; cA = nA; cB = nB; ++ui;
        if constexpr (ALIGN_EPI) { if (wr == 1) PG8_BAR; }
    }
    PG8_WAIT_V(0);
    if constexpr (!ALIGN_EPI) { if (wr == 0) PG8_BAR; }
    PG8_BAR;
    if constexpr (Epi::AFTER_DRAIN) { E.fused(acc, cur, wr, wc, fr, fq, lds, wid, lane); S.done(cur); }
#undef PG8_SA
#undef PG8_SB
#undef PG8_STAGE
#undef PG8_LDA
#undef PG8_LDB
#undef PG8_MMA
#undef PG8_WAIT_V
#undef PG8_WAIT_L
#undef PG8_BAR
#undef PG8_SCHED
}
}
#define GAS __attribute__((address_space(1)))
#define LAS __attribute__((address_space(3)))
typedef unsigned short bf16;
typedef unsigned v4u __attribute__((ext_vector_type(4)));
typedef float f32x4 __attribute__((ext_vector_type(4)));
typedef short bf16x8 __attribute__((ext_vector_type(8)));
typedef GAS unsigned gu32;
typedef GAS unsigned long long gu64;
#define RLX_AGENT __ATOMIC_RELAXED, __HIP_MEMORY_SCOPE_AGENT
#define LDS_WAIT() asm volatile("s_waitcnt lgkmcnt(0)" ::: "memory")
#define VM_WAIT() asm volatile("s_waitcnt vmcnt(0)" ::: "memory")
__device__ __forceinline__ unsigned long long rt() { return __builtin_amdgcn_s_memrealtime(); }
__device__ __forceinline__ unsigned f2bf(float f) { unsigned u = __builtin_bit_cast(unsigned, f); return (u + 0x7fffu + ((u >> 16) & 1u)) >> 16; }
__device__ __forceinline__ unsigned pk2(float lo, float hi) { return f2bf(lo) | (f2bf(hi) << 16); }

#define XB_TMO      128
#define XB_XCNT(j)  (256  + 64 * (j))
#define XB_XSUB(j)  (1280 + 64 * (j))
#define XB_XGEN(j)  (2304 + 64 * (j))
#define XB_TOP      3328
#define XB_TOPGEN   3392
#define XCD_BAR_WORDS 3456
#define XB_SPIN_CAP (1u << 18)

__device__ __forceinline__ unsigned xb_ld(unsigned* p)              { return __hip_atomic_load(p, __ATOMIC_RELAXED, __HIP_MEMORY_SCOPE_AGENT); }
__device__ __forceinline__ unsigned xb_add(unsigned* p, unsigned v) { return __hip_atomic_fetch_add(p, v, __ATOMIC_RELAXED, __HIP_MEMORY_SCOPE_AGENT); }
__device__ __forceinline__ unsigned xb_xcc_id() { return (unsigned)__builtin_amdgcn_s_getreg((3 << 11) | 20) & 0xFu; }
#define XB_SPIN(cond, bar) do { unsigned _sp = 0; while (cond) { __builtin_amdgcn_s_sleep(1); \
    if ((++_sp & 255u) == 0u) { if (xb_ld(&(bar)[XB_TMO])) break; if (_sp > XB_SPIN_CAP) { atomicAdd(&(bar)[XB_TMO], 1u); break; } } } } while (0)

struct XcdBarrier {
    unsigned* bar; unsigned x;
    volatile LAS unsigned* st;
};

__device__ __forceinline__ XcdBarrier xcd_barrier_post(unsigned* bar, volatile LAS unsigned* st) {
    XcdBarrier b; b.bar = bar; b.x = xb_xcc_id(); b.st = st;
    if (threadIdx.x == 0) (void)xb_add(&bar[XB_XCNT(b.x)], 1u);
    return b;
}
__device__ __forceinline__ void xcd_barrier_complete(unsigned* bar, unsigned x, unsigned& nloc, unsigned& nx) {
    const unsigned G = gridDim.x * gridDim.y * gridDim.z;
    unsigned sum, cnt, mine, sp = 0u;
    for (;;) {
        sum = 0u; cnt = 0u; mine = 0u;
#pragma unroll
        for (unsigned j = 0; j < 16; ++j) { const unsigned c = xb_ld(&bar[XB_XCNT(j)]); sum += c; cnt += (c > 0u) ? 1u : 0u; mine = (j == x) ? c : mine; }
        if (sum == G) break;
        __builtin_amdgcn_s_sleep(1);
        if ((++sp & 255u) == 0u) { if (xb_ld(&bar[XB_TMO])) break; if (sp > XB_SPIN_CAP) { atomicAdd(&bar[XB_TMO], 1u); break; } }
    }
    nloc = mine > 0u ? mine : 1u; nx = cnt > 0u ? cnt : 1u;
}

__device__ __forceinline__ void xcd_barrier(const XcdBarrier& b) {
    asm volatile("s_waitcnt vmcnt(0)" ::: "memory");
    __syncthreads();
    if (threadIdx.x == 0) {
        unsigned* bar = b.bar;
        __builtin_amdgcn_s_waitcnt(0);
        unsigned nloc = b.st[0], nx = b.st[1];
        if (nloc == 0u) { xcd_barrier_complete(bar, b.x, nloc, nx); b.st[0] = nloc; b.st[1] = nx; }
        const unsigned old = xb_add(&bar[XB_XSUB(b.x)], 1u);
        const unsigned gen = old / nloc;
        if (old + 1u == (gen + 1u) * nloc) {
            __builtin_amdgcn_fence(__ATOMIC_RELEASE, "agent");
            asm volatile("s_waitcnt vmcnt(0)" ::: "memory");
            const unsigned og = xb_add(&bar[XB_TOP], 1u);
            const unsigned tg = og / nx;
            if (og + 1u == (tg + 1u) * nx) xb_add(&bar[XB_TOPGEN], 1u);
            else XB_SPIN(xb_ld(&bar[XB_TOPGEN]) == tg, bar);
            __builtin_amdgcn_fence(__ATOMIC_ACQUIRE, "agent");
            xb_add(&bar[XB_XGEN(b.x)], 1u);
            asm volatile("s_waitcnt vmcnt(0)" ::: "memory");
        } else {
            XB_SPIN(xb_ld(&bar[XB_XGEN(b.x)]) == gen, bar);
            __builtin_amdgcn_fence(__ATOMIC_ACQUIRE, "agent");
            asm volatile("s_waitcnt vmcnt(0)" ::: "memory");
        }
    }
    __syncthreads();
}
constexpr int BATCH = 4, T = 4096, DM = 2048, DEPTH = 4, M = BATCH * T;
constexpr int D_IN = 6600, NPROJ = 6656;
constexpr int SC_MLQK = 0, SC_MLV = 1024, SC_MLI = 1536, SC_MLF = 1540, SC_MLO = 1544, SC_MLZ = 2056, SC_CQ = 2568, SC_CKV = 3080, SC_KR = 3336, SC_MLAZ = 3400, SC_RW = 4424, SC_RWZ = 6088;
constexpr int PC_MLQK = 0, PC_MLV = 1024, PC_MLO = 1536, PC_MLZ = 2048, PC_CQ = 2560, PC_CKV = 3072, PC_MLAZ = 3328, PC_RW = 4352, PC_SPEC = 5888, PC_RWZ = 6144;
constexpr int SPEC_TILE = PC_SPEC / 256;
constexpr int NQ = 1536, NKV = 2048;
constexpr float NORM_EPS = 1e-6f, RW_GN_EPS = 64e-5f;
typedef unsigned short bf16_t;
__device__ __forceinline__ float bf2f(unsigned v) { return __uint_as_float(v << 16); }
__device__ __forceinline__ float wave_sum(float v) {
#pragma unroll
    for (int o = 1; o < 64; o <<= 1) v += __shfl_xor(v, o);
    return v;
}
__device__ __forceinline__ float sigmoidf_(float x) { return 1.f / (1.f + __expf(-x)); }
__device__ __forceinline__ float siluf_(float x) { return x / (1.f + __expf(-x)); }
__device__ __forceinline__ float softplusf_(float x) { return fmaxf(x, 0.f) + log1pf(__expf(-fabsf(x))); }

namespace att {
typedef unsigned short bf16_t;
typedef short bf16x8 __attribute__((ext_vector_type(8)));
typedef short s16x4 __attribute__((ext_vector_type(4)));
typedef float f32x16 __attribute__((ext_vector_type(16)));
typedef float f32x4 __attribute__((ext_vector_type(4)));
typedef unsigned u32x4 __attribute__((ext_vector_type(4)));
constexpr int NW = 8, QBLK = 32, KVBLK = 64, QB = NW * QBLK;
constexpr int QP = 1536, KVP = 2048, KRP = 64, OP = 2048;
constexpr int SHM_V = KVBLK * 128 * 2, SHM_K = KVBLK * 128 * 2, SHM_R = KVBLK * 64 * 2;
constexpr int OFF_V = 0, OFF_K = 2 * SHM_V, OFF_R = OFF_K + SHM_K, OFF_WS = OFF_R + SHM_R, OFF_Q = OFF_WS + NW * 64 * 4, LDS_BYTES = OFF_Q + NW * 12288;
constexpr float SCALE = 0.07216878364870322f;
constexpr float THR = 8.f;
constexpr unsigned WBIG = 1u << 30;
#define KSWZ(row, colB) ((row) * 256 + ((colB) ^ (((row) & 7) << 4)))
#define RSWZ(row, colB) ((row) * 128 + ((colB) ^ (((row) & 7) << 4)))
#define SBAR() __builtin_amdgcn_sched_barrier(0)
__device__ __forceinline__ int v_st(int k, int c) { const int kk = (k & ~0xC) | ((k & 4) << 1) | ((k & 8) >> 1); return ((kk >> 3) * 4 + (c >> 5)) * 512 + ((kk & 7) * 32 + (c & 31)) * 2; }
__device__ __forceinline__ int v_rd_base(int lane) { return ((lane & 3) << 3) | (((lane >> 2) & 3) << 6) | (((lane >> 4) & 1) << 5) | (((lane >> 5) & 1) << 8); }
constexpr int v_rd_off(int d0, int ks, int half) { return d0 * 512 + ks * 4096 + half * 2048; }
__device__ __forceinline__ int crow(int r, int hi) { return (r & 3) + 8 * (r >> 2) + 4 * hi; }
__device__ __forceinline__ unsigned cvtpk(float lo, float hi) { unsigned r; asm volatile("v_cvt_pk_bf16_f32 %0, %1, %2" : "=v"(r) : "v"(lo), "v"(hi)); return r; }
__device__ __forceinline__ bf16x8 load8(const bf16_t* p) { return *reinterpret_cast<const bf16x8*>(p); }
__device__ __forceinline__ float bf2f(bf16_t v) { return __uint_as_float((unsigned)v << 16); }
__device__ __forceinline__ void mask_tile(f32x16& p0, f32x16& p1, int dq, unsigned W) {
    const float NEG = -__builtin_inff();
#pragma unroll
    for (int r = 0; r < 16; ++r) {
        const int c = (r & 3) + 8 * (r >> 2);
        if ((unsigned)(dq - c) >= W) p0[r] = NEG;
        if ((unsigned)(dq - c - 32) >= W) p1[r] = NEG;
    }
}
__device__ __forceinline__ void partialSM(f32x16& p0, f32x16& p1, float& m_reg, float& mn, float& alpha) {
    float pmax = p0[0]; for (int r = 1; r < 16; ++r) pmax = fmaxf(pmax, p0[r]); for (int r = 0; r < 16; ++r) pmax = fmaxf(pmax, p1[r]);
    { auto rr = __builtin_amdgcn_permlane32_swap(__float_as_uint(pmax), __float_as_uint(pmax), false, false);
      pmax = fmaxf(__uint_as_float(rr[0]), __uint_as_float(rr[1])); }
    constexpr float C2 = 1.4426950408889634f * SCALE;
    if (__builtin_expect(__all((pmax - m_reg) * SCALE <= THR), 1)) { mn = m_reg; alpha = 1.f; }
    else { mn = fmaxf(m_reg, pmax); alpha = __builtin_amdgcn_exp2f((m_reg - mn) * C2); m_reg = mn; }
    const float mnL = -mn * C2;
    for (int r = 0; r < 16; ++r) p0[r] = fmaf(p0[r], C2, mnL); for (int r = 0; r < 16; ++r) p1[r] = fmaf(p1[r], C2, mnL);
    for (int r = 0; r < 16; ++r) p0[r] = __builtin_amdgcn_exp2f(p0[r]);
}
__device__ __forceinline__ void finishSM(f32x16& p0, f32x16& p1, float alpha, float& l_reg, bf16x8& pa0, bf16x8& pa1, bf16x8& pa2, bf16x8& pa3) {
    for (int r = 0; r < 16; ++r) p1[r] = __builtin_amdgcn_exp2f(p1[r]);
    float ps = 0; for (int r = 0; r < 16; ++r) ps += p0[r]; for (int r = 0; r < 16; ++r) ps += p1[r];
    { auto rr = __builtin_amdgcn_permlane32_swap(__float_as_uint(ps), __float_as_uint(ps), false, false);
      ps = __uint_as_float(rr[0]) + __uint_as_float(rr[1]); }
    l_reg = l_reg * alpha + ps;
#define PK4(P, B_, OUT) do { unsigned a0 = cvtpk(P[B_+0], P[B_+1]), a1 = cvtpk(P[B_+2], P[B_+3]);                          \
        unsigned b0 = cvtpk(P[B_+4], P[B_+5]), b1 = cvtpk(P[B_+6], P[B_+7]);                                             \
        auto r0 = __builtin_amdgcn_permlane32_swap(a0, b0, false, false); auto r1 = __builtin_amdgcn_permlane32_swap(a1, b1, false, false); \
        u32x4 w = {r0[0], r1[0], r0[1], r1[1]}; OUT = *reinterpret_cast<bf16x8*>(&w); } while (0)
    PK4(p0, 0, pa0); PK4(p0, 8, pa1); PK4(p1, 0, pa2); PK4(p1, 8, pa3);
#undef PK4
}
__device__ __forceinline__ void qkt(f32x16& p0, f32x16& p1, const char* K_lds, const char* R_lds, const char* Qw, int r32, int hi) {
    p0 = f32x16{}; p1 = f32x16{};
    const char* kb[4]; const char* rb[4];
#pragma unroll
    for (int dd = 0; dd < 4; ++dd) { kb[dd] = K_lds + KSWZ(r32, (dd * 16 + hi * 8) * 2); rb[dd] = R_lds + RSWZ(r32, (dd * 16 + hi * 8) * 2); }
#pragma unroll
    for (int d0 = 0; d0 < 8; ++d0) { const char* a = kb[d0 & 3] + (d0 >> 2) * 128;
        bf16x8 b0 = *reinterpret_cast<const bf16x8*>(a);
        bf16x8 b1 = *reinterpret_cast<const bf16x8*>(a + 32 * 256);
        bf16x8 q = *reinterpret_cast<const bf16x8*>(Qw + d0 * 1024);
        p0 = __builtin_amdgcn_mfma_f32_32x32x16_bf16(b0, q, p0, 0, 0, 0);
        p1 = __builtin_amdgcn_mfma_f32_32x32x16_bf16(b1, q, p1, 0, 0, 0); }
#pragma unroll
    for (int e = 0; e < 4; ++e) { const char* a = rb[e];
        bf16x8 b0 = *reinterpret_cast<const bf16x8*>(a);
        bf16x8 b1 = *reinterpret_cast<const bf16x8*>(a + 32 * 128);
        bf16x8 q = *reinterpret_cast<const bf16x8*>(Qw + (8 + e) * 1024);
        p0 = __builtin_amdgcn_mfma_f32_32x32x16_bf16(b0, q, p0, 0, 0, 0);
        p1 = __builtin_amdgcn_mfma_f32_32x32x16_bf16(b1, q, p1, 0, 0, 0); }
}
template <int VB>
__device__ __forceinline__ void pv_tile(f32x16* o, int vb0, bf16x8 pa0, bf16x8 pa1, bf16x8 pa2, bf16x8 pa3) {
#define TRRD(dst, off) asm volatile("ds_read_b64_tr_b16 %0, %1 offset:%2" : "=&v"(dst) : "v"(vb0), "i"(off) : "memory")
#define PV_D0(d0) do { s16x4 l0, l1, l2, l3, h0, h1, h2, h3; constexpr int b_ = OFF_V + VB * SHM_V + v_rd_off(d0, 0, 0); \
        TRRD(l0, b_); TRRD(h0, b_ + 2048); TRRD(l1, b_ + 4096); TRRD(h1, b_ + 6144); TRRD(l2, b_ + 8192); TRRD(h2, b_ + 10240); TRRD(l3, b_ + 12288); TRRD(h3, b_ + 14336); \
        asm volatile("s_waitcnt lgkmcnt(0)" ::: "memory"); SBAR();   \
        o[d0] = __builtin_amdgcn_mfma_f32_32x32x16_bf16(pa0, (bf16x8){l0[0], l0[1], l0[2], l0[3], h0[0], h0[1], h0[2], h0[3]}, o[d0], 0, 0, 0);   \
        o[d0] = __builtin_amdgcn_mfma_f32_32x32x16_bf16(pa1, (bf16x8){l1[0], l1[1], l1[2], l1[3], h1[0], h1[1], h1[2], h1[3]}, o[d0], 0, 0, 0);   \
        o[d0] = __builtin_amdgcn_mfma_f32_32x32x16_bf16(pa2, (bf16x8){l2[0], l2[1], l2[2], l2[3], h2[0], h2[1], h2[2], h2[3]}, o[d0], 0, 0, 0);   \
        o[d0] = __builtin_amdgcn_mfma_f32_32x32x16_bf16(pa3, (bf16x8){l3[0], l3[1], l3[2], l3[3], h3[0], h3[1], h3[2], h3[3]}, o[d0], 0, 0, 0); } while (0)
    PV_D0(0); PV_D0(1); PV_D0(2); PV_D0(3);
#undef PV_D0
#undef TRRD
}
struct BlockRef { const bf16_t* Q; const bf16_t* K; const bf16_t* V; const bf16_t* KR; bf16_t* O; const bf16_t* Z; const float* CSq; int P0; };
struct Seam { bf16x8 qr[12]; bf16x8 st_v0, st_v1, st_k0, st_k1, st_r; };
#define ROWKV(p, k0, rr) ((p) + (size_t)((k0) + (rr)) * KVP + sc)
#define VMW() asm volatile("s_waitcnt vmcnt(0)" ::: "memory")
#define VMWN(n) asm volatile("s_waitcnt vmcnt(%0)" :: "i"(n) : "memory")
#define SLOAD_H(Kp, Vp, Rp, k0) do { S.st_v0 = load8(ROWKV(Vp, k0, sr)); S.st_v1 = load8(ROWKV(Vp, k0, 32 + sr));              \
                         S.st_k0 = load8(ROWKV(Kp, k0, sr)); S.st_k1 = load8(ROWKV(Kp, k0, 32 + sr)); S.st_r = load8((Rp) + (size_t)((k0) + rr_) * KRP + rc_); } while (0)
#define SWRITE_HK() do { *(bf16x8*)(K_lds + kws) = S.st_k0; *(bf16x8*)(K_lds + kws + 32 * 256) = S.st_k1; *(bf16x8*)(R_lds + rws) = S.st_r; } while (0)
#define SWRITE_HV(bf) do { *(bf16x8*)(V_lds + (bf) * SHM_V + vst0) = S.st_v0; *(bf16x8*)(V_lds + (bf) * SHM_V + vst1) = S.st_v1; } while (0)
#define SWRITE_H(bf) do { SWRITE_HV(bf); SWRITE_HK(); } while (0)
__device__ __forceinline__ void attn_prime(const BlockRef& cur, char* lds, Seam& S) {
    int tid_o = threadIdx.x; asm volatile("" : "+v"(tid_o));
    const int tid = tid_o, wid = __builtin_amdgcn_readfirstlane(tid >> 6), lane = tid & 63, r32 = lane & 31, hi = lane >> 5;
    const int sr = tid >> 4, sc = (tid & 15) * 8, kws = KSWZ(sr, sc * 2), rr_ = tid >> 3, rc_ = (tid & 7) * 8, rws = RSWZ(rr_, rc_ * 2);
    char* K_lds = lds + OFF_K; char* R_lds = lds + OFF_R;
#pragma unroll
    for (int d0 = 0; d0 < 12; ++d0) S.qr[d0] = load8(cur.Q + (size_t)(wid * QBLK + r32) * QP + d0 * 16 + hi * 8);
    SLOAD_H(cur.K, cur.V, cur.KR, 0); VMW(); SWRITE_HK();
    __syncthreads();
}
__device__ __forceinline__ void attn_block(const BlockRef& cur, const BlockRef& nxt, char* lds, Seam& S) {
    int tid_o = threadIdx.x; asm volatile("" : "+v"(tid_o));
    const int tid = tid_o, wid = __builtin_amdgcn_readfirstlane(tid >> 6), lane = tid & 63, r32 = lane & 31, hi = lane >> 5;
    const int NT = cur.P0 / KVBLK + 4;
    const int qlo = cur.P0 + wid * QBLK, qm = qlo + r32 - 4 * hi;
    char* V_lds = lds + OFF_V; char* K_lds = lds + OFF_K; char* R_lds = lds + OFF_R;
    float* ws = (float*)(lds + OFF_WS) + wid * 64; float* li_l = ws, * al_l = ws + 32;
    float m_reg = -1e30f, l_reg = 0; f32x16 o[4] = {};
    const int sr = tid >> 4, sc = (tid & 15) * 8, vst0 = v_st(sr, sc), vst1 = v_st(32 + sr, sc), kws = KSWZ(sr, sc * 2), rr_ = tid >> 3, rc_ = (tid & 7) * 8, rws = RSWZ(rr_, rc_ * 2);
    const int vb0 = (int)(uintptr_t)lds + v_rd_base(lane);
    char* Qw = lds + OFF_Q + wid * 12288 + lane * 16;
    const bf16_t* Kh = cur.K; const bf16_t* Vh = cur.V; const bf16_t* Rh = cur.KR;
#define RESC(a) do { if (__any((a) < 1.f)) { if (hi == 0) al_l[r32] = (a); asm volatile("s_waitcnt lgkmcnt(0)" ::: "memory");              \
                     for (int d_ = 0; d_ < 4; ++d_) for (int r = 0; r < 16; ++r) o[d_][r] *= al_l[crow(r, hi)]; } } while (0)
#define KBASE(t) ((t) * KVBLK)
#define MASKT(P0_, P1_, t) do { const int kb_ = KBASE(t); if (kb_ + KVBLK - 1 > qlo) mask_tile(P0_, P1_, qm - kb_, WBIG); } while (0)
    constexpr int NQL = 12;
#define SEAM_K0() do { VMWN(NQL); SWRITE_HK(); SBAR(); } while (0)
    f32x16 pA0, pA1, pB0, pB1; float mnA, mnB, alA, alB; bf16x8 pa0, pa1, pa2, pa3;
#pragma unroll
    for (int e = 0; e < 4; ++e) { const f32x4* cp = (const f32x4*)(cur.CSq + (size_t)(wid * QBLK + r32) * 64 + (e * 8 + hi * 4) * 2); const f32x4 c0 = cp[0], c1 = cp[1];
        const bf16x8 raw = S.qr[8 + e]; float x[8];
#pragma unroll
        for (int j = 0; j < 8; ++j) x[j] = __uint_as_float((unsigned)(unsigned short)raw[j] << 16);
        u32x4 w;
        w.x = cvtpk(x[0] * c0[0] - x[1] * c0[1], x[1] * c0[0] + x[0] * c0[1]); w.y = cvtpk(x[2] * c0[2] - x[3] * c0[3], x[3] * c0[2] + x[2] * c0[3]);
        w.z = cvtpk(x[4] * c1[0] - x[5] * c1[1], x[5] * c1[0] + x[4] * c1[1]); w.w = cvtpk(x[6] * c1[2] - x[7] * c1[3], x[7] * c1[2] + x[6] * c1[3]);
        S.qr[8 + e] = *reinterpret_cast<bf16x8*>(&w); }
#pragma unroll
    for (int d0 = 0; d0 < 12; ++d0) *(bf16x8*)(Qw + d0 * 1024) = S.qr[d0];
    SWRITE_HV(0); SBAR();
    SLOAD_H(Kh, Vh, Rh, KBASE(1));
    SBAR(); qkt(pA0, pA1, K_lds, R_lds, Qw, r32, hi);
    MASKT(pA0, pA1, 0); partialSM(pA0, pA1, m_reg, mnA, alA);
    __syncthreads();
    VMW(); SWRITE_H(1);
    __syncthreads();
#define HALF_STEP(PX0, PX1, mnX, alX, PY0, PY1, alY, t, VB, SB) do {                                                          \
        SBAR(); qkt(PX0, PX1, K_lds, R_lds, Qw, r32, hi);                                                                     \
        finishSM(PY0, PY1, alY, l_reg, pa0, pa1, pa2, pa3); SBAR();                                                           \
        if ((t) + 1 < NT) { SLOAD_H(Kh, Vh, Rh, KBASE((t) + 1)); SBAR(); }                                                    \
        pv_tile<VB>(o, vb0, pa0, pa1, pa2, pa3); MASKT(PX0, PX1, (t)); partialSM(PX0, PX1, m_reg, mnX, alX);                  \
        __syncthreads();                                                                                                      \
        if ((t) + 1 < NT) { VMW(); SWRITE_H(SB); }                                                                            \
        RESC(alX); __syncthreads(); } while (0)
    for (int t = 1; t + 1 < NT; t += 2) {
        HALF_STEP(pB0, pB1, mnB, alB, pA0, pA1, alA, t, 0, 0);
        HALF_STEP(pA0, pA1, mnA, alA, pB0, pB1, alB, t + 1, 1, 1);
    }
    SBAR(); qkt(pB0, pB1, K_lds, R_lds, Qw, r32, hi); SBAR();
    SLOAD_H(nxt.K, nxt.V, nxt.KR, 0); SBAR();
    finishSM(pA0, pA1, alA, l_reg, pa0, pa1, pa2, pa3); SBAR();
    pv_tile<0>(o, vb0, pa0, pa1, pa2, pa3);
    MASKT(pB0, pB1, NT - 1); partialSM(pB0, pB1, m_reg, mnB, alB); __syncthreads(); RESC(alB);
    finishSM(pB0, pB1, alB, l_reg, pa0, pa1, pa2, pa3); SBAR(); pv_tile<1>(o, vb0, pa0, pa1, pa2, pa3);
    SBAR();
#pragma unroll
    for (int d0 = 0; d0 < 12; ++d0) S.qr[d0] = load8(nxt.Q + (size_t)(wid * QBLK + r32) * QP + d0 * 16 + hi * 8);
    SBAR(); SEAM_K0();
    if (hi == 0) li_l[r32] = l_reg; asm volatile("s_waitcnt lgkmcnt(0)" ::: "memory");
    float rli[16];
#pragma unroll
    for (int r = 0; r < 16; ++r) rli[r] = __builtin_amdgcn_rcpf(li_l[crow(r, hi)]);
    bf16_t* Ow = cur.O + (size_t)(wid * QBLK) * OP; const bf16_t* Zw = cur.Z + (size_t)(wid * QBLK) * NPROJ;
#pragma unroll
    for (int r = 0; r < 16; ++r) { const int orow = crow(r, hi);
#pragma unroll
        for (int d0 = 0; d0 < 4; ++d0) { const float z = bf2f(Zw[(size_t)orow * NPROJ + d0 * 32 + r32]);
            const float v = o[d0][r] * rli[r] * (z / (1.f + __expf(-z)));
            const float vn = __shfl_xor(v, 1);
            if ((r32 & 1) == 0) *(unsigned*)(Ow + (size_t)orow * OP + d0 * 32 + r32) = cvtpk(v, vn); } }
    __syncthreads();
#undef RESC
#undef KBASE
#undef MASKT
#undef SEAM_K0
#undef HALF_STEP
}
#undef ROWKV
#undef VMW
#undef VMWN
#undef SLOAD_H
#undef SWRITE_HK
#undef SWRITE_HV
#undef SWRITE_H
#undef KSWZ
#undef RSWZ
#undef SBAR
}
namespace mm {
typedef short bf16x8 __attribute__((ext_vector_type(8)));
typedef float f32x4 __attribute__((ext_vector_type(4)));
typedef unsigned u32x2 __attribute__((ext_vector_type(2)));
#define MM_LAS __attribute__((address_space(3)))
typedef float f32x2_t __attribute__((ext_vector_type(2))); typedef __bf16 bf16x2_t __attribute__((ext_vector_type(2)));
__device__ __forceinline__ unsigned cvtpk(float lo, float hi) { const f32x2_t v = {lo, hi}; const bf16x2_t b = __builtin_convertvector(v, bf16x2_t); return __builtin_bit_cast(unsigned, b); }
template <int NK>
__device__ __forceinline__ void blk(f32x4& acc, const MM_LAS unsigned char* A, int apitch, const MM_LAS unsigned char* Bt, int bpitch, int lane) {
    const MM_LAS unsigned char* ap = A + (lane & 15) * apitch + (lane >> 4) * 16;
    const MM_LAS unsigned char* bp = Bt + (lane & 15) * bpitch + (lane >> 4) * 16;
#pragma unroll
    for (int ks = 0; ks < NK; ++ks) { const bf16x8 a = *(const MM_LAS bf16x8*)(ap + ks * 64), b = *(const MM_LAS bf16x8*)(bp + ks * 64); acc = __builtin_amdgcn_mfma_f32_16x16x32_bf16(a, b, acc, 0, 0, 0); }
}
__device__ __forceinline__ void store_T(const f32x4& acc, MM_LAS unsigned char* img, int pitch, int jbase, int ibase, int lane) {
    u32x2 w; w.x = cvtpk(acc[0], acc[1]); w.y = cvtpk(acc[2], acc[3]);
    *(MM_LAS u32x2*)(img + (jbase + (lane & 15)) * pitch + (ibase + 4 * (lane >> 4)) * 2) = w;
}
__device__ __forceinline__ float bfl(unsigned short v) { return __uint_as_float((unsigned)v << 16); }
__device__ __forceinline__ unsigned short f2b(float f) { return (unsigned short)(cvtpk(f, 0.f) & 0xffffu); }
}

namespace mlk {
constexpr int PQ = 272, PS = 144;
constexpr int O_QI = 0, O_KI = 17408, O_WKT = 34816, O_VT = 53248, O_CI = 73984, O_SI = 113152, O_TAB = 122368, LDS_END = 124416;
constexpr int HBP = 132;
}
__device__ __forceinline__ void mlstm_unit(unsigned char* lds_g, int b, int h, const bf16_t* QKC, const bf16_t* PROJ, const float* LI, const float* LF, const float* ng, bf16_t* MIXED) {
    using namespace mlk; using mm::f32x4; using mm::bf16x8;
    MM_LAS unsigned char* L = (MM_LAS unsigned char*)lds_g;
    int tid_o = threadIdx.x; asm volatile("" : "+v"(tid_o));
    const int tid = tid_o, lane = tid & 63, wave = __builtin_amdgcn_readfirstlane(tid >> 6);
    MM_LAS unsigned char *QI = L + O_QI, *KI = L + O_KI, *WKT = L + O_WKT, *VT = L + O_VT, *CI = L + O_CI, *SI = L + O_SI;
    MM_LAS float* TAB = (MM_LAS float*)(L + O_TAB);
    MM_LAS float* HB = (MM_LAS float*)L;
    for (int i = tid; i < 39168 / 4; i += 512) ((MM_LAS unsigned*)CI)[i] = 0u;
    for (int i = tid; i < 16 * PS / 4; i += 512) ((MM_LAS unsigned*)(VT + 128 * PS))[i] = (i < PS / 4) ? 0x3f803f80u : 0u;
    f32x4 cacc[9];
#pragma unroll
    for (int i = 0; i < 9; ++i) cacc[i] = (f32x4){0.f, 0.f, 0.f, 0.f};
    float m_run = 0.f;
    const int t = lane, cg = wave;
    const size_t mrow0 = (size_t)b * T;
    bf16x8 q0, q1, k0, k1, v0, v1; float li = 0.f, lf = 0.f;
#define ML_LOAD(c_) do { const size_t m_ = mrow0 + (size_t)(c_) * 64 + t; const bf16_t* qp = QKC + m_ * 1024 + h * 128 + 16 * cg; const bf16_t* vp = PROJ + m_ * NPROJ + PC_MLV + h * 128 + 16 * cg; \
        q0 = *(const bf16x8*)qp; q1 = *(const bf16x8*)(qp + 8); k0 = *(const bf16x8*)(qp + 512); k1 = *(const bf16x8*)(qp + 520); v0 = *(const bf16x8*)vp; v1 = *(const bf16x8*)(vp + 8); \
        if (wave == 0) { li = LI[m_ * 4 + h]; lf = LF[m_ * 4 + h]; } } while (0)
    ML_LOAD(0);
    const int et = tid >> 3, ep = tid & 7;
    f32x4 ngr[4];
#pragma unroll
    for (int i = 0; i < 4; ++i) ngr[i] = *(const f32x4*)(ng + 16 * ep + 4 * i);
    typedef unsigned u32x4_ __attribute__((ext_vector_type(4)));
    for (int c = 0; c < 64; ++c) {
        const size_t em_ = mrow0 + (size_t)c * 64 + et;
        const u32x4_ eo0 = *(const u32x4_*)(PROJ + em_ * NPROJ + PC_MLO + h * 128 + 16 * ep), eo1 = *(const u32x4_*)(PROJ + em_ * NPROJ + PC_MLO + h * 128 + 16 * ep + 8);
        const u32x4_ ez0 = *(const u32x4_*)(PROJ + em_ * NPROJ + PC_MLZ + h * 128 + 16 * ep), ez1 = *(const u32x4_*)(PROJ + em_ * NPROJ + PC_MLZ + h * 128 + 16 * ep + 8);
        if (wave == 0) {
            float bb = lf;
#pragma unroll
            for (int o = 1; o < 64; o <<= 1) { const float u = __shfl_up(bb, o); if (lane >= o) bb += u; }
            const float a = li - bb; float pm = a;
#pragma unroll
            for (int o = 1; o < 64; o <<= 1) { const float u = __shfl_up(pm, o); if (lane >= o) pm = fmaxf(pm, u); }
            const float mx = fmaxf(m_run, pm), mxL = __shfl(mx, 63), bL = __shfl(bb, 63);
            TAB[t] = a; TAB[64 + t] = mx; TAB[128 + t] = __expf(m_run - mx); TAB[192 + t] = __expf(-(bb + mx)); TAB[256 + t] = __expf(a - mxL);
            if (lane == 0) TAB[320] = __expf(m_run - mxL);
            m_run = bL + mxL;
        }
        __syncthreads();
        {
            *(MM_LAS bf16x8*)(QI + t * PQ + cg * 32) = q0; *(MM_LAS bf16x8*)(QI + t * PQ + cg * 32 + 16) = q1;
            *(MM_LAS bf16x8*)(KI + t * PQ + cg * 32) = k0; *(MM_LAS bf16x8*)(KI + t * PQ + cg * 32 + 16) = k1;
            const float wt = TAB[256 + t];
#pragma unroll
            for (int e = 0; e < 8; ++e) {
                *(MM_LAS unsigned short*)(WKT + (16 * cg + e) * PS + t * 2) = mm::f2b(wt * mm::bfl((unsigned short)k0[e]));
                *(MM_LAS unsigned short*)(WKT + (16 * cg + 8 + e) * PS + t * 2) = mm::f2b(wt * mm::bfl((unsigned short)k1[e]));
                *(MM_LAS unsigned short*)(VT + (16 * cg + e) * PS + t * 2) = (unsigned short)v0[e];
                *(MM_LAS unsigned short*)(VT + (16 * cg + 8 + e) * PS + t * 2) = (unsigned short)v1[e]; }
        }
        if (c + 1 < 64) ML_LOAD(c + 1);
        __syncthreads();
        {
            const int bi = wave >> 1;
#pragma unroll
            for (int jj = 0; jj < 2; ++jj) { const int bj = 2 * (wave & 1) + jj; f32x4 acc = (f32x4){0.f, 0.f, 0.f, 0.f};
                if (bi <= bj) { mm::blk<4>(acc, KI + bi * 16 * PQ, PQ, QI + bj * 16 * PQ, PQ, lane);
                    const int tt = 16 * bj + (lane & 15); const float mxt = TAB[64 + tt];
#pragma unroll
                    for (int r = 0; r < 4; ++r) { const int s = 16 * bi + 4 * (lane >> 4) + r; acc[r] = (s <= tt) ? acc[r] * __expf(TAB[s] - mxt) : 0.f; } }
                mm::store_T(acc, SI, PS, 16 * bj, 16 * bi, lane); }
        }
        __syncthreads();
        f32x4 res[5];
        {
#pragma unroll
            for (int n = 0; n < 5; ++n) { const int id = wave + 8 * n; res[n] = (f32x4){0.f, 0.f, 0.f, 0.f};
                if (id < 36) { const int vb = id >> 2, tb = id & 3; f32x4 ai = (f32x4){0.f, 0.f, 0.f, 0.f}, aa = (f32x4){0.f, 0.f, 0.f, 0.f};
                    mm::blk<4>(ai, QI + tb * 16 * PQ, PQ, CI + vb * 16 * PQ, PQ, lane);
                    mm::blk<2>(aa, SI + tb * 16 * PS, PS, VT + vb * 16 * PS, PS, lane);
#pragma unroll
                    for (int r = 0; r < 4; ++r) res[n][r] = TAB[128 + 16 * tb + 4 * (lane >> 4) + r] * ai[r] + aa[r]; } }
            const float decay = TAB[320];
#pragma unroll
            for (int vb = 0; vb < 9; ++vb) { cacc[vb] = cacc[vb] * decay; mm::blk<2>(cacc[vb], WKT + wave * 16 * PS, PS, VT + vb * 16 * PS, PS, lane); }
        }
        const float em_l = TAB[192 + 16 * (wave & 3) + 4 * (lane >> 4) + 0], em_1 = TAB[192 + 16 * (wave & 3) + 4 * (lane >> 4) + 1], em_2 = TAB[192 + 16 * (wave & 3) + 4 * (lane >> 4) + 2], em_3 = TAB[192 + 16 * (wave & 3) + 4 * (lane >> 4) + 3];
        __syncthreads();
        {
#pragma unroll
            for (int n = 0; n < 5; ++n) { const int id = wave + 8 * n;
                if (id < 36) { const int vb = id >> 2, tb = id & 3, j = lane & 15;
#pragma unroll
                    for (int r = 0; r < 4; ++r) { const int tt = 16 * tb + 4 * (lane >> 4) + r;
                        if (vb < 8 || j == 0) HB[tt * HBP + 16 * vb + j] = res[n][r];
                        else if (j == 1) HB[tt * HBP + 129] = (r == 0 ? em_l : r == 1 ? em_1 : r == 2 ? em_2 : em_3); } } }
#pragma unroll
            for (int vb = 0; vb < 9; ++vb) mm::store_T(cacc[vb], CI, PQ, 16 * vb, 16 * wave, lane);
        }
        __syncthreads();
        {
            const MM_LAS float* hr = HB + et * HBP; const float rdn = 1.f / fmaxf(fabsf(hr[128]), hr[129]);
            f32x4 hv[4]; float sm = 0.f;
#pragma unroll
            for (int i = 0; i < 4; ++i) { hv[i] = *(const MM_LAS f32x4*)(hr + 16 * ep + 4 * i) * rdn; sm += (hv[i][0] + hv[i][1]) + (hv[i][2] + hv[i][3]); }
            sm += __shfl_xor(sm, 1); sm += __shfl_xor(sm, 2); sm += __shfl_xor(sm, 4);
            const float mean = sm * (1.f / 128.f); float sq = 0.f;
#pragma unroll
            for (int i = 0; i < 4; ++i) { hv[i] = hv[i] - mean; sq += (hv[i][0] * hv[i][0] + hv[i][1] * hv[i][1]) + (hv[i][2] * hv[i][2] + hv[i][3] * hv[i][3]); }
            sq += __shfl_xor(sq, 1); sq += __shfl_xor(sq, 2); sq += __shfl_xor(sq, 4);
            const float rstd = 1.f / sqrtf(sq * (1.f / 128.f) + NORM_EPS);
            u32x4_ o0, o1;
#pragma unroll
            for (int i = 0; i < 4; ++i) { const unsigned go0 = (i < 2 ? eo0 : eo1)[(2 * i) & 3], go1 = (i < 2 ? eo0 : eo1)[(2 * i + 1) & 3], gz0 = (i < 2 ? ez0 : ez1)[(2 * i) & 3], gz1 = (i < 2 ? ez0 : ez1)[(2 * i + 1) & 3];
                const float g0 = siluf_(bf2f(gz0 & 0xffffu)) * sigmoidf_(bf2f(go0 & 0xffffu)), g1 = siluf_(bf2f(gz0 >> 16)) * sigmoidf_(bf2f(go0 >> 16));
                const float g2 = siluf_(bf2f(gz1 & 0xffffu)) * sigmoidf_(bf2f(go1 & 0xffffu)), g3 = siluf_(bf2f(gz1 >> 16)) * sigmoidf_(bf2f(go1 >> 16));
                const unsigned w0 = mm::cvtpk(g0 * hv[i][0] * rstd * ngr[i][0], g1 * hv[i][1] * rstd * ngr[i][1]), w1 = mm::cvtpk(g2 * hv[i][2] * rstd * ngr[i][2], g3 * hv[i][3] * rstd * ngr[i][3]);
                if (i < 2) { o0[2 * i] = w0; o0[2 * i + 1] = w1; } else { o1[2 * i - 4] = w0; o1[2 * i - 3] = w1; } }
            *(u32x4_*)(MIXED + em_ * DM + h * 128 + 16 * ep) = o0; *(u32x4_*)(MIXED + em_ * DM + h * 128 + 16 * ep + 8) = o1;
        }
    }
    __syncthreads();
#undef ML_LOAD
}
namespace rwk {
constexpr int PS = 144, SLOT = 9216;
constexpr int S_AT = 0, S_RT = 1, S_BTT = 2, S_KTT = 3, S_VTT = 4, S_AAK = 5, S_ARB = 6, S_ARK = 7, S_ATT = 8, S_TAT = 9, S_Z0 = 10, S_Z1 = 11, S_Z2 = 12, S_Z3 = 13, S_T0 = 14, S_T1 = 15;
constexpr int O_TAB = 16 * SLOT, O_PQ = O_TAB + 256, LDS_END = O_PQ + 4096, FP = 68;
constexpr int REC = 32768, R_RA = 0, R_MT = 8192, R_YC = 16384, R_NT = 24576;
constexpr int NUNITS = BATCH * 8 * 64;
}
__device__ __forceinline__ void rwkv_local(unsigned char* lds_g, int first, int stride, const float* RWW, const bf16_t* RWB, size_t RWS, unsigned char* RWX) {
    using namespace rwk; using mm::f32x4; using mm::bf16x8;
    MM_LAS unsigned char* L = (MM_LAS unsigned char*)lds_g;
    int tid_o = threadIdx.x; asm volatile("" : "+v"(tid_o));
    const int tid = tid_o, lane = tid & 63, wave = __builtin_amdgcn_readfirstlane(tid >> 6);
#define SL(n) (L + (n) * SLOT)
    MM_LAS float* WLT = (MM_LAS float*)(L + O_TAB); MM_LAS float* TF = (MM_LAS float*)SL(S_Z0); MM_LAS float* AF = (MM_LAS float*)SL(S_T0); MM_LAS float* PQ = (MM_LAS float*)(L + O_PQ);
    const int t = lane, cg = wave, bi = wave >> 1, bj0 = 2 * (wave & 1), lj = lane & 15, lq = lane >> 4;
    bf16x8 gr, gk, gv, ga, gb; f32x4 gw0, gw1;
#define RW_LOAD(u_) do { const int bh_ = (u_) >> 6, c_ = (u_) & 63; const size_t o_ = ((size_t)(bh_ >> 3) * T + (size_t)c_ * 64 + t) * 512 + (bh_ & 7) * 64 + 8 * cg; \
        gr = *(const bf16x8*)(RWB + o_); gk = *(const bf16x8*)(RWB + RWS + o_); gv = *(const bf16x8*)(RWB + 2 * RWS + o_); ga = *(const bf16x8*)(RWB + 3 * RWS + o_); gb = *(const bf16x8*)(RWB + 4 * RWS + o_); \
        gw0 = *(const f32x4*)(RWW + o_); gw1 = *(const f32x4*)(RWW + o_ + 4); } while (0)
    if (first >= NUNITS) return;
    RW_LOAD(first);
    for (int u = first; u < NUNITS; u += stride) {
        unsigned char* rec = RWX + (size_t)u * REC;
        __syncthreads();
        {
            float lw[8], cw[8];
#pragma unroll
            for (int e = 0; e < 4; ++e) { lw[e] = gw0[e]; lw[4 + e] = gw1[e]; }
#pragma unroll
            for (int e = 0; e < 8; ++e) { float s = lw[e];
#pragma unroll
                for (int o = 1; o < 64; o <<= 1) { const float u = __shfl_up(s, o); if (lane >= o) s += u; }
                cw[e] = s; }
            float av[8], bv[8], kv[8], rv[8];
#pragma unroll
            for (int e = 0; e < 8; ++e) { const float Wt = __expf(cw[e]), Wp = __expf(cw[e] - lw[e]), iW = __expf(-cw[e]);
                av[e] = mm::bfl((unsigned short)ga[e]) * Wp; bv[e] = mm::bfl((unsigned short)gb[e]) * iW; kv[e] = mm::bfl((unsigned short)gk[e]) * iW; rv[e] = mm::bfl((unsigned short)gr[e]) * Wt;
                if (lane == 63) WLT[8 * cg + e] = Wt; }
            typedef unsigned u32x4_ __attribute__((ext_vector_type(4)));
            u32x4_ pa, pb, pk, pr;
            pa.x = mm::cvtpk(av[0], av[1]); pa.y = mm::cvtpk(av[2], av[3]); pa.z = mm::cvtpk(av[4], av[5]); pa.w = mm::cvtpk(av[6], av[7]);
            pb.x = mm::cvtpk(bv[0], bv[1]); pb.y = mm::cvtpk(bv[2], bv[3]); pb.z = mm::cvtpk(bv[4], bv[5]); pb.w = mm::cvtpk(bv[6], bv[7]);
            pk.x = mm::cvtpk(kv[0], kv[1]); pk.y = mm::cvtpk(kv[2], kv[3]); pk.z = mm::cvtpk(kv[4], kv[5]); pk.w = mm::cvtpk(kv[6], kv[7]);
            pr.x = mm::cvtpk(rv[0], rv[1]); pr.y = mm::cvtpk(rv[2], rv[3]); pr.z = mm::cvtpk(rv[4], rv[5]); pr.w = mm::cvtpk(rv[6], rv[7]);
            *(MM_LAS u32x4_*)(SL(S_AT) + t * PS + cg * 16) = pa; *(MM_LAS u32x4_*)(SL(S_RT) + t * PS + cg * 16) = pr;
            *(MM_LAS u32x4_*)(SL(S_Z0) + t * PS + cg * 16) = pb; *(MM_LAS u32x4_*)(SL(S_Z1) + t * PS + cg * 16) = pk;
#pragma unroll
            for (int e = 0; e < 8; ++e) { const unsigned wb = (e & 1) ? (pb[e >> 1] >> 16) : (pb[e >> 1] & 0xffffu), wk = (e & 1) ? (pk[e >> 1] >> 16) : (pk[e >> 1] & 0xffffu);
                *(MM_LAS unsigned short*)(SL(S_BTT) + (8 * cg + e) * PS + t * 2) = (unsigned short)wb;
                *(MM_LAS unsigned short*)(SL(S_KTT) + (8 * cg + e) * PS + t * 2) = (unsigned short)wk;
                *(MM_LAS unsigned short*)(SL(S_VTT) + (8 * cg + e) * PS + t * 2) = (unsigned short)gv[e];
                *(MM_LAS unsigned short*)(SL(S_ATT) + (8 * cg + e) * PS + t * 2) = (unsigned short)((e & 1) ? (pa[e >> 1] >> 16) : (pa[e >> 1] & 0xffffu)); }
        }
        if (u + stride < NUNITS) RW_LOAD(u + stride);
        __syncthreads();
        {
#pragma unroll
            for (int jj = 0; jj < 2; ++jj) { const int bj = bj0 + jj; const int tt = 16 * bj + lj, s0 = 16 * bi + 4 * lq;
                f32x4 ab = (f32x4){0.f, 0.f, 0.f, 0.f}, ak = ab, rb = ab, rk = ab;
                if (bi <= bj) {
                    mm::blk<2>(ab, SL(S_Z0) + bi * 16 * PS, PS, SL(S_AT) + bj * 16 * PS, PS, lane);
                    mm::blk<2>(ak, SL(S_Z1) + bi * 16 * PS, PS, SL(S_AT) + bj * 16 * PS, PS, lane);
                    mm::blk<2>(rb, SL(S_Z0) + bi * 16 * PS, PS, SL(S_RT) + bj * 16 * PS, PS, lane);
                    mm::blk<2>(rk, SL(S_Z1) + bi * 16 * PS, PS, SL(S_RT) + bj * 16 * PS, PS, lane);
#pragma unroll
                    for (int r = 0; r < 4; ++r) { const int s = s0 + r; if (!(s < tt)) { ab[r] = 0.f; ak[r] = 0.f; } if (!(s <= tt)) { rb[r] = 0.f; rk[r] = 0.f; } } }
                mm::store_T(ak, SL(S_AAK), PS, 16 * bj, 16 * bi, lane); mm::store_T(rb, SL(S_ARB), PS, 16 * bj, 16 * bi, lane); mm::store_T(rk, SL(S_ARK), PS, 16 * bj, 16 * bi, lane);
                *(MM_LAS f32x4*)(AF + tt * FP + s0) = ab; }
        }
        __syncthreads();
        if (wave < 4) { if (lane < 16) {
                float Tc[16]; const MM_LAS float* ar = AF + (16 * wave) * FP + 16 * wave;
#pragma unroll
                for (int r = 0; r < 16; ++r) { float acc = (r == lane) ? 1.f : 0.f;
#pragma unroll
                    for (int q4 = 0; q4 < (r + 3) / 4; ++q4) { const f32x4 a4 = *(const MM_LAS f32x4*)(ar + r * FP + 4 * q4);
#pragma unroll
                        for (int e = 0; e < 4; ++e) if (4 * q4 + e < r) acc += a4[e] * Tc[4 * q4 + e]; }
                    Tc[r] = acc; TF[(16 * wave + r) * FP + 16 * wave + lane] = acc; } } }
        else { const int z = (wave - 4) * 64 + lane, zb = z >> 7, zi = (z >> 4) & 7, zj = z & 15;
#pragma unroll
            for (int hh = 0; hh < 2; ++hh) TF[(32 * zb + zi + 8 * hh) * FP + 32 * zb + 16 + zj] = 0.f; }
        __syncthreads();
        {
            const int pr_ = tid >> 8, i = (tid >> 4) & 15, j = tid & 15, rb = 32 * pr_ + 16, cb = 32 * pr_; float acc = 0.f;
#pragma unroll
            for (int k4 = 0; k4 < 4; ++k4) { const f32x4 a4 = *(const MM_LAS f32x4*)(AF + (rb + i) * FP + cb + 4 * k4);
#pragma unroll
                for (int e = 0; e < 4; ++e) acc += a4[e] * TF[(cb + 4 * k4 + e) * FP + cb + j]; }
            PQ[pr_ * 256 + i * 16 + j] = acc; }
        __syncthreads();
        {
            const int pr_ = tid >> 8, i = (tid >> 4) & 15, j = tid & 15, rb = 32 * pr_ + 16, cb = 32 * pr_; float acc = 0.f;
#pragma unroll
            for (int k4 = 0; k4 < 4; ++k4) { const f32x4 a4 = *(const MM_LAS f32x4*)(TF + (rb + i) * FP + rb + 4 * k4);
#pragma unroll
                for (int e = 0; e < 4; ++e) acc += a4[e] * PQ[pr_ * 256 + (4 * k4 + e) * 16 + j]; }
            TF[(rb + i) * FP + cb + j] = acc; }
        __syncthreads();
        {
            const int i = tid >> 4, jq = tid & 15; float acc0 = 0.f, acc1 = 0.f;
#pragma unroll
            for (int k4 = 0; k4 < 8; ++k4) { const f32x4 a4 = *(const MM_LAS f32x4*)(AF + (32 + i) * FP + 4 * k4);
#pragma unroll
                for (int e = 0; e < 4; ++e) { acc0 += a4[e] * TF[(4 * k4 + e) * FP + jq]; acc1 += a4[e] * TF[(4 * k4 + e) * FP + 16 + jq]; }
                if (k4 & 1) asm volatile("" ::: "memory"); }
            PQ[i * 32 + jq] = acc0; PQ[i * 32 + 16 + jq] = acc1; }
        __syncthreads();
        {
            const int i = tid >> 4, jq = tid & 15; float acc0 = 0.f, acc1 = 0.f;
#pragma unroll
            for (int k4 = 0; k4 < 8; ++k4) { const f32x4 a4 = *(const MM_LAS f32x4*)(TF + (32 + i) * FP + 32 + 4 * k4);
#pragma unroll
                for (int e = 0; e < 4; ++e) { acc0 += a4[e] * PQ[(4 * k4 + e) * 32 + jq]; acc1 += a4[e] * PQ[(4 * k4 + e) * 32 + 16 + jq]; }
                if (k4 & 1) asm volatile("" ::: "memory"); }
            TF[(32 + i) * FP + jq] = acc0; TF[(32 + i) * FP + 16 + jq] = acc1; }
        __syncthreads();
        {
            const int tr = tid >> 3, s8 = (tid & 7) * 8; const f32x4 x0 = *(const MM_LAS f32x4*)(TF + tr * FP + s8), x1 = *(const MM_LAS f32x4*)(TF + tr * FP + s8 + 4);
            float y[8];
#pragma unroll
            for (int e = 0; e < 4; ++e) { y[e] = (s8 + e <= tr) ? x0[e] : 0.f; y[4 + e] = (s8 + 4 + e <= tr) ? x1[e] : 0.f; }
            typedef unsigned u32x4_ __attribute__((ext_vector_type(4))); u32x4_ w;
            w.x = mm::cvtpk(y[0], y[1]); w.y = mm::cvtpk(y[2], y[3]); w.z = mm::cvtpk(y[4], y[5]); w.w = mm::cvtpk(y[6], y[7]);
            *(MM_LAS u32x4_*)(SL(S_T0) + tr * PS + s8 * 2) = w; }
        {
#pragma unroll
            for (int jj = 0; jj < 2; ++jj) { const int bj = bj0 + jj; f32x4 d = (f32x4){0.f, 0.f, 0.f, 0.f};
                mm::blk<2>(d, SL(S_AAK) + bi * 16 * PS, PS, SL(S_VTT) + bj * 16 * PS, PS, lane);
                mm::store_T(d, SL(S_Z2), PS, 16 * bj, 16 * bi, lane); }
        }
        __syncthreads();
        {
#pragma unroll
            for (int jj = 0; jj < 2; ++jj) { const int bj = bj0 + jj; f32x4 d = (f32x4){0.f, 0.f, 0.f, 0.f}, e2 = d;
                mm::blk<2>(d, SL(S_T0) + bi * 16 * PS, PS, SL(S_ATT) + bj * 16 * PS, PS, lane); mm::store_T(d, SL(S_TAT), PS, 16 * bj, 16 * bi, lane);
                mm::blk<2>(e2, SL(S_T0) + bi * 16 * PS, PS, SL(S_Z2) + bj * 16 * PS, PS, lane); mm::store_T(e2, SL(S_Z3), PS, 16 * bj, 16 * bi, lane); }
        }
        __syncthreads();
        {
#pragma unroll
            for (int jj = 0; jj < 2; ++jj) { const int bj = bj0 + jj;
                f32x4 d;
#pragma unroll
                for (int r = 0; r < 4; ++r) d[r] = mm::bfl(*(const MM_LAS unsigned short*)(SL(S_RT) + (16 * bi + 4 * lq + r) * PS + (16 * bj + lj) * 2));
                mm::blk<2>(d, SL(S_ARB) + bi * 16 * PS, PS, SL(S_TAT) + bj * 16 * PS, PS, lane);
#pragma unroll
                for (int r = 0; r < 4; ++r) *(unsigned short*)(rec + R_RA + ((16 * bi + 4 * lq + r) * 64 + 16 * bj + lj) * 2) = mm::f2b(d[r]);
                asm volatile("" ::: "memory");
                f32x4 mt = (f32x4){0.f, 0.f, 0.f, 0.f};
                mm::blk<2>(mt, SL(S_TAT) + bi * 16 * PS, PS, SL(S_BTT) + bj * 16 * PS, PS, lane);
                const float wl = WLT[16 * bj + lj];
#pragma unroll
                for (int r = 0; r < 4; ++r) mt[r] = (mt[r] + ((16 * bi + 4 * lq + r) == (16 * bj + lj) ? 1.f : 0.f)) * wl;
                { mm::u32x2 w; w.x = mm::cvtpk(mt[0], mt[1]); w.y = mm::cvtpk(mt[2], mt[3]); *(mm::u32x2*)(rec + R_MT + ((16 * bj + lj) * 64 + 16 * bi + 4 * lq) * 2) = w; }
                asm volatile("" ::: "memory");
                f32x4 yc = (f32x4){0.f, 0.f, 0.f, 0.f};
                mm::blk<2>(yc, SL(S_ARB) + bi * 16 * PS, PS, SL(S_Z3) + bj * 16 * PS, PS, lane); mm::blk<2>(yc, SL(S_ARK) + bi * 16 * PS, PS, SL(S_VTT) + bj * 16 * PS, PS, lane);
                { mm::u32x2 w; w.x = mm::cvtpk(yc[0], yc[1]); w.y = mm::cvtpk(yc[2], yc[3]); *(mm::u32x2*)(rec + R_YC + (((bi * 4 + bj) * 64) + lane) * 8) = w; }
                asm volatile("" ::: "memory");
                f32x4 nt = (f32x4){0.f, 0.f, 0.f, 0.f};
                mm::blk<2>(nt, SL(S_BTT) + bi * 16 * PS, PS, SL(S_Z3) + bj * 16 * PS, PS, lane); mm::blk<2>(nt, SL(S_KTT) + bi * 16 * PS, PS, SL(S_VTT) + bj * 16 * PS, PS, lane);
#pragma unroll
                for (int r = 0; r < 4; ++r) nt[r] *= WLT[16 * bi + 4 * lq + r];
                { mm::u32x2 w; w.x = mm::cvtpk(nt[0], nt[1]); w.y = mm::cvtpk(nt[2], nt[3]); *(mm::u32x2*)(rec + R_NT + (((bi * 4 + bj) * 64) + lane) * 8) = w; } }
        }
    }
    __syncthreads();
#undef RW_LOAD
}
namespace rws { constexpr int PS = 144, SLOT = 9216, S_RA = 0, S_MT = 1, S_SA = 2, S_SB = 3, O_YB = 4 * SLOT, YP = 68, O_LN = O_YB + 64 * YP * 4, LDS_END = O_LN + 512; }
__device__ __forceinline__ void rwkv_seq(unsigned char* lds_g, int b, int h, const unsigned char* RWX, const bf16_t* RWB, size_t RWS, const float* BONUS, const bf16_t* PROJ, const float* ln_g, const float* ln_b, bf16_t* MIXED) {
    using namespace rws; using mm::f32x4;
    MM_LAS unsigned char* L = (MM_LAS unsigned char*)lds_g;
    int tid_o = threadIdx.x; asm volatile("" : "+v"(tid_o));
    const int tid = tid_o, lane = tid & 63, wave = __builtin_amdgcn_readfirstlane(tid >> 6);
    MM_LAS float* YB = (MM_LAS float*)(L + O_YB); MM_LAS float* LNT = (MM_LAS float*)(L + O_LN);
    for (int i = tid; i < 2 * SLOT / 4; i += 512) ((MM_LAS unsigned*)SL(S_SA))[i] = 0u;
    if (tid < 128) LNT[tid] = tid < 64 ? ln_g[tid] : ln_b[tid - 64];
    const int bi = wave >> 1, bj0 = 2 * (wave & 1), lj = lane & 15, lq = lane >> 4, et = tid >> 3, ep = tid & 7;
    const size_t mrow0 = (size_t)b * T; const unsigned char* rec0 = RWX + (size_t)((b * 8 + h) * 64) * rwk::REC;
    typedef unsigned u32x4e __attribute__((ext_vector_type(4)));
    u32x4e gra, gmt; mm::u32x2 gyc[2], gnt[2];
#define SQ_LOAD(c_) do { const unsigned char* r_ = rec0 + (size_t)(c_) * rwk::REC; gra = *(const u32x4e*)(r_ + rwk::R_RA + tid * 16); gmt = *(const u32x4e*)(r_ + rwk::R_MT + tid * 16); \
        _Pragma("unroll") for (int jj = 0; jj < 2; ++jj) { gyc[jj] = *(const mm::u32x2*)(r_ + rwk::R_YC + (((bi * 4 + bj0 + jj) * 64) + lane) * 8); gnt[jj] = *(const mm::u32x2*)(r_ + rwk::R_NT + (((bi * 4 + bj0 + jj) * 64) + lane) * 8); } } while (0)
    SQ_LOAD(0);
    for (int c = 0; c < 64; ++c) {
        const size_t em_ = mrow0 + (size_t)c * 64 + et;
        const u32x4e ez = *(const u32x4e*)(PROJ + em_ * NPROJ + PC_RWZ + h * 64 + 8 * ep), ev = *(const u32x4e*)(RWB + 2 * RWS + em_ * 512 + h * 64 + 8 * ep);
        const float ebon = BONUS[em_ * 8 + h];
        MM_LAS unsigned char* S0 = SL((c & 1) ? S_SB : S_SA); MM_LAS unsigned char* S0n = SL((c & 1) ? S_SA : S_SB);
        *(MM_LAS u32x4e*)(SL(S_RA) + et * PS + ep * 16) = gra; *(MM_LAS u32x4e*)(SL(S_MT) + et * PS + ep * 16) = gmt;
        f32x4 yi[2], ni[2];
#pragma unroll
        for (int jj = 0; jj < 2; ++jj) { yi[jj] = (f32x4){__uint_as_float(gyc[jj].x << 16), __uint_as_float(gyc[jj].x & 0xffff0000u), __uint_as_float(gyc[jj].y << 16), __uint_as_float(gyc[jj].y & 0xffff0000u)};
            ni[jj] = (f32x4){__uint_as_float(gnt[jj].x << 16), __uint_as_float(gnt[jj].x & 0xffff0000u), __uint_as_float(gnt[jj].y << 16), __uint_as_float(gnt[jj].y & 0xffff0000u)}; }
        if (c + 1 < 64) SQ_LOAD(c + 1);
        __syncthreads();
#pragma unroll
        for (int jj = 0; jj < 2; ++jj) { const int bj = bj0 + jj;
            mm::blk<2>(yi[jj], SL(S_RA) + bi * 16 * PS, PS, S0 + bj * 16 * PS, PS, lane);
#pragma unroll
            for (int r = 0; r < 4; ++r) YB[(16 * bi + 4 * lq + r) * YP + 16 * bj + lj] = yi[jj][r];
            mm::blk<2>(ni[jj], SL(S_MT) + bi * 16 * PS, PS, S0 + bj * 16 * PS, PS, lane);
            mm::store_T(ni[jj], S0n, PS, 16 * bj, 16 * bi, lane); }
        __syncthreads();
        {
            f32x4 y0 = *(const MM_LAS f32x4*)(YB + et * YP + 8 * ep), y1 = *(const MM_LAS f32x4*)(YB + et * YP + 8 * ep + 4);
            float sm = ((y0[0] + y0[1]) + (y0[2] + y0[3])) + ((y1[0] + y1[1]) + (y1[2] + y1[3]));
            sm += __shfl_xor(sm, 1); sm += __shfl_xor(sm, 2); sm += __shfl_xor(sm, 4);
            const float mean = sm * (1.f / 64.f); y0 = y0 - mean; y1 = y1 - mean;
            float sq = ((y0[0] * y0[0] + y0[1] * y0[1]) + (y0[2] * y0[2] + y0[3] * y0[3])) + ((y1[0] * y1[0] + y1[1] * y1[1]) + (y1[2] * y1[2] + y1[3] * y1[3]));
            sq += __shfl_xor(sq, 1); sq += __shfl_xor(sq, 2); sq += __shfl_xor(sq, 4);
            const float rstd = 1.f / sqrtf(sq * (1.f / 64.f) + RW_GN_EPS);
            const f32x4 lg0 = *(const MM_LAS f32x4*)(LNT + 8 * ep), lg1 = *(const MM_LAS f32x4*)(LNT + 8 * ep + 4), lb0 = *(const MM_LAS f32x4*)(LNT + 64 + 8 * ep), lb1 = *(const MM_LAS f32x4*)(LNT + 64 + 8 * ep + 4);
            u32x4e o;
#pragma unroll
            for (int i = 0; i < 4; ++i) { const float ya = (i < 2 ? y0 : y1)[(2 * i) & 3], yb = (i < 2 ? y0 : y1)[(2 * i + 1) & 3], ga = (i < 2 ? lg0 : lg1)[(2 * i) & 3], gb_ = (i < 2 ? lg0 : lg1)[(2 * i + 1) & 3], ba = (i < 2 ? lb0 : lb1)[(2 * i) & 3], bb_ = (i < 2 ? lb0 : lb1)[(2 * i + 1) & 3];
                const float na = ya * rstd * ga + ba + ebon * bf2f(ev[i] & 0xffffu), nb = yb * rstd * gb_ + bb_ + ebon * bf2f(ev[i] >> 16);
                o[i] = mm::cvtpk(siluf_(bf2f(ez[i] & 0xffffu)) * na, siluf_(bf2f(ez[i] >> 16)) * nb); }
            *(u32x4e*)(MIXED + em_ * DM + 1536 + h * 64 + 8 * ep) = o;
        }
    }
    __syncthreads();
#undef SQ_LOAD
#undef SL
}
namespace prp {
constexpr int PS = 144, PW = 1040, PT = 80;
constexpr int O_X = 0, O_A = 9216, O_AIM = 18432, O_VIM = 84992, O_T1 = 151552, LDS_END = 156672;
typedef unsigned u32x4 __attribute__((ext_vector_type(4)));
template <int NK>
__device__ __forceinline__ void blk_g(mm::f32x4& acc, const MM_LAS unsigned char* A, int apitch, const bf16_t* Bt, int bpitch, int lane) {
    const MM_LAS unsigned char* ap = A + (lane & 15) * apitch + (lane >> 4) * 16; const bf16_t* bp = Bt + (size_t)(lane & 15) * bpitch + (lane >> 4) * 8;
#pragma unroll
    for (int ks = 0; ks < NK; ++ks) { const mm::bf16x8 a = *(const MM_LAS mm::bf16x8*)(ap + ks * 64), b = *(const mm::bf16x8*)(bp + ks * 32); acc = __builtin_amdgcn_mfma_f32_16x16x32_bf16(a, b, acc, 0, 0, 0); }
}
__device__ __forceinline__ void unpack8(const u32x4 w, float (&f)[8]) {
#pragma unroll
    for (int i = 0; i < 4; ++i) { f[2 * i] = __uint_as_float(w[i] << 16); f[2 * i + 1] = __uint_as_float(w[i] & 0xffff0000u); } }
__device__ __forceinline__ u32x4 pack8(const float (&f)[8]) { u32x4 w; w.x = mm::cvtpk(f[0], f[1]); w.y = mm::cvtpk(f[2], f[3]); w.z = mm::cvtpk(f[4], f[5]); w.w = mm::cvtpk(f[6], f[7]); return w; }
}
struct PrepP {
    const float *mu, *w0, *a0, *v0, *k_k, *k_a, *r_k, *conv_w, *conv_b, *i_bias, *f_bias; const bf16_t *W2T, *A2T, *V1T, *V2T; int layer;
    const bf16_t* PROJ; const float* SPEC; const float* CS; float* RWW; bf16_t* RWB; bf16_t* VFIRST; float* BONUS; bf16_t* CQN; bf16_t* CKVN; bf16_t* KR; bf16_t* QKC; float* LI; float* LF;
};
__device__ __forceinline__ void prep_tile(unsigned char* lds_g, int tile, const PrepP& P) {
    using namespace prp; using mm::f32x4; using mm::bf16x8;
    MM_LAS unsigned char* L = (MM_LAS unsigned char*)lds_g;
    int tid_o = threadIdx.x; asm volatile("" : "+v"(tid_o));
    const int tid = tid_o, lane = tid & 63, wave = __builtin_amdgcn_readfirstlane(tid >> 6);
    const int m0 = tile * 64, t0 = m0 % T;
    constexpr size_t RWS = (size_t)M * 512;
    const bool resid = P.layer > 0;
    { const int t = tid >> 3, p = tid & 7; const size_t m = (size_t)m0 + t; const bool has_prev = (t0 + t) > 0;
#pragma unroll
      for (int which = 0; which < 2; ++which) { const float* cp = P.SPEC + m * 256 + which * 64 + 8 * p; const f32x4 c0 = *(const f32x4*)cp, c1 = *(const f32x4*)(cp + 4);
          f32x4 p0 = (f32x4){0.f, 0.f, 0.f, 0.f}, p1 = p0; if (has_prev) { p0 = *(const f32x4*)(cp - 256); p1 = *(const f32x4*)(cp - 252); }
          const f32x4 mu0 = *(const f32x4*)(P.mu + 1536 + which * 64 + 8 * p), mu1 = *(const f32x4*)(P.mu + 1536 + which * 64 + 8 * p + 4);
          float f[8];
#pragma unroll
          for (int e = 0; e < 4; ++e) { f[e] = c0[e] + mu0[e] * (p0[e] - c0[e]); f[4 + e] = c1[e] + mu1[e] * (p1[e] - c1[e]); }
          if (which == 0) {
#pragma unroll
              for (int e = 0; e < 8; ++e) f[e] = tanhf(f[e]); }
          *(MM_LAS u32x4*)(L + (which ? O_A : O_X) + t * PS + p * 16) = pack8(f); } }
    if (resid) { const int t = lane, hh = wave; const size_t m = (size_t)m0 + t; const bool has_prev = (t0 + t) > 0;
        const bf16_t* cp = P.PROJ + m * NPROJ + PC_RW + 1024 + hh * 64;
#pragma unroll
        for (int g = 0; g < 8; ++g) { float c[8], pv[8], mu_[8], o[8]; unpack8(*(const u32x4*)(cp + 8 * g), c);
            if (has_prev) unpack8(*(const u32x4*)(cp - NPROJ + 8 * g), pv); else {
#pragma unroll
                for (int e = 0; e < 8; ++e) pv[e] = 0.f; }
            const f32x4 m0_ = *(const f32x4*)(P.mu + 1024 + hh * 64 + 8 * g), m1_ = *(const f32x4*)(P.mu + 1024 + hh * 64 + 8 * g + 4);
#pragma unroll
            for (int e = 0; e < 4; ++e) { mu_[e] = m0_[e]; mu_[4 + e] = m1_[e]; }
#pragma unroll
            for (int e = 0; e < 8; ++e) o[e] = c[e] + mu_[e] * (pv[e] - c[e]);
            *(MM_LAS u32x4*)(L + O_VIM + t * PW + hh * 128 + g * 16) = pack8(o); } }
    __syncthreads();
    { bf16x8 fx[4][2], fa[4][2];
#pragma unroll
      for (int bi = 0; bi < 4; ++bi)
#pragma unroll
          for (int ks = 0; ks < 2; ++ks) { fx[bi][ks] = *(const MM_LAS bf16x8*)(L + O_X + (16 * bi + (lane & 15)) * PS + (lane >> 4) * 16 + ks * 64); fa[bi][ks] = *(const MM_LAS bf16x8*)(L + O_A + (16 * bi + (lane & 15)) * PS + (lane >> 4) * 16 + ks * 64); }
#pragma unroll
      for (int bjl = 0; bjl < 4; ++bjl) { const int c = 64 * wave + 16 * bjl + (lane & 15);
          const bf16_t* wp = P.W2T + (size_t)c * 64 + (lane >> 4) * 8; const bf16_t* ap = P.A2T + (size_t)c * 64 + (lane >> 4) * 8;
          const bf16x8 bw0 = *(const bf16x8*)wp, bw1 = *(const bf16x8*)(wp + 32), ba0 = *(const bf16x8*)ap, ba1 = *(const bf16x8*)(ap + 32);
          const float w0c = P.w0[c], a0c = P.a0[c];
#pragma unroll
          for (int bi = 0; bi < 4; ++bi) { f32x4 aw = (f32x4){0.f, 0.f, 0.f, 0.f}, aa = aw;
              aw = __builtin_amdgcn_mfma_f32_16x16x32_bf16(fx[bi][0], bw0, aw, 0, 0, 0); aw = __builtin_amdgcn_mfma_f32_16x16x32_bf16(fx[bi][1], bw1, aw, 0, 0, 0);
              aa = __builtin_amdgcn_mfma_f32_16x16x32_bf16(fa[bi][0], ba0, aa, 0, 0, 0); aa = __builtin_amdgcn_mfma_f32_16x16x32_bf16(fa[bi][1], ba1, aa, 0, 0, 0);
#pragma unroll
              for (int r = 0; r < 4; ++r) { const int t = 16 * bi + 4 * (lane >> 4) + r;
                  const float logw = -softplusf_(-(aw[r] + w0c)) - 0.5f;
                  P.RWW[((size_t)m0 + t) * 512 + c] = -__expf(logw);
                  *(MM_LAS unsigned short*)(L + O_AIM + t * PW + c * 2) = mm::f2b(sigmoidf_(aa[r] + a0c)); } } }
      if (resid) { const int bi = wave >> 1, bj = wave & 1; f32x4 d = (f32x4){0.f, 0.f, 0.f, 0.f};
          blk_g<16>(d, L + O_VIM + bi * 16 * PW, PW, P.V1T + (size_t)bj * 16 * 512, 512, lane);
#pragma unroll
          for (int r = 0; r < 4; ++r) *(MM_LAS unsigned short*)(L + O_T1 + (16 * bi + 4 * (lane >> 4) + r) * PT + (16 * bj + (lane & 15)) * 2) = mm::f2b(d[r]); } }
    __syncthreads();
    { MM_LAS float* PT_ = (MM_LAS float*)(L + O_X);
      PT_[tid] = P.mu[tid]; PT_[512 + tid] = P.mu[512 + tid]; PT_[1024 + tid] = P.mu[1024 + tid]; PT_[1536 + tid] = P.k_k[tid]; PT_[2048 + tid] = P.k_a[tid]; PT_[2560 + tid] = P.r_k[tid]; }
    if (resid) { bf16x8 ft[4];
#pragma unroll
        for (int bi = 0; bi < 4; ++bi) ft[bi] = *(const MM_LAS bf16x8*)(L + O_T1 + (16 * bi + (lane & 15)) * PT + (lane >> 4) * 16);
#pragma unroll
        for (int bjl = 0; bjl < 4; ++bjl) { const int c = 64 * wave + 16 * bjl + (lane & 15); const bf16x8 b = *(const bf16x8*)(P.V2T + (size_t)c * 32 + (lane >> 4) * 8); const float v0c = P.v0[c];
#pragma unroll
            for (int bi = 0; bi < 4; ++bi) { f32x4 d = (f32x4){0.f, 0.f, 0.f, 0.f}; d = __builtin_amdgcn_mfma_f32_16x16x32_bf16(ft[bi], b, d, 0, 0, 0);
#pragma unroll
                for (int r = 0; r < 4; ++r) *(MM_LAS unsigned short*)(L + O_VIM + (16 * bi + 4 * (lane >> 4) + r) * PW + c * 2) = mm::f2b(sigmoidf_(d[r] + v0c)); } } }
    __syncthreads();
    { const int t = lane, hh = wave; const size_t m = (size_t)m0 + t; const bool has_prev = (t0 + t) > 0; const int cb = hh * 64;
      const bf16_t* cp = P.PROJ + m * NPROJ + PC_RW + cb; const size_t ob = m * 512 + cb;
      const MM_LAS float* PT_ = (const MM_LAS float*)(L + O_X) + cb;
#define PRM(arr, g, e) (PT_[(arr) * 512 + 8 * (g) + (e)])
      float ss = 0.f, bon = 0.f;
      u32x4 ksp[8];
      const u32x4 zero4 = (u32x4){0u, 0u, 0u, 0u};
#define LDC(off, g) (*(const u32x4*)(cp + (off) + 8 * (g)))
#define LDP(off, g) (has_prev ? *(const u32x4*)(cp + (off) - NPROJ + 8 * (g)) : zero4)
      { u32x4 nc = LDC(512, 0), np = LDP(512, 0);
#pragma unroll
        for (int g = 0; g < 8; ++g) { const u32x4 rc = nc, rp = np; if (g < 7) { nc = LDC(512, g + 1); np = LDP(512, g + 1); }
          float c[8], pv[8], o[8]; unpack8(rc, c); unpack8(rp, pv);
#pragma unroll
          for (int e = 0; e < 8; ++e) { o[e] = c[e] + PRM(1, g, e) * (pv[e] - c[e]); const float q = o[e] * PRM(3, g, e); ss += q * q; }
          ksp[g] = pack8(o); asm volatile("" ::: "memory"); } }
      const float rn = 1.f / fmaxf(sqrtf(ss), 1e-12f);
      { u32x4 nc = LDC(0, 0), np = LDP(0, 0);
#pragma unroll
        for (int g = 0; g < 8; ++g) { const u32x4 rc = nc, rp = np; if (g < 7) { nc = LDC(0, g + 1); np = LDP(0, g + 1); }
          float ks_[8], a_[8], c[8], pv[8], rr[8], okh[8], oa[8], ob_[8]; unpack8(ksp[g], ks_); unpack8(*(const MM_LAS u32x4*)(L + O_AIM + t * PW + cb * 2 + g * 16), a_); unpack8(rc, c); unpack8(rp, pv);
#pragma unroll
          for (int e = 0; e < 8; ++e) { rr[e] = c[e] + PRM(0, g, e) * (pv[e] - c[e]); const float kkn = ks_[e] * PRM(3, g, e) * rn; okh[e] = ks_[e] * (1.f + (a_[e] - 1.f) * PRM(4, g, e)); oa[e] = -kkn; ob_[e] = kkn * a_[e]; bon += rr[e] * okh[e] * PRM(5, g, e); }
          *(u32x4*)(P.RWB + ob + 8 * g) = pack8(rr); *(u32x4*)(P.RWB + RWS + ob + 8 * g) = pack8(okh); *(u32x4*)(P.RWB + 3 * RWS + ob + 8 * g) = pack8(oa); *(u32x4*)(P.RWB + 4 * RWS + ob + 8 * g) = pack8(ob_);
          asm volatile("" ::: "memory"); } }
      P.BONUS[m * 8 + hh] = bon;
      { u32x4 nc = LDC(1024, 0), np = LDP(1024, 0), nf = resid ? *(const u32x4*)(P.VFIRST + ob) : zero4;
#pragma unroll
        for (int g = 0; g < 8; ++g) { const u32x4 rc = nc, rp = np, rf = nf; if (g < 7) { nc = LDC(1024, g + 1); np = LDP(1024, g + 1); if (resid) nf = *(const u32x4*)(P.VFIRST + ob + 8 * (g + 1)); }
          float c[8], pv[8], o[8]; unpack8(rc, c); unpack8(rp, pv);
#pragma unroll
          for (int e = 0; e < 8; ++e) o[e] = c[e] + PRM(2, g, e) * (pv[e] - c[e]);
          if (resid) { float gg[8], vf[8]; unpack8(*(const MM_LAS u32x4*)(L + O_VIM + t * PW + cb * 2 + g * 16), gg); unpack8(rf, vf);
#pragma unroll
              for (int e = 0; e < 8; ++e) o[e] = o[e] + (vf[e] - o[e]) * gg[e]; }
          else *(u32x4*)(P.VFIRST + ob + 8 * g) = pack8(o);
          *(u32x4*)(P.RWB + 2 * RWS + ob + 8 * g) = pack8(o); asm volatile("" ::: "memory"); } }
#undef LDC
#undef LDP
#undef PRM
    }
    { const int t = tid >> 3, p = tid & 7; const size_t m = (size_t)m0 + t;
      { const bf16_t* cp = P.PROJ + m * NPROJ + PC_CQ + 64 * p; u32x4 w[8]; float s = 0.f;
#pragma unroll
        for (int g = 0; g < 8; ++g) { w[g] = *(const u32x4*)(cp + 8 * g); float f[8]; unpack8(w[g], f);
#pragma unroll
            for (int e = 0; e < 8; ++e) s += f[e] * f[e]; }
        s += __shfl_xor(s, 1); s += __shfl_xor(s, 2); s += __shfl_xor(s, 4);
        const float rstd = 1.f / sqrtf(s * (1.f / 512.f) + NORM_EPS);
#pragma unroll
        for (int g = 0; g < 8; ++g) { float f[8]; unpack8(w[g], f);
#pragma unroll
            for (int e = 0; e < 8; ++e) f[e] *= rstd;
            *(u32x4*)(P.CQN + m * 512 + 64 * p + 8 * g) = pack8(f); } }
      { const bf16_t* cp = P.PROJ + m * NPROJ + PC_CKV + 32 * p; u32x4 w[4]; float s = 0.f;
#pragma unroll
        for (int g = 0; g < 4; ++g) { w[g] = *(const u32x4*)(cp + 8 * g); float f[8]; unpack8(w[g], f);
#pragma unroll
            for (int e = 0; e < 8; ++e) s += f[e] * f[e]; }
        s += __shfl_xor(s, 1); s += __shfl_xor(s, 2); s += __shfl_xor(s, 4);
        const float rstd = 1.f / sqrtf(s * (1.f / 256.f) + NORM_EPS);
#pragma unroll
        for (int g = 0; g < 4; ++g) { float f[8]; unpack8(w[g], f);
#pragma unroll
            for (int e = 0; e < 8; ++e) f[e] *= rstd;
            *(u32x4*)(P.CKVN + m * 256 + 32 * p + 8 * g) = pack8(f); } }
      { const float* sp = P.SPEC + m * 256 + 128 + 8 * p; const f32x4 x0 = *(const f32x4*)sp, x1 = *(const f32x4*)(sp + 4);
        const float* cs = P.CS + (m * 32 + 4 * p) * 2; const f32x4 c0 = *(const f32x4*)cs, c1 = *(const f32x4*)(cs + 4);
        float o[8];
        o[0] = x0[0] * c0[0] - x0[1] * c0[1]; o[1] = x0[1] * c0[0] + x0[0] * c0[1]; o[2] = x0[2] * c0[2] - x0[3] * c0[3]; o[3] = x0[3] * c0[2] + x0[2] * c0[3];
        o[4] = x1[0] * c1[0] - x1[1] * c1[1]; o[5] = x1[1] * c1[0] + x1[0] * c1[1]; o[6] = x1[2] * c1[2] - x1[3] * c1[3]; o[7] = x1[3] * c1[2] + x1[2] * c1[3];
        *(u32x4*)(P.KR + m * 64 + 8 * p) = pack8(o); }
      { const int gh = p; const float val = P.SPEC[m * 256 + 192 + gh];
        if (gh < 4) P.LI[m * 4 + gh] = val + P.i_bias[gh]; else P.LF[m * 4 + gh - 4] = -softplusf_(-(val + P.f_bias[gh - 4])); } }
    { const int cgp = tid & 127, tq = tid >> 7, ch = 8 * cgp; const float sc_ = ch < 512 ? 0.08838834764831845f : 1.f;
      float cw[4][8], cbv[8];
#pragma unroll
      for (int j = 0; j < 4; ++j) { const f32x4 a = *(const f32x4*)(P.conv_w + j * 1024 + ch), b = *(const f32x4*)(P.conv_w + j * 1024 + ch + 4);
#pragma unroll
          for (int e = 0; e < 4; ++e) { cw[j][e] = a[e]; cw[j][4 + e] = b[e]; } }
      { const f32x4 a = *(const f32x4*)(P.conv_b + ch), b = *(const f32x4*)(P.conv_b + ch + 4);
#pragma unroll
        for (int e = 0; e < 4; ++e) { cbv[e] = a[e]; cbv[4 + e] = b[e]; } }
      float x0[8], x1[8], x2[8];
      const int tb = 16 * tq;
#pragma unroll
      for (int e = 0; e < 8; ++e) { x0[e] = 0.f; x1[e] = 0.f; x2[e] = 0.f; }
      if (t0 + tb >= 3) { unpack8(*(const u32x4*)(P.PROJ + ((size_t)m0 + tb - 3) * NPROJ + PC_MLQK + ch), x0); unpack8(*(const u32x4*)(P.PROJ + ((size_t)m0 + tb - 2) * NPROJ + PC_MLQK + ch), x1); unpack8(*(const u32x4*)(P.PROJ + ((size_t)m0 + tb - 1) * NPROJ + PC_MLQK + ch), x2); }
#pragma unroll 4
      for (int i = 0; i < 16; ++i) { float x3[8], y[8]; unpack8(*(const u32x4*)(P.PROJ + ((size_t)m0 + tb + i) * NPROJ + PC_MLQK + ch), x3);
#pragma unroll
          for (int e = 0; e < 8; ++e) { const float v = cbv[e] + cw[0][e] * x0[e] + cw[1][e] * x1[e] + cw[2][e] * x2[e] + cw[3][e] * x3[e]; y[e] = siluf_(v) * sc_; x0[e] = x1[e]; x1[e] = x2[e]; x2[e] = x3[e]; }
          *(u32x4*)(P.QKC + ((size_t)m0 + tb + i) * 1024 + ch) = pack8(y); } }
    __syncthreads();
}
constexpr size_t MiB = 1u << 20;
constexpr size_t WS_CTL = 0, CTL_ZERO_BYTES = 1 * MiB;
constexpr size_t WS_WIN = 1 * MiB;
constexpr size_t WS_WUQ = WS_WIN + 104 * MiB;
constexpr size_t WS_WUKV = WS_WUQ + 6 * MiB;
constexpr size_t WS_WOUT = WS_WUKV + 4 * MiB;
constexpr size_t WS_CS = WS_WOUT + 32 * MiB;
constexpr size_t WS_XN = WS_CS + 4 * MiB;
constexpr size_t WS_PROJ = WS_XN + 64 * MiB;
constexpr size_t WS_SPEC = WS_PROJ + 208 * MiB;
constexpr size_t WS_CQN = WS_SPEC + 16 * MiB;
constexpr size_t WS_CKVN = WS_CQN + 16 * MiB;
constexpr size_t WS_KR = WS_CKVN + 8 * MiB;
constexpr size_t WS_Q = WS_KR + 2 * MiB;
constexpr size_t WS_KV = WS_Q + 48 * MiB;
constexpr size_t WS_QKC = WS_KV + 64 * MiB;
constexpr size_t WS_GATE = WS_QKC + 32 * MiB;
constexpr size_t WS_RWW = WS_GATE + 1 * MiB;
constexpr size_t WS_RWB = WS_RWW + 32 * MiB;
constexpr size_t WS_VFIRST = WS_RWB + 80 * MiB;
constexpr size_t WS_BONUS = WS_VFIRST + 16 * MiB;
constexpr size_t WS_LR = WS_BONUS + 1 * MiB;
constexpr size_t LR_STRIDE = 196608, LR_W2T = 0, LR_A2T = 65536, LR_V1T = 131072, LR_V2T = 163840;
constexpr size_t WS_RWX = WS_LR + 1 * MiB;
constexpr size_t WS_END = WS_RWX + 64 * MiB;
static_assert(WS_END <= 865075200ull, "d_ws map exceeds the guaranteed workspace (4 x the largest tensor)");
constexpr int CW_BAR = 4096;
constexpr int LDS_BYTES = 163840, RING_BYTES = 158720, MISC_OFF = RING_BYTES + 320;
static_assert(att::LDS_BYTES <= RING_BYTES, "attention LDS");

struct Args { const float* in[28]; float* out; unsigned char* ws; int ph_lo, ph_hi; };

struct MapWin { __device__ __forceinline__ int operator()(int n) const {
    if (n < 1536) return n;
    if (n < 2048) return SC_MLO + (n - 1536);
    if (n < 2560) return SC_MLZ + (n - 2048);
    if (n < 3072) return SC_CQ + (n - 2560);
    if (n < 3328) return SC_CKV + (n - 3072);
    if (n < 4352) return SC_MLAZ + (n - 3328);
    if (n < 5888) return SC_RW + (n - 4352);
    if (n < 6144) { const int j = n - 5888;
        if (j < 128) return SC_RW + 1536 + j;
        if (j < 192) { const int q = j - 128; return SC_KR + ((q & 1) ? 32 + (q >> 1) : (q >> 1)); }
        if (j < 196) return SC_MLI + (j - 192);
        if (j < 200) return SC_MLF + (j - 196);
        return -1; }
    return SC_RWZ + (n - 6144); } };
struct MapUq { __device__ __forceinline__ int operator()(int n) const { const int h = n / 192, d = n % 192; if (d < 128) return n; const int q = d - 128; return h * 192 + 128 + ((q & 1) ? 32 + (q >> 1) : (q >> 1)); } };
struct MapId { __device__ __forceinline__ int operator()(int n) const { return n; } };

template <class Map>
__device__ __forceinline__ void transpose_item(const float* W, int K, int Nsrc, bf16_t* WT, const float* gain, LAS float* scr, int kb, int nb, int lane, Map map) {
    const int k0 = 64 * kb, n0 = 32 * nb, sc = map(n0 + (lane & 31));
#pragma unroll 8
    for (int i = 0; i < 32; ++i) { const int kk = 2 * i + (lane >> 5); float v = 0.f;
        if (sc >= 0) { v = W[(size_t)(k0 + kk) * Nsrc + sc]; if (gain) v *= gain[k0 + kk]; }
        scr[kk * 33 + (lane & 31)] = v; }
    LDS_WAIT(); asm volatile("" ::: "memory");
    const int c = lane & 7;
#pragma unroll
    for (int j = 0; j < 4; ++j) { const int n = (lane >> 3) + 8 * j; const LAS float* s = scr + (8 * c) * 33 + n;
        v4u o; o.x = pk2(s[0 * 33], s[1 * 33]); o.y = pk2(s[2 * 33], s[3 * 33]); o.z = pk2(s[4 * 33], s[5 * 33]); o.w = pk2(s[6 * 33], s[7 * 33]);
        *(v4u*)(WT + (size_t)(n0 + n) * K + k0 + 8 * c) = o; }
    LDS_WAIT(); asm volatile("" ::: "memory");
}

template <int MODE>
__device__ __forceinline__ void norm_row(const float* xrow, bf16_t* orow, float* frow, const float* g, int lane) {
    const f32x4* xr = (const f32x4*)xrow + lane;
    f32x4 v[8]; float s = 0.f;
#pragma unroll
    for (int j = 0; j < 8; ++j) { v[j] = xr[64 * j]; s += (v[j].x * v[j].x + v[j].y * v[j].y) + (v[j].z * v[j].z + v[j].w * v[j].w); }
    const float rstd = 1.f / sqrtf(wave_sum(s) * (1.f / DM) + NORM_EPS);
    if (MODE == 0) { unsigned long long* o8 = (unsigned long long*)orow + lane;
#pragma unroll
        for (int j = 0; j < 8; ++j) o8[64 * j] = (unsigned long long)pk2(v[j].x * rstd, v[j].y * rstd) | ((unsigned long long)pk2(v[j].z * rstd, v[j].w * rstd) << 32);
    } else { f32x4* o = (f32x4*)frow + lane; const f32x4* gr = (const f32x4*)g + lane;
#pragma unroll
        for (int j = 0; j < 8; ++j) { const f32x4 gg = gr[64 * j]; o[64 * j] = v[j] * rstd * gg; } }
}

__device__ __forceinline__ att::BlockRef mk_block(const bf16_t* Q, const bf16_t* KV, const bf16_t* KR, bf16_t* MIXED, const bf16_t* PROJ, const float* CS, int L_, int pass_) {
    const int bh = L_ >> 3, x = L_ & 7, qb = pass_ ? 15 - x : x, b = bh >> 3, h = bh & 7; att::BlockRef r;
    const size_t rb = (size_t)b * T, rq = rb + (size_t)qb * 256;
    r.Q = Q + rq * NQ + h * 192; r.K = KV + rb * NKV + h * 256; r.V = r.K + 128; r.KR = KR + rb * 64; r.O = MIXED + rq * DM + 512 + h * 128; r.Z = PROJ + rq * NPROJ + PC_MLAZ + h * 128; r.CSq = CS + rq * 64; r.P0 = qb * 256; return r;
}
#ifndef REP_PREP
#define REP_PREP 1
#endif
#ifndef REP_MIX
#define REP_MIX 1
#endif
#ifndef REP_RW
#define REP_RW 1
#endif
#ifndef REP_ML
#define REP_ML 1
#endif
__global__ void __launch_bounds__(512, 2) fwd(Args args) {
    extern __shared__ __attribute__((aligned(16))) unsigned char lds[];
    const int tid = threadIdx.x, lane = tid & 63, wave = __builtin_amdgcn_readfirstlane(tid >> 6);
    const int G = gridDim.x, bid = blockIdx.x;
    unsigned char* ws = args.ws;
    volatile LAS unsigned* MISC = (volatile LAS unsigned*)((LAS unsigned char*)lds + MISC_OFF);
    for (int u = tid; u < (LDS_BYTES - RING_BYTES) / 4; u += 512) ((LAS unsigned*)((LAS unsigned char*)lds + RING_BYTES))[u] = 0u;
    __syncthreads();
    const bool one_launch = (args.ph_hi - args.ph_lo) > 1;
    XcdBarrier bar; bar.bar = (unsigned*)(ws + WS_CTL) + CW_BAR; bar.x = 0; bar.st = nullptr;
    if (one_launch) bar = xcd_barrier_post((unsigned*)(ws + WS_CTL) + CW_BAR, MISC + 8);
    const int lo = args.ph_lo, hi = args.ph_hi;
#define IN(k) (lo <= (k) && (k) < hi)
#define SEAM(k) do { if (IN(k) && IN((k) + 1)) xcd_barrier(bar); } while (0)

    const float* x_in = args.in[0]; const int* positions = (const int*)args.in[1];
    float* X = args.out;
    bf16_t* WIN = (bf16_t*)(ws + WS_WIN); bf16_t* WUQ = (bf16_t*)(ws + WS_WUQ); bf16_t* WUKV = (bf16_t*)(ws + WS_WUKV); bf16_t* WOUT = (bf16_t*)(ws + WS_WOUT);
    float* CS = (float*)(ws + WS_CS); bf16_t* XN = (bf16_t*)(ws + WS_XN); bf16_t* MIXED = XN; bf16_t* PROJ = (bf16_t*)(ws + WS_PROJ); float* SPEC = (float*)(ws + WS_SPEC);
    bf16_t* CQN = (bf16_t*)(ws + WS_CQN); bf16_t* CKVN = (bf16_t*)(ws + WS_CKVN); bf16_t* KR = (bf16_t*)(ws + WS_KR); bf16_t* Q = (bf16_t*)(ws + WS_Q); bf16_t* KV = (bf16_t*)(ws + WS_KV);
    bf16_t* QKC = (bf16_t*)(ws + WS_QKC); float* LI = (float*)(ws + WS_GATE); float* LF = LI + (size_t)M * 4;
    float* RWW = (float*)(ws + WS_RWW); bf16_t* RWB = (bf16_t*)(ws + WS_RWB); bf16_t* VFIRST = (bf16_t*)(ws + WS_VFIRST); float* BONUS = (float*)(ws + WS_BONUS);
    constexpr size_t RWS = (size_t)M * 512;

    if (IN(0)) {
#ifndef NO_PRO
        LAS float* scr = (LAS float*)((LAS unsigned char*)lds + wave * 16384);
        const int gw = bid * 8 + wave, NGW = G * 8;
        constexpr int I_IN = (DM / 64) * (NPROJ / 32), I_UQ = (512 / 64) * (NQ / 32), I_UKV = (256 / 64) * (NKV / 32), I_OUT = (DM / 64) * (DM / 32), I_L = I_IN + I_UQ + I_UKV + I_OUT;
        for (int it = gw; it < DEPTH * I_L; it += NGW) {
            const int l = it / I_L; int r = it % I_L;
            if (r < I_IN) { transpose_item(args.in[3] + (size_t)l * DM * D_IN, DM, D_IN, WIN + (size_t)l * NPROJ * DM, args.in[2] + l * DM, scr, r / (NPROJ / 32), r % (NPROJ / 32), lane, MapWin()); continue; } r -= I_IN;
            if (r < I_UQ) { transpose_item(args.in[10] + (size_t)l * 512 * NQ, 512, NQ, WUQ + (size_t)l * NQ * 512, args.in[9] + l * 512, scr, r / (NQ / 32), r % (NQ / 32), lane, MapUq()); continue; } r -= I_UQ;
            if (r < I_UKV) { transpose_item(args.in[12] + (size_t)l * 256 * NKV, 256, NKV, WUKV + (size_t)l * NKV * 256, args.in[11] + l * 256, scr, r / (NKV / 32), r % (NKV / 32), lane, MapId()); continue; } r -= I_UKV;
            transpose_item(args.in[26] + (size_t)l * DM * DM, DM, DM, WOUT + (size_t)l * DM * DM, (const float*)nullptr, scr, r / (DM / 32), r % (DM / 32), lane, MapId());
        }
        for (int it = gw; it < DEPTH * 40; it += NGW) {
            const int l = it / 40, r = it % 40; unsigned char* lr = ws + WS_LR + (size_t)l * LR_STRIDE;
            if (r < 16) transpose_item(args.in[15] + (size_t)l * 64 * 512, 64, 512, (bf16_t*)(lr + LR_W2T), (const float*)nullptr, scr, 0, r, lane, MapId());
            else if (r < 32) transpose_item(args.in[17] + (size_t)l * 64 * 512, 64, 512, (bf16_t*)(lr + LR_A2T), (const float*)nullptr, scr, 0, r - 16, lane, MapId());
            else if (l > 0) transpose_item(args.in[19] + (size_t)(l - 1) * 512 * 32, 512, 32, (bf16_t*)(lr + LR_V1T), (const float*)nullptr, scr, r - 32, 0, lane, MapId());
        }
        for (int i = bid * 512 + tid; i < (DEPTH - 1) * 512 * 32; i += G * 512) { const int l = 1 + i / 16384, e = i % 16384, c = e >> 5, j = e & 31;
            ((bf16_t*)(ws + WS_LR + (size_t)l * LR_STRIDE + LR_V2T))[c * 32 + j] = (bf16_t)f2bf(args.in[20][(size_t)(l - 1) * 32 * 512 + j * 512 + c]); }
        for (int i = bid * 512 + tid; i < M * 32; i += G * 512) { const int m = i >> 5, j = i & 31;
            const float inv_freq = powf(10000.f, -(float)(2 * j) / 64.f);
            const float ang = (float)positions[m] * inv_freq;
            const double a = (double)ang; const double n = rint(a * 0.15915494309189535); const float r = (float)(a - n * 6.283185307179586);
            CS[2 * i] = cosf(r); CS[2 * i + 1] = sinf(r); }
        for (int m = gw; m < M; m += NGW) norm_row<0>(x_in + (size_t)m * DM, XN + (size_t)m * DM, nullptr, nullptr, lane);
#endif
    }
    SEAM(0);

#ifdef FIXL
    for (int l = 0; l < 1; ++l) {
#else
    for (int l = 0; l < DEPTH; ++l) {
#endif
        const int pb = 1 + l * 6;
        int tid_o = threadIdx.x; asm volatile("" : "+v"(tid_o));
        const int tid = tid_o, lane = tid & 63, wave = __builtin_amdgcn_readfirstlane(tid >> 6);
        if (IN(pb + 0)) {
#ifndef NO_G1
            pg8::Gemm g{XN, WIN + (size_t)l * NPROJ * DM, M, NPROJ, DM}; pg8::StaticOrder S; S.init(M, NPROJ, G, bid);
            pg8::EpiProj E{PROJ, NPROJ, SPEC, SPEC_TILE};
            pg8::gemm_phase<pg8::EpiProj, pg8::StaticOrder, true, true>((LAS unsigned char*)lds, g, S, E);
#endif
        }
        SEAM(pb + 0);
        if (IN(pb + 1)) {
#ifndef NO_PREP
            PrepP P;
            P.mu = args.in[13] + l * 1664; P.w0 = args.in[14] + l * 512; P.a0 = args.in[16] + l * 512; P.v0 = args.in[18] + (l > 0 ? (l - 1) * 512 : 0);
            P.k_k = args.in[21] + l * 512; P.k_a = args.in[22] + l * 512; P.r_k = args.in[23] + l * 512;
            P.conv_w = args.in[4] + (size_t)l * 4 * 1024; P.conv_b = args.in[5] + l * 1024; P.i_bias = args.in[6] + l * 4; P.f_bias = args.in[7] + l * 4;
            const unsigned char* lr = ws + WS_LR + (size_t)l * LR_STRIDE;
            P.W2T = (const bf16_t*)(lr + LR_W2T); P.A2T = (const bf16_t*)(lr + LR_A2T); P.V1T = (const bf16_t*)(lr + LR_V1T); P.V2T = (const bf16_t*)(lr + LR_V2T); P.layer = l;
            P.PROJ = PROJ; P.SPEC = SPEC; P.CS = CS; P.RWW = RWW; P.RWB = RWB; P.VFIRST = VFIRST; P.BONUS = BONUS; P.CQN = CQN; P.CKVN = CKVN; P.KR = KR; P.QKC = QKC; P.LI = LI; P.LF = LF;
            for (int rep_ = 0; rep_ < REP_PREP; ++rep_)
            for (int tile = bid; tile < M / 64; tile += G) prep_tile(lds, tile, P);
#endif
        }
        SEAM(pb + 1);
        if (IN(pb + 2)) {
#ifndef NO_G23
            { pg8::Gemm g{CQN, WUQ + (size_t)l * NQ * 512, M, NQ, 512}; pg8::StaticOrder S; S.init(M, NQ, G, bid);
              pg8::EpiPlain E{Q, NQ};
              pg8::gemm_phase<pg8::EpiPlain, pg8::StaticOrder, true, true>((LAS unsigned char*)lds, g, S, E); }
            { pg8::Gemm g{CKVN, WUKV + (size_t)l * NKV * 256, M, NKV, 256}; pg8::StaticOrder S; S.init(M, NKV, G, bid);
              pg8::EpiPlain E{KV, NKV};
              pg8::gemm_phase<pg8::EpiPlain, pg8::StaticOrder, true, true>((LAS unsigned char*)lds, g, S, E); }
#endif
            rwkv_local(lds, bid, G, RWW, RWB, RWS, ws + WS_RWX);
        }
        SEAM(pb + 2);
        if (IN(pb + 3)) for (int rep_ = 0; rep_ < REP_MIX; ++rep_) {
#ifndef NO_SCANS
            if (bid < 32 && G >= 64) {
                for (int rr_ = 0; rr_ < REP_RW; ++rr_) rwkv_seq(lds, bid >> 3, bid & 7, ws + WS_RWX, RWB, RWS, BONUS, PROJ, args.in[24] + l * 512 + (bid & 7) * 64, args.in[25] + l * 512 + (bid & 7) * 64, MIXED);
            } else if (bid < 48 && G >= 64) {
                const int u = bid - 32;
                for (int rr_ = 0; rr_ < REP_ML; ++rr_) mlstm_unit(lds, u >> 2, u & 3, QKC, PROJ, LI, LF, args.in[8] + l * 512 + (u & 3) * 128, MIXED);
            } else
#endif
            {
#ifndef NO_ATT
                const int first = (G >= 64) ? bid - 48 : bid, stride = (G >= 64) ? G - 48 : G; constexpr int total = BATCH * 8 * 8;
                if (first < total) {
                    att::Seam S; int L = first, pass = 0;
#define mk(L_, pass_) mk_block(Q, KV, KR, MIXED, PROJ, CS, (L_), (pass_))
                    att::BlockRef cur = mk(L, 0);
                    att::attn_prime(cur, (char*)lds, S);
                    for (;;) {
                        const bool more_pass = pass == 0, more_item = L + stride < total, last = !more_pass && !more_item;
                        int Ln = L, passn = pass + 1; if (!more_pass) { passn = 0; Ln = more_item ? L + stride : L; }
                        const att::BlockRef nxt = last ? cur : mk(Ln, passn);
                        att::attn_block(cur, nxt, (char*)lds, S);
                        if (last) break;
                        cur = nxt; L = Ln; pass = passn;
                    }
#undef mk
                }
#endif
            }
        }
        SEAM(pb + 3);
        if (IN(pb + 4)) {
#ifndef NO_G4
            pg8::Gemm g{MIXED, WOUT + (size_t)l * DM * DM, M, DM, DM}; pg8::StaticOrder S; S.init(M, DM, G, bid);
            pg8::EpiResid E{l == 0 ? x_in : (const float*)X, X, DM};
            pg8::gemm_phase<pg8::EpiResid, pg8::StaticOrder, true, true>((LAS unsigned char*)lds, g, S, E);
#endif
        }
        SEAM(pb + 4);
        if (IN(pb + 5)) {
            const int gw = bid * 8 + wave, NGW = G * 8;
            if (l + 1 < DEPTH) { for (int m = gw; m < M; m += NGW) norm_row<0>(X + (size_t)m * DM, XN + (size_t)m * DM, nullptr, nullptr, lane); }
            else { for (int m = gw; m < M; m += NGW) norm_row<1>(X + (size_t)m * DM, nullptr, X + (size_t)m * DM, args.in[27], lane); }
        }
        SEAM(pb + 5);
    }
#undef IN
#undef SEAM
}

constexpr int N_PHASES = 1 + DEPTH * 6;
#ifndef MK_ONE_LAUNCH
#define MK_ONE_LAUNCH 1
#endif
extern "C" void kernel_launch(void* const* d_in, const int* in_sizes, int n_in, void* d_out, int out_size, void* d_ws, size_t ws_size, hipStream_t stream) {
    static int grid = 0;
    if (grid == 0) {
        if (n_in != 28 || out_size != M * DM || ws_size < WS_END) { fprintf(stderr, "kernel_launch: unexpected shapes (n_in %d, out %d, ws %zu < %zu)\n", n_in, out_size, ws_size, (size_t)WS_END); grid = -1; return; }
        int dev = 0, cus = 0;
        if (hipGetDevice(&dev) != hipSuccess || hipDeviceGetAttribute(&cus, hipDeviceAttributeMultiprocessorCount, dev) != hipSuccess) { grid = -1; return; }
        if (hipFuncSetAttribute((const void*)fwd, hipFuncAttributeMaxDynamicSharedMemorySize, LDS_BYTES) != hipSuccess) { fprintf(stderr, "kernel_launch: hipFuncSetAttribute failed\n"); grid = -1; return; }
        int per_cu = 0;
        if (hipOccupancyMaxActiveBlocksPerMultiprocessor(&per_cu, (const void*)fwd, 512, LDS_BYTES) != hipSuccess || per_cu < 1) fprintf(stderr, "kernel_launch: occupancy query says %d\n", per_cu);
        (void)hipGetLastError();
        grid = cus;
    }
    if (grid < 0) return;
    if (hipMemsetAsync((char*)d_ws + WS_CTL, 0, CTL_ZERO_BYTES, stream) != hipSuccess) return;
    Args a; memset(&a, 0, sizeof(a));
    for (int i = 0; i < 28; ++i) a.in[i] = (const float*)d_in[i];
    a.out = (float*)d_out; a.ws = (unsigned char*)d_ws;
#if MK_ONE_LAUNCH
    a.ph_lo = 0; a.ph_hi = N_PHASES;
    hipLaunchKernelGGL(fwd, dim3(grid), dim3(512), LDS_BYTES, stream, a);
#else
    for (int p = 0; p < N_PHASES; ++p) { a.ph_lo = p; a.ph_hi = p + 1; hipLaunchKernelGGL(fwd, dim3(grid), dim3(512), LDS_BYTES, stream, a); }
#endif
}
```

```cpp
#include <hip/hip_runtime.h>
#include <cstdio>
#include <cstdint>
#include <cstring>
namespace pg8 {
#define PG8_LAS __attribute__((address_space(3)))
typedef unsigned short bf16_t;
typedef short bf16x8 __attribute__((ext_vector_type(8)));
typedef float f32x4 __attribute__((ext_vector_type(4)));
typedef unsigned u32x4 __attribute__((ext_vector_type(4)));
constexpr int BM = 256, BK = 64, HALF = 128, HTB = HALF * BK * 2  , STAGE_BYTES = 8 * HTB, NXCD = 8, WGM = 8;

__host__ __device__ __forceinline__ int lds_byte(int r, int c) { const int st = (r >> 4) * 2 + (c >> 5), rr = r & 15, cc = c & 31, ob = rr * 64 + cc * 2; return st * 1024 + (ob ^ (((ob >> 9) & 1) << 5)); }
__host__ __device__ __forceinline__ void stage_rc(int b, int& R, int& C) { const int st = b / 1024, sb = b % 1024, swz = sb ^ (((sb >> 9) & 1) << 5); R = (st >> 1) * 16 + swz / 64; C = (st & 1) * 32 + (swz % 64) / 2; }
__host__ __device__ __forceinline__ int perm32(int rho) { const int n = rho >> 4, i = rho & 15; return 8 * (i >> 2) + 4 * n + (i & 3); }

struct Unit { int pm, pn; };
struct Gemm { const bf16_t* A; const bf16_t* Bt; int M, N, K; };

struct StaticOrder {
    int nM, nN, nwg, G, c;
    __host__ __device__ void init(int M, int N, int G_, int c_) { nM = M / BM; nN = N / BM; nwg = nM * nN; G = G_; c = c_; }
    __host__ __device__ bool next(int i, Unit& u) const {
        const long L = (long)i * G + c; if (L >= nwg) return false;
        int wgid = (int)L; { const int q = nwg / NXCD, r = nwg % NXCD, xcd = wgid % NXCD, off = wgid / NXCD; wgid = (xcd < r ? xcd * (q + 1) : r * (q + 1) + (xcd - r) * q) + off; }
        const int nig = WGM * nN, gid = wgid / nig, fm = gid * WGM, gsz = (nM - fm) < WGM ? (nM - fm) : WGM;
        u.pm = fm + ((wgid % nig) % gsz); u.pn = (wgid % nig) / gsz; return true;
    }
    __device__ __forceinline__ void a_ready(const Unit&) const {}
    __device__ __forceinline__ void done(const Unit&) const {}
};

__device__ __forceinline__ unsigned cvt_pk_bf16(float lo, float hi) { unsigned r; asm volatile("v_cvt_pk_bf16_f32 %0, %1, %2" : "=v"(r) : "v"(lo), "v"(hi)); return r; }
typedef float f32x2 __attribute__((ext_vector_type(2)));
typedef unsigned u32x2 __attribute__((ext_vector_type(2)));
struct EpiProj {
    static constexpr bool PERM = true, AFTER_DRAIN = false;
    bf16_t* O; int ldc; float* spec; int spec_tile;
    __device__ __forceinline__ void operator()(const f32x4 (&acc)[2][2][4][2], const Unit& u, int wr, int wc, int fr, int fq) const {
        const int row0 = u.pm * BM + wr * 64 + fr, col0 = u.pn * BM + wc * 32 + 8 * fq;
        if (u.pn == spec_tile) {
            float* sp0 = spec + (size_t)row0 * 256 + wc * 32 + 8 * fq;
#pragma unroll
            for (int ai = 0; ai < 2; ++ai)
#pragma unroll
                for (int m = 0; m < 4; ++m) { float* sp_p = sp0 + (size_t)(ai * HALF + m * 16) * 256;
#pragma unroll
                    for (int bj = 0; bj < 2; ++bj) { *(f32x4*)(sp_p + bj * HALF) = acc[ai][bj][m][0]; *(f32x4*)(sp_p + bj * HALF + 4) = acc[ai][bj][m][1]; } }
        }
        bf16_t* o0 = O + (size_t)row0 * ldc + col0;
#pragma unroll
        for (int ai = 0; ai < 2; ++ai)
#pragma unroll
            for (int m = 0; m < 4; ++m) { bf16_t* rowp = o0 + (size_t)(ai * HALF + m * 16) * ldc;
#pragma unroll
                for (int bj = 0; bj < 2; ++bj) { const f32x4 v0 = acc[ai][bj][m][0], v1 = acc[ai][bj][m][1];
                    u32x4 w; w.x = cvt_pk_bf16(v0[0], v0[1]); w.y = cvt_pk_bf16(v0[2], v0[3]); w.z = cvt_pk_bf16(v1[0], v1[1]); w.w = cvt_pk_bf16(v1[2], v1[3]);
                    *(u32x4*)(rowp + bj * HALF) = w; } }
    }
};
struct EpiQ {
    static constexpr bool PERM = true, AFTER_DRAIN = false;
    bf16_t* O; const float* cs;
    __device__ __forceinline__ void operator()(const f32x4 (&acc)[2][2][4][2], const Unit& u, int wr, int wc, int fr, int fq) const {
        const int row0 = u.pm * BM + wr * 64 + fr, col0 = u.pn * BM + wc * 32 + 8 * fq;
#pragma unroll
        for (int ai = 0; ai < 2; ++ai)
#pragma unroll
            for (int m = 0; m < 4; ++m) { const int row = row0 + ai * HALF + m * 16; bf16_t* rowp = O + (size_t)row * 1536 + col0;
#pragma unroll
                for (int bj = 0; bj < 2; ++bj) { f32x4 v0 = acc[ai][bj][m][0], v1 = acc[ai][bj][m][1];
                    const int d = (col0 + bj * HALF) % 192;
                    if (d >= 128) { const int i0 = (d - 128) >> 1; const f32x4* cp = (const f32x4*)(cs + (size_t)row * 64 + i0 * 2); const f32x4 c0 = cp[0], c1 = cp[1];
                        f32x4 r0, r1;
                        r0[0] = v0[0] * c0[0] - v0[1] * c0[1]; r0[1] = v0[1] * c0[0] + v0[0] * c0[1];
                        r0[2] = v0[2] * c0[2] - v0[3] * c0[3]; r0[3] = v0[3] * c0[2] + v0[2] * c0[3];
                        r1[0] = v1[0] * c1[0] - v1[1] * c1[1]; r1[1] = v1[1] * c1[0] + v1[0] * c1[1];
                        r1[2] = v1[2] * c1[2] - v1[3] * c1[3]; r1[3] = v1[3] * c1[2] + v1[2] * c1[3];
                        v0 = r0; v1 = r1; }
                    u32x4 w; w.x = cvt_pk_bf16(v0[0], v0[1]); w.y = cvt_pk_bf16(v0[2], v0[3]); w.z = cvt_pk_bf16(v1[0], v1[1]); w.w = cvt_pk_bf16(v1[2], v1[3]);
                    *(u32x4*)(rowp + bj * HALF) = w; } }
    }
};
struct EpiPlain {
    static constexpr bool PERM = true, AFTER_DRAIN = false;
    bf16_t* O; int ldc;
    __device__ __forceinline__ void operator()(const f32x4 (&acc)[2][2][4][2], const Unit& u, int wr, int wc, int fr, int fq) const {
        const int row0 = u.pm * BM + wr * 64 + fr, col0 = u.pn * BM + wc * 32 + 8 * fq;
#pragma unroll
        for (int ai = 0; ai < 2; ++ai)
#pragma unroll
            for (int m = 0; m < 4; ++m) { bf16_t* rowp = O + (size_t)(row0 + ai * HALF + m * 16) * ldc + col0;
#pragma unroll
                for (int bj = 0; bj < 2; ++bj) { const f32x4 v0 = acc[ai][bj][m][0], v1 = acc[ai][bj][m][1];
                    u32x4 w; w.x = cvt_pk_bf16(v0[0], v0[1]); w.y = cvt_pk_bf16(v0[2], v0[3]); w.z = cvt_pk_bf16(v1[0], v1[1]); w.w = cvt_pk_bf16(v1[2], v1[3]);
                    *(u32x4*)(rowp + bj * HALF) = w; } }
    }
};
struct EpiResid {
    static constexpr bool PERM = false, AFTER_DRAIN = false;
    const float* base; float* out; int ldc;
    __device__ __forceinline__ void operator()(const f32x4 (&acc)[2][2][4][2], const Unit& u, int wr, int wc, int fr, int fq) const {
        const int row0 = u.pm * BM + wr * 64 + fr, col0 = u.pn * BM + wc * 32 + 4 * fq;
#pragma unroll
        for (int ai = 0; ai < 2; ++ai)
#pragma unroll
            for (int m = 0; m < 4; ++m) { const size_t off = (size_t)(row0 + ai * HALF + m * 16) * ldc + col0;
#pragma unroll
                for (int bj = 0; bj < 2; ++bj)
#pragma unroll
                    for (int n = 0; n < 2; ++n) { const f32x4 bs = *(const f32x4*)(base + off + bj * HALF + n * 16); *(f32x4*)(out + off + bj * HALF + n * 16) = bs + acc[ai][bj][m][n]; } }
    }
};
template <class Epi, class Sched, bool ALIGN_EPI = false, bool SP2 = false>
__device__ __forceinline__ void gemm_phase(PG8_LAS unsigned char* lds, const Gemm g, const Sched& S, const Epi& E) {
    int tid_o = threadIdx.x; asm volatile("" : "+v"(tid_o));
    const int tid = tid_o, wid = __builtin_amdgcn_readfirstlane(tid >> 6), lane = tid & 63, wr = wid >> 2, wc = wid & 3, fr = lane & 15, fq = lane >> 4;
    const int K = g.K, nt = K / BK;
    unsigned voffA[2], voffB[2];
#pragma unroll
    for (int i = 0; i < 2; ++i) { int R, C; stage_rc(tid * 16 + i * 8192, R, C); const int Rb = Epi::PERM ? ((R & ~31) + perm32(R & 31)) : R;
        voffA[i] = (unsigned)(R * K + C) * 2u; voffB[i] = (unsigned)(Rb * K + C) * 2u; }
    const size_t kstep = (size_t)(BK * 2);
    const size_t hstep = (size_t)HALF * K * 2;
    const size_t tstep = 2 * hstep;
    const unsigned ldsw = (unsigned)wid * 1024u;
    const int aoff = lds_byte(wr * 64 + fr, fq * 8), boff = lds_byte(wc * 32 + fr, fq * 8);
#define PG8_SA(b, h) (((b) * 2 + (h)) * HTB)
#define PG8_SB(b, h) ((4 + (b) * 2 + (h)) * HTB)
#define PG8_STAGE(bufoff, gbase, voff) do { _Pragma("unroll") for (int _i = 0; _i < 2; ++_i) \
        __builtin_amdgcn_global_load_lds((const unsigned*)((const char*)(gbase) + (voff)[_i]), (PG8_LAS unsigned*)(lds + (bufoff) + ldsw + _i * 8192), 16, 0, 0); } while (0)
#define PG8_LDA(dst, b, h) do { _Pragma("unroll") for (int m = 0; m < 4; ++m) _Pragma("unroll") for (int k = 0; k < 2; ++k) dst[m][k] = *(const PG8_LAS bf16x8*)(lds + PG8_SA(b, h) + aoff + m * 2048 + k * 1024); } while (0)
#define PG8_LDB(dst, b, h) do { _Pragma("unroll") for (int n = 0; n < 2; ++n) _Pragma("unroll") for (int k = 0; k < 2; ++k) dst[n][k] = *(const PG8_LAS bf16x8*)(lds + PG8_SB(b, h) + boff + n * 2048 + k * 1024); } while (0)
#define PG8_MMA(ai, bj, At, Bt) do { __builtin_amdgcn_s_setprio(1); _Pragma("unroll") for (int m = 0; m < 4; ++m) _Pragma("unroll") for (int n = 0; n < 2; ++n) _Pragma("unroll") for (int k = 0; k < 2; ++k) \
        acc[ai][bj][m][n] = __builtin_amdgcn_mfma_f32_16x16x32_bf16(Bt[n][k], At[m][k], acc[ai][bj][m][n], 0, 0, 0); __builtin_amdgcn_s_setprio(0); } while (0)
#define PG8_WAIT_V(n) asm volatile("s_waitcnt vmcnt(" #n ")" ::: "memory")
#define PG8_WAIT_L(n) asm volatile("s_waitcnt lgkmcnt(" #n ")" ::: "memory")
#define PG8_BAR __builtin_amdgcn_s_barrier()
#define PG8_SCHED __builtin_amdgcn_sched_barrier(0)
    Unit cur, nxt; int ui = 0;
    if (!S.next(0, cur)) return;
    f32x4 acc[2][2][4][2];
#pragma unroll
    for (int a = 0; a < 2; ++a)
#pragma unroll
        for (int b = 0; b < 2; ++b)
#pragma unroll
            for (int m = 0; m < 4; ++m)
#pragma unroll
                for (int n = 0; n < 2; ++n) acc[a][b][m][n] = (f32x4){0.f, 0.f, 0.f, 0.f};
    bf16x8 At[4][2], B0[2][2], B1[2][2];
    const char* cA = (const char*)g.A + (size_t)cur.pm * tstep; const char* cB = (const char*)g.Bt + (size_t)cur.pn * tstep;
    S.a_ready(cur);
    if constexpr (SP2) {
        PG8_STAGE(PG8_SB(0, 0), cB, voffB); PG8_STAGE(PG8_SB(0, 1), cB + hstep, voffB); PG8_STAGE(PG8_SA(0, 0), cA, voffA); PG8_STAGE(PG8_SA(0, 1), cA + hstep, voffA);
        if (wr == 1) PG8_BAR;
        PG8_WAIT_V(2); PG8_BAR;
        PG8_STAGE(PG8_SB(1, 0), cB + kstep, voffB); PG8_STAGE(PG8_SA(1, 0), cA + kstep, voffA); PG8_STAGE(PG8_SB(1, 1), cB + hstep + kstep, voffB);
        PG8_WAIT_V(6); PG8_BAR;
    } else {
        PG8_STAGE(PG8_SB(0, 0), cB, voffB); PG8_STAGE(PG8_SA(0, 0), cA, voffA); PG8_STAGE(PG8_SB(0, 1), cB + hstep, voffB); PG8_STAGE(PG8_SA(0, 1), cA + hstep, voffA);
        if (wr == 1) PG8_BAR;
        PG8_WAIT_V(4); PG8_BAR;
        PG8_STAGE(PG8_SB(1, 0), cB + kstep, voffB); PG8_STAGE(PG8_SA(1, 0), cA + kstep, voffA); PG8_STAGE(PG8_SB(1, 1), cB + hstep + kstep, voffB);
        PG8_WAIT_V(6); PG8_BAR;
    }
    for (;;) {
        const bool has_next = S.next(ui + 1, nxt);
        const char* nA = has_next ? (const char*)g.A + (size_t)nxt.pm * tstep : cA; const char* nB = has_next ? (const char*)g.Bt + (size_t)nxt.pn * tstep : cB;
        for (int t = 0; t < nt; t += 2) {
            const bool last = (t == nt - 2);
            const char* a1 = cA + (size_t)(t + 1) * kstep;
            const char* a2 = last ? nA : cA + (size_t)(t + 2) * kstep; const char* b2 = last ? nB : cB + (size_t)(t + 2) * kstep;
            const char* a3 = a2 + kstep; const char* b3 = b2 + kstep;
            if (last && has_next) S.a_ready(nxt);
            if constexpr (SP2) {
            PG8_LDB(B0, 0, 0); PG8_LDB(B1, 0, 1); PG8_SCHED; PG8_LDA(At, 0, 0); PG8_STAGE(PG8_SA(1, 1), a1 + hstep, voffA);
            PG8_WAIT_V(8); PG8_WAIT_L(0); PG8_BAR; PG8_MMA(0, 0, At, B0); PG8_MMA(0, 1, At, B1); PG8_BAR; PG8_SCHED;
            PG8_LDA(At, 0, 1); PG8_STAGE(PG8_SB(0, 0), b2, voffB); PG8_STAGE(PG8_SB(0, 1), b2 + hstep, voffB); PG8_STAGE(PG8_SA(0, 0), a2, voffA);
            PG8_WAIT_V(8); PG8_WAIT_L(0); PG8_BAR; PG8_MMA(1, 0, At, B0); PG8_MMA(1, 1, At, B1); PG8_BAR; PG8_SCHED;
            PG8_LDB(B0, 1, 0); PG8_LDB(B1, 1, 1); PG8_SCHED; PG8_LDA(At, 1, 0); PG8_STAGE(PG8_SA(0, 1), a2 + hstep, voffA);
            PG8_WAIT_V(8); PG8_WAIT_L(0); PG8_BAR; PG8_MMA(0, 0, At, B0); PG8_MMA(0, 1, At, B1); PG8_BAR; PG8_SCHED;
            PG8_LDA(At, 1, 1); PG8_STAGE(PG8_SB(1, 0), b3, voffB); PG8_STAGE(PG8_SB(1, 1), b3 + hstep, voffB); PG8_STAGE(PG8_SA(1, 0), a3, voffA);
            PG8_WAIT_V(8); PG8_WAIT_L(0); PG8_BAR; PG8_MMA(1, 0, At, B0); PG8_MMA(1, 1, At, B1); PG8_BAR; PG8_SCHED;
            } else {
            PG8_LDB(B0, 0, 0); PG8_SCHED; PG8_LDA(At, 0, 0); PG8_STAGE(PG8_SA(1, 1), a1 + hstep, voffA);
            PG8_WAIT_L(8); PG8_BAR; PG8_WAIT_L(0); PG8_MMA(0, 0, At, B0); PG8_BAR; PG8_SCHED;
            PG8_LDB(B1, 0, 1); PG8_STAGE(PG8_SB(0, 0), b2, voffB);
            PG8_BAR; PG8_WAIT_L(0); PG8_MMA(0, 1, At, B1); PG8_BAR;
            PG8_LDA(At, 0, 1); PG8_STAGE(PG8_SA(0, 0), a2, voffA);
            PG8_BAR; PG8_WAIT_L(0); PG8_MMA(1, 0, At, B0); PG8_BAR; PG8_SCHED;
            PG8_STAGE(PG8_SB(0, 1), b2 + hstep, voffB);
            PG8_WAIT_V(6); PG8_BAR; PG8_MMA(1, 1, At, B1); PG8_BAR;
            PG8_LDB(B0, 1, 0); PG8_SCHED; PG8_LDA(At, 1, 0); PG8_STAGE(PG8_SA(0, 1), a2 + hstep, voffA);
            PG8_WAIT_L(8); PG8_BAR; PG8_WAIT_L(0); PG8_MMA(0, 0, At, B0); PG8_BAR; PG8_SCHED;
            PG8_LDB(B1, 1, 1); PG8_STAGE(PG8_SB(1, 0), b3, voffB);
            PG8_BAR; PG8_WAIT_L(0); PG8_MMA(0, 1, At, B1); PG8_BAR;
            PG8_LDA(At, 1, 1); PG8_STAGE(PG8_SA(1, 0), a3, voffA);
            PG8_BAR; PG8_WAIT_L(0); PG8_MMA(1, 0, At, B0); PG8_BAR; PG8_SCHED;
            PG8_STAGE(PG8_SB(1, 1), b3 + hstep, voffB);
            PG8_WAIT_V(6); PG8_BAR; PG8_MMA(1, 1, At, B1); PG8_BAR;
            }
        }
        if constexpr (ALIGN_EPI) { if (wr == 0) PG8_BAR; }
        if constexpr (!Epi::AFTER_DRAIN) { E(acc, cur, wr, wc, fr, fq); S.done(cur); }
        if (!has_next) break;
#pragma unroll
        for (int a = 0; a < 2; ++a)
#pragma unroll
            for (int b = 0; b < 2; ++b)
#pragma unroll
                for (int m = 0; m < 4; ++m)
#pragma unroll
                    for (int n = 0; n < 2; ++n) acc[a][b][m][n] = (f32x4){0.f, 0.f, 0.f, 0.f};
        cur = nxt; cA = nA; cB = nB; ++ui;
        if constexpr (ALIGN_EPI) { if (wr == 1) PG8_BAR; }
    }
    PG8_WAIT_V(0);
    if constexpr (!ALIGN_EPI) { if (wr == 0) PG8_BAR; }
    PG8_BAR;
    if constexpr (Epi::AFTER_DRAIN) { E.fused(acc, cur, wr, wc, fr, fq, lds, wid, lane); S.done(cur); }
#undef PG8_SA
#undef PG8_SB
#undef PG8_STAGE
#undef PG8_LDA
#undef PG8_LDB
#undef PG8_MMA
#undef PG8_WAIT_V
#undef PG8_WAIT_L
#undef PG8_BAR
#undef PG8_SCHED
}
}
#define GAS __attribute__((address_space(1)))
#define LAS __attribute__((address_space(3)))
typedef unsigned short bf16;
typedef unsigned v4u __attribute__((ext_vector_type(4)));
typedef float f32x4 __attribute__((ext_vector_type(4)));
typedef short bf16x8 __attribute__((ext_vector_type(8)));
typedef GAS unsigned gu32;
typedef GAS unsigned long long gu64;
#define RLX_AGENT __ATOMIC_RELAXED, __HIP_MEMORY_SCOPE_AGENT
#define LDS_WAIT() asm volatile("s_waitcnt lgkmcnt(0)" ::: "memory")
#define VM_WAIT() asm volatile("s_waitcnt vmcnt(0)" ::: "memory")
__device__ __forceinline__ unsigned long long rt() { return __builtin_amdgcn_s_memrealtime(); }
__device__ __forceinline__ unsigned f2bf(float f) { unsigned u = __builtin_bit_cast(unsigned, f); return (u + 0x7fffu + ((u >> 16) & 1u)) >> 16; }
__device__ __forceinline__ unsigned pk2(float lo, float hi) { return f2bf(lo) | (f2bf(hi) << 16); }

#define XB_TMO      128
#define XB_XCNT(j)  (256  + 64 * (j))
#define XB_XSUB(j)  (1280 + 64 * (j))
#define XB_XGEN(j)  (2304 + 64 * (j))
#define XB_TOP      3328
#define XB_TOPGEN   3392
#define XCD_BAR_WORDS 3456
#define XB_SPIN_CAP (1u << 18)

__device__ __forceinline__ unsigned xb_ld(unsigned* p)              { return __hip_atomic_load(p, __ATOMIC_RELAXED, __HIP_MEMORY_SCOPE_AGENT); }
__device__ __forceinline__ unsigned xb_add(unsigned* p, unsigned v) { return __hip_atomic_fetch_add(p, v, __ATOMIC_RELAXED, __HIP_MEMORY_SCOPE_AGENT); }
__device__ __forceinline__ unsigned xb_xcc_id() { return (unsigned)__builtin_amdgcn_s_getreg((3 << 11) | 20) & 0xFu; }
#define XB_SPIN(cond, bar) do { unsigned _sp = 0; while (cond) { __builtin_amdgcn_s_sleep(1); \
    if ((++_sp & 255u) == 0u) { if (xb_ld(&(bar)[XB_TMO])) break; if (_sp > XB_SPIN_CAP) { atomicAdd(&(bar)[XB_TMO], 1u); break; } } } } while (0)

struct XcdBarrier {
    unsigned* bar; unsigned x;
    volatile LAS unsigned* st;
};

__device__ __forceinline__ XcdBarrier xcd_barrier_post(unsigned* bar, volatile LAS unsigned* st) {
    XcdBarrier b; b.bar = bar; b.x = xb_xcc_id(); b.st = st;
    if (threadIdx.x == 0) (void)xb_add(&bar[XB_XCNT(b.x)], 1u);
    return b;
}
__device__ __forceinline__ void xcd_barrier_complete(unsigned* bar, unsigned x, unsigned& nloc, unsigned& nx) {
    const unsigned G = gridDim.x * gridDim.y * gridDim.z;
    unsigned sum, cnt, mine, sp = 0u;
    for (;;) {
        sum = 0u; cnt = 0u; mine = 0u;
#pragma unroll
        for (unsigned j = 0; j < 16; ++j) { const unsigned c = xb_ld(&bar[XB_XCNT(j)]); sum += c; cnt += (c > 0u) ? 1u : 0u; mine = (j == x) ? c : mine; }
        if (sum == G) break;
        __builtin_amdgcn_s_sleep(1);
        if ((++sp & 255u) == 0u) { if (xb_ld(&bar[XB_TMO])) break; if (sp > XB_SPIN_CAP) { atomicAdd(&bar[XB_TMO], 1u); break; } }
    }
    nloc = mine > 0u ? mine : 1u; nx = cnt > 0u ? cnt : 1u;
}

__device__ __forceinline__ void xcd_barrier(const XcdBarrier& b) {
    asm volatile("s_waitcnt vmcnt(0)" ::: "memory");
    __syncthreads();
    if (threadIdx.x == 0) {
        unsigned* bar = b.bar;
        __builtin_amdgcn_s_waitcnt(0);
        unsigned nloc = b.st[0], nx = b.st[1];
        if (nloc == 0u) { xcd_barrier_complete(bar, b.x, nloc, nx); b.st[0] = nloc; b.st[1] = nx; }
        const unsigned old = xb_add(&bar[XB_XSUB(b.x)], 1u);
        const unsigned gen = old / nloc;
        if (old + 1u == (gen + 1u) * nloc) {
            __builtin_amdgcn_fence(__ATOMIC_RELEASE, "agent");
            asm volatile("s_waitcnt vmcnt(0)" ::: "memory");
            const unsigned og = xb_add(&bar[XB_TOP], 1u);
            const unsigned tg = og / nx;
            if (og + 1u == (tg + 1u) * nx) xb_add(&bar[XB_TOPGEN], 1u);
            else XB_SPIN(xb_ld(&bar[XB_TOPGEN]) == tg, bar);
            __builtin_amdgcn_fence(__ATOMIC_ACQUIRE, "agent");
            xb_add(&bar[XB_XGEN(b.x)], 1u);
            asm volatile("s_waitcnt vmcnt(0)" ::: "memory");
        } else {
            XB_SPIN(xb_ld(&bar[XB_XGEN(b.x)]) == gen, bar);
            __builtin_amdgcn_fence(__ATOMIC_ACQUIRE, "agent");
            asm volatile("s_waitcnt vmcnt(0)" ::: "memory");
        }
    }
    __syncthreads();
}
constexpr int BATCH = 4, T = 4096, DM = 2048, DEPTH = 4, M = BATCH * T;
constexpr int D_IN = 6600, NPROJ = 6656;
constexpr int SC_MLQK = 0, SC_MLV = 1024, SC_MLI = 1536, SC_MLF = 1540, SC_MLO = 1544, SC_MLZ = 2056, SC_CQ = 2568, SC_CKV = 3080, SC_KR = 3336, SC_MLAZ = 3400, SC_RW = 4424, SC_RWZ = 6088;
constexpr int PC_MLQK = 0, PC_MLV = 1024, PC_MLO = 1536, PC_MLZ = 2048, PC_CQ = 2560, PC_CKV = 3072, PC_MLAZ = 3328, PC_RW = 4352, PC_SPEC = 5888, PC_RWZ = 6144;
constexpr int SPEC_TILE = PC_SPEC / 256;
constexpr int NQ = 1536, NKV = 2048;
constexpr float NORM_EPS = 1e-6f, RW_GN_EPS = 64e-5f;
typedef unsigned short bf16_t;
__device__ __forceinline__ float bf2f(unsigned v) { return __uint_as_float(v << 16); }
__device__ __forceinline__ float wave_sum(float v) {
#pragma unroll
    for (int o = 1; o < 64; o <<= 1) v += __shfl_xor(v, o);
    return v;
}
__device__ __forceinline__ float sigmoidf_(float x) { return 1.f / (1.f + __expf(-x)); }
__device__ __forceinline__ float siluf_(float x) { return x / (1.f + __expf(-x)); }
__device__ __forceinline__ float softplusf_(float x) { return fmaxf(x, 0.f) + __logf(1.f + __expf(-fabsf(x))); }
__device__ __forceinline__ float tanhf_(float x) { const float e = __expf(-2.f * fabsf(x)); const float r = (1.f - e) / (1.f + e); return x < 0.f ? -r : r; }

namespace att {
typedef unsigned short bf16_t;
typedef short bf16x8 __attribute__((ext_vector_type(8)));
typedef short s16x4 __attribute__((ext_vector_type(4)));
typedef float f32x16 __attribute__((ext_vector_type(16)));
typedef float f32x4 __attribute__((ext_vector_type(4)));
typedef unsigned u32x4 __attribute__((ext_vector_type(4)));
constexpr int NW = 8, QBLK = 32, KVBLK = 64, QB = NW * QBLK;
constexpr int QP = 1536, KVP = 2048, KRP = 64, OP = 2048;
constexpr int SHM_V = KVBLK * 128 * 2, SHM_K = KVBLK * 128 * 2, SHM_R = KVBLK * 64 * 2;
constexpr int OFF_V = 0, OFF_K = 2 * SHM_V, OFF_R = OFF_K + SHM_K, OFF_WS = OFF_R + SHM_R, OFF_Q = OFF_WS + NW * 64 * 4, LDS_BYTES = OFF_Q + NW * 12288;
constexpr float SCALE = 0.07216878364870322f;
constexpr float THR = 8.f;
constexpr unsigned WBIG = 1u << 30;
#define KSWZ(row, colB) ((row) * 256 + ((colB) ^ (((row) & 7) << 4)))
#define RSWZ(row, colB) ((row) * 128 + ((colB) ^ (((row) & 7) << 4)))
#define SBAR() __builtin_amdgcn_sched_barrier(0)
__device__ __forceinline__ int v_st(int k, int c) { const int kk = (k & ~0xC) | ((k & 4) << 1) | ((k & 8) >> 1); return ((kk >> 3) * 4 + (c >> 5)) * 512 + ((kk & 7) * 32 + (c & 31)) * 2; }
__device__ __forceinline__ int v_rd_base(int lane) { return ((lane & 3) << 3) | (((lane >> 2) & 3) << 6) | (((lane >> 4) & 1) << 5) | (((lane >> 5) & 1) << 8); }
constexpr int v_rd_off(int d0, int ks, int half) { return d0 * 512 + ks * 4096 + half * 2048; }
__device__ __forceinline__ int crow(int r, int hi) { return (r & 3) + 8 * (r >> 2) + 4 * hi; }
__device__ __forceinline__ unsigned cvtpk(float lo, float hi) { unsigned r; asm volatile("v_cvt_pk_bf16_f32 %0, %1, %2" : "=v"(r) : "v"(lo), "v"(hi)); return r; }
__device__ __forceinline__ bf16x8 load8(const bf16_t* p) { return *reinterpret_cast<const bf16x8*>(p); }
__device__ __forceinline__ float bf2f(bf16_t v) { return __uint_as_float((unsigned)v << 16); }
__device__ __forceinline__ void mask_tile(f32x16& p0, f32x16& p1, int dq, unsigned W) {
    const float NEG = -__builtin_inff();
#pragma unroll
    for (int r = 0; r < 16; ++r) {
        const int c = (r & 3) + 8 * (r >> 2);
        if ((unsigned)(dq - c) >= W) p0[r] = NEG;
        if ((unsigned)(dq - c - 32) >= W) p1[r] = NEG;
    }
}
__device__ __forceinline__ void partialSM(f32x16& p0, f32x16& p1, float& m_reg, float& mn, float& alpha) {
    float pmax = p0[0]; for (int r = 1; r < 16; ++r) pmax = fmaxf(pmax, p0[r]); for (int r = 0; r < 16; ++r) pmax = fmaxf(pmax, p1[r]);
    { auto rr = __builtin_amdgcn_permlane32_swap(__float_as_uint(pmax), __float_as_uint(pmax), false, false);
      pmax = fmaxf(__uint_as_float(rr[0]), __uint_as_float(rr[1])); }
    constexpr float C2 = 1.4426950408889634f * SCALE;
    if (__builtin_expect(__all((pmax - m_reg) * SCALE <= THR), 1)) { mn = m_reg; alpha = 1.f; }
    else { mn = fmaxf(m_reg, pmax); alpha = __builtin_amdgcn_exp2f((m_reg - mn) * C2); m_reg = mn; }
    const float mnL = -mn * C2;
    for (int r = 0; r < 16; ++r) p0[r] = fmaf(p0[r], C2, mnL); for (int r = 0; r < 16; ++r) p1[r] = fmaf(p1[r], C2, mnL);
    for (int r = 0; r < 16; ++r) p0[r] = __builtin_amdgcn_exp2f(p0[r]);
}
__device__ __forceinline__ void finishSM(f32x16& p0, f32x16& p1, float alpha, float& l_reg, bf16x8& pa0, bf16x8& pa1, bf16x8& pa2, bf16x8& pa3) {
    for (int r = 0; r < 16; ++r) p1[r] = __builtin_amdgcn_exp2f(p1[r]);
    float ps = 0; for (int r = 0; r < 16; ++r) ps += p0[r]; for (int r = 0; r < 16; ++r) ps += p1[r];
    { auto rr = __builtin_amdgcn_permlane32_swap(__float_as_uint(ps), __float_as_uint(ps), false, false);
      ps = __uint_as_float(rr[0]) + __uint_as_float(rr[1]); }
    l_reg = l_reg * alpha + ps;
#define PK4(P, B_, OUT) do { unsigned a0 = cvtpk(P[B_+0], P[B_+1]), a1 = cvtpk(P[B_+2], P[B_+3]);                          \
        unsigned b0 = cvtpk(P[B_+4], P[B_+5]), b1 = cvtpk(P[B_+6], P[B_+7]);                                             \
        auto r0 = __builtin_amdgcn_permlane32_swap(a0, b0, false, false); auto r1 = __builtin_amdgcn_permlane32_swap(a1, b1, false, false); \
        u32x4 w = {r0[0], r1[0], r0[1], r1[1]}; OUT = *reinterpret_cast<bf16x8*>(&w); } while (0)
    PK4(p0, 0, pa0); PK4(p0, 8, pa1); PK4(p1, 0, pa2); PK4(p1, 8, pa3);
#undef PK4
}
__device__ __forceinline__ void qkt(f32x16& p0, f32x16& p1, const char* K_lds, const char* R_lds, const char* Qw, int r32, int hi) {
    p0 = f32x16{}; p1 = f32x16{};
    const char* kb[4]; const char* rb[4];
#pragma unroll
    for (int dd = 0; dd < 4; ++dd) { kb[dd] = K_lds + KSWZ(r32, (dd * 16 + hi * 8) * 2); rb[dd] = R_lds + RSWZ(r32, (dd * 16 + hi * 8) * 2); }
#pragma unroll
    for (int d0 = 0; d0 < 8; ++d0) { const char* a = kb[d0 & 3] + (d0 >> 2) * 128;
        bf16x8 b0 = *reinterpret_cast<const bf16x8*>(a);
        bf16x8 b1 = *reinterpret_cast<const bf16x8*>(a + 32 * 256);
        bf16x8 q = *reinterpret_cast<const bf16x8*>(Qw + d0 * 1024);
        p0 = __builtin_amdgcn_mfma_f32_32x32x16_bf16(b0, q, p0, 0, 0, 0);
        p1 = __builtin_amdgcn_mfma_f32_32x32x16_bf16(b1, q, p1, 0, 0, 0); }
#pragma unroll
    for (int e = 0; e < 4; ++e) { const char* a = rb[e];
        bf16x8 b0 = *reinterpret_cast<const bf16x8*>(a);
        bf16x8 b1 = *reinterpret_cast<const bf16x8*>(a + 32 * 128);
        bf16x8 q = *reinterpret_cast<const bf16x8*>(Qw + (8 + e) * 1024);
        p0 = __builtin_amdgcn_mfma_f32_32x32x16_bf16(b0, q, p0, 0, 0, 0);
        p1 = __builtin_amdgcn_mfma_f32_32x32x16_bf16(b1, q, p1, 0, 0, 0); }
}
template <int VB>
__device__ __forceinline__ void pv_tile(f32x16* o, int vb0, bf16x8 pa0, bf16x8 pa1, bf16x8 pa2, bf16x8 pa3) {
#define TRRD(dst, off) asm volatile("ds_read_b64_tr_b16 %0, %1 offset:%2" : "=&v"(dst) : "v"(vb0), "i"(off) : "memory")
#define PV_D0(d0) do { s16x4 l0, l1, l2, l3, h0, h1, h2, h3; constexpr int b_ = OFF_V + VB * SHM_V + v_rd_off(d0, 0, 0); \
        TRRD(l0, b_); TRRD(h0, b_ + 2048); TRRD(l1, b_ + 4096); TRRD(h1, b_ + 6144); TRRD(l2, b_ + 8192); TRRD(h2, b_ + 10240); TRRD(l3, b_ + 12288); TRRD(h3, b_ + 14336); \
        asm volatile("s_waitcnt lgkmcnt(0)" ::: "memory"); SBAR();   \
        o[d0] = __builtin_amdgcn_mfma_f32_32x32x16_bf16(pa0, (bf16x8){l0[0], l0[1], l0[2], l0[3], h0[0], h0[1], h0[2], h0[3]}, o[d0], 0, 0, 0);   \
        o[d0] = __builtin_amdgcn_mfma_f32_32x32x16_bf16(pa1, (bf16x8){l1[0], l1[1], l1[2], l1[3], h1[0], h1[1], h1[2], h1[3]}, o[d0], 0, 0, 0);   \
        o[d0] = __builtin_amdgcn_mfma_f32_32x32x16_bf16(pa2, (bf16x8){l2[0], l2[1], l2[2], l2[3], h2[0], h2[1], h2[2], h2[3]}, o[d0], 0, 0, 0);   \
        o[d0] = __builtin_amdgcn_mfma_f32_32x32x16_bf16(pa3, (bf16x8){l3[0], l3[1], l3[2], l3[3], h3[0], h3[1], h3[2], h3[3]}, o[d0], 0, 0, 0); } while (0)
    PV_D0(0); PV_D0(1); PV_D0(2); PV_D0(3);
#undef PV_D0
#undef TRRD
}
struct BlockRef { const bf16_t* Q; const bf16_t* K; const bf16_t* V; const bf16_t* KR; bf16_t* O; const bf16_t* Z; const float* CSq; int P0; };
struct Seam { bf16x8 qr[12]; bf16x8 st_v0, st_v1, st_k0, st_k1, st_r; };
#define ROWKV(p, k0, rr) ((p) + (size_t)((k0) + (rr)) * KVP + sc)
#define VMW() asm volatile("s_waitcnt vmcnt(0)" ::: "memory")
#define VMWN(n) asm volatile("s_waitcnt vmcnt(%0)" :: "i"(n) : "memory")
#define SLOAD_H(Kp, Vp, Rp, k0) do { S.st_v0 = load8(ROWKV(Vp, k0, sr)); S.st_v1 = load8(ROWKV(Vp, k0, 32 + sr));              \
                         S.st_k0 = load8(ROWKV(Kp, k0, sr)); S.st_k1 = load8(ROWKV(Kp, k0, 32 + sr)); S.st_r = load8((Rp) + (size_t)((k0) + rr_) * KRP + rc_); } while (0)
#define SWRITE_HK() do { *(bf16x8*)(K_lds + kws) = S.st_k0; *(bf16x8*)(K_lds + kws + 32 * 256) = S.st_k1; *(bf16x8*)(R_lds + rws) = S.st_r; } while (0)
#define SWRITE_HV(bf) do { *(bf16x8*)(V_lds + (bf) * SHM_V + vst0) = S.st_v0; *(bf16x8*)(V_lds + (bf) * SHM_V + vst1) = S.st_v1; } while (0)
#define SWRITE_H(bf) do { SWRITE_HV(bf); SWRITE_HK(); } while (0)
__device__ __forceinline__ void attn_prime(const BlockRef& cur, char* lds, Seam& S) {
    int tid_o = threadIdx.x; asm volatile("" : "+v"(tid_o));
    const int tid = tid_o, wid = __builtin_amdgcn_readfirstlane(tid >> 6), lane = tid & 63, r32 = lane & 31, hi = lane >> 5;
    const int sr = tid >> 4, sc = (tid & 15) * 8, kws = KSWZ(sr, sc * 2), rr_ = tid >> 3, rc_ = (tid & 7) * 8, rws = RSWZ(rr_, rc_ * 2);
    char* K_lds = lds + OFF_K; char* R_lds = lds + OFF_R;
#pragma unroll
    for (int d0 = 0; d0 < 12; ++d0) S.qr[d0] = load8(cur.Q + (size_t)(wid * QBLK + r32) * QP + d0 * 16 + hi * 8);
    SLOAD_H(cur.K, cur.V, cur.KR, 0); VMW(); SWRITE_HK();
    __syncthreads();
}
__device__ __forceinline__ void attn_block(const BlockRef& cur, const BlockRef& nxt, char* lds, Seam& S) {
    int tid_o = threadIdx.x; asm volatile("" : "+v"(tid_o));
    const int tid = tid_o, wid = __builtin_amdgcn_readfirstlane(tid >> 6), lane = tid & 63, r32 = lane & 31, hi = lane >> 5;
    const int NT = cur.P0 / KVBLK + 4;
    const int qlo = cur.P0 + wid * QBLK, qm = qlo + r32 - 4 * hi;
    char* V_lds = lds + OFF_V; char* K_lds = lds + OFF_K; char* R_lds = lds + OFF_R;
    float* ws = (float*)(lds + OFF_WS) + wid * 64; float* li_l = ws, * al_l = ws + 32;
    float m_reg = -1e30f, l_reg = 0; f32x16 o[4] = {};
    const int sr = tid >> 4, sc = (tid & 15) * 8, vst0 = v_st(sr, sc), vst1 = v_st(32 + sr, sc), kws = KSWZ(sr, sc * 2), rr_ = tid >> 3, rc_ = (tid & 7) * 8, rws = RSWZ(rr_, rc_ * 2);
    const int vb0 = (int)(uintptr_t)lds + v_rd_base(lane);
    char* Qw = lds + OFF_Q + wid * 12288 + lane * 16;
    const bf16_t* Kh = cur.K; const bf16_t* Vh = cur.V; const bf16_t* Rh = cur.KR;
#define RESC(a) do { if (__any((a) < 1.f)) { if (hi == 0) al_l[r32] = (a); asm volatile("s_waitcnt lgkmcnt(0)" ::: "memory");              \
                     for (int d_ = 0; d_ < 4; ++d_) for (int r = 0; r < 16; ++r) o[d_][r] *= al_l[crow(r, hi)]; } } while (0)
#define KBASE(t) ((t) * KVBLK)
#define MASKT(P0_, P1_, t) do { const int kb_ = KBASE(t); if (kb_ + KVBLK - 1 > qlo) mask_tile(P0_, P1_, qm - kb_, WBIG); } while (0)
    constexpr int NQL = 12;
#define SEAM_K0() do { VMWN(NQL); SWRITE_HK(); SBAR(); } while (0)
    f32x16 pA0, pA1, pB0, pB1; float mnA, mnB, alA, alB; bf16x8 pa0, pa1, pa2, pa3;
#pragma unroll
    for (int e = 0; e < 4; ++e) { const f32x4* cp = (const f32x4*)(cur.CSq + (size_t)(wid * QBLK + r32) * 64 + (e * 8 + hi * 4) * 2); const f32x4 c0 = cp[0], c1 = cp[1];
        const bf16x8 raw = S.qr[8 + e]; float x[8];
#pragma unroll
        for (int j = 0; j < 8; ++j) x[j] = __uint_as_float((unsigned)(unsigned short)raw[j] << 16);
        u32x4 w;
        w.x = cvtpk(x[0] * c0[0] - x[1] * c0[1], x[1] * c0[0] + x[0] * c0[1]); w.y = cvtpk(x[2] * c0[2] - x[3] * c0[3], x[3] * c0[2] + x[2] * c0[3]);
        w.z = cvtpk(x[4] * c1[0] - x[5] * c1[1], x[5] * c1[0] + x[4] * c1[1]); w.w = cvtpk(x[6] * c1[2] - x[7] * c1[3], x[7] * c1[2] + x[6] * c1[3]);
        S.qr[8 + e] = *reinterpret_cast<bf16x8*>(&w); }
#pragma unroll
    for (int d0 = 0; d0 < 12; ++d0) *(bf16x8*)(Qw + d0 * 1024) = S.qr[d0];
    SWRITE_HV(0); SBAR();
    SLOAD_H(Kh, Vh, Rh, KBASE(1));
    SBAR(); qkt(pA0, pA1, K_lds, R_lds, Qw, r32, hi);
    MASKT(pA0, pA1, 0); partialSM(pA0, pA1, m_reg, mnA, alA);
    __syncthreads();
    VMW(); SWRITE_H(1);
    __syncthreads();
#define HALF_STEP(PX0, PX1, mnX, alX, PY0, PY1, alY, t, VB, SB) do {                                                          \
        SBAR(); qkt(PX0, PX1, K_lds, R_lds, Qw, r32, hi);                                                                     \
        finishSM(PY0, PY1, alY, l_reg, pa0, pa1, pa2, pa3); SBAR();                                                           \
        if ((t) + 1 < NT) { SLOAD_H(Kh, Vh, Rh, KBASE((t) + 1)); SBAR(); }                                                    \
        pv_tile<VB>(o, vb0, pa0, pa1, pa2, pa3); MASKT(PX0, PX1, (t)); partialSM(PX0, PX1, m_reg, mnX, alX);                  \
        __syncthreads();                                                                                                      \
        if ((t) + 1 < NT) { VMW(); SWRITE_H(SB); }                                                                            \
        RESC(alX); __syncthreads(); } while (0)
    for (int t = 1; t + 1 < NT; t += 2) {
        HALF_STEP(pB0, pB1, mnB, alB, pA0, pA1, alA, t, 0, 0);
        HALF_STEP(pA0, pA1, mnA, alA, pB0, pB1, alB, t + 1, 1, 1);
    }
    SBAR(); qkt(pB0, pB1, K_lds, R_lds, Qw, r32, hi); SBAR();
    SLOAD_H(nxt.K, nxt.V, nxt.KR, 0); SBAR();
    finishSM(pA0, pA1, alA, l_reg, pa0, pa1, pa2, pa3); SBAR();
    pv_tile<0>(o, vb0, pa0, pa1, pa2, pa3);
    MASKT(pB0, pB1, NT - 1); partialSM(pB0, pB1, m_reg, mnB, alB); __syncthreads(); RESC(alB);
    finishSM(pB0, pB1, alB, l_reg, pa0, pa1, pa2, pa3); SBAR(); pv_tile<1>(o, vb0, pa0, pa1, pa2, pa3);
    SBAR();
#pragma unroll
    for (int d0 = 0; d0 < 12; ++d0) S.qr[d0] = load8(nxt.Q + (size_t)(wid * QBLK + r32) * QP + d0 * 16 + hi * 8);
    SBAR(); SEAM_K0();
    if (hi == 0) li_l[r32] = l_reg; asm volatile("s_waitcnt lgkmcnt(0)" ::: "memory");
    float rli[16];
#pragma unroll
    for (int r = 0; r < 16; ++r) rli[r] = __builtin_amdgcn_rcpf(li_l[crow(r, hi)]);
    bf16_t* Ow = cur.O + (size_t)(wid * QBLK) * OP; const bf16_t* Zw = cur.Z + (size_t)(wid * QBLK) * NPROJ;
#pragma unroll
    for (int r = 0; r < 16; ++r) { const int orow = crow(r, hi);
#pragma unroll
        for (int d0 = 0; d0 < 4; ++d0) { const float z = bf2f(Zw[(size_t)orow * NPROJ + d0 * 32 + r32]);
            const float v = o[d0][r] * rli[r] * (z / (1.f + __expf(-z)));
            const float vn = __shfl_xor(v, 1);
            if ((r32 & 1) == 0) *(unsigned*)(Ow + (size_t)orow * OP + d0 * 32 + r32) = cvtpk(v, vn); } }
    __syncthreads();
#undef RESC
#undef KBASE
#undef MASKT
#undef SEAM_K0
#undef HALF_STEP
}
#undef ROWKV
#undef VMW
#undef VMWN
#undef SLOAD_H
#undef SWRITE_HK
#undef SWRITE_HV
#undef SWRITE_H
#undef KSWZ
#undef RSWZ
#undef SBAR
}
namespace mm {
typedef short bf16x8 __attribute__((ext_vector_type(8)));
typedef float f32x4 __attribute__((ext_vector_type(4)));
typedef unsigned u32x2 __attribute__((ext_vector_type(2)));
#define MM_LAS __attribute__((address_space(3)))
typedef float f32x2_t __attribute__((ext_vector_type(2))); typedef __bf16 bf16x2_t __attribute__((ext_vector_type(2)));
__device__ __forceinline__ unsigned cvtpk(float lo, float hi) { const f32x2_t v = {lo, hi}; const bf16x2_t b = __builtin_convertvector(v, bf16x2_t); return __builtin_bit_cast(unsigned, b); }
template <int NK>
__device__ __forceinline__ void blk(f32x4& acc, const MM_LAS unsigned char* A, int apitch, const MM_LAS unsigned char* Bt, int bpitch, int lane) {
    const MM_LAS unsigned char* ap = A + (lane & 15) * apitch + (lane >> 4) * 16;
    const MM_LAS unsigned char* bp = Bt + (lane & 15) * bpitch + (lane >> 4) * 16;
#pragma unroll
    for (int ks = 0; ks < NK; ++ks) { const bf16x8 a = *(const MM_LAS bf16x8*)(ap + ks * 64), b = *(const MM_LAS bf16x8*)(bp + ks * 64); acc = __builtin_amdgcn_mfma_f32_16x16x32_bf16(a, b, acc, 0, 0, 0); }
}
__device__ __forceinline__ void store_T(const f32x4& acc, MM_LAS unsigned char* img, int pitch, int jbase, int ibase, int lane) {
    u32x2 w; w.x = cvtpk(acc[0], acc[1]); w.y = cvtpk(acc[2], acc[3]);
    *(MM_LAS u32x2*)(img + (jbase + (lane & 15)) * pitch + (ibase + 4 * (lane >> 4)) * 2) = w;
}
__device__ __forceinline__ float bfl(unsigned short v) { return __uint_as_float((unsigned)v << 16); }
__device__ __forceinline__ unsigned short f2b(float f) { return (unsigned short)(cvtpk(f, 0.f) & 0xffffu); }
}

namespace mlk {
constexpr int PQ = 272, PS = 144;
constexpr int REC = 18432, NUNITS = BATCH * 4 * 64;
constexpr int LO_QI = 0, LO_KI = 17408, LO_VT = 34816, LO_SI = 55552, LO_TAB = 64768, L_END = 65280;
constexpr int O_QI = 0, O_WKT = 17408, O_VT = 35840, O_CI = 56576, O_TAB = 95744, O_HB = 97792, LDS_END = 131584;
constexpr int HBP = 132;
}
__device__ __forceinline__ void mlstm_local(unsigned char* lds_g, int first, int stride, const bf16_t* QKC, const bf16_t* PROJ, const float* GA, const float* GPM, unsigned char* MLX) {
    using namespace mlk; using mm::f32x4; using mm::bf16x8;
    MM_LAS unsigned char* L = (MM_LAS unsigned char*)lds_g;
    int tid_o = threadIdx.x; asm volatile("" : "+v"(tid_o));
    const int tid = tid_o, lane = tid & 63, wave = __builtin_amdgcn_readfirstlane(tid >> 6);
    MM_LAS unsigned char *QI = L + LO_QI, *KI = L + LO_KI, *VT = L + LO_VT, *SI = L + LO_SI; MM_LAS float* TAB = (MM_LAS float*)(L + LO_TAB);
    if (first >= NUNITS) return;
    for (int i = tid; i < 16 * PS / 4; i += 512) ((MM_LAS unsigned*)(VT + 128 * PS))[i] = (i < PS / 4) ? 0x3f803f80u : 0u;
    const int t = lane, cg = wave;
    bf16x8 q0, q1, k0, k1, v0, v1; float ga = 0.f, gp = 0.f;
#define ML_LOAD(u_) do { const int bh_ = (u_) >> 6, c_ = (u_) & 63, h_ = bh_ & 3; const size_t m_ = (size_t)(bh_ >> 2) * T + (size_t)c_ * 64 + t; const bf16_t* qp = QKC + m_ * 1024 + h_ * 128 + 16 * cg; const bf16_t* vp = PROJ + m_ * NPROJ + PC_MLV + h_ * 128 + 16 * cg; \
        q0 = *(const bf16x8*)qp; q1 = *(const bf16x8*)(qp + 8); k0 = *(const bf16x8*)(qp + 512); k1 = *(const bf16x8*)(qp + 520); v0 = *(const bf16x8*)vp; v1 = *(const bf16x8*)(vp + 8); \
        if (wave == 0) { ga = GA[m_ * 4 + h_]; gp = GPM[m_ * 4 + h_]; } } while (0)
    ML_LOAD(first);
    for (int u = first; u < NUNITS; u += stride) {
        unsigned char* rec = MLX + (size_t)u * REC;
        __syncthreads();
        *(MM_LAS bf16x8*)(QI + t * PQ + cg * 32) = q0; *(MM_LAS bf16x8*)(QI + t * PQ + cg * 32 + 16) = q1;
        *(MM_LAS bf16x8*)(KI + t * PQ + cg * 32) = k0; *(MM_LAS bf16x8*)(KI + t * PQ + cg * 32 + 16) = k1;
#pragma unroll
        for (int e = 0; e < 8; ++e) { *(MM_LAS unsigned short*)(VT + (16 * cg + e) * PS + t * 2) = (unsigned short)v0[e]; *(MM_LAS unsigned short*)(VT + (16 * cg + 8 + e) * PS + t * 2) = (unsigned short)v1[e]; }
        if (wave == 0) { TAB[t] = ga; TAB[64 + t] = gp; }
        if (u + stride < NUNITS) ML_LOAD(u + stride);
        __syncthreads();
        {
            const int bi = wave >> 1;
#pragma unroll
            for (int jj = 0; jj < 2; ++jj) { const int bj = 2 * (wave & 1) + jj; f32x4 acc = (f32x4){0.f, 0.f, 0.f, 0.f};
                if (bi <= bj) { mm::blk<4>(acc, KI + bi * 16 * PQ, PQ, QI + bj * 16 * PQ, PQ, lane);
                    const int tt = 16 * bj + (lane & 15); const float pmt = TAB[64 + tt];
#pragma unroll
                    for (int r = 0; r < 4; ++r) { const int s = 16 * bi + 4 * (lane >> 4) + r; acc[r] = (s <= tt) ? acc[r] * __expf(TAB[s] - pmt) : 0.f; } }
                mm::store_T(acc, SI, PS, 16 * bj, 16 * bi, lane); }
        }
        __syncthreads();
#pragma unroll
        for (int n = 0; n < 5; ++n) { const int id = wave + 8 * n;
            if (id < 36) { const int vb = id >> 2, tb = id & 3; f32x4 aa = (f32x4){0.f, 0.f, 0.f, 0.f};
                mm::blk<2>(aa, SI + tb * 16 * PS, PS, VT + vb * 16 * PS, PS, lane);
                mm::u32x2 w; w.x = mm::cvtpk(aa[0], aa[1]); w.y = mm::cvtpk(aa[2], aa[3]); *(mm::u32x2*)(rec + (id * 64 + lane) * 8) = w; } }
    }
    __syncthreads();
#undef ML_LOAD
}
__device__ __forceinline__ void mlstm_seq(unsigned char* lds_g, int b, int h, const bf16_t* QKC, const bf16_t* PROJ, const float* GA, const float* GB, const float* GPM, const unsigned char* MLX, const float* ng, bf16_t* MIXED) {
    using namespace mlk; using mm::f32x4; using mm::bf16x8;
    MM_LAS unsigned char* L = (MM_LAS unsigned char*)lds_g;
    int tid_o = threadIdx.x; asm volatile("" : "+v"(tid_o));
    const int tid = tid_o, lane = tid & 63, wave = __builtin_amdgcn_readfirstlane(tid >> 6);
    MM_LAS unsigned char *QI = L + O_QI, *WKT = L + O_WKT, *VT = L + O_VT, *CI = L + O_CI;
    MM_LAS float* TAB = (MM_LAS float*)(L + O_TAB);
    MM_LAS float* HB = (MM_LAS float*)(L + O_HB);
    for (int i = tid; i < 39168 / 4; i += 512) ((MM_LAS unsigned*)CI)[i] = 0u;
    for (int i = tid; i < 16 * PS / 4; i += 512) ((MM_LAS unsigned*)(VT + 128 * PS))[i] = (i < PS / 4) ? 0x3f803f80u : 0u;
    f32x4 cacc[9];
#pragma unroll
    for (int i = 0; i < 9; ++i) cacc[i] = (f32x4){0.f, 0.f, 0.f, 0.f};
    float m_run = 0.f;
    const int t = lane, cg = wave;
    const size_t mrow0 = (size_t)b * T; const unsigned char* rec0 = MLX + (size_t)((b * 4 + h) * 64) * REC;
    bf16x8 q0, q1, k0, k1, v0, v1; float ga, gb, gp;
#define ML_LOAD(c_) do { const size_t m_ = mrow0 + (size_t)(c_) * 64 + t; const bf16_t* qp = QKC + m_ * 1024 + h * 128 + 16 * cg; const bf16_t* vp = PROJ + m_ * NPROJ + PC_MLV + h * 128 + 16 * cg; \
        q0 = *(const bf16x8*)qp; q1 = *(const bf16x8*)(qp + 8); k0 = *(const bf16x8*)(qp + 520 - 8); k1 = *(const bf16x8*)(qp + 520); v0 = *(const bf16x8*)vp; v1 = *(const bf16x8*)(vp + 8); \
        ga = GA[m_ * 4 + h]; gb = GB[m_ * 4 + h]; gp = GPM[m_ * 4 + h]; } while (0)
    ML_LOAD(0);
    const int et = tid >> 3, ep = tid & 7;
    f32x4 ngr[4];
#pragma unroll
    for (int i = 0; i < 4; ++i) ngr[i] = *(const f32x4*)(ng + 16 * ep + 4 * i);
    typedef unsigned u32x4_ __attribute__((ext_vector_type(4)));
    for (int c = 0; c < 64; ++c) {
        const size_t em_ = mrow0 + (size_t)c * 64 + et;
        const u32x4_ eg0 = *(const u32x4_*)(PROJ + em_ * NPROJ + PC_MLO + h * 128 + 16 * ep), eg1 = *(const u32x4_*)(PROJ + em_ * NPROJ + PC_MLO + h * 128 + 16 * ep + 8);
        mm::u32x2 ib[5];
#pragma unroll
        for (int n = 0; n < 5; ++n) { const int id = wave + 8 * n; ib[n] = (mm::u32x2){0u, 0u}; if (id < 36) ib[n] = *(const mm::u32x2*)(rec0 + (size_t)c * REC + (id * 64 + lane) * 8); }
        const float mx = fmaxf(m_run, gp), mxL = __shfl(mx, 63), bL = __shfl(gb, 63);
        const float wt = __expf(ga - mxL), decay = __expf(m_run - mxL);
        if (wave == 0) { TAB[t] = __expf(m_run - mx); TAB[64 + t] = __expf(gp - mx); TAB[128 + t] = __expf(-(gb + mx)); }
        m_run = bL + mxL;
        {
            *(MM_LAS bf16x8*)(QI + t * PQ + cg * 32) = q0; *(MM_LAS bf16x8*)(QI + t * PQ + cg * 32 + 16) = q1;
#pragma unroll
            for (int e = 0; e < 8; ++e) {
                *(MM_LAS unsigned short*)(WKT + (16 * cg + e) * PS + t * 2) = mm::f2b(wt * mm::bfl((unsigned short)k0[e]));
                *(MM_LAS unsigned short*)(WKT + (16 * cg + 8 + e) * PS + t * 2) = mm::f2b(wt * mm::bfl((unsigned short)k1[e]));
                *(MM_LAS unsigned short*)(VT + (16 * cg + e) * PS + t * 2) = (unsigned short)v0[e];
                *(MM_LAS unsigned short*)(VT + (16 * cg + 8 + e) * PS + t * 2) = (unsigned short)v1[e]; }
        }
        if (c + 1 < 64) ML_LOAD(c + 1);
        __syncthreads();
        f32x4 res[5];
        {
#pragma unroll
            for (int n = 0; n < 5; ++n) { const int id = wave + 8 * n; res[n] = (f32x4){0.f, 0.f, 0.f, 0.f};
                if (id < 36) { const int vb = id >> 2, tb = id & 3; f32x4 ai = (f32x4){0.f, 0.f, 0.f, 0.f};
                    mm::blk<4>(ai, QI + tb * 16 * PQ, PQ, CI + vb * 16 * PQ, PQ, lane);
                    const f32x4 in4 = (f32x4){__uint_as_float(ib[n].x << 16), __uint_as_float(ib[n].x & 0xffff0000u), __uint_as_float(ib[n].y << 16), __uint_as_float(ib[n].y & 0xffff0000u)};
#pragma unroll
                    for (int r = 0; r < 4; ++r) { const int tt = 16 * tb + 4 * (lane >> 4) + r; res[n][r] = TAB[tt] * ai[r] + TAB[64 + tt] * in4[r]; } } }
#pragma unroll
            for (int vb = 0; vb < 9; ++vb) { cacc[vb] = cacc[vb] * decay; mm::blk<2>(cacc[vb], WKT + wave * 16 * PS, PS, VT + vb * 16 * PS, PS, lane); }
        }
        const float em_l = TAB[128 + 16 * (wave & 3) + 4 * (lane >> 4) + 0], em_1 = TAB[128 + 16 * (wave & 3) + 4 * (lane >> 4) + 1], em_2 = TAB[128 + 16 * (wave & 3) + 4 * (lane >> 4) + 2], em_3 = TAB[128 + 16 * (wave & 3) + 4 * (lane >> 4) + 3];
        __syncthreads();
        {
#pragma unroll
            for (int n = 0; n < 5; ++n) { const int id = wave + 8 * n;
                if (id < 36) { const int vb = id >> 2, tb = id & 3, j = lane & 15;
#pragma unroll
                    for (int r = 0; r < 4; ++r) { const int tt = 16 * tb + 4 * (lane >> 4) + r;
                        if (vb < 8 || j == 0) HB[tt * HBP + 16 * vb + j] = res[n][r];
                        else if (j == 1) HB[tt * HBP + 129] = (r == 0 ? em_l : r == 1 ? em_1 : r == 2 ? em_2 : em_3); } } }
#pragma unroll
            for (int vb = 0; vb < 9; ++vb) mm::store_T(cacc[vb], CI, PQ, 16 * vb, 16 * wave, lane);
        }
        __syncthreads();
        {
            const MM_LAS float* hr = HB + et * HBP; const float rdn = 1.f / fmaxf(fabsf(hr[128]), hr[129]);
            f32x4 hv[4]; float sm = 0.f;
#pragma unroll
            for (int i = 0; i < 4; ++i) { hv[i] = *(const MM_LAS f32x4*)(hr + 16 * ep + 4 * i) * rdn; sm += (hv[i][0] + hv[i][1]) + (hv[i][2] + hv[i][3]); }
            sm += __shfl_xor(sm, 1); sm += __shfl_xor(sm, 2); sm += __shfl_xor(sm, 4);
            const float mean = sm * (1.f / 128.f); float sq = 0.f;
#pragma unroll
            for (int i = 0; i < 4; ++i) { hv[i] = hv[i] - mean; sq += (hv[i][0] * hv[i][0] + hv[i][1] * hv[i][1]) + (hv[i][2] * hv[i][2] + hv[i][3] * hv[i][3]); }
            sq += __shfl_xor(sq, 1); sq += __shfl_xor(sq, 2); sq += __shfl_xor(sq, 4);
            const float rstd = 1.f / sqrtf(sq * (1.f / 128.f) + NORM_EPS);
            u32x4_ o0, o1;
#pragma unroll
            for (int i = 0; i < 4; ++i) { const unsigned g0_ = (i < 2 ? eg0 : eg1)[(2 * i) & 3], g1_ = (i < 2 ? eg0 : eg1)[(2 * i + 1) & 3];
                const unsigned w0 = mm::cvtpk(bf2f(g0_ & 0xffffu) * hv[i][0] * rstd * ngr[i][0], bf2f(g0_ >> 16) * hv[i][1] * rstd * ngr[i][1]), w1 = mm::cvtpk(bf2f(g1_ & 0xffffu) * hv[i][2] * rstd * ngr[i][2], bf2f(g1_ >> 16) * hv[i][3] * rstd * ngr[i][3]);
                if (i < 2) { o0[2 * i] = w0; o0[2 * i + 1] = w1; } else { o1[2 * i - 4] = w0; o1[2 * i - 3] = w1; } }
            *(u32x4_*)(MIXED + em_ * DM + h * 128 + 16 * ep) = o0; *(u32x4_*)(MIXED + em_ * DM + h * 128 + 16 * ep + 8) = o1;
        }
    }
    __syncthreads();
#undef ML_LOAD
}
namespace rwk {
constexpr int PS = 144, SLOT = 9216;
constexpr int S_AT = 0, S_RT = 1, S_BTT = 2, S_KTT = 3, S_VTT = 4, S_AAK = 5, S_ARB = 6, S_ARK = 7, S_ATT = 8, S_TAT = 9, S_Z0 = 10, S_Z1 = 11, S_Z2 = 12, S_Z3 = 13, S_T0 = 14, S_T1 = 15;
constexpr int O_TAB = 16 * SLOT, O_PQ = O_TAB + 256, LDS_END = O_PQ + 4096, FP = 68;
constexpr int REC = 32768, R_RA = 0, R_MT = 8192, R_YC = 16384, R_NT = 24576;
constexpr int NUNITS = BATCH * 8 * 64;
}
__device__ __forceinline__ void rwkv_local(unsigned char* lds_g, int first, int stride, const float* RWW, const bf16_t* RWB, size_t RWS, unsigned char* RWX) {
    using namespace rwk; using mm::f32x4; using mm::bf16x8;
    MM_LAS unsigned char* L = (MM_LAS unsigned char*)lds_g;
    int tid_o = threadIdx.x; asm volatile("" : "+v"(tid_o));
    const int tid = tid_o, lane = tid & 63, wave = __builtin_amdgcn_readfirstlane(tid >> 6);
#define SL(n) (L + (n) * SLOT)
    MM_LAS float* WLT = (MM_LAS float*)(L + O_TAB); MM_LAS float* TF = (MM_LAS float*)SL(S_Z0); MM_LAS float* AF = (MM_LAS float*)SL(S_T0); MM_LAS float* PQ = (MM_LAS float*)(L + O_PQ);
    const int t = lane, cg = wave, bi = wave >> 1, bj0 = 2 * (wave & 1), lj = lane & 15, lq = lane >> 4;
    bf16x8 gr, gk, gv, ga, gb; f32x4 gw0, gw1;
#define RW_LOAD(u_) do { const int bh_ = (u_) >> 6, c_ = (u_) & 63; const size_t o_ = ((size_t)(bh_ >> 3) * T + (size_t)c_ * 64 + t) * 512 + (bh_ & 7) * 64 + 8 * cg; \
        gr = *(const bf16x8*)(RWB + o_); gk = *(const bf16x8*)(RWB + RWS + o_); gv = *(const bf16x8*)(RWB + 2 * RWS + o_); ga = *(const bf16x8*)(RWB + 3 * RWS + o_); gb = *(const bf16x8*)(RWB + 4 * RWS + o_); \
        gw0 = *(const f32x4*)(RWW + o_); gw1 = *(const f32x4*)(RWW + o_ + 4); } while (0)
    if (first >= NUNITS) return;
    RW_LOAD(first);
    for (int u = first; u < NUNITS; u += stride) {
        unsigned char* rec = RWX + (size_t)u * REC;
        __syncthreads();
        {
            float lw[8], cw[8];
#pragma unroll
            for (int e = 0; e < 4; ++e) { lw[e] = gw0[e]; lw[4 + e] = gw1[e]; }
#pragma unroll
            for (int e = 0; e < 8; ++e) { float s = lw[e];
#pragma unroll
                for (int o = 1; o < 64; o <<= 1) { const float u = __shfl_up(s, o); if (lane >= o) s += u; }
                cw[e] = s; }
            float av[8], bv[8], kv[8], rv[8];
#pragma unroll
            for (int e = 0; e < 8; ++e) { const float Wt = __expf(cw[e]), Wp = __expf(cw[e] - lw[e]), iW = __expf(-cw[e]);
                av[e] = mm::bfl((unsigned short)ga[e]) * Wp; bv[e] = mm::bfl((unsigned short)gb[e]) * iW; kv[e] = mm::bfl((unsigned short)gk[e]) * iW; rv[e] = mm::bfl((unsigned short)gr[e]) * Wt;
                if (lane == 63) WLT[8 * cg + e] = Wt; }
            typedef unsigned u32x4_ __attribute__((ext_vector_type(4)));
            u32x4_ pa, pb, pk, pr;
            pa.x = mm::cvtpk(av[0], av[1]); pa.y = mm::cvtpk(av[2], av[3]); pa.z = mm::cvtpk(av[4], av[5]); pa.w = mm::cvtpk(av[6], av[7]);
            pb.x = mm::cvtpk(bv[0], bv[1]); pb.y = mm::cvtpk(bv[2], bv[3]); pb.z = mm::cvtpk(bv[4], bv[5]); pb.w = mm::cvtpk(bv[6], bv[7]);
            pk.x = mm::cvtpk(kv[0], kv[1]); pk.y = mm::cvtpk(kv[2], kv[3]); pk.z = mm::cvtpk(kv[4], kv[5]); pk.w = mm::cvtpk(kv[6], kv[7]);
            pr.x = mm::cvtpk(rv[0], rv[1]); pr.y = mm::cvtpk(rv[2], rv[3]); pr.z = mm::cvtpk(rv[4], rv[5]); pr.w = mm::cvtpk(rv[6], rv[7]);
            *(MM_LAS u32x4_*)(SL(S_AT) + t * PS + cg * 16) = pa; *(MM_LAS u32x4_*)(SL(S_RT) + t * PS + cg * 16) = pr;
            *(MM_LAS u32x4_*)(SL(S_Z0) + t * PS + cg * 16) = pb; *(MM_LAS u32x4_*)(SL(S_Z1) + t * PS + cg * 16) = pk; asm volatile("" ::: "memory");
#pragma unroll
            for (int e = 0; e < 8; ++e) { const unsigned wb = (e & 1) ? (pb[e >> 1] >> 16) : (pb[e >> 1] & 0xffffu), wk = (e & 1) ? (pk[e >> 1] >> 16) : (pk[e >> 1] & 0xffffu);
                *(MM_LAS unsigned short*)(SL(S_BTT) + (8 * cg + e) * PS + t * 2) = (unsigned short)wb;
                *(MM_LAS unsigned short*)(SL(S_KTT) + (8 * cg + e) * PS + t * 2) = (unsigned short)wk;
                *(MM_LAS unsigned short*)(SL(S_VTT) + (8 * cg + e) * PS + t * 2) = (unsigned short)gv[e];
                *(MM_LAS unsigned short*)(SL(S_ATT) + (8 * cg + e) * PS + t * 2) = (unsigned short)((e & 1) ? (pa[e >> 1] >> 16) : (pa[e >> 1] & 0xffffu)); }
        }
        if (u + stride < NUNITS) RW_LOAD(u + stride);
        __syncthreads();
        {
#pragma unroll
            for (int jj = 0; jj < 2; ++jj) { const int bj = bj0 + jj; const int tt = 16 * bj + lj, s0 = 16 * bi + 4 * lq;
                f32x4 ab = (f32x4){0.f, 0.f, 0.f, 0.f}, ak = ab, rb = ab, rk = ab;
                if (bi <= bj) {
                    mm::blk<2>(ab, SL(S_Z0) + bi * 16 * PS, PS, SL(S_AT) + bj * 16 * PS, PS, lane);
                    mm::blk<2>(ak, SL(S_Z1) + bi * 16 * PS, PS, SL(S_AT) + bj * 16 * PS, PS, lane);
                    mm::blk<2>(rb, SL(S_Z0) + bi * 16 * PS, PS, SL(S_RT) + bj * 16 * PS, PS, lane);
                    mm::blk<2>(rk, SL(S_Z1) + bi * 16 * PS, PS, SL(S_RT) + bj * 16 * PS, PS, lane);
#pragma unroll
                    for (int r = 0; r < 4; ++r) { const int s = s0 + r; if (!(s < tt)) { ab[r] = 0.f; ak[r] = 0.f; } if (!(s <= tt)) { rb[r] = 0.f; rk[r] = 0.f; } } }
                mm::store_T(ak, SL(S_AAK), PS, 16 * bj, 16 * bi, lane); mm::store_T(rb, SL(S_ARB), PS, 16 * bj, 16 * bi, lane); mm::store_T(rk, SL(S_ARK), PS, 16 * bj, 16 * bi, lane);
                *(MM_LAS f32x4*)(AF + tt * FP + s0) = ab; asm volatile("" ::: "memory"); }
        }
        __syncthreads();
        if (wave < 4) { if (lane < 16) {
                float Tc[16]; const MM_LAS float* ar = AF + (16 * wave) * FP + 16 * wave;
#pragma unroll
                for (int r = 0; r < 16; ++r) { float acc = (r == lane) ? 1.f : 0.f;
#pragma unroll
                    for (int q4 = 0; q4 < (r + 3) / 4; ++q4) { const f32x4 a4 = *(const MM_LAS f32x4*)(ar + r * FP + 4 * q4);
#pragma unroll
                        for (int e = 0; e < 4; ++e) if (4 * q4 + e < r) acc += a4[e] * Tc[4 * q4 + e]; }
                    Tc[r] = acc; TF[(16 * wave + r) * FP + 16 * wave + lane] = acc; } } }
        else { const int z = (wave - 4) * 64 + lane, zb = z >> 7, zi = (z >> 4) & 7, zj = z & 15;
#pragma unroll
            for (int hh = 0; hh < 2; ++hh) TF[(32 * zb + zi + 8 * hh) * FP + 32 * zb + 16 + zj] = 0.f; }
        __syncthreads();
        {
            const int pr_ = tid >> 8, i = (tid >> 4) & 15, j = tid & 15, rb = 32 * pr_ + 16, cb = 32 * pr_; float acc = 0.f;
#pragma unroll
            for (int k4 = 0; k4 < 4; ++k4) { const f32x4 a4 = *(const MM_LAS f32x4*)(AF + (rb + i) * FP + cb + 4 * k4);
#pragma unroll
                for (int e = 0; e < 4; ++e) acc += a4[e] * TF[(cb + 4 * k4 + e) * FP + cb + j]; }
            PQ[pr_ * 256 + i * 16 + j] = acc; }
        __syncthreads();
        {
            const int pr_ = tid >> 8, i = (tid >> 4) & 15, j = tid & 15, rb = 32 * pr_ + 16, cb = 32 * pr_; float acc = 0.f;
#pragma unroll
            for (int k4 = 0; k4 < 4; ++k4) { const f32x4 a4 = *(const MM_LAS f32x4*)(TF + (rb + i) * FP + rb + 4 * k4);
#pragma unroll
                for (int e = 0; e < 4; ++e) acc += a4[e] * PQ[pr_ * 256 + (4 * k4 + e) * 16 + j]; }
            TF[(rb + i) * FP + cb + j] = acc; }
        __syncthreads();
        {
            const int i = tid >> 4, jq = tid & 15; float acc0 = 0.f, acc1 = 0.f;
#pragma unroll
            for (int k4 = 0; k4 < 8; ++k4) { const f32x4 a4 = *(const MM_LAS f32x4*)(AF + (32 + i) * FP + 4 * k4);
#pragma unroll
                for (int e = 0; e < 4; ++e) { acc0 += a4[e] * TF[(4 * k4 + e) * FP + jq]; acc1 += a4[e] * TF[(4 * k4 + e) * FP + 16 + jq]; }
                if (k4 & 1) asm volatile("" ::: "memory"); }
            PQ[i * 32 + jq] = acc0; PQ[i * 32 + 16 + jq] = acc1; }
        __syncthreads();
        {
            const int i = tid >> 4, jq = tid & 15; float acc0 = 0.f, acc1 = 0.f;
#pragma unroll
            for (int k4 = 0; k4 < 8; ++k4) { const f32x4 a4 = *(const MM_LAS f32x4*)(TF + (32 + i) * FP + 32 + 4 * k4);
#pragma unroll
                for (int e = 0; e < 4; ++e) { acc0 += a4[e] * PQ[(4 * k4 + e) * 32 + jq]; acc1 += a4[e] * PQ[(4 * k4 + e) * 32 + 16 + jq]; }
                if (k4 & 1) asm volatile("" ::: "memory"); }
            TF[(32 + i) * FP + jq] = acc0; TF[(32 + i) * FP + 16 + jq] = acc1; }
        __syncthreads();
        {
            const int tr = tid >> 3, s8 = (tid & 7) * 8; const f32x4 x0 = *(const MM_LAS f32x4*)(TF + tr * FP + s8), x1 = *(const MM_LAS f32x4*)(TF + tr * FP + s8 + 4);
            float y[8];
#pragma unroll
            for (int e = 0; e < 4; ++e) { y[e] = (s8 + e <= tr) ? x0[e] : 0.f; y[4 + e] = (s8 + 4 + e <= tr) ? x1[e] : 0.f; }
            typedef unsigned u32x4_ __attribute__((ext_vector_type(4))); u32x4_ w;
            w.x = mm::cvtpk(y[0], y[1]); w.y = mm::cvtpk(y[2], y[3]); w.z = mm::cvtpk(y[4], y[5]); w.w = mm::cvtpk(y[6], y[7]);
            *(MM_LAS u32x4_*)(SL(S_T0) + tr * PS + s8 * 2) = w; }
        {
#pragma unroll
            for (int jj = 0; jj < 2; ++jj) { const int bj = bj0 + jj; f32x4 d = (f32x4){0.f, 0.f, 0.f, 0.f};
                mm::blk<2>(d, SL(S_AAK) + bi * 16 * PS, PS, SL(S_VTT) + bj * 16 * PS, PS, lane);
                mm::store_T(d, SL(S_Z2), PS, 16 * bj, 16 * bi, lane); }
        }
        __syncthreads();
        {
#pragma unroll
            for (int jj = 0; jj < 2; ++jj) { const int bj = bj0 + jj; f32x4 d = (f32x4){0.f, 0.f, 0.f, 0.f}, e2 = d;
                mm::blk<2>(d, SL(S_T0) + bi * 16 * PS, PS, SL(S_ATT) + bj * 16 * PS, PS, lane); mm::store_T(d, SL(S_TAT), PS, 16 * bj, 16 * bi, lane);
                mm::blk<2>(e2, SL(S_T0) + bi * 16 * PS, PS, SL(S_Z2) + bj * 16 * PS, PS, lane); mm::store_T(e2, SL(S_Z3), PS, 16 * bj, 16 * bi, lane); }
        }
        __syncthreads();
        {
#pragma unroll
            for (int jj = 0; jj < 2; ++jj) { const int bj = bj0 + jj;
                f32x4 d;
#pragma unroll
                for (int r = 0; r < 4; ++r) d[r] = mm::bfl(*(const MM_LAS unsigned short*)(SL(S_RT) + (16 * bi + 4 * lq + r) * PS + (16 * bj + lj) * 2));
                mm::blk<2>(d, SL(S_ARB) + bi * 16 * PS, PS, SL(S_TAT) + bj * 16 * PS, PS, lane);
#pragma unroll
                for (int r = 0; r < 4; ++r) *(unsigned short*)(rec + R_RA + ((16 * bi + 4 * lq + r) * 64 + 16 * bj + lj) * 2) = mm::f2b(d[r]);
                asm volatile("" ::: "memory");
                f32x4 mt = (f32x4){0.f, 0.f, 0.f, 0.f};
                mm::blk<2>(mt, SL(S_TAT) + bi * 16 * PS, PS, SL(S_BTT) + bj * 16 * PS, PS, lane);
                const float wl = WLT[16 * bj + lj];
#pragma unroll
                for (int r = 0; r < 4; ++r) mt[r] = (mt[r] + ((16 * bi + 4 * lq + r) == (16 * bj + lj) ? 1.f : 0.f)) * wl;
                { mm::u32x2 w; w.x = mm::cvtpk(mt[0], mt[1]); w.y = mm::cvtpk(mt[2], mt[3]); *(mm::u32x2*)(rec + R_MT + ((16 * bj + lj) * 64 + 16 * bi + 4 * lq) * 2) = w; }
                asm volatile("" ::: "memory");
                f32x4 yc = (f32x4){0.f, 0.f, 0.f, 0.f};
                mm::blk<2>(yc, SL(S_ARB) + bi * 16 * PS, PS, SL(S_Z3) + bj * 16 * PS, PS, lane); mm::blk<2>(yc, SL(S_ARK) + bi * 16 * PS, PS, SL(S_VTT) + bj * 16 * PS, PS, lane);
                { mm::u32x2 w; w.x = mm::cvtpk(yc[0], yc[1]); w.y = mm::cvtpk(yc[2], yc[3]); *(mm::u32x2*)(rec + R_YC + (((bi * 4 + bj) * 64) + lane) * 8) = w; }
                asm volatile("" ::: "memory");
                f32x4 nt = (f32x4){0.f, 0.f, 0.f, 0.f};
                mm::blk<2>(nt, SL(S_BTT) + bi * 16 * PS, PS, SL(S_Z3) + bj * 16 * PS, PS, lane); mm::blk<2>(nt, SL(S_KTT) + bi * 16 * PS, PS, SL(S_VTT) + bj * 16 * PS, PS, lane);
#pragma unroll
                for (int r = 0; r < 4; ++r) nt[r] *= WLT[16 * bi + 4 * lq + r];
                { mm::u32x2 w; w.x = mm::cvtpk(nt[0], nt[1]); w.y = mm::cvtpk(nt[2], nt[3]); *(mm::u32x2*)(rec + R_NT + (((bi * 4 + bj) * 64) + lane) * 8) = w; } }
        }
    }
    __syncthreads();
#undef RW_LOAD
}
namespace rws { constexpr int PS = 144, SLOT = 9216, S_RA = 0, S_MT = 1, S_SA = 2, S_SB = 3, O_YB = 4 * SLOT, YP = 68, O_LN = O_YB + 64 * YP * 4, LDS_END = O_LN + 512; }
__device__ __forceinline__ void rwkv_seq(unsigned char* lds_g, int b, int h, const unsigned char* RWX, const bf16_t* RWB, size_t RWS, const float* BONUS, const bf16_t* PROJ, const float* ln_g, const float* ln_b, bf16_t* MIXED) {
    using namespace rws; using mm::f32x4;
    MM_LAS unsigned char* L = (MM_LAS unsigned char*)lds_g;
    int tid_o = threadIdx.x; asm volatile("" : "+v"(tid_o));
    const int tid = tid_o, lane = tid & 63, wave = __builtin_amdgcn_readfirstlane(tid >> 6);
    MM_LAS float* YB = (MM_LAS float*)(L + O_YB); MM_LAS float* LNT = (MM_LAS float*)(L + O_LN);
    for (int i = tid; i < 2 * SLOT / 4; i += 512) ((MM_LAS unsigned*)SL(S_SA))[i] = 0u;
    if (tid < 128) LNT[tid] = tid < 64 ? ln_g[tid] : ln_b[tid - 64];
    const int bi = wave >> 1, bj0 = 2 * (wave & 1), lj = lane & 15, lq = lane >> 4, et = tid >> 3, ep = tid & 7;
    const size_t mrow0 = (size_t)b * T; const unsigned char* rec0 = RWX + (size_t)((b * 8 + h) * 64) * rwk::REC;
    typedef unsigned u32x4e __attribute__((ext_vector_type(4)));
    u32x4e gra, gmt; mm::u32x2 gyc[2], gnt[2];
#define SQ_LOAD(c_) do { const unsigned char* r_ = rec0 + (size_t)(c_) * rwk::REC; gra = *(const u32x4e*)(r_ + rwk::R_RA + tid * 16); gmt = *(const u32x4e*)(r_ + rwk::R_MT + tid * 16); \
        _Pragma("unroll") for (int jj = 0; jj < 2; ++jj) { gyc[jj] = *(const mm::u32x2*)(r_ + rwk::R_YC + (((bi * 4 + bj0 + jj) * 64) + lane) * 8); gnt[jj] = *(const mm::u32x2*)(r_ + rwk::R_NT + (((bi * 4 + bj0 + jj) * 64) + lane) * 8); } } while (0)
    SQ_LOAD(0);
    for (int c = 0; c < 64; ++c) {
        const size_t em_ = mrow0 + (size_t)c * 64 + et;
        const u32x4e ez = *(const u32x4e*)(PROJ + em_ * NPROJ + PC_RWZ + h * 64 + 8 * ep), ev = *(const u32x4e*)(RWB + 2 * RWS + em_ * 512 + h * 64 + 8 * ep);
        const float ebon = BONUS[em_ * 8 + h];
        MM_LAS unsigned char* S0 = SL((c & 1) ? S_SB : S_SA); MM_LAS unsigned char* S0n = SL((c & 1) ? S_SA : S_SB);
        *(MM_LAS u32x4e*)(SL(S_RA) + et * PS + ep * 16) = gra; *(MM_LAS u32x4e*)(SL(S_MT) + et * PS + ep * 16) = gmt;
        f32x4 yi[2], ni[2];
#pragma unroll
        for (int jj = 0; jj < 2; ++jj) { yi[jj] = (f32x4){__uint_as_float(gyc[jj].x << 16), __uint_as_float(gyc[jj].x & 0xffff0000u), __uint_as_float(gyc[jj].y << 16), __uint_as_float(gyc[jj].y & 0xffff0000u)};
            ni[jj] = (f32x4){__uint_as_float(gnt[jj].x << 16), __uint_as_float(gnt[jj].x & 0xffff0000u), __uint_as_float(gnt[jj].y << 16), __uint_as_float(gnt[jj].y & 0xffff0000u)}; }
        if (c + 1 < 64) SQ_LOAD(c + 1);
        __syncthreads();
#pragma unroll
        for (int jj = 0; jj < 2; ++jj) { const int bj = bj0 + jj;
            mm::blk<2>(yi[jj], SL(S_RA) + bi * 16 * PS, PS, S0 + bj * 16 * PS, PS, lane);
#pragma unroll
            for (int r = 0; r < 4; ++r) YB[(16 * bi + 4 * lq + r) * YP + 16 * bj + lj] = yi[jj][r];
            mm::blk<2>(ni[jj], SL(S_MT) + bi * 16 * PS, PS, S0 + bj * 16 * PS, PS, lane);
            mm::store_T(ni[jj], S0n, PS, 16 * bj, 16 * bi, lane); }
        __syncthreads();
        {
            f32x4 y0 = *(const MM_LAS f32x4*)(YB + et * YP + 8 * ep), y1 = *(const MM_LAS f32x4*)(YB + et * YP + 8 * ep + 4);
            float sm = ((y0[0] + y0[1]) + (y0[2] + y0[3])) + ((y1[0] + y1[1]) + (y1[2] + y1[3]));
            sm += __shfl_xor(sm, 1); sm += __shfl_xor(sm, 2); sm += __shfl_xor(sm, 4);
            const float mean = sm * (1.f / 64.f); y0 = y0 - mean; y1 = y1 - mean;
            float sq = ((y0[0] * y0[0] + y0[1] * y0[1]) + (y0[2] * y0[2] + y0[3] * y0[3])) + ((y1[0] * y1[0] + y1[1] * y1[1]) + (y1[2] * y1[2] + y1[3] * y1[3]));
            sq += __shfl_xor(sq, 1); sq += __shfl_xor(sq, 2); sq += __shfl_xor(sq, 4);
            const float rstd = 1.f / sqrtf(sq * (1.f / 64.f) + RW_GN_EPS);
            const f32x4 lg0 = *(const MM_LAS f32x4*)(LNT + 8 * ep), lg1 = *(const MM_LAS f32x4*)(LNT + 8 * ep + 4), lb0 = *(const MM_LAS f32x4*)(LNT + 64 + 8 * ep), lb1 = *(const MM_LAS f32x4*)(LNT + 64 + 8 * ep + 4);
            u32x4e o;
#pragma unroll
            for (int i = 0; i < 4; ++i) { const float ya = (i < 2 ? y0 : y1)[(2 * i) & 3], yb = (i < 2 ? y0 : y1)[(2 * i + 1) & 3], ga = (i < 2 ? lg0 : lg1)[(2 * i) & 3], gb_ = (i < 2 ? lg0 : lg1)[(2 * i + 1) & 3], ba = (i < 2 ? lb0 : lb1)[(2 * i) & 3], bb_ = (i < 2 ? lb0 : lb1)[(2 * i + 1) & 3];
                const float na = ya * rstd * ga + ba + ebon * bf2f(ev[i] & 0xffffu), nb = yb * rstd * gb_ + bb_ + ebon * bf2f(ev[i] >> 16);
                o[i] = mm::cvtpk(siluf_(bf2f(ez[i] & 0xffffu)) * na, siluf_(bf2f(ez[i] >> 16)) * nb); }
            *(u32x4e*)(MIXED + em_ * DM + 1536 + h * 64 + 8 * ep) = o;
        }
    }
    __syncthreads();
#undef SQ_LOAD
#undef SL
}
namespace prp {
constexpr int PS = 144, PW = 1040, PT = 80;
constexpr int O_X = 0, O_A = 9216, O_AIM = 18432, O_VIM = 84992, O_T1 = 151552, LDS_END = 156672;
typedef unsigned u32x4 __attribute__((ext_vector_type(4)));
template <int NK>
__device__ __forceinline__ void blk_g(mm::f32x4& acc, const MM_LAS unsigned char* A, int apitch, const bf16_t* Bt, int bpitch, int lane) {
    const MM_LAS unsigned char* ap = A + (lane & 15) * apitch + (lane >> 4) * 16; const bf16_t* bp = Bt + (size_t)(lane & 15) * bpitch + (lane >> 4) * 8;
#pragma unroll
    for (int ks = 0; ks < NK; ++ks) { const mm::bf16x8 a = *(const MM_LAS mm::bf16x8*)(ap + ks * 64), b = *(const mm::bf16x8*)(bp + ks * 32); acc = __builtin_amdgcn_mfma_f32_16x16x32_bf16(a, b, acc, 0, 0, 0); }
}
__device__ __forceinline__ void unpack8(const u32x4 w, float (&f)[8]) {
#pragma unroll
    for (int i = 0; i < 4; ++i) { f[2 * i] = __uint_as_float(w[i] << 16); f[2 * i + 1] = __uint_as_float(w[i] & 0xffff0000u); } }
__device__ __forceinline__ u32x4 pack8(const float (&f)[8]) { u32x4 w; w.x = mm::cvtpk(f[0], f[1]); w.y = mm::cvtpk(f[2], f[3]); w.z = mm::cvtpk(f[4], f[5]); w.w = mm::cvtpk(f[6], f[7]); return w; }
}
struct PrepP {
    const float *mu, *w0, *a0, *v0, *k_k, *k_a, *r_k, *conv_w, *conv_b, *i_bias, *f_bias; const bf16_t *W2T, *A2T, *V1T, *V2T; int layer;
    const bf16_t* PROJ; const float* SPEC; const float* CS; float* RWW; bf16_t* RWB; bf16_t* VFIRST; float* BONUS; bf16_t* CQN; bf16_t* CKVN; bf16_t* KR; bf16_t* QKC; float* LI; float* LF; float* PMX;
};
__device__ __forceinline__ void prep_tile(unsigned char* lds_g, int tile, const PrepP& P) {
    using namespace prp; using mm::f32x4; using mm::bf16x8;
    MM_LAS unsigned char* L = (MM_LAS unsigned char*)lds_g;
    int tid_o = threadIdx.x; asm volatile("" : "+v"(tid_o));
    const int tid = tid_o, lane = tid & 63, wave = __builtin_amdgcn_readfirstlane(tid >> 6);
    const int m0 = tile * 64, t0 = m0 % T;
    constexpr size_t RWS = (size_t)M * 512;
    const bool resid = P.layer > 0;
    { const int t = tid >> 3, p = tid & 7; const size_t m = (size_t)m0 + t; const bool has_prev = (t0 + t) > 0;
#pragma unroll
      for (int which = 0; which < 2; ++which) { const float* cp = P.SPEC + m * 256 + which * 64 + 8 * p; const f32x4 c0 = *(const f32x4*)cp, c1 = *(const f32x4*)(cp + 4);
          f32x4 p0 = (f32x4){0.f, 0.f, 0.f, 0.f}, p1 = p0; if (has_prev) { p0 = *(const f32x4*)(cp - 256); p1 = *(const f32x4*)(cp - 252); }
          const f32x4 mu0 = *(const f32x4*)(P.mu + 1536 + which * 64 + 8 * p), mu1 = *(const f32x4*)(P.mu + 1536 + which * 64 + 8 * p + 4);
          float f[8];
#pragma unroll
          for (int e = 0; e < 4; ++e) { f[e] = c0[e] + mu0[e] * (p0[e] - c0[e]); f[4 + e] = c1[e] + mu1[e] * (p1[e] - c1[e]); }
          if (which == 0) {
#pragma unroll
              for (int e = 0; e < 8; ++e) f[e] = tanhf_(f[e]); }
          *(MM_LAS u32x4*)(L + (which ? O_A : O_X) + t * PS + p * 16) = pack8(f); } }
    if (resid) { const int t = lane, hh = wave; const size_t m = (size_t)m0 + t; const bool has_prev = (t0 + t) > 0;
        const bf16_t* cp = P.PROJ + m * NPROJ + PC_RW + 1024 + hh * 64;
#pragma unroll
        for (int g = 0; g < 8; ++g) { float c[8], pv[8], mu_[8], o[8]; unpack8(*(const u32x4*)(cp + 8 * g), c);
            if (has_prev) unpack8(*(const u32x4*)(cp - NPROJ + 8 * g), pv); else {
#pragma unroll
                for (int e = 0; e < 8; ++e) pv[e] = 0.f; }
            const f32x4 m0_ = *(const f32x4*)(P.mu + 1024 + hh * 64 + 8 * g), m1_ = *(const f32x4*)(P.mu + 1024 + hh * 64 + 8 * g + 4);
#pragma unroll
            for (int e = 0; e < 4; ++e) { mu_[e] = m0_[e]; mu_[4 + e] = m1_[e]; }
#pragma unroll
            for (int e = 0; e < 8; ++e) o[e] = c[e] + mu_[e] * (pv[e] - c[e]);
            *(MM_LAS u32x4*)(L + O_VIM + t * PW + hh * 128 + g * 16) = pack8(o); } }
    __syncthreads();
    { bf16x8 fx[4][2], fa[4][2];
#pragma unroll
      for (int bi = 0; bi < 4; ++bi)
#pragma unroll
          for (int ks = 0; ks < 2; ++ks) { fx[bi][ks] = *(const MM_LAS bf16x8*)(L + O_X + (16 * bi + (lane & 15)) * PS + (lane >> 4) * 16 + ks * 64); fa[bi][ks] = *(const MM_LAS bf16x8*)(L + O_A + (16 * bi + (lane & 15)) * PS + (lane >> 4) * 16 + ks * 64); }
#pragma unroll
      for (int bjl = 0; bjl < 4; ++bjl) { const int c = 64 * wave + 16 * bjl + (lane & 15);
          const bf16_t* wp = P.W2T + (size_t)c * 64 + (lane >> 4) * 8; const bf16_t* ap = P.A2T + (size_t)c * 64 + (lane >> 4) * 8;
          const bf16x8 bw0 = *(const bf16x8*)wp, bw1 = *(const bf16x8*)(wp + 32), ba0 = *(const bf16x8*)ap, ba1 = *(const bf16x8*)(ap + 32);
          const float w0c = P.w0[c], a0c = P.a0[c];
#pragma unroll
          for (int bi = 0; bi < 4; ++bi) { f32x4 aw = (f32x4){0.f, 0.f, 0.f, 0.f}, aa = aw;
              aw = __builtin_amdgcn_mfma_f32_16x16x32_bf16(fx[bi][0], bw0, aw, 0, 0, 0); aw = __builtin_amdgcn_mfma_f32_16x16x32_bf16(fx[bi][1], bw1, aw, 0, 0, 0);
              aa = __builtin_amdgcn_mfma_f32_16x16x32_bf16(fa[bi][0], ba0, aa, 0, 0, 0); aa = __builtin_amdgcn_mfma_f32_16x16x32_bf16(fa[bi][1], ba1, aa, 0, 0, 0);
#pragma unroll
              for (int r = 0; r < 4; ++r) { const int t = 16 * bi + 4 * (lane >> 4) + r;
                  const float logw = -softplusf_(-(aw[r] + w0c)) - 0.5f;
                  P.RWW[((size_t)m0 + t) * 512 + c] = -__expf(logw);
                  *(MM_LAS unsigned short*)(L + O_AIM + t * PW + c * 2) = mm::f2b(sigmoidf_(aa[r] + a0c)); } }
          asm volatile("" ::: "memory"); }
      if (resid) { const int bi = wave >> 1, bj = wave & 1; f32x4 d = (f32x4){0.f, 0.f, 0.f, 0.f};
          blk_g<16>(d, L + O_VIM + bi * 16 * PW, PW, P.V1T + (size_t)bj * 16 * 512, 512, lane);
#pragma unroll
          for (int r = 0; r < 4; ++r) *(MM_LAS unsigned short*)(L + O_T1 + (16 * bi + 4 * (lane >> 4) + r) * PT + (16 * bj + (lane & 15)) * 2) = mm::f2b(d[r]); } }
    __syncthreads();
    { MM_LAS float* PT_ = (MM_LAS float*)(L + O_X);
      PT_[tid] = P.mu[tid]; PT_[512 + tid] = P.mu[512 + tid]; PT_[1024 + tid] = P.mu[1024 + tid]; PT_[1536 + tid] = P.k_k[tid]; PT_[2048 + tid] = P.k_a[tid]; PT_[2560 + tid] = P.r_k[tid]; }
    if (resid) { bf16x8 ft[4];
#pragma unroll
        for (int bi = 0; bi < 4; ++bi) ft[bi] = *(const MM_LAS bf16x8*)(L + O_T1 + (16 * bi + (lane & 15)) * PT + (lane >> 4) * 16);
#pragma unroll
        for (int bjl = 0; bjl < 4; ++bjl) { const int c = 64 * wave + 16 * bjl + (lane & 15); const bf16x8 b = *(const bf16x8*)(P.V2T + (size_t)c * 32 + (lane >> 4) * 8); const float v0c = P.v0[c];
#pragma unroll
            for (int bi = 0; bi < 4; ++bi) { f32x4 d = (f32x4){0.f, 0.f, 0.f, 0.f}; d = __builtin_amdgcn_mfma_f32_16x16x32_bf16(ft[bi], b, d, 0, 0, 0);
#pragma unroll
                for (int r = 0; r < 4; ++r) *(MM_LAS unsigned short*)(L + O_VIM + (16 * bi + 4 * (lane >> 4) + r) * PW + c * 2) = mm::f2b(sigmoidf_(d[r] + v0c)); } } }
    __syncthreads();
    { const int t = lane, hh = wave; const size_t m = (size_t)m0 + t; const bool has_prev = (t0 + t) > 0; const int cb = hh * 64;
      const bf16_t* cp = P.PROJ + m * NPROJ + PC_RW + cb; const size_t ob = m * 512 + cb;
      const MM_LAS float* PT_ = (const MM_LAS float*)(L + O_X) + cb;
#define PRM(arr, g, e) (PT_[(arr) * 512 + 8 * (g) + (e)])
      float ss = 0.f, bon = 0.f;
      u32x4 ksp[8];
      const u32x4 zero4 = (u32x4){0u, 0u, 0u, 0u};
#define LDC(off, g) (*(const u32x4*)(cp + (off) + 8 * (g)))
#define LDP(off, g) (has_prev ? *(const u32x4*)(cp + (off) - NPROJ + 8 * (g)) : zero4)
      { u32x4 nc = LDC(512, 0), np = LDP(512, 0);
#pragma unroll
        for (int g = 0; g < 8; ++g) { const u32x4 rc = nc, rp = np; if (g < 7) { nc = LDC(512, g + 1); np = LDP(512, g + 1); }
          float c[8], pv[8], o[8]; unpack8(rc, c); unpack8(rp, pv);
#pragma unroll
          for (int e = 0; e < 8; ++e) { o[e] = c[e] + PRM(1, g, e) * (pv[e] - c[e]); const float q = o[e] * PRM(3, g, e); ss += q * q; }
          ksp[g] = pack8(o); asm volatile("" ::: "memory"); } }
      const float rn = 1.f / fmaxf(sqrtf(ss), 1e-12f);
      { u32x4 nc = LDC(0, 0), np = LDP(0, 0);
#pragma unroll
        for (int g = 0; g < 8; ++g) { const u32x4 rc = nc, rp = np; if (g < 7) { nc = LDC(0, g + 1); np = LDP(0, g + 1); }
          float ks_[8], a_[8], c[8], pv[8], rr[8], okh[8], oa[8], ob_[8]; unpack8(ksp[g], ks_); unpack8(*(const MM_LAS u32x4*)(L + O_AIM + t * PW + cb * 2 + g * 16), a_); unpack8(rc, c); unpack8(rp, pv);
#pragma unroll
          for (int e = 0; e < 8; ++e) { rr[e] = c[e] + PRM(0, g, e) * (pv[e] - c[e]); const float kkn = ks_[e] * PRM(3, g, e) * rn; okh[e] = ks_[e] * (1.f + (a_[e] - 1.f) * PRM(4, g, e)); oa[e] = -kkn; ob_[e] = kkn * a_[e]; bon += rr[e] * okh[e] * PRM(5, g, e); }
          *(u32x4*)(P.RWB + ob + 8 * g) = pack8(rr); *(u32x4*)(P.RWB + RWS + ob + 8 * g) = pack8(okh); *(u32x4*)(P.RWB + 3 * RWS + ob + 8 * g) = pack8(oa); *(u32x4*)(P.RWB + 4 * RWS + ob + 8 * g) = pack8(ob_);
          asm volatile("" ::: "memory"); } }
      P.BONUS[m * 8 + hh] = bon;
      { u32x4 nc = LDC(1024, 0), np = LDP(1024, 0), nf = resid ? *(const u32x4*)(P.VFIRST + ob) : zero4;
#pragma unroll
        for (int g = 0; g < 8; ++g) { const u32x4 rc = nc, rp = np, rf = nf; if (g < 7) { nc = LDC(1024, g + 1); np = LDP(1024, g + 1); if (resid) nf = *(const u32x4*)(P.VFIRST + ob + 8 * (g + 1)); }
          float c[8], pv[8], o[8]; unpack8(rc, c); unpack8(rp, pv);
#pragma unroll
          for (int e = 0; e < 8; ++e) o[e] = c[e] + PRM(2, g, e) * (pv[e] - c[e]);
          if (resid) { float gg[8], vf[8]; unpack8(*(const MM_LAS u32x4*)(L + O_VIM + t * PW + cb * 2 + g * 16), gg); unpack8(rf, vf);
#pragma unroll
              for (int e = 0; e < 8; ++e) o[e] = o[e] + (vf[e] - o[e]) * gg[e]; }
          else *(u32x4*)(P.VFIRST + ob + 8 * g) = pack8(o);
          *(u32x4*)(P.RWB + 2 * RWS + ob + 8 * g) = pack8(o); asm volatile("" ::: "memory"); } }
#undef LDC
#undef LDP
#undef PRM
    }
    { const int t = tid >> 3, p = tid & 7; const size_t m = (size_t)m0 + t;
      { const bf16_t* cp = P.PROJ + m * NPROJ + PC_CQ + 64 * p; u32x4 w[8]; float s = 0.f;
#pragma unroll
        for (int g = 0; g < 8; ++g) { w[g] = *(const u32x4*)(cp + 8 * g); float f[8]; unpack8(w[g], f);
#pragma unroll
            for (int e = 0; e < 8; ++e) s += f[e] * f[e]; }
        s += __shfl_xor(s, 1); s += __shfl_xor(s, 2); s += __shfl_xor(s, 4);
        const float rstd = 1.f / sqrtf(s * (1.f / 512.f) + NORM_EPS);
#pragma unroll
        for (int g = 0; g < 8; ++g) { float f[8]; unpack8(w[g], f);
#pragma unroll
            for (int e = 0; e < 8; ++e) f[e] *= rstd;
            *(u32x4*)(P.CQN + m * 512 + 64 * p + 8 * g) = pack8(f); } }
      { const bf16_t* cp = P.PROJ + m * NPROJ + PC_CKV + 32 * p; u32x4 w[4]; float s = 0.f;
#pragma unroll
        for (int g = 0; g < 4; ++g) { w[g] = *(const u32x4*)(cp + 8 * g); float f[8]; unpack8(w[g], f);
#pragma unroll
            for (int e = 0; e < 8; ++e) s += f[e] * f[e]; }
        s += __shfl_xor(s, 1); s += __shfl_xor(s, 2); s += __shfl_xor(s, 4);
        const float rstd = 1.f / sqrtf(s * (1.f / 256.f) + NORM_EPS);
#pragma unroll
        for (int g = 0; g < 4; ++g) { float f[8]; unpack8(w[g], f);
#pragma unroll
            for (int e = 0; e < 8; ++e) f[e] *= rstd;
            *(u32x4*)(P.CKVN + m * 256 + 32 * p + 8 * g) = pack8(f); } }
      { const float* sp = P.SPEC + m * 256 + 128 + 8 * p; const f32x4 x0 = *(const f32x4*)sp, x1 = *(const f32x4*)(sp + 4);
        const float* cs = P.CS + (m * 32 + 4 * p) * 2; const f32x4 c0 = *(const f32x4*)cs, c1 = *(const f32x4*)(cs + 4);
        float o[8];
        o[0] = x0[0] * c0[0] - x0[1] * c0[1]; o[1] = x0[1] * c0[0] + x0[0] * c0[1]; o[2] = x0[2] * c0[2] - x0[3] * c0[3]; o[3] = x0[3] * c0[2] + x0[2] * c0[3];
        o[4] = x1[0] * c1[0] - x1[1] * c1[1]; o[5] = x1[1] * c1[0] + x1[0] * c1[1]; o[6] = x1[2] * c1[2] - x1[3] * c1[3]; o[7] = x1[3] * c1[2] + x1[2] * c1[3];
        *(u32x4*)(P.KR + m * 64 + 8 * p) = pack8(o); }
      { bf16_t* op = const_cast<bf16_t*>(P.PROJ) + m * NPROJ + PC_MLO + 64 * p; const bf16_t* zp = P.PROJ + m * NPROJ + PC_MLZ + 64 * p;
#pragma unroll
        for (int g = 0; g < 8; ++g) { float o_[8], z_[8], r_[8]; unpack8(*(const u32x4*)(op + 8 * g), o_); unpack8(*(const u32x4*)(zp + 8 * g), z_);
#pragma unroll
            for (int e = 0; e < 8; ++e) r_[e] = siluf_(z_[e]) * sigmoidf_(o_[e]);
            *(u32x4*)(op + 8 * g) = pack8(r_); if (g & 1) asm volatile("" ::: "memory"); } }
      { const int gh = p; const float val = P.SPEC[m * 256 + 192 + gh]; MM_LAS float* GT = (MM_LAS float*)(L + O_T1);
        GT[gh * 64 + t] = gh < 4 ? val + P.i_bias[gh] : -softplusf_(-(val + P.f_bias[gh - 4])); } }
    __syncthreads();
    if (wave < 4) { const MM_LAS float* GT = (const MM_LAS float*)(L + O_T1); const float li = GT[wave * 64 + lane]; float bb = GT[(4 + wave) * 64 + lane];
#pragma unroll
        for (int o = 1; o < 64; o <<= 1) { const float u = __shfl_up(bb, o); if (lane >= o) bb += u; }
        const float a = li - bb; float pm = a;
#pragma unroll
        for (int o = 1; o < 64; o <<= 1) { const float u = __shfl_up(pm, o); if (lane >= o) pm = fmaxf(pm, u); }
        const size_t gi = ((size_t)m0 + lane) * 4 + wave; P.LI[gi] = a; P.LF[gi] = bb; P.PMX[gi] = pm; }
    { const int cgp = tid & 127, tq = tid >> 7, ch = 8 * cgp; const float sc_ = ch < 512 ? 0.08838834764831845f : 1.f;
      float cw[4][8], cbv[8];
#pragma unroll
      for (int j = 0; j < 4; ++j) { const f32x4 a = *(const f32x4*)(P.conv_w + j * 1024 + ch), b = *(const f32x4*)(P.conv_w + j * 1024 + ch + 4);
#pragma unroll
          for (int e = 0; e < 4; ++e) { cw[j][e] = a[e]; cw[j][4 + e] = b[e]; } }
      { const f32x4 a = *(const f32x4*)(P.conv_b + ch), b = *(const f32x4*)(P.conv_b + ch + 4);
#pragma unroll
        for (int e = 0; e < 4; ++e) { cbv[e] = a[e]; cbv[4 + e] = b[e]; } }
      float x0[8], x1[8], x2[8];
      const int tb = 16 * tq;
#pragma unroll
      for (int e = 0; e < 8; ++e) { x0[e] = 0.f; x1[e] = 0.f; x2[e] = 0.f; }
      if (t0 + tb >= 3) { unpack8(*(const u32x4*)(P.PROJ + ((size_t)m0 + tb - 3) * NPROJ + PC_MLQK + ch), x0); unpack8(*(const u32x4*)(P.PROJ + ((size_t)m0 + tb - 2) * NPROJ + PC_MLQK + ch), x1); unpack8(*(const u32x4*)(P.PROJ + ((size_t)m0 + tb - 1) * NPROJ + PC_MLQK + ch), x2); }
#pragma unroll 4
      for (int i = 0; i < 16; ++i) { float x3[8], y[8]; unpack8(*(const u32x4*)(P.PROJ + ((size_t)m0 + tb + i) * NPROJ + PC_MLQK + ch), x3);
#pragma unroll
          for (int e = 0; e < 8; ++e) { const float v = cbv[e] + cw[0][e] * x0[e] + cw[1][e] * x1[e] + cw[2][e] * x2[e] + cw[3][e] * x3[e]; y[e] = siluf_(v) * sc_; x0[e] = x1[e]; x1[e] = x2[e]; x2[e] = x3[e]; }
          *(u32x4*)(P.QKC + ((size_t)m0 + tb + i) * 1024 + ch) = pack8(y); } }
    __syncthreads();
}
constexpr size_t MiB = 1u << 20;
constexpr size_t WS_CTL = 0, CTL_ZERO_BYTES = 1 * MiB;
constexpr size_t WS_WIN = 1 * MiB;
constexpr size_t WS_WUQ = WS_WIN + 104 * MiB;
constexpr size_t WS_WUKV = WS_WUQ + 6 * MiB;
constexpr size_t WS_WOUT = WS_WUKV + 4 * MiB;
constexpr size_t WS_CS = WS_WOUT + 32 * MiB;
constexpr size_t WS_XN = WS_CS + 4 * MiB;
constexpr size_t WS_PROJ = WS_XN + 64 * MiB;
constexpr size_t WS_SPEC = WS_PROJ + 208 * MiB;
constexpr size_t WS_CQN = WS_SPEC + 16 * MiB;
constexpr size_t WS_CKVN = WS_CQN + 16 * MiB;
constexpr size_t WS_KR = WS_CKVN + 8 * MiB;
constexpr size_t WS_Q = WS_KR + 2 * MiB;
constexpr size_t WS_KV = WS_Q + 48 * MiB;
constexpr size_t WS_QKC = WS_KV + 64 * MiB;
constexpr size_t WS_GATE = WS_QKC + 32 * MiB;
constexpr size_t WS_RWW = WS_GATE + 1 * MiB;
constexpr size_t WS_RWB = WS_RWW + 32 * MiB;
constexpr size_t WS_VFIRST = WS_RWB + 80 * MiB;
constexpr size_t WS_BONUS = WS_VFIRST + 16 * MiB;
constexpr size_t WS_LR = WS_BONUS + 1 * MiB;
constexpr size_t LR_STRIDE = 196608, LR_W2T = 0, LR_A2T = 65536, LR_V1T = 131072, LR_V2T = 163840;
constexpr size_t WS_RWX = WS_LR + 1 * MiB;
constexpr size_t WS_MLX = WS_RWX + 64 * MiB;
constexpr size_t WS_END = WS_MLX + 18 * MiB;
static_assert(WS_END <= 865075200ull, "d_ws map exceeds the guaranteed workspace (4 x the largest tensor)");
constexpr int CW_BAR = 4096;
constexpr int LDS_BYTES = 163840, RING_BYTES = 158720, MISC_OFF = RING_BYTES + 320;
static_assert(att::LDS_BYTES <= RING_BYTES, "attention LDS");

struct Args { const float* in[28]; float* out; unsigned char* ws; int ph_lo, ph_hi; };

struct MapWin { __device__ __forceinline__ int operator()(int n) const {
    if (n < 1536) return n;
    if (n < 2048) return SC_MLO + (n - 1536);
    if (n < 2560) return SC_MLZ + (n - 2048);
    if (n < 3072) return SC_CQ + (n - 2560);
    if (n < 3328) return SC_CKV + (n - 3072);
    if (n < 4352) return SC_MLAZ + (n - 3328);
    if (n < 5888) return SC_RW + (n - 4352);
    if (n < 6144) { const int j = n - 5888;
        if (j < 128) return SC_RW + 1536 + j;
        if (j < 192) { const int q = j - 128; return SC_KR + ((q & 1) ? 32 + (q >> 1) : (q >> 1)); }
        if (j < 196) return SC_MLI + (j - 192);
        if (j < 200) return SC_MLF + (j - 196);
        return -1; }
    return SC_RWZ + (n - 6144); } };
struct MapUq { __device__ __forceinline__ int operator()(int n) const { const int h = n / 192, d = n % 192; if (d < 128) return n; const int q = d - 128; return h * 192 + 128 + ((q & 1) ? 32 + (q >> 1) : (q >> 1)); } };
struct MapId { __device__ __forceinline__ int operator()(int n) const { return n; } };

template <class Map>
__device__ __forceinline__ void transpose_item(const float* W, int K, int Nsrc, bf16_t* WT, const float* gain, LAS float* scr, int kb, int nb, int lane, Map map) {
    const int k0 = 64 * kb, n0 = 32 * nb, sc = map(n0 + (lane & 31));
#pragma unroll 8
    for (int i = 0; i < 32; ++i) { const int kk = 2 * i + (lane >> 5); float v = 0.f;
        if (sc >= 0) { v = W[(size_t)(k0 + kk) * Nsrc + sc]; if (gain) v *= gain[k0 + kk]; }
        scr[kk * 33 + (lane & 31)] = v; }
    LDS_WAIT(); asm volatile("" ::: "memory");
    const int c = lane & 7;
#pragma unroll
    for (int j = 0; j < 4; ++j) { const int n = (lane >> 3) + 8 * j; const LAS float* s = scr + (8 * c) * 33 + n;
        v4u o; o.x = pk2(s[0 * 33], s[1 * 33]); o.y = pk2(s[2 * 33], s[3 * 33]); o.z = pk2(s[4 * 33], s[5 * 33]); o.w = pk2(s[6 * 33], s[7 * 33]);
        *(v4u*)(WT + (size_t)(n0 + n) * K + k0 + 8 * c) = o; }
    LDS_WAIT(); asm volatile("" ::: "memory");
}

template <int MODE>
__device__ __forceinline__ void norm_row(const float* xrow, bf16_t* orow, float* frow, const float* g, int lane) {
    const f32x4* xr = (const f32x4*)xrow + lane;
    f32x4 v[8]; float s = 0.f;
#pragma unroll
    for (int j = 0; j < 8; ++j) { v[j] = xr[64 * j]; s += (v[j].x * v[j].x + v[j].y * v[j].y) + (v[j].z * v[j].z + v[j].w * v[j].w); }
    const float rstd = 1.f / sqrtf(wave_sum(s) * (1.f / DM) + NORM_EPS);
    if (MODE == 0) { unsigned long long* o8 = (unsigned long long*)orow + lane;
#pragma unroll
        for (int j = 0; j < 8; ++j) o8[64 * j] = (unsigned long long)pk2(v[j].x * rstd, v[j].y * rstd) | ((unsigned long long)pk2(v[j].z * rstd, v[j].w * rstd) << 32);
    } else { f32x4* o = (f32x4*)frow + lane; const f32x4* gr = (const f32x4*)g + lane;
#pragma unroll
        for (int j = 0; j < 8; ++j) { const f32x4 gg = gr[64 * j]; o[64 * j] = v[j] * rstd * gg; } }
}

__device__ __forceinline__ att::BlockRef mk_block(const bf16_t* Q, const bf16_t* KV, const bf16_t* KR, bf16_t* MIXED, const bf16_t* PROJ, const float* CS, int L_, int pass_) {
    const int bh = L_ >> 3, x = L_ & 7, qb = pass_ ? 15 - x : x, b = bh >> 3, h = bh & 7; att::BlockRef r;
    const size_t rb = (size_t)b * T, rq = rb + (size_t)qb * 256;
    r.Q = Q + rq * NQ + h * 192; r.K = KV + rb * NKV + h * 256; r.V = r.K + 128; r.KR = KR + rb * 64; r.O = MIXED + rq * DM + 512 + h * 128; r.Z = PROJ + rq * NPROJ + PC_MLAZ + h * 128; r.CSq = CS + rq * 64; r.P0 = qb * 256; return r;
}
#ifndef REP_PREP
#define REP_PREP 1
#endif
#ifndef REP_MIX
#define REP_MIX 1
#endif
#ifndef REP_RW
#define REP_RW 1
#endif
#ifndef REP_ML
#define REP_ML 1
#endif
#ifndef REP_ATT
#define REP_ATT 1
#endif
__global__ void __launch_bounds__(512, 2) fwd(Args args) {
    extern __shared__ __attribute__((aligned(16))) unsigned char lds[];
    const int tid = threadIdx.x, lane = tid & 63, wave = __builtin_amdgcn_readfirstlane(tid >> 6);
    const int G = gridDim.x, bid = blockIdx.x;
    unsigned char* ws = args.ws;
    volatile LAS unsigned* MISC = (volatile LAS unsigned*)((LAS unsigned char*)lds + MISC_OFF);
    for (int u = tid; u < (LDS_BYTES - RING_BYTES) / 4; u += 512) ((LAS unsigned*)((LAS unsigned char*)lds + RING_BYTES))[u] = 0u;
    __syncthreads();
    const bool one_launch = (args.ph_hi - args.ph_lo) > 1;
    XcdBarrier bar; bar.bar = (unsigned*)(ws + WS_CTL) + CW_BAR; bar.x = 0; bar.st = nullptr;
    if (one_launch) bar = xcd_barrier_post((unsigned*)(ws + WS_CTL) + CW_BAR, MISC + 8);
    const int lo = args.ph_lo, hi = args.ph_hi;
#define IN(k) (lo <= (k) && (k) < hi)
#define SEAM(k) do { if (IN(k) && IN((k) + 1)) xcd_barrier(bar); } while (0)

    const float* x_in = args.in[0]; const int* positions = (const int*)args.in[1];
    float* X = args.out;
    bf16_t* WIN = (bf16_t*)(ws + WS_WIN); bf16_t* WUQ = (bf16_t*)(ws + WS_WUQ); bf16_t* WUKV = (bf16_t*)(ws + WS_WUKV); bf16_t* WOUT = (bf16_t*)(ws + WS_WOUT);
    float* CS = (float*)(ws + WS_CS); bf16_t* XN = (bf16_t*)(ws + WS_XN); bf16_t* MIXED = XN; bf16_t* PROJ = (bf16_t*)(ws + WS_PROJ); float* SPEC = (float*)(ws + WS_SPEC);
    bf16_t* CQN = (bf16_t*)(ws + WS_CQN); bf16_t* CKVN = (bf16_t*)(ws + WS_CKVN); bf16_t* KR = (bf16_t*)(ws + WS_KR); bf16_t* Q = (bf16_t*)(ws + WS_Q); bf16_t* KV = (bf16_t*)(ws + WS_KV);
    bf16_t* QKC = (bf16_t*)(ws + WS_QKC); float* LI = (float*)(ws + WS_GATE); float* LF = LI + (size_t)M * 4;
    float* RWW = (float*)(ws + WS_RWW); bf16_t* RWB = (bf16_t*)(ws + WS_RWB); bf16_t* VFIRST = (bf16_t*)(ws + WS_VFIRST); float* BONUS = (float*)(ws + WS_BONUS);
    constexpr size_t RWS = (size_t)M * 512;

    if (IN(0)) {
#ifndef NO_PRO
        LAS float* scr = (LAS float*)((LAS unsigned char*)lds + wave * 16384);
        const int gw = bid * 8 + wave, NGW = G * 8;
        constexpr int I_IN = (DM / 64) * (NPROJ / 32), I_UQ = (512 / 64) * (NQ / 32), I_UKV = (256 / 64) * (NKV / 32), I_OUT = (DM / 64) * (DM / 32), I_L = I_IN + I_UQ + I_UKV + I_OUT;
        for (int it = gw; it < DEPTH * I_L; it += NGW) {
            const int l = it / I_L; int r = it % I_L;
            if (r < I_IN) { transpose_item(args.in[3] + (size_t)l * DM * D_IN, DM, D_IN, WIN + (size_t)l * NPROJ * DM, args.in[2] + l * DM, scr, r / (NPROJ / 32), r % (NPROJ / 32), lane, MapWin()); continue; } r -= I_IN;
            if (r < I_UQ) { transpose_item(args.in[10] + (size_t)l * 512 * NQ, 512, NQ, WUQ + (size_t)l * NQ * 512, args.in[9] + l * 512, scr, r / (NQ / 32), r % (NQ / 32), lane, MapUq()); continue; } r -= I_UQ;
            if (r < I_UKV) { transpose_item(args.in[12] + (size_t)l * 256 * NKV, 256, NKV, WUKV + (size_t)l * NKV * 256, args.in[11] + l * 256, scr, r / (NKV / 32), r % (NKV / 32), lane, MapId()); continue; } r -= I_UKV;
            transpose_item(args.in[26] + (size_t)l * DM * DM, DM, DM, WOUT + (size_t)l * DM * DM, (const float*)nullptr, scr, r / (DM / 32), r % (DM / 32), lane, MapId());
        }
        for (int it = gw; it < DEPTH * 40; it += NGW) {
            const int l = it / 40, r = it % 40; unsigned char* lr = ws + WS_LR + (size_t)l * LR_STRIDE;
            if (r < 16) transpose_item(args.in[15] + (size_t)l * 64 * 512, 64, 512, (bf16_t*)(lr + LR_W2T), (const float*)nullptr, scr, 0, r, lane, MapId());
            else if (r < 32) transpose_item(args.in[17] + (size_t)l * 64 * 512, 64, 512, (bf16_t*)(lr + LR_A2T), (const float*)nullptr, scr, 0, r - 16, lane, MapId());
            else if (l > 0) transpose_item(args.in[19] + (size_t)(l - 1) * 512 * 32, 512, 32, (bf16_t*)(lr + LR_V1T), (const float*)nullptr, scr, r - 32, 0, lane, MapId());
        }
        for (int i = bid * 512 + tid; i < (DEPTH - 1) * 512 * 32; i += G * 512) { const int l = 1 + i / 16384, e = i % 16384, c = e >> 5, j = e & 31;
            ((bf16_t*)(ws + WS_LR + (size_t)l * LR_STRIDE + LR_V2T))[c * 32 + j] = (bf16_t)f2bf(args.in[20][(size_t)(l - 1) * 32 * 512 + j * 512 + c]); }
        for (int i = bid * 512 + tid; i < M * 32; i += G * 512) { const int m = i >> 5, j = i & 31;
            const float inv_freq = powf(10000.f, -(float)(2 * j) / 64.f);
            const float ang = (float)positions[m] * inv_freq;
            const double a = (double)ang; const double n = rint(a * 0.15915494309189535); const float r = (float)(a - n * 6.283185307179586);
            CS[2 * i] = cosf(r); CS[2 * i + 1] = sinf(r); }
        for (int m = gw; m < M; m += NGW) norm_row<0>(x_in + (size_t)m * DM, XN + (size_t)m * DM, nullptr, nullptr, lane);
#endif
    }
    SEAM(0);

#ifdef FIXL
    for (int l = 0; l < 1; ++l) {
#else
    for (int l = 0; l < DEPTH; ++l) {
#endif
        const int pb = 1 + l * 6;
        int tid_o = threadIdx.x; asm volatile("" : "+v"(tid_o));
        const int tid = tid_o, lane = tid & 63, wave = __builtin_amdgcn_readfirstlane(tid >> 6);
        if (IN(pb + 0)) {
#ifndef NO_G1
            pg8::Gemm g{XN, WIN + (size_t)l * NPROJ * DM, M, NPROJ, DM}; pg8::StaticOrder S; S.init(M, NPROJ, G, bid);
            pg8::EpiProj E{PROJ, NPROJ, SPEC, SPEC_TILE};
            pg8::gemm_phase<pg8::EpiProj, pg8::StaticOrder, true, true>((LAS unsigned char*)lds, g, S, E);
#endif
        }
        SEAM(pb + 0);
        if (IN(pb + 1)) {
#ifndef NO_PREP
            PrepP P;
            P.mu = args.in[13] + l * 1664; P.w0 = args.in[14] + l * 512; P.a0 = args.in[16] + l * 512; P.v0 = args.in[18] + (l > 0 ? (l - 1) * 512 : 0);
            P.k_k = args.in[21] + l * 512; P.k_a = args.in[22] + l * 512; P.r_k = args.in[23] + l * 512;
            P.conv_w = args.in[4] + (size_t)l * 4 * 1024; P.conv_b = args.in[5] + l * 1024; P.i_bias = args.in[6] + l * 4; P.f_bias = args.in[7] + l * 4;
            const unsigned char* lr = ws + WS_LR + (size_t)l * LR_STRIDE;
            P.W2T = (const bf16_t*)(lr + LR_W2T); P.A2T = (const bf16_t*)(lr + LR_A2T); P.V1T = (const bf16_t*)(lr + LR_V1T); P.V2T = (const bf16_t*)(lr + LR_V2T); P.layer = l;
            P.PROJ = PROJ; P.SPEC = SPEC; P.CS = CS; P.RWW = RWW; P.RWB = RWB; P.VFIRST = VFIRST; P.BONUS = BONUS; P.CQN = CQN; P.CKVN = CKVN; P.KR = KR; P.QKC = QKC; P.LI = LI; P.LF = LF; P.PMX = LF + (size_t)M * 4;
            for (int tile = bid; tile < M / 64; tile += G) prep_tile(lds, tile, P);
#endif
        }
        SEAM(pb + 1);
        if (IN(pb + 2)) {
#ifndef NO_G23
            { pg8::Gemm g{CQN, WUQ + (size_t)l * NQ * 512, M, NQ, 512}; pg8::StaticOrder S; S.init(M, NQ, G, bid);
              pg8::EpiPlain E{Q, NQ};
              pg8::gemm_phase<pg8::EpiPlain, pg8::StaticOrder, true, true>((LAS unsigned char*)lds, g, S, E); }
            { pg8::Gemm g{CKVN, WUKV + (size_t)l * NKV * 256, M, NKV, 256}; pg8::StaticOrder S; S.init(M, NKV, G, bid);
              pg8::EpiPlain E{KV, NKV};
              pg8::gemm_phase<pg8::EpiPlain, pg8::StaticOrder, true, true>((LAS unsigned char*)lds, g, S, E); }
#endif
            rwkv_local(lds, bid, G, RWW, RWB, RWS, ws + WS_RWX);
            mlstm_local(lds, bid, G, QKC, PROJ, LI, LF + (size_t)M * 4, ws + WS_MLX);
        }
        SEAM(pb + 2);
        if (IN(pb + 3)) {
#ifndef NO_SCANS
            if (bid < 32 && G >= 64) {
                rwkv_seq(lds, bid >> 3, bid & 7, ws + WS_RWX, RWB, RWS, BONUS, PROJ, args.in[24] + l * 512 + (bid & 7) * 64, args.in[25] + l * 512 + (bid & 7) * 64, MIXED);
            } else if (bid < 48 && G >= 64) {
                const int u = bid - 32;
                mlstm_seq(lds, u >> 2, u & 3, QKC, PROJ, LI, LF, LF + (size_t)M * 4, ws + WS_MLX, args.in[8] + l * 512 + (u & 3) * 128, MIXED);
            } else
#endif
            {
#ifndef NO_ATT
                const int first = (G >= 64) ? bid - 48 : bid, stride = (G >= 64) ? G - 48 : G; constexpr int total = BATCH * 8 * 8;
                if (first < total) {
                    att::Seam S; int L = first, pass = 0;
#define mk(L_, pass_) mk_block(Q, KV, KR, MIXED, PROJ, CS, (L_), (pass_))
                    att::BlockRef cur = mk(L, 0);
                    att::attn_prime(cur, (char*)lds, S);
                    for (;;) {
                        const bool more_pass = pass == 0, more_item = L + stride < total, last = !more_pass && !more_item;
                        int Ln = L, passn = pass + 1; if (!more_pass) { passn = 0; Ln = more_item ? L + stride : L; }
                        const att::BlockRef nxt = last ? cur : mk(Ln, passn);
                        att::attn_block(cur, nxt, (char*)lds, S);
                        if (last) break;
                        cur = nxt; L = Ln; pass = passn;
                    }
#undef mk
                }
#endif
            }
        }
        SEAM(pb + 3);
        if (IN(pb + 4)) {
#ifndef NO_G4
            pg8::Gemm g{MIXED, WOUT + (size_t)l * DM * DM, M, DM, DM}; pg8::StaticOrder S; S.init(M, DM, G, bid);
            pg8::EpiResid E{l == 0 ? x_in : (const float*)X, X, DM};
            pg8::gemm_phase<pg8::EpiResid, pg8::StaticOrder, true, true>((LAS unsigned char*)lds, g, S, E);
#endif
        }
        SEAM(pb + 4);
        if (IN(pb + 5)) {
            const int gw = bid * 8 + wave, NGW = G * 8;
            if (l + 1 < DEPTH) { for (int m = gw; m < M; m += NGW) norm_row<0>(X + (size_t)m * DM, XN + (size_t)m * DM, nullptr, nullptr, lane); }
            else { for (int m = gw; m < M; m += NGW) norm_row<1>(X + (size_t)m * DM, nullptr, X + (size_t)m * DM, args.in[27], lane); }
        }
        SEAM(pb + 5);
    }
#undef IN
#undef SEAM
}

constexpr int N_PHASES = 1 + DEPTH * 6;
#ifndef MK_ONE_LAUNCH
#define MK_ONE_LAUNCH 1
#endif
extern "C" void kernel_launch(void* const* d_in, const int* in_sizes, int n_in, void* d_out, int out_size, void* d_ws, size_t ws_size, hipStream_t stream) {
    static int grid = 0;
    if (grid == 0) {
        if (n_in != 28 || out_size != M * DM || ws_size < WS_END) { fprintf(stderr, "kernel_launch: unexpected shapes (n_in %d, out %d, ws %zu < %zu)\n", n_in, out_size, ws_size, (size_t)WS_END); grid = -1; return; }
        int dev = 0, cus = 0;
        if (hipGetDevice(&dev) != hipSuccess || hipDeviceGetAttribute(&cus, hipDeviceAttributeMultiprocessorCount, dev) != hipSuccess) { grid = -1; return; }
        if (hipFuncSetAttribute((const void*)fwd, hipFuncAttributeMaxDynamicSharedMemorySize, LDS_BYTES) != hipSuccess) { fprintf(stderr, "kernel_launch: hipFuncSetAttribute failed\n"); grid = -1; return; }
        int per_cu = 0;
        if (hipOccupancyMaxActiveBlocksPerMultiprocessor(&per_cu, (const void*)fwd, 512, LDS_BYTES) != hipSuccess || per_cu < 1) fprintf(stderr, "kernel_launch: occupancy query says %d\n", per_cu);
        (void)hipGetLastError();
        grid = cus;
    }
    if (grid < 0) return;
    if (hipMemsetAsync((char*)d_ws + WS_CTL, 0, CTL_ZERO_BYTES, stream) != hipSuccess) return;
    Args a; memset(&a, 0, sizeof(a));
    for (int i = 0; i < 28; ++i) a.in[i] = (const float*)d_in[i];
    a.out = (float*)d_out; a.ws = (unsigned char*)d_ws;
#if MK_ONE_LAUNCH
    a.ph_lo = 0; a.ph_hi = N_PHASES;
    hipLaunchKernelGGL(fwd, dim3(grid), dim3(512), LDS_BYTES, stream, a);
#else
    for (int p = 0; p < N_PHASES; ++p) { a.ph_lo = p; a.ph_hi = p + 1; hipLaunchKernelGGL(fwd, dim3(grid), dim3(512), LDS_BYTES, stream, a); }
#endif
}
```

```cpp
#include <hip/hip_runtime.h>
#include <cstdio>
#include <cstdint>
#include <cstring>
namespace pg8 {
#define PG8_LAS __attribute__((address_space(3)))
typedef unsigned short bf16_t;
typedef short bf16x8 __attribute__((ext_vector_type(8)));
typedef float f32x4 __attribute__((ext_vector_type(4)));
typedef unsigned u32x4 __attribute__((ext_vector_type(4)));
constexpr int BM = 256, BK = 64, HALF = 128, HTB = HALF * BK * 2  , STAGE_BYTES = 8 * HTB, NXCD = 8, WGM = 8;

__host__ __device__ __forceinline__ int lds_byte(int r, int c) { const int st = (r >> 4) * 2 + (c >> 5), rr = r & 15, cc = c & 31, ob = rr * 64 + cc * 2; return st * 1024 + (ob ^ (((ob >> 9) & 1) << 5)); }
__host__ __device__ __forceinline__ void stage_rc(int b, int& R, int& C) { const int st = b / 1024, sb = b % 1024, swz = sb ^ (((sb >> 9) & 1) << 5); R = (st >> 1) * 16 + swz / 64; C = (st & 1) * 32 + (swz % 64) / 2; }
__host__ __device__ __forceinline__ int perm32(int rho) { const int n = rho >> 4, i = rho & 15; return 8 * (i >> 2) + 4 * n + (i & 3); }

struct Unit { int pm, pn; };
struct Gemm { const bf16_t* A; const bf16_t* Bt; int M, N, K; };

struct StaticOrder {
    int nM, nN, nwg, G, c;
    __host__ __device__ void init(int M, int N, int G_, int c_) { nM = M / BM; nN = N / BM; nwg = nM * nN; G = G_; c = c_; }
    __host__ __device__ bool next(int i, Unit& u) const {
        const long L = (long)i * G + c; if (L >= nwg) return false;
        int wgid = (int)L; { const int q = nwg / NXCD, r = nwg % NXCD, xcd = wgid % NXCD, off = wgid / NXCD; wgid = (xcd < r ? xcd * (q + 1) : r * (q + 1) + (xcd - r) * q) + off; }
        const int nig = WGM * nN, gid = wgid / nig, fm = gid * WGM, gsz = (nM - fm) < WGM ? (nM - fm) : WGM;
        u.pm = fm + ((wgid % nig) % gsz); u.pn = (wgid % nig) / gsz; return true;
    }
    __device__ __forceinline__ void a_ready(const Unit&) const {}
    __device__ __forceinline__ void done(const Unit&) const {}
};

__device__ __forceinline__ unsigned cvt_pk_bf16(float lo, float hi) { unsigned r; asm volatile("v_cvt_pk_bf16_f32 %0, %1, %2" : "=v"(r) : "v"(lo), "v"(hi)); return r; }
typedef float f32x2 __attribute__((ext_vector_type(2)));
typedef unsigned u32x2 __attribute__((ext_vector_type(2)));
struct EpiProj {
    static constexpr bool PERM = true, AFTER_DRAIN = false;
    bf16_t* O; int ldc; float* spec; int spec_tile;
    __device__ __forceinline__ void operator()(const f32x4 (&acc)[2][2][4][2], const Unit& u, int wr, int wc, int fr, int fq) const {
        const int row0 = u.pm * BM + wr * 64 + fr, col0 = u.pn * BM + wc * 32 + 8 * fq;
        if (u.pn == spec_tile) {
            float* sp0 = spec + (size_t)row0 * 256 + wc * 32 + 8 * fq;
#pragma unroll
            for (int ai = 0; ai < 2; ++ai)
#pragma unroll
                for (int m = 0; m < 4; ++m) { float* sp_p = sp0 + (size_t)(ai * HALF + m * 16) * 256;
#pragma unroll
                    for (int bj = 0; bj < 2; ++bj) { *(f32x4*)(sp_p + bj * HALF) = acc[ai][bj][m][0]; *(f32x4*)(sp_p + bj * HALF + 4) = acc[ai][bj][m][1]; } }
        }
        bf16_t* o0 = O + (size_t)row0 * ldc + col0;
#pragma unroll
        for (int ai = 0; ai < 2; ++ai)
#pragma unroll
            for (int m = 0; m < 4; ++m) { bf16_t* rowp = o0 + (size_t)(ai * HALF + m * 16) * ldc;
#pragma unroll
                for (int bj = 0; bj < 2; ++bj) { const f32x4 v0 = acc[ai][bj][m][0], v1 = acc[ai][bj][m][1];
                    u32x4 w; w.x = cvt_pk_bf16(v0[0], v0[1]); w.y = cvt_pk_bf16(v0[2], v0[3]); w.z = cvt_pk_bf16(v1[0], v1[1]); w.w = cvt_pk_bf16(v1[2], v1[3]);
                    *(u32x4*)(rowp + bj * HALF) = w; } }
    }
};
struct EpiQ {
    static constexpr bool PERM = true, AFTER_DRAIN = false;
    bf16_t* O; const float* cs;
    __device__ __forceinline__ void operator()(const f32x4 (&acc)[2][2][4][2], const Unit& u, int wr, int wc, int fr, int fq) const {
        const int row0 = u.pm * BM + wr * 64 + fr, col0 = u.pn * BM + wc * 32 + 8 * fq;
#pragma unroll
        for (int ai = 0; ai < 2; ++ai)
#pragma unroll
            for (int m = 0; m < 4; ++m) { const int row = row0 + ai * HALF + m * 16; bf16_t* rowp = O + (size_t)row * 1536 + col0;
#pragma unroll
                for (int bj = 0; bj < 2; ++bj) { f32x4 v0 = acc[ai][bj][m][0], v1 = acc[ai][bj][m][1];
                    const int d = (col0 + bj * HALF) % 192;
                    if (d >= 128) { const int i0 = (d - 128) >> 1; const f32x4* cp = (const f32x4*)(cs + (size_t)row * 64 + i0 * 2); const f32x4 c0 = cp[0], c1 = cp[1];
                        f32x4 r0, r1;
                        r0[0] = v0[0] * c0[0] - v0[1] * c0[1]; r0[1] = v0[1] * c0[0] + v0[0] * c0[1];
                        r0[2] = v0[2] * c0[2] - v0[3] * c0[3]; r0[3] = v0[3] * c0[2] + v0[2] * c0[3];
                        r1[0] = v1[0] * c1[0] - v1[1] * c1[1]; r1[1] = v1[1] * c1[0] + v1[0] * c1[1];
                        r1[2] = v1[2] * c1[2] - v1[3] * c1[3]; r1[3] = v1[3] * c1[2] + v1[2] * c1[3];
                        v0 = r0; v1 = r1; }
                    u32x4 w; w.x = cvt_pk_bf16(v0[0], v0[1]); w.y = cvt_pk_bf16(v0[2], v0[3]); w.z = cvt_pk_bf16(v1[0], v1[1]); w.w = cvt_pk_bf16(v1[2], v1[3]);
                    *(u32x4*)(rowp + bj * HALF) = w; } }
    }
};
struct EpiPlain {
    static constexpr bool PERM = true, AFTER_DRAIN = false;
    bf16_t* O; int ldc;
    __device__ __forceinline__ void operator()(const f32x4 (&acc)[2][2][4][2], const Unit& u, int wr, int wc, int fr, int fq) const {
        const int row0 = u.pm * BM + wr * 64 + fr, col0 = u.pn * BM + wc * 32 + 8 * fq;
#pragma unroll
        for (int ai = 0; ai < 2; ++ai)
#pragma unroll
            for (int m = 0; m < 4; ++m) { bf16_t* rowp = O + (size_t)(row0 + ai * HALF + m * 16) * ldc + col0;
#pragma unroll
                for (int bj = 0; bj < 2; ++bj) { const f32x4 v0 = acc[ai][bj][m][0], v1 = acc[ai][bj][m][1];
                    u32x4 w; w.x = cvt_pk_bf16(v0[0], v0[1]); w.y = cvt_pk_bf16(v0[2], v0[3]); w.z = cvt_pk_bf16(v1[0], v1[1]); w.w = cvt_pk_bf16(v1[2], v1[3]);
                    *(u32x4*)(rowp + bj * HALF) = w; } }
    }
};
struct EpiResid {
    static constexpr bool PERM = false, AFTER_DRAIN = false;
    const float* base; float* out; int ldc;
    __device__ __forceinline__ void operator()(const f32x4 (&acc)[2][2][4][2], const Unit& u, int wr, int wc, int fr, int fq) const {
        const int row0 = u.pm * BM + wr * 64 + fr, col0 = u.pn * BM + wc * 32 + 4 * fq;
#pragma unroll
        for (int ai = 0; ai < 2; ++ai)
#pragma unroll
            for (int m = 0; m < 4; ++m) { const size_t off = (size_t)(row0 + ai * HALF + m * 16) * ldc + col0;
#pragma unroll
                for (int bj = 0; bj < 2; ++bj)
#pragma unroll
                    for (int n = 0; n < 2; ++n) { const f32x4 bs = *(const f32x4*)(base + off + bj * HALF + n * 16); *(f32x4*)(out + off + bj * HALF + n * 16) = bs + acc[ai][bj][m][n]; } }
    }
};
template <class Epi, class Sched, bool ALIGN_EPI = false, bool SP2 = false>
__device__ __forceinline__ void gemm_phase(PG8_LAS unsigned char* lds, const Gemm g, const Sched& S, const Epi& E) {
    int tid_o = threadIdx.x; asm volatile("" : "+v"(tid_o));
    const int tid = tid_o, wid = __builtin_amdgcn_readfirstlane(tid >> 6), lane = tid & 63, wr = wid >> 2, wc = wid & 3, fr = lane & 15, fq = lane >> 4;
    const int K = g.K, nt = K / BK;
    unsigned voffA[2], voffB[2];
#pragma unroll
    for (int i = 0; i < 2; ++i) { int R, C; stage_rc(tid * 16 + i * 8192, R, C); const int Rb = Epi::PERM ? ((R & ~31) + perm32(R & 31)) : R;
        voffA[i] = (unsigned)(R * K + C) * 2u; voffB[i] = (unsigned)(Rb * K + C) * 2u; }
    const size_t kstep = (size_t)(BK * 2);
    const size_t hstep = (size_t)HALF * K * 2;
    const size_t tstep = 2 * hstep;
    const unsigned ldsw = (unsigned)wid * 1024u;
    const int aoff = lds_byte(wr * 64 + fr, fq * 8), boff = lds_byte(wc * 32 + fr, fq * 8);
#define PG8_SA(b, h) (((b) * 2 + (h)) * HTB)
#define PG8_SB(b, h) ((4 + (b) * 2 + (h)) * HTB)
#define PG8_STAGE(bufoff, gbase, voff) do { _Pragma("unroll") for (int _i = 0; _i < 2; ++_i) \
        __builtin_amdgcn_global_load_lds((const unsigned*)((const char*)(gbase) + (voff)[_i]), (PG8_LAS unsigned*)(lds + (bufoff) + ldsw + _i * 8192), 16, 0, 0); } while (0)
#define PG8_LDA(dst, b, h) do { _Pragma("unroll") for (int m = 0; m < 4; ++m) _Pragma("unroll") for (int k = 0; k < 2; ++k) dst[m][k] = *(const PG8_LAS bf16x8*)(lds + PG8_SA(b, h) + aoff + m * 2048 + k * 1024); } while (0)
#define PG8_LDB(dst, b, h) do { _Pragma("unroll") for (int n = 0; n < 2; ++n) _Pragma("unroll") for (int k = 0; k < 2; ++k) dst[n][k] = *(const PG8_LAS bf16x8*)(lds + PG8_SB(b, h) + boff + n * 2048 + k * 1024); } while (0)
#define PG8_MMA(ai, bj, At, Bt) do { __builtin_amdgcn_s_setprio(1); _Pragma("unroll") for (int m = 0; m < 4; ++m) _Pragma("unroll") for (int n = 0; n < 2; ++n) _Pragma("unroll") for (int k = 0; k < 2; ++k) \
        acc[ai][bj][m][n] = __builtin_amdgcn_mfma_f32_16x16x32_bf16(Bt[n][k], At[m][k], acc[ai][bj][m][n], 0, 0, 0); __builtin_amdgcn_s_setprio(0); } while (0)
#define PG8_WAIT_V(n) asm volatile("s_waitcnt vmcnt(" #n ")" ::: "memory")
#define PG8_WAIT_L(n) asm volatile("s_waitcnt lgkmcnt(" #n ")" ::: "memory")
#define PG8_BAR __builtin_amdgcn_s_barrier()
#define PG8_SCHED __builtin_amdgcn_sched_barrier(0)
    Unit cur, nxt; int ui = 0;
    if (!S.next(0, cur)) return;
    f32x4 acc[2][2][4][2];
#pragma unroll
    for (int a = 0; a < 2; ++a)
#pragma unroll
        for (int b = 0; b < 2; ++b)
#pragma unroll
            for (int m = 0; m < 4; ++m)
#pragma unroll
                for (int n = 0; n < 2; ++n) acc[a][b][m][n] = (f32x4){0.f, 0.f, 0.f, 0.f};
    bf16x8 At[4][2], B0[2][2], B1[2][2];
    const char* cA = (const char*)g.A + (size_t)cur.pm * tstep; const char* cB = (const char*)g.Bt + (size_t)cur.pn * tstep;
    S.a_ready(cur);
    if constexpr (SP2) {
        PG8_STAGE(PG8_SB(0, 0), cB, voffB); PG8_STAGE(PG8_SB(0, 1), cB + hstep, voffB); PG8_STAGE(PG8_SA(0, 0), cA, voffA); PG8_STAGE(PG8_SA(0, 1), cA + hstep, voffA);
        if (wr == 1) PG8_BAR;
        PG8_WAIT_V(2); PG8_BAR;
        PG8_STAGE(PG8_SB(1, 0), cB + kstep, voffB); PG8_STAGE(PG8_SA(1, 0), cA + kstep, voffA); PG8_STAGE(PG8_SB(1, 1), cB + hstep + kstep, voffB);
        PG8_WAIT_V(6); PG8_BAR;
    } else {
        PG8_STAGE(PG8_SB(0, 0), cB, voffB); PG8_STAGE(PG8_SA(0, 0), cA, voffA); PG8_STAGE(PG8_SB(0, 1), cB + hstep, voffB); PG8_STAGE(PG8_SA(0, 1), cA + hstep, voffA);
        if (wr == 1) PG8_BAR;
        PG8_WAIT_V(4); PG8_BAR;
        PG8_STAGE(PG8_SB(1, 0), cB + kstep, voffB); PG8_STAGE(PG8_SA(1, 0), cA + kstep, voffA); PG8_STAGE(PG8_SB(1, 1), cB + hstep + kstep, voffB);
        PG8_WAIT_V(6); PG8_BAR;
    }
    for (;;) {
        const bool has_next = S.next(ui + 1, nxt);
        const char* nA = has_next ? (const char*)g.A + (size_t)nxt.pm * tstep : cA; const char* nB = has_next ? (const char*)g.Bt + (size_t)nxt.pn * tstep : cB;
        for (int t = 0; t < nt; t += 2) {
            const bool last = (t == nt - 2);
            const char* a1 = cA + (size_t)(t + 1) * kstep;
            const char* a2 = last ? nA : cA + (size_t)(t + 2) * kstep; const char* b2 = last ? nB : cB + (size_t)(t + 2) * kstep;
            const char* a3 = a2 + kstep; const char* b3 = b2 + kstep;
            if (last && has_next) S.a_ready(nxt);
            if constexpr (SP2) {
            PG8_LDB(B0, 0, 0); PG8_LDB(B1, 0, 1); PG8_SCHED; PG8_LDA(At, 0, 0); PG8_STAGE(PG8_SA(1, 1), a1 + hstep, voffA);
            PG8_WAIT_V(8); PG8_WAIT_L(0); PG8_BAR; PG8_MMA(0, 0, At, B0); PG8_MMA(0, 1, At, B1); PG8_BAR; PG8_SCHED;
            PG8_LDA(At, 0, 1); PG8_STAGE(PG8_SB(0, 0), b2, voffB); PG8_STAGE(PG8_SB(0, 1), b2 + hstep, voffB); PG8_STAGE(PG8_SA(0, 0), a2, voffA);
            PG8_WAIT_V(8); PG8_WAIT_L(0); PG8_BAR; PG8_MMA(1, 0, At, B0); PG8_MMA(1, 1, At, B1); PG8_BAR; PG8_SCHED;
            PG8_LDB(B0, 1, 0); PG8_LDB(B1, 1, 1); PG8_SCHED; PG8_LDA(At, 1, 0); PG8_STAGE(PG8_SA(0, 1), a2 + hstep, voffA);
            PG8_WAIT_V(8); PG8_WAIT_L(0); PG8_BAR; PG8_MMA(0, 0, At, B0); PG8_MMA(0, 1, At, B1); PG8_BAR; PG8_SCHED;
            PG8_LDA(At, 1, 1); PG8_STAGE(PG8_SB(1, 0), b3, voffB); PG8_STAGE(PG8_SB(1, 1), b3 + hstep, voffB); PG8_STAGE(PG8_SA(1, 0), a3, voffA);
            PG8_WAIT_V(8); PG8_WAIT_L(0); PG8_BAR; PG8_MMA(1, 0, At, B0); PG8_MMA(1, 1, At, B1); PG8_BAR; PG8_SCHED;
            } else {
            PG8_LDB(B0, 0, 0); PG8_SCHED; PG8_LDA(At, 0, 0); PG8_STAGE(PG8_SA(1, 1), a1 + hstep, voffA);
            PG8_WAIT_L(8); PG8_BAR; PG8_WAIT_L(0); PG8_MMA(0, 0, At, B0); PG8_BAR; PG8_SCHED;
            PG8_LDB(B1, 0, 1); PG8_STAGE(PG8_SB(0, 0), b2, voffB);
            PG8_BAR; PG8_WAIT_L(0); PG8_MMA(0, 1, At, B1); PG8_BAR;
            PG8_LDA(At, 0, 1); PG8_STAGE(PG8_SA(0, 0), a2, voffA);
            PG8_BAR; PG8_WAIT_L(0); PG8_MMA(1, 0, At, B0); PG8_BAR; PG8_SCHED;
            PG8_STAGE(PG8_SB(0, 1), b2 + hstep, voffB);
            PG8_WAIT_V(6); PG8_BAR; PG8_MMA(1, 1, At, B1); PG8_BAR;
            PG8_LDB(B0, 1, 0); PG8_SCHED; PG8_LDA(At, 1, 0); PG8_STAGE(PG8_SA(0, 1), a2 + hstep, voffA);
            PG8_WAIT_L(8); PG8_BAR; PG8_WAIT_L(0); PG8_MMA(0, 0, At, B0); PG8_BAR; PG8_SCHED;
            PG8_LDB(B1, 1, 1); PG8_STAGE(PG8_SB(1, 0), b3, voffB);
            PG8_BAR; PG8_WAIT_L(0); PG8_MMA(0, 1, At, B1); PG8_BAR;
            PG8_LDA(At, 1, 1); PG8_STAGE(PG8_SA(1, 0), a3, voffA);
            PG8_BAR; PG8_WAIT_L(0); PG8_MMA(1, 0, At, B0); PG8_BAR; PG8_SCHED;
            PG8_STAGE(PG8_SB(1, 1), b3 + hstep, voffB);
            PG8_WAIT_V(6); PG8_BAR; PG8_MMA(1, 1, At, B1); PG8_BAR;
            }
        }
        if constexpr (ALIGN_EPI) { if (wr == 0) PG8_BAR; }
        if constexpr (!Epi::AFTER_DRAIN) { E(acc, cur, wr, wc, fr, fq); S.done(cur); }
        if (!has_next) break;
#pragma unroll
        for (int a = 0; a < 2; ++a)
#pragma unroll
            for (int b = 0; b < 2; ++b)
#pragma unroll
                for (int m = 0; m < 4; ++m)
#pragma unroll
                    for (int n = 0; n < 2; ++n) acc[a][b][m][n] = (f32x4){0.f, 0.f, 0.f, 0.f};
        cur = nxt; cA = nA; cB = nB; ++ui;
        if constexpr (ALIGN_EPI) { if (wr == 1) PG8_BAR; }
    }
    PG8_WAIT_V(0);
    if constexpr (!ALIGN_EPI) { if (wr == 0) PG8_BAR; }
    PG8_BAR;
    if constexpr (Epi::AFTER_DRAIN) { E.fused(acc, cur, wr, wc, fr, fq, lds, wid, lane); S.done(cur); }
#undef PG8_SA
#undef PG8_SB
#undef PG8_STAGE
#undef PG8_LDA
#undef PG8_LDB
#undef PG8_MMA
#undef PG8_WAIT_V
#undef PG8_WAIT_L
#undef PG8_BAR
#undef PG8_SCHED
}
}
#define GAS __attribute__((address_space(1)))
#define LAS __attribute__((address_space(3)))
typedef unsigned short bf16;
typedef unsigned v4u __attribute__((ext_vector_type(4)));
typedef float f32x4 __attribute__((ext_vector_type(4)));
typedef short bf16x8 __attribute__((ext_vector_type(8)));
typedef GAS unsigned gu32;
typedef GAS unsigned long long gu64;
#define RLX_AGENT __ATOMIC_RELAXED, __HIP_MEMORY_SCOPE_AGENT
#define LDS_WAIT() asm volatile("s_waitcnt lgkmcnt(0)" ::: "memory")
#define VM_WAIT() asm volatile("s_waitcnt vmcnt(0)" ::: "memory")
__device__ __forceinline__ unsigned long long rt() { return __builtin_amdgcn_s_memrealtime(); }
__device__ __forceinline__ unsigned f2bf(float f) { unsigned u = __builtin_bit_cast(unsigned, f); return (u + 0x7fffu + ((u >> 16) & 1u)) >> 16; }
__device__ __forceinline__ unsigned pk2(float lo, float hi) { return f2bf(lo) | (f2bf(hi) << 16); }

#define XB_TMO      128
#define XB_XCNT(j)  (256  + 64 * (j))
#define XB_XSUB(j)  (1280 + 64 * (j))
#define XB_XGEN(j)  (2304 + 64 * (j))
#define XB_TOP      3328
#define XB_TOPGEN   3392
#define XCD_BAR_WORDS 3456
#define XB_SPIN_CAP (1u << 18)

__device__ __forceinline__ unsigned xb_ld(unsigned* p)              { return __hip_atomic_load(p, __ATOMIC_RELAXED, __HIP_MEMORY_SCOPE_AGENT); }
__device__ __forceinline__ unsigned xb_add(unsigned* p, unsigned v) { return __hip_atomic_fetch_add(p, v, __ATOMIC_RELAXED, __HIP_MEMORY_SCOPE_AGENT); }
__device__ __forceinline__ unsigned xb_xcc_id() { return (unsigned)__builtin_amdgcn_s_getreg((3 << 11) | 20) & 0xFu; }
#define XB_SPIN(cond, bar) do { unsigned _sp = 0; while (cond) { __builtin_amdgcn_s_sleep(1); \
    if ((++_sp & 255u) == 0u) { if (xb_ld(&(bar)[XB_TMO])) break; if (_sp > XB_SPIN_CAP) { atomicAdd(&(bar)[XB_TMO], 1u); break; } } } } while (0)

struct XcdBarrier {
    unsigned* bar; unsigned x;
    volatile LAS unsigned* st;
};

__device__ __forceinline__ XcdBarrier xcd_barrier_post(unsigned* bar, volatile LAS unsigned* st) {
    XcdBarrier b; b.bar = bar; b.x = xb_xcc_id(); b.st = st;
    if (threadIdx.x == 0) (void)xb_add(&bar[XB_XCNT(b.x)], 1u);
    return b;
}
__device__ __forceinline__ void xcd_barrier_complete(unsigned* bar, unsigned x, unsigned& nloc, unsigned& nx) {
    const unsigned G = gridDim.x * gridDim.y * gridDim.z;
    unsigned sum, cnt, mine, sp = 0u;
    for (;;) {
        sum = 0u; cnt = 0u; mine = 0u;
#pragma unroll
        for (unsigned j = 0; j < 16; ++j) { const unsigned c = xb_ld(&bar[XB_XCNT(j)]); sum += c; cnt += (c > 0u) ? 1u : 0u; mine = (j == x) ? c : mine; }
        if (sum == G) break;
        __builtin_amdgcn_s_sleep(1);
        if ((++sp & 255u) == 0u) { if (xb_ld(&bar[XB_TMO])) break; if (sp > XB_SPIN_CAP) { atomicAdd(&bar[XB_TMO], 1u); break; } }
    }
    nloc = mine > 0u ? mine : 1u; nx = cnt > 0u ? cnt : 1u;
}

__device__ __forceinline__ void xcd_barrier(const XcdBarrier& b) {
    asm volatile("s_waitcnt vmcnt(0)" ::: "memory");
    __syncthreads();
    if (threadIdx.x == 0) {
        unsigned* bar = b.bar;
        __builtin_amdgcn_s_waitcnt(0);
        unsigned nloc = b.st[0], nx = b.st[1];
        if (nloc == 0u) { xcd_barrier_complete(bar, b.x, nloc, nx); b.st[0] = nloc; b.st[1] = nx; }
        const unsigned old = xb_add(&bar[XB_XSUB(b.x)], 1u);
        const unsigned gen = old / nloc;
        if (old + 1u == (gen + 1u) * nloc) {
            __builtin_amdgcn_fence(__ATOMIC_RELEASE, "agent");
            asm volatile("s_waitcnt vmcnt(0)" ::: "memory");
            const unsigned og = xb_add(&bar[XB_TOP], 1u);
            const unsigned tg = og / nx;
            if (og + 1u == (tg + 1u) * nx) xb_add(&bar[XB_TOPGEN], 1u);
            else XB_SPIN(xb_ld(&bar[XB_TOPGEN]) == tg, bar);
            __builtin_amdgcn_fence(__ATOMIC_ACQUIRE, "agent");
            xb_add(&bar[XB_XGEN(b.x)], 1u);
            asm volatile("s_waitcnt vmcnt(0)" ::: "memory");
        } else {
            XB_SPIN(xb_ld(&bar[XB_XGEN(b.x)]) == gen, bar);
            __builtin_amdgcn_fence(__ATOMIC_ACQUIRE, "agent");
            asm volatile("s_waitcnt vmcnt(0)" ::: "memory");
        }
    }
    __syncthreads();
}
constexpr int BATCH = 4, T = 4096, DM = 2048, DEPTH = 4, M = BATCH * T;
constexpr int D_IN = 6600, NPROJ = 6656;
constexpr int SC_MLQK = 0, SC_MLV = 1024, SC_MLI = 1536, SC_MLF = 1540, SC_MLO = 1544, SC_MLZ = 2056, SC_CQ = 2568, SC_CKV = 3080, SC_KR = 3336, SC_MLAZ = 3400, SC_RW = 4424, SC_RWZ = 6088;
constexpr int PC_MLQK = 0, PC_MLV = 1024, PC_MLO = 1536, PC_MLZ = 2048, PC_CQ = 2560, PC_CKV = 3072, PC_MLAZ = 3328, PC_RW = 4352, PC_SPEC = 5888, PC_RWZ = 6144;
constexpr int SPEC_TILE = PC_SPEC / 256;
constexpr int NQ = 1536, NKV = 2048;
constexpr float NORM_EPS = 1e-6f, RW_GN_EPS = 64e-5f;
typedef unsigned short bf16_t;
__device__ __forceinline__ float bf2f(unsigned v) { return __uint_as_float(v << 16); }
__device__ __forceinline__ float wave_sum(float v) {
#pragma unroll
    for (int o = 1; o < 64; o <<= 1) v += __shfl_xor(v, o);
    return v;
}
__device__ __forceinline__ float sigmoidf_(float x) { return 1.f / (1.f + __expf(-x)); }
__device__ __forceinline__ float siluf_(float x) { return x / (1.f + __expf(-x)); }
__device__ __forceinline__ float softplusf_(float x) { return fmaxf(x, 0.f) + __logf(1.f + __expf(-fabsf(x))); }
__device__ __forceinline__ float tanhf_(float x) { const float e = __expf(-2.f * fabsf(x)); const float r = (1.f - e) / (1.f + e); return x < 0.f ? -r : r; }

namespace att {
typedef unsigned short bf16_t;
typedef short bf16x8 __attribute__((ext_vector_type(8)));
typedef short s16x4 __attribute__((ext_vector_type(4)));
typedef float f32x16 __attribute__((ext_vector_type(16)));
typedef float f32x4 __attribute__((ext_vector_type(4)));
typedef unsigned u32x4 __attribute__((ext_vector_type(4)));
constexpr int NW = 8, QBLK = 32, KVBLK = 64, QB = NW * QBLK;
constexpr int QP = 1536, KVP = 2048, KRP = 64, OP = 2048;
constexpr int SHM_V = KVBLK * 128 * 2, SHM_K = KVBLK * 128 * 2, SHM_R = KVBLK * 64 * 2;
constexpr int OFF_V = 0, OFF_K = 2 * SHM_V, OFF_R = OFF_K + SHM_K, OFF_WS = OFF_R + SHM_R, OFF_Q = OFF_WS + NW * 64 * 4, LDS_BYTES = OFF_Q + NW * 12288;
constexpr float SCALE = 0.07216878364870322f;
constexpr float THR = 8.f;
constexpr unsigned WBIG = 1u << 30;
#define KSWZ(row, colB) ((row) * 256 + ((colB) ^ (((row) & 7) << 4)))
#define RSWZ(row, colB) ((row) * 128 + ((colB) ^ (((row) & 7) << 4)))
#define SBAR() __builtin_amdgcn_sched_barrier(0)
__device__ __forceinline__ int v_st(int k, int c) { const int kk = (k & ~0xC) | ((k & 4) << 1) | ((k & 8) >> 1); return ((kk >> 3) * 4 + (c >> 5)) * 512 + ((kk & 7) * 32 + (c & 31)) * 2; }
__device__ __forceinline__ int v_rd_base(int lane) { return ((lane & 3) << 3) | (((lane >> 2) & 3) << 6) | (((lane >> 4) & 1) << 5) | (((lane >> 5) & 1) << 8); }
constexpr int v_rd_off(int d0, int ks, int half) { return d0 * 512 + ks * 4096 + half * 2048; }
__device__ __forceinline__ int crow(int r, int hi) { return (r & 3) + 8 * (r >> 2) + 4 * hi; }
__device__ __forceinline__ unsigned cvtpk(float lo, float hi) { unsigned r; asm volatile("v_cvt_pk_bf16_f32 %0, %1, %2" : "=v"(r) : "v"(lo), "v"(hi)); return r; }
__device__ __forceinline__ bf16x8 load8(const bf16_t* p) { return *reinterpret_cast<const bf16x8*>(p); }
__device__ __forceinline__ float bf2f(bf16_t v) { return __uint_as_float((unsigned)v << 16); }
__device__ __forceinline__ void mask_tile(f32x16& p0, f32x16& p1, int dq, unsigned W) {
    const float NEG = -__builtin_inff();
#pragma unroll
    for (int r = 0; r < 16; ++r) {
        const int c = (r & 3) + 8 * (r >> 2);
        if ((unsigned)(dq - c) >= W) p0[r] = NEG;
        if ((unsigned)(dq - c - 32) >= W) p1[r] = NEG;
    }
}
__device__ __forceinline__ void partialSM(f32x16& p0, f32x16& p1, float& m_reg, float& mn, float& alpha) {
    float pmax = p0[0]; for (int r = 1; r < 16; ++r) pmax = fmaxf(pmax, p0[r]); for (int r = 0; r < 16; ++r) pmax = fmaxf(pmax, p1[r]);
    { auto rr = __builtin_amdgcn_permlane32_swap(__float_as_uint(pmax), __float_as_uint(pmax), false, false);
      pmax = fmaxf(__uint_as_float(rr[0]), __uint_as_float(rr[1])); }
    constexpr float C2 = 1.4426950408889634f * SCALE;
    if (__builtin_expect(__all((pmax - m_reg) * SCALE <= THR), 1)) { mn = m_reg; alpha = 1.f; }
    else { mn = fmaxf(m_reg, pmax); alpha = __builtin_amdgcn_exp2f((m_reg - mn) * C2); m_reg = mn; }
    const float mnL = -mn * C2;
    for (int r = 0; r < 16; ++r) p0[r] = fmaf(p0[r], C2, mnL); for (int r = 0; r < 16; ++r) p1[r] = fmaf(p1[r], C2, mnL);
    for (int r = 0; r < 16; ++r) p0[r] = __builtin_amdgcn_exp2f(p0[r]);
}
__device__ __forceinline__ void finishSM(f32x16& p0, f32x16& p1, float alpha, float& l_reg, bf16x8& pa0, bf16x8& pa1, bf16x8& pa2, bf16x8& pa3) {
    for (int r = 0; r < 16; ++r) p1[r] = __builtin_amdgcn_exp2f(p1[r]);
    float ps = 0; for (int r = 0; r < 16; ++r) ps += p0[r]; for (int r = 0; r < 16; ++r) ps += p1[r];
    { auto rr = __builtin_amdgcn_permlane32_swap(__float_as_uint(ps), __float_as_uint(ps), false, false);
      ps = __uint_as_float(rr[0]) + __uint_as_float(rr[1]); }
    l_reg = l_reg * alpha + ps;
#define PK4(P, B_, OUT) do { unsigned a0 = cvtpk(P[B_+0], P[B_+1]), a1 = cvtpk(P[B_+2], P[B_+3]);                          \
        unsigned b0 = cvtpk(P[B_+4], P[B_+5]), b1 = cvtpk(P[B_+6], P[B_+7]);                                             \
        auto r0 = __builtin_amdgcn_permlane32_swap(a0, b0, false, false); auto r1 = __builtin_amdgcn_permlane32_swap(a1, b1, false, false); \
        u32x4 w = {r0[0], r1[0], r0[1], r1[1]}; OUT = *reinterpret_cast<bf16x8*>(&w); } while (0)
    PK4(p0, 0, pa0); PK4(p0, 8, pa1); PK4(p1, 0, pa2); PK4(p1, 8, pa3);
#undef PK4
}
__device__ __forceinline__ void qkt(f32x16& p0, f32x16& p1, const char* K_lds, const char* R_lds, const char* Qw, int r32, int hi) {
    p0 = f32x16{}; p1 = f32x16{};
    const char* kb[4]; const char* rb[4];
#pragma unroll
    for (int dd = 0; dd < 4; ++dd) { kb[dd] = K_lds + KSWZ(r32, (dd * 16 + hi * 8) * 2); rb[dd] = R_lds + RSWZ(r32, (dd * 16 + hi * 8) * 2); }
#pragma unroll
    for (int d0 = 0; d0 < 8; ++d0) { const char* a = kb[d0 & 3] + (d0 >> 2) * 128;
        bf16x8 b0 = *reinterpret_cast<const bf16x8*>(a);
        bf16x8 b1 = *reinterpret_cast<const bf16x8*>(a + 32 * 256);
        bf16x8 q = *reinterpret_cast<const bf16x8*>(Qw + d0 * 1024);
        p0 = __builtin_amdgcn_mfma_f32_32x32x16_bf16(b0, q, p0, 0, 0, 0);
        p1 = __builtin_amdgcn_mfma_f32_32x32x16_bf16(b1, q, p1, 0, 0, 0); }
#pragma unroll
    for (int e = 0; e < 4; ++e) { const char* a = rb[e];
        bf16x8 b0 = *reinterpret_cast<const bf16x8*>(a);
        bf16x8 b1 = *reinterpret_cast<const bf16x8*>(a + 32 * 128);
        bf16x8 q = *reinterpret_cast<const bf16x8*>(Qw + (8 + e) * 1024);
        p0 = __builtin_amdgcn_mfma_f32_32x32x16_bf16(b0, q, p0, 0, 0, 0);
        p1 = __builtin_amdgcn_mfma_f32_32x32x16_bf16(b1, q, p1, 0, 0, 0); }
}
template <int VB>
__device__ __forceinline__ void pv_tile(f32x16* o, int vb0, bf16x8 pa0, bf16x8 pa1, bf16x8 pa2, bf16x8 pa3) {
#define TRRD(dst, off) asm volatile("ds_read_b64_tr_b16 %0, %1 offset:%2" : "=&v"(dst) : "v"(vb0), "i"(off) : "memory")
#define PV_D0(d0) do { s16x4 l0, l1, l2, l3, h0, h1, h2, h3; constexpr int b_ = OFF_V + VB * SHM_V + v_rd_off(d0, 0, 0); \
        TRRD(l0, b_); TRRD(h0, b_ + 2048); TRRD(l1, b_ + 4096); TRRD(h1, b_ + 6144); TRRD(l2, b_ + 8192); TRRD(h2, b_ + 10240); TRRD(l3, b_ + 12288); TRRD(h3, b_ + 14336); \
        asm volatile("s_waitcnt lgkmcnt(0)" ::: "memory"); SBAR();   \
        o[d0] = __builtin_amdgcn_mfma_f32_32x32x16_bf16(pa0, (bf16x8){l0[0], l0[1], l0[2], l0[3], h0[0], h0[1], h0[2], h0[3]}, o[d0], 0, 0, 0);   \
        o[d0] = __builtin_amdgcn_mfma_f32_32x32x16_bf16(pa1, (bf16x8){l1[0], l1[1], l1[2], l1[3], h1[0], h1[1], h1[2], h1[3]}, o[d0], 0, 0, 0);   \
        o[d0] = __builtin_amdgcn_mfma_f32_32x32x16_bf16(pa2, (bf16x8){l2[0], l2[1], l2[2], l2[3], h2[0], h2[1], h2[2], h2[3]}, o[d0], 0, 0, 0);   \
        o[d0] = __builtin_amdgcn_mfma_f32_32x32x16_bf16(pa3, (bf16x8){l3[0], l3[1], l3[2], l3[3], h3[0], h3[1], h3[2], h3[3]}, o[d0], 0, 0, 0); } while (0)
    PV_D0(0); PV_D0(1); PV_D0(2); PV_D0(3);
#undef PV_D0
#undef TRRD
}
struct BlockRef { const bf16_t* Q; const bf16_t* K; const bf16_t* V; const bf16_t* KR; bf16_t* O; const bf16_t* Z; const float* CSq; int P0; };
struct Seam { bf16x8 qr[12]; bf16x8 st_v0, st_v1, st_k0, st_k1, st_r; };
#define ROWKV(p, k0, rr) ((p) + (size_t)((k0) + (rr)) * KVP + sc)
#define VMW() asm volatile("s_waitcnt vmcnt(0)" ::: "memory")
#define VMWN(n) asm volatile("s_waitcnt vmcnt(%0)" :: "i"(n) : "memory")
#define SLOAD_H(Kp, Vp, Rp, k0) do { S.st_v0 = load8(ROWKV(Vp, k0, sr)); S.st_v1 = load8(ROWKV(Vp, k0, 32 + sr));              \
                         S.st_k0 = load8(ROWKV(Kp, k0, sr)); S.st_k1 = load8(ROWKV(Kp, k0, 32 + sr)); S.st_r = load8((Rp) + (size_t)((k0) + rr_) * KRP + rc_); } while (0)
#define SWRITE_HK() do { *(bf16x8*)(K_lds + kws) = S.st_k0; *(bf16x8*)(K_lds + kws + 32 * 256) = S.st_k1; *(bf16x8*)(R_lds + rws) = S.st_r; } while (0)
#define SWRITE_HV(bf) do { *(bf16x8*)(V_lds + (bf) * SHM_V + vst0) = S.st_v0; *(bf16x8*)(V_lds + (bf) * SHM_V + vst1) = S.st_v1; } while (0)
#define SWRITE_H(bf) do { SWRITE_HV(bf); SWRITE_HK(); } while (0)
__device__ __forceinline__ void attn_prime(const BlockRef& cur, char* lds, Seam& S) {
    int tid_o = threadIdx.x; asm volatile("" : "+v"(tid_o));
    const int tid = tid_o, wid = __builtin_amdgcn_readfirstlane(tid >> 6), lane = tid & 63, r32 = lane & 31, hi = lane >> 5;
    const int sr = tid >> 4, sc = (tid & 15) * 8, kws = KSWZ(sr, sc * 2), rr_ = tid >> 3, rc_ = (tid & 7) * 8, rws = RSWZ(rr_, rc_ * 2);
    char* K_lds = lds + OFF_K; char* R_lds = lds + OFF_R;
#pragma unroll
    for (int d0 = 0; d0 < 12; ++d0) S.qr[d0] = load8(cur.Q + (size_t)(wid * QBLK + r32) * QP + d0 * 16 + hi * 8);
    SLOAD_H(cur.K, cur.V, cur.KR, 0); VMW(); SWRITE_HK();
    __syncthreads();
}
__device__ __forceinline__ void attn_block(const BlockRef& cur, const BlockRef& nxt, char* lds, Seam& S) {
    int tid_o = threadIdx.x; asm volatile("" : "+v"(tid_o));
    const int tid = tid_o, wid = __builtin_amdgcn_readfirstlane(tid >> 6), lane = tid & 63, r32 = lane & 31, hi = lane >> 5;
    const int NT = cur.P0 / KVBLK + 4;
    const int qlo = cur.P0 + wid * QBLK, qm = qlo + r32 - 4 * hi;
    char* V_lds = lds + OFF_V; char* K_lds = lds + OFF_K; char* R_lds = lds + OFF_R;
    float* ws = (float*)(lds + OFF_WS) + wid * 64; float* li_l = ws, * al_l = ws + 32;
    float m_reg = -1e30f, l_reg = 0; f32x16 o[4] = {};
    const int sr = tid >> 4, sc = (tid & 15) * 8, vst0 = v_st(sr, sc), vst1 = v_st(32 + sr, sc), kws = KSWZ(sr, sc * 2), rr_ = tid >> 3, rc_ = (tid & 7) * 8, rws = RSWZ(rr_, rc_ * 2);
    const int vb0 = (int)(uintptr_t)lds + v_rd_base(lane);
    char* Qw = lds + OFF_Q + wid * 12288 + lane * 16;
    const bf16_t* Kh = cur.K; const bf16_t* Vh = cur.V; const bf16_t* Rh = cur.KR;
#define RESC(a) do { if (__any((a) < 1.f)) { if (hi == 0) al_l[r32] = (a); asm volatile("s_waitcnt lgkmcnt(0)" ::: "memory");              \
                     for (int d_ = 0; d_ < 4; ++d_) for (int r = 0; r < 16; ++r) o[d_][r] *= al_l[crow(r, hi)]; } } while (0)
#define KBASE(t) ((t) * KVBLK)
#define MASKT(P0_, P1_, t) do { const int kb_ = KBASE(t); if (kb_ + KVBLK - 1 > qlo) mask_tile(P0_, P1_, qm - kb_, WBIG); } while (0)
    constexpr int NQL = 12;
#define SEAM_K0() do { VMWN(NQL); SWRITE_HK(); SBAR(); } while (0)
    f32x16 pA0, pA1, pB0, pB1; float mnA, mnB, alA, alB; bf16x8 pa0, pa1, pa2, pa3;
#pragma unroll
    for (int e = 0; e < 4; ++e) { const f32x4* cp = (const f32x4*)(cur.CSq + (size_t)(wid * QBLK + r32) * 64 + (e * 8 + hi * 4) * 2); const f32x4 c0 = cp[0], c1 = cp[1];
        const bf16x8 raw = S.qr[8 + e]; float x[8];
#pragma unroll
        for (int j = 0; j < 8; ++j) x[j] = __uint_as_float((unsigned)(unsigned short)raw[j] << 16);
        u32x4 w;
        w.x = cvtpk(x[0] * c0[0] - x[1] * c0[1], x[1] * c0[0] + x[0] * c0[1]); w.y = cvtpk(x[2] * c0[2] - x[3] * c0[3], x[3] * c0[2] + x[2] * c0[3]);
        w.z = cvtpk(x[4] * c1[0] - x[5] * c1[1], x[5] * c1[0] + x[4] * c1[1]); w.w = cvtpk(x[6] * c1[2] - x[7] * c1[3], x[7] * c1[2] + x[6] * c1[3]);
        S.qr[8 + e] = *reinterpret_cast<bf16x8*>(&w); }
#pragma unroll
    for (int d0 = 0; d0 < 12; ++d0) *(bf16x8*)(Qw + d0 * 1024) = S.qr[d0];
    SWRITE_HV(0); SBAR();
    SLOAD_H(Kh, Vh, Rh, KBASE(1));
    SBAR(); qkt(pA0, pA1, K_lds, R_lds, Qw, r32, hi);
    MASKT(pA0, pA1, 0); partialSM(pA0, pA1, m_reg, mnA, alA);
    __syncthreads();
    VMW(); SWRITE_H(1);
    __syncthreads();
#define HALF_STEP(PX0, PX1, mnX, alX, PY0, PY1, alY, t, VB, SB) do {                                                          \
        SBAR(); qkt(PX0, PX1, K_lds, R_lds, Qw, r32, hi);                                                                     \
        finishSM(PY0, PY1, alY, l_reg, pa0, pa1, pa2, pa3); SBAR();                                                           \
        if ((t) + 1 < NT) { SLOAD_H(Kh, Vh, Rh, KBASE((t) + 1)); SBAR(); }                                                    \
        pv_tile<VB>(o, vb0, pa0, pa1, pa2, pa3); MASKT(PX0, PX1, (t)); partialSM(PX0, PX1, m_reg, mnX, alX);                  \
        __syncthreads();                                                                                                      \
        if ((t) + 1 < NT) { VMW(); SWRITE_H(SB); }                                                                            \
        RESC(alX); __syncthreads(); } while (0)
    for (int t = 1; t + 1 < NT; t += 2) {
        HALF_STEP(pB0, pB1, mnB, alB, pA0, pA1, alA, t, 0, 0);
        HALF_STEP(pA0, pA1, mnA, alA, pB0, pB1, alB, t + 1, 1, 1);
    }
    SBAR(); qkt(pB0, pB1, K_lds, R_lds, Qw, r32, hi); SBAR();
    SLOAD_H(nxt.K, nxt.V, nxt.KR, 0); SBAR();
    finishSM(pA0, pA1, alA, l_reg, pa0, pa1, pa2, pa3); SBAR();
    pv_tile<0>(o, vb0, pa0, pa1, pa2, pa3);
    MASKT(pB0, pB1, NT - 1); partialSM(pB0, pB1, m_reg, mnB, alB); __syncthreads(); RESC(alB);
    finishSM(pB0, pB1, alB, l_reg, pa0, pa1, pa2, pa3); SBAR(); pv_tile<1>(o, vb0, pa0, pa1, pa2, pa3);
    SBAR();
#pragma unroll
    for (int d0 = 0; d0 < 12; ++d0) S.qr[d0] = load8(nxt.Q + (size_t)(wid * QBLK + r32) * QP + d0 * 16 + hi * 8);
    SBAR(); SEAM_K0();
    if (hi == 0) li_l[r32] = l_reg; asm volatile("s_waitcnt lgkmcnt(0)" ::: "memory");
    float rli[16];
#pragma unroll
    for (int r = 0; r < 16; ++r) rli[r] = __builtin_amdgcn_rcpf(li_l[crow(r, hi)]);
    bf16_t* Ow = cur.O + (size_t)(wid * QBLK) * OP; const bf16_t* Zw = cur.Z + (size_t)(wid * QBLK) * NPROJ;
#pragma unroll
    for (int r = 0; r < 16; ++r) { const int orow = crow(r, hi);
#pragma unroll
        for (int d0 = 0; d0 < 4; ++d0) { const float z = bf2f(Zw[(size_t)orow * NPROJ + d0 * 32 + r32]);
            const float v = o[d0][r] * rli[r] * (z / (1.f + __expf(-z)));
            const float vn = __shfl_xor(v, 1);
            if ((r32 & 1) == 0) *(unsigned*)(Ow + (size_t)orow * OP + d0 * 32 + r32) = cvtpk(v, vn); } }
    __syncthreads();
#undef RESC
#undef KBASE
#undef MASKT
#undef SEAM_K0
#undef HALF_STEP
}
#undef ROWKV
#undef VMW
#undef VMWN
#undef SLOAD_H
#undef SWRITE_HK
#undef SWRITE_HV
#undef SWRITE_H
#undef KSWZ
#undef RSWZ
#undef SBAR
}
namespace mm {
typedef short bf16x8 __attribute__((ext_vector_type(8)));
typedef float f32x4 __attribute__((ext_vector_type(4)));
typedef unsigned u32x2 __attribute__((ext_vector_type(2)));
#define MM_LAS __attribute__((address_space(3)))
typedef float f32x2_t __attribute__((ext_vector_type(2))); typedef __bf16 bf16x2_t __attribute__((ext_vector_type(2)));
__device__ __forceinline__ unsigned cvtpk(float lo, float hi) { const f32x2_t v = {lo, hi}; const bf16x2_t b = __builtin_convertvector(v, bf16x2_t); return __builtin_bit_cast(unsigned, b); }
template <int NK>
__device__ __forceinline__ void blk(f32x4& acc, const MM_LAS unsigned char* A, int apitch, const MM_LAS unsigned char* Bt, int bpitch, int lane) {
    const MM_LAS unsigned char* ap = A + (lane & 15) * apitch + (lane >> 4) * 16;
    const MM_LAS unsigned char* bp = Bt + (lane & 15) * bpitch + (lane >> 4) * 16;
#pragma unroll
    for (int ks = 0; ks < NK; ++ks) { const bf16x8 a = *(const MM_LAS bf16x8*)(ap + ks * 64), b = *(const MM_LAS bf16x8*)(bp + ks * 64); acc = __builtin_amdgcn_mfma_f32_16x16x32_bf16(a, b, acc, 0, 0, 0); }
}
__device__ __forceinline__ void store_T(const f32x4& acc, MM_LAS unsigned char* img, int pitch, int jbase, int ibase, int lane) {
    u32x2 w; w.x = cvtpk(acc[0], acc[1]); w.y = cvtpk(acc[2], acc[3]);
    *(MM_LAS u32x2*)(img + (jbase + (lane & 15)) * pitch + (ibase + 4 * (lane >> 4)) * 2) = w;
}
__device__ __forceinline__ float bfl(unsigned short v) { return __uint_as_float((unsigned)v << 16); }
__device__ __forceinline__ unsigned short f2b(float f) { return (unsigned short)(cvtpk(f, 0.f) & 0xffffu); }
}

namespace mlk {
constexpr int PQ = 272, PS = 144;
constexpr int REC = 18432, NUNITS = BATCH * 4 * 64;
constexpr int LO_QI = 0, LO_KI = 17408, LO_VT = 34816, LO_SI = 55552, LO_TAB = 64768, LO_WKT = 65536, L_END = 83968;
constexpr int O_QI = 0, O_WKT = 17408, O_VT = 35840, O_CI = 56576, O_TAB = 95744, O_HB = 97792, LDS_END = 131584;
constexpr int HBP = 132;
}
__device__ __forceinline__ void mlstm_local(unsigned char* lds_g, int first, int stride, const bf16_t* QKC, bf16_t* PROJ, const float* GA, const float* GPM, unsigned char* MLX) {
    using namespace mlk; using mm::f32x4; using mm::bf16x8;
    MM_LAS unsigned char* L = (MM_LAS unsigned char*)lds_g;
    int tid_o = threadIdx.x; asm volatile("" : "+v"(tid_o));
    const int tid = tid_o, lane = tid & 63, wave = __builtin_amdgcn_readfirstlane(tid >> 6);
    MM_LAS unsigned char *QI = L + LO_QI, *KI = L + LO_KI, *VT = L + LO_VT, *SI = L + LO_SI, *WKT = L + LO_WKT; MM_LAS float* TAB = (MM_LAS float*)(L + LO_TAB);
    if (first >= NUNITS) return;
    for (int i = tid; i < 16 * PS / 4; i += 512) ((MM_LAS unsigned*)(VT + 128 * PS))[i] = (i < PS / 4) ? 0x3f803f80u : 0u;
    const int t = lane, cg = wave;
    bf16x8 q0, q1, k0, k1, v0, v1; float ga = 0.f, gp = 0.f;
#define ML_LOAD(u_) do { const int bh_ = (u_) >> 6, c_ = (u_) & 63, h_ = bh_ & 3; const size_t m_ = (size_t)(bh_ >> 2) * T + (size_t)c_ * 64 + t; const bf16_t* qp = QKC + m_ * 1024 + h_ * 128 + 16 * cg; const bf16_t* vp = PROJ + m_ * NPROJ + PC_MLV + h_ * 128 + 16 * cg; \
        q0 = *(const bf16x8*)qp; q1 = *(const bf16x8*)(qp + 8); k0 = *(const bf16x8*)(qp + 512); k1 = *(const bf16x8*)(qp + 520); v0 = *(const bf16x8*)vp; v1 = *(const bf16x8*)(vp + 8); \
        ga = GA[m_ * 4 + h_]; gp = GPM[m_ * 4 + h_]; } while (0)
    ML_LOAD(first);
    for (int u = first; u < NUNITS; u += stride) {
        const int ubh = u >> 6, uh = ubh & 3; const size_t um0 = (size_t)(ubh >> 2) * T + (size_t)(u & 63) * 64;
        unsigned char* rec = MLX + (size_t)u * REC;
        __syncthreads();
        *(MM_LAS bf16x8*)(QI + t * PQ + cg * 32) = q0; *(MM_LAS bf16x8*)(QI + t * PQ + cg * 32 + 16) = q1;
        *(MM_LAS bf16x8*)(KI + t * PQ + cg * 32) = k0; *(MM_LAS bf16x8*)(KI + t * PQ + cg * 32 + 16) = k1;
#pragma unroll
        for (int e = 0; e < 8; ++e) { *(MM_LAS unsigned short*)(VT + (16 * cg + e) * PS + t * 2) = (unsigned short)v0[e]; *(MM_LAS unsigned short*)(VT + (16 * cg + 8 + e) * PS + t * 2) = (unsigned short)v1[e]; }
        { const float wl = __expf(ga - __shfl(gp, 63));
#pragma unroll
          for (int e = 0; e < 8; ++e) { *(MM_LAS unsigned short*)(WKT + (16 * cg + e) * PS + t * 2) = mm::f2b(wl * mm::bfl((unsigned short)k0[e])); *(MM_LAS unsigned short*)(WKT + (16 * cg + 8 + e) * PS + t * 2) = mm::f2b(wl * mm::bfl((unsigned short)k1[e])); } }
        if (wave == 0) { TAB[t] = ga; TAB[64 + t] = gp; }
        if (u + stride < NUNITS) ML_LOAD(u + stride);
        __syncthreads();
        {
            const int row = tid >> 1, half = tid & 1, which = row >> 7, r = row & 127; const MM_LAS unsigned char* src = (which ? VT : WKT) + r * PS + half * 64;
            bf16_t* dst = PROJ + (um0 + (r & 63)) * NPROJ + PC_MLQK + uh * 256 + which * 128 + (r >> 6) * 64 + half * 32;
            typedef unsigned u32x4_ __attribute__((ext_vector_type(4)));
#pragma unroll
            for (int i = 0; i < 4; ++i) *(u32x4_*)(dst + 8 * i) = *(const MM_LAS u32x4_*)(src + 16 * i);
        }
        {
            const int bi = wave >> 1;
#pragma unroll
            for (int jj = 0; jj < 2; ++jj) { const int bj = 2 * (wave & 1) + jj; f32x4 acc = (f32x4){0.f, 0.f, 0.f, 0.f};
                if (bi <= bj) { mm::blk<4>(acc, KI + bi * 16 * PQ, PQ, QI + bj * 16 * PQ, PQ, lane);
                    const int tt = 16 * bj + (lane & 15); const float pmt = TAB[64 + tt];
#pragma unroll
                    for (int r = 0; r < 4; ++r) { const int s = 16 * bi + 4 * (lane >> 4) + r; acc[r] = (s <= tt) ? acc[r] * __expf(TAB[s] - pmt) : 0.f; } }
                mm::store_T(acc, SI, PS, 16 * bj, 16 * bi, lane); }
        }
        __syncthreads();
#pragma unroll
        for (int n = 0; n < 5; ++n) { const int id = wave + 8 * n;
            if (id < 36) { const int vb = id >> 2, tb = id & 3; f32x4 aa = (f32x4){0.f, 0.f, 0.f, 0.f};
                mm::blk<2>(aa, SI + tb * 16 * PS, PS, VT + vb * 16 * PS, PS, lane);
                mm::u32x2 w; w.x = mm::cvtpk(aa[0], aa[1]); w.y = mm::cvtpk(aa[2], aa[3]); *(mm::u32x2*)(rec + (id * 64 + lane) * 8) = w; } }
    }
    __syncthreads();
#undef ML_LOAD
}
__device__ __forceinline__ void mlstm_seq(unsigned char* lds_g, int b, int h, const bf16_t* QKC, const bf16_t* PROJ, const float* GA, const float* GB, const float* GPM, const unsigned char* MLX, const float* ng, bf16_t* MIXED) {
    using namespace mlk; using mm::f32x4; using mm::bf16x8;
    MM_LAS unsigned char* L = (MM_LAS unsigned char*)lds_g;
    int tid_o = threadIdx.x; asm volatile("" : "+v"(tid_o));
    const int tid = tid_o, lane = tid & 63, wave = __builtin_amdgcn_readfirstlane(tid >> 6);
    MM_LAS unsigned char *QI = L + O_QI, *WKT = L + O_WKT, *VT = L + O_VT, *CI = L + O_CI;
    MM_LAS float* TAB = (MM_LAS float*)(L + O_TAB);
    MM_LAS float* HB = (MM_LAS float*)(L + O_HB);
    for (int i = tid; i < 39168 / 4; i += 512) ((MM_LAS unsigned*)CI)[i] = 0u;
    for (int i = tid; i < 16 * PS / 4; i += 512) ((MM_LAS unsigned*)(VT + 128 * PS))[i] = (i < PS / 4) ? 0x3f803f80u : 0u;
    f32x4 cacc[9];
#pragma unroll
    for (int i = 0; i < 9; ++i) cacc[i] = (f32x4){0.f, 0.f, 0.f, 0.f};
    float m_run = 0.f;
    const int t = lane, cg = wave;
    const size_t mrow0 = (size_t)b * T; const unsigned char* rec0 = MLX + (size_t)((b * 4 + h) * 64) * REC;
    bf16x8 q0, q1; float ga, gb, gp; typedef unsigned u32x4i __attribute__((ext_vector_type(4))); u32x4i im[4];
    const int irow = tid >> 1, ihalf = tid & 1, iwhich = irow >> 7, ir = irow & 127;
#define ML_LOAD(c_) do { const size_t m_ = mrow0 + (size_t)(c_) * 64 + t; const bf16_t* qp = QKC + m_ * 1024 + h * 128 + 16 * cg; q0 = *(const bf16x8*)qp; q1 = *(const bf16x8*)(qp + 8); \
        ga = GA[m_ * 4 + h]; gb = GB[m_ * 4 + h]; gp = GPM[m_ * 4 + h]; \
        const bf16_t* ip_ = PROJ + (mrow0 + (size_t)(c_) * 64 + (ir & 63)) * NPROJ + PC_MLQK + h * 256 + iwhich * 128 + (ir >> 6) * 64 + ihalf * 32; \
        _Pragma("unroll") for (int i_ = 0; i_ < 4; ++i_) im[i_] = *(const u32x4i*)(ip_ + 8 * i_); } while (0)
    ML_LOAD(0);
    const int et = tid >> 3, ep = tid & 7;
    f32x4 ngr[4];
#pragma unroll
    for (int i = 0; i < 4; ++i) ngr[i] = *(const f32x4*)(ng + 16 * ep + 4 * i);
    typedef unsigned u32x4_ __attribute__((ext_vector_type(4)));
    mm::u32x2 ibn[5];
#pragma unroll
    for (int n = 0; n < 5; ++n) { const int id = wave + 8 * n; ibn[n] = (mm::u32x2){0u, 0u}; if (id < 36) ibn[n] = *(const mm::u32x2*)(rec0 + (id * 64 + lane) * 8); }
    for (int c = 0; c < 64; ++c) {
        const size_t em_ = mrow0 + (size_t)c * 64 + et;
        const u32x4_ eg0 = *(const u32x4_*)(PROJ + em_ * NPROJ + PC_MLO + h * 128 + 16 * ep), eg1 = *(const u32x4_*)(PROJ + em_ * NPROJ + PC_MLO + h * 128 + 16 * ep + 8);
        mm::u32x2 ib[5];
#pragma unroll
        for (int n = 0; n < 5; ++n) ib[n] = ibn[n];
        if (c + 1 < 64) {
#pragma unroll
            for (int n = 0; n < 5; ++n) { const int id = wave + 8 * n; if (id < 36) ibn[n] = *(const mm::u32x2*)(rec0 + (size_t)(c + 1) * REC + (id * 64 + lane) * 8); } }
        const float mx = fmaxf(m_run, gp), mxL = __shfl(mx, 63), bL = __shfl(gb, 63);
        const float decay = __expf(m_run - mxL), sigma = __expf(__shfl(gp, 63) - mxL);
        if (wave == 0) { TAB[t] = __expf(m_run - mx); TAB[64 + t] = __expf(gp - mx); TAB[128 + t] = __expf(-(gb + mx)); }
        m_run = bL + mxL;
        {
            *(MM_LAS bf16x8*)(QI + t * PQ + cg * 32) = q0; *(MM_LAS bf16x8*)(QI + t * PQ + cg * 32 + 16) = q1;
            MM_LAS unsigned char* dst = (iwhich ? VT : WKT) + ir * PS + ihalf * 64;
#pragma unroll
            for (int i = 0; i < 4; ++i) *(MM_LAS u32x4i*)(dst + 16 * i) = im[i];
        }
        if (c + 1 < 64) ML_LOAD(c + 1);
        __syncthreads();
        f32x4 res[5];
        {
#pragma unroll
            for (int n = 0; n < 5; ++n) { const int id = wave + 8 * n; res[n] = (f32x4){0.f, 0.f, 0.f, 0.f};
                if (id < 36) { const int vb = id >> 2, tb = id & 3; f32x4 ai = (f32x4){0.f, 0.f, 0.f, 0.f};
                    mm::blk<4>(ai, QI + tb * 16 * PQ, PQ, CI + vb * 16 * PQ, PQ, lane);
                    const f32x4 in4 = (f32x4){__uint_as_float(ib[n].x << 16), __uint_as_float(ib[n].x & 0xffff0000u), __uint_as_float(ib[n].y << 16), __uint_as_float(ib[n].y & 0xffff0000u)};
#pragma unroll
                    for (int r = 0; r < 4; ++r) { const int tt = 16 * tb + 4 * (lane >> 4) + r; res[n][r] = TAB[tt] * ai[r] + TAB[64 + tt] * in4[r]; } } }
#pragma unroll
            for (int vb = 0; vb < 9; ++vb) { f32x4 dl = (f32x4){0.f, 0.f, 0.f, 0.f}; mm::blk<2>(dl, WKT + wave * 16 * PS, PS, VT + vb * 16 * PS, PS, lane); cacc[vb] = cacc[vb] * decay + dl * sigma; }
        }
        const float em_l = TAB[128 + 16 * (wave & 3) + 4 * (lane >> 4) + 0], em_1 = TAB[128 + 16 * (wave & 3) + 4 * (lane >> 4) + 1], em_2 = TAB[128 + 16 * (wave & 3) + 4 * (lane >> 4) + 2], em_3 = TAB[128 + 16 * (wave & 3) + 4 * (lane >> 4) + 3];
        __syncthreads();
        {
#pragma unroll
            for (int n = 0; n < 5; ++n) { const int id = wave + 8 * n;
                if (id < 36) { const int vb = id >> 2, tb = id & 3, j = lane & 15;
#pragma unroll
                    for (int r = 0; r < 4; ++r) { const int tt = 16 * tb + 4 * (lane >> 4) + r;
                        if (vb < 8 || j == 0) HB[tt * HBP + 16 * vb + j] = res[n][r];
                        else if (j == 1) HB[tt * HBP + 129] = (r == 0 ? em_l : r == 1 ? em_1 : r == 2 ? em_2 : em_3); } } }
#pragma unroll
            for (int vb = 0; vb < 9; ++vb) mm::store_T(cacc[vb], CI, PQ, 16 * vb, 16 * wave, lane);
        }
        __syncthreads();
        {
            const MM_LAS float* hr = HB + et * HBP; const float rdn = 1.f / fmaxf(fabsf(hr[128]), hr[129]);
            f32x4 hv[4]; float sm = 0.f;
#pragma unroll
            for (int i = 0; i < 4; ++i) { hv[i] = *(const MM_LAS f32x4*)(hr + 16 * ep + 4 * i) * rdn; sm += (hv[i][0] + hv[i][1]) + (hv[i][2] + hv[i][3]); }
            sm += __shfl_xor(sm, 1); sm += __shfl_xor(sm, 2); sm += __shfl_xor(sm, 4);
            const float mean = sm * (1.f / 128.f); float sq = 0.f;
#pragma unroll
            for (int i = 0; i < 4; ++i) { hv[i] = hv[i] - mean; sq += (hv[i][0] * hv[i][0] + hv[i][1] * hv[i][1]) + (hv[i][2] * hv[i][2] + hv[i][3] * hv[i][3]); }
            sq += __shfl_xor(sq, 1); sq += __shfl_xor(sq, 2); sq += __shfl_xor(sq, 4);
            const float rstd = 1.f / sqrtf(sq * (1.f / 128.f) + NORM_EPS);
            u32x4_ o0, o1;
#pragma unroll
            for (int i = 0; i < 4; ++i) { const unsigned g0_ = (i < 2 ? eg0 : eg1)[(2 * i) & 3], g1_ = (i < 2 ? eg0 : eg1)[(2 * i + 1) & 3];
                const unsigned w0 = mm::cvtpk(bf2f(g0_ & 0xffffu) * hv[i][0] * rstd * ngr[i][0], bf2f(g0_ >> 16) * hv[i][1] * rstd * ngr[i][1]), w1 = mm::cvtpk(bf2f(g1_ & 0xffffu) * hv[i][2] * rstd * ngr[i][2], bf2f(g1_ >> 16) * hv[i][3] * rstd * ngr[i][3]);
                if (i < 2) { o0[2 * i] = w0; o0[2 * i + 1] = w1; } else { o1[2 * i - 4] = w0; o1[2 * i - 3] = w1; } }
            *(u32x4_*)(MIXED + em_ * DM + h * 128 + 16 * ep) = o0; *(u32x4_*)(MIXED + em_ * DM + h * 128 + 16 * ep + 8) = o1;
        }
    }
    __syncthreads();
#undef ML_LOAD
}
namespace rwk {
constexpr int PS = 144, SLOT = 9216;
constexpr int S_AT = 0, S_RT = 1, S_BTT = 2, S_KTT = 3, S_VTT = 4, S_AAK = 5, S_ARB = 6, S_ARK = 7, S_ATT = 8, S_TAT = 9, S_Z0 = 10, S_Z1 = 11, S_Z2 = 12, S_Z3 = 13, S_T0 = 14, S_T1 = 15;
constexpr int O_TAB = 16 * SLOT, O_PQ = O_TAB + 256, LDS_END = O_PQ + 4096, FP = 68;
constexpr int REC = 32768, R_RA = 0, R_MT = 8192, R_YC = 16384, R_NT = 24576;
constexpr int NUNITS = BATCH * 8 * 64;
}
__device__ __forceinline__ void rwkv_local(unsigned char* lds_g, int first, int stride, const float* RWW, const bf16_t* RWB, size_t RWS, unsigned char* RWX) {
    using namespace rwk; using mm::f32x4; using mm::bf16x8;
    MM_LAS unsigned char* L = (MM_LAS unsigned char*)lds_g;
    int tid_o = threadIdx.x; asm volatile("" : "+v"(tid_o));
    const int tid = tid_o, lane = tid & 63, wave = __builtin_amdgcn_readfirstlane(tid >> 6);
#define SL(n) (L + (n) * SLOT)
    MM_LAS float* WLT = (MM_LAS float*)(L + O_TAB); MM_LAS float* TF = (MM_LAS float*)SL(S_Z0); MM_LAS float* AF = (MM_LAS float*)SL(S_T0); MM_LAS float* PQ = (MM_LAS float*)(L + O_PQ);
    const int t = lane, cg = wave, bi = wave >> 1, bj0 = 2 * (wave & 1), lj = lane & 15, lq = lane >> 4;
    bf16x8 gr, gk, gv, ga, gb; f32x4 gw0, gw1;
#define RW_LOAD(u_) do { const int bh_ = (u_) >> 6, c_ = (u_) & 63; const size_t o_ = ((size_t)(bh_ >> 3) * T + (size_t)c_ * 64 + t) * 512 + (bh_ & 7) * 64 + 8 * cg; \
        gr = *(const bf16x8*)(RWB + o_); gk = *(const bf16x8*)(RWB + RWS + o_); gv = *(const bf16x8*)(RWB + 2 * RWS + o_); ga = *(const bf16x8*)(RWB + 3 * RWS + o_); gb = *(const bf16x8*)(RWB + 4 * RWS + o_); \
        gw0 = *(const f32x4*)(RWW + o_); gw1 = *(const f32x4*)(RWW + o_ + 4); } while (0)
    if (first >= NUNITS) return;
    RW_LOAD(first);
    for (int u = first; u < NUNITS; u += stride) {
        unsigned char* rec = RWX + (size_t)u * REC;
        __syncthreads();
        {
            float lw[8], cw[8];
#pragma unroll
            for (int e = 0; e < 4; ++e) { lw[e] = gw0[e]; lw[4 + e] = gw1[e]; }
#pragma unroll
            for (int e = 0; e < 8; ++e) { float s = lw[e];
#pragma unroll
                for (int o = 1; o < 64; o <<= 1) { const float u = __shfl_up(s, o); if (lane >= o) s += u; }
                cw[e] = s; }
            float av[8], bv[8], kv[8], rv[8];
#pragma unroll
            for (int e = 0; e < 8; ++e) { const float Wt = __expf(cw[e]), Wp = __expf(cw[e] - lw[e]), iW = __expf(-cw[e]);
                av[e] = mm::bfl((unsigned short)ga[e]) * Wp; bv[e] = mm::bfl((unsigned short)gb[e]) * iW; kv[e] = mm::bfl((unsigned short)gk[e]) * iW; rv[e] = mm::bfl((unsigned short)gr[e]) * Wt;
                if (lane == 63) WLT[8 * cg + e] = Wt; }
            typedef unsigned u32x4_ __attribute__((ext_vector_type(4)));
            u32x4_ pa, pb, pk, pr;
            pa.x = mm::cvtpk(av[0], av[1]); pa.y = mm::cvtpk(av[2], av[3]); pa.z = mm::cvtpk(av[4], av[5]); pa.w = mm::cvtpk(av[6], av[7]);
            pb.x = mm::cvtpk(bv[0], bv[1]); pb.y = mm::cvtpk(bv[2], bv[3]); pb.z = mm::cvtpk(bv[4], bv[5]); pb.w = mm::cvtpk(bv[6], bv[7]);
            pk.x = mm::cvtpk(kv[0], kv[1]); pk.y = mm::cvtpk(kv[2], kv[3]); pk.z = mm::cvtpk(kv[4], kv[5]); pk.w = mm::cvtpk(kv[6], kv[7]);
            pr.x = mm::cvtpk(rv[0], rv[1]); pr.y = mm::cvtpk(rv[2], rv[3]); pr.z = mm::cvtpk(rv[4], rv[5]); pr.w = mm::cvtpk(rv[6], rv[7]);
            *(MM_LAS u32x4_*)(SL(S_AT) + t * PS + cg * 16) = pa; *(MM_LAS u32x4_*)(SL(S_RT) + t * PS + cg * 16) = pr;
            *(MM_LAS u32x4_*)(SL(S_Z0) + t * PS + cg * 16) = pb; *(MM_LAS u32x4_*)(SL(S_Z1) + t * PS + cg * 16) = pk; asm volatile("" ::: "memory");
#pragma unroll
            for (int e = 0; e < 8; ++e) { const unsigned wb = (e & 1) ? (pb[e >> 1] >> 16) : (pb[e >> 1] & 0xffffu), wk = (e & 1) ? (pk[e >> 1] >> 16) : (pk[e >> 1] & 0xffffu);
                *(MM_LAS unsigned short*)(SL(S_BTT) + (8 * cg + e) * PS + t * 2) = (unsigned short)wb;
                *(MM_LAS unsigned short*)(SL(S_KTT) + (8 * cg + e) * PS + t * 2) = (unsigned short)wk;
                *(MM_LAS unsigned short*)(SL(S_VTT) + (8 * cg + e) * PS + t * 2) = (unsigned short)gv[e];
                *(MM_LAS unsigned short*)(SL(S_ATT) + (8 * cg + e) * PS + t * 2) = (unsigned short)((e & 1) ? (pa[e >> 1] >> 16) : (pa[e >> 1] & 0xffffu)); }
        }
        if (u + stride < NUNITS) RW_LOAD(u + stride);
        __syncthreads();
        {
#pragma unroll
            for (int jj = 0; jj < 2; ++jj) { const int bj = bj0 + jj; const int tt = 16 * bj + lj, s0 = 16 * bi + 4 * lq;
                f32x4 ab = (f32x4){0.f, 0.f, 0.f, 0.f}, ak = ab, rb = ab, rk = ab;
                if (bi <= bj) {
                    mm::blk<2>(ab, SL(S_Z0) + bi * 16 * PS, PS, SL(S_AT) + bj * 16 * PS, PS, lane);
                    mm::blk<2>(ak, SL(S_Z1) + bi * 16 * PS, PS, SL(S_AT) + bj * 16 * PS, PS, lane);
                    mm::blk<2>(rb, SL(S_Z0) + bi * 16 * PS, PS, SL(S_RT) + bj * 16 * PS, PS, lane);
                    mm::blk<2>(rk, SL(S_Z1) + bi * 16 * PS, PS, SL(S_RT) + bj * 16 * PS, PS, lane);
#pragma unroll
                    for (int r = 0; r < 4; ++r) { const int s = s0 + r; if (!(s < tt)) { ab[r] = 0.f; ak[r] = 0.f; } if (!(s <= tt)) { rb[r] = 0.f; rk[r] = 0.f; } } }
                mm::store_T(ak, SL(S_AAK), PS, 16 * bj, 16 * bi, lane); mm::store_T(rb, SL(S_ARB), PS, 16 * bj, 16 * bi, lane); mm::store_T(rk, SL(S_ARK), PS, 16 * bj, 16 * bi, lane);
                *(MM_LAS f32x4*)(AF + tt * FP + s0) = ab; asm volatile("" ::: "memory"); }
        }
        __syncthreads();
        if (wave < 4) { if (lane < 16) {
                float Tc[16]; const MM_LAS float* ar = AF + (16 * wave) * FP + 16 * wave;
#pragma unroll
                for (int r = 0; r < 16; ++r) { float acc = (r == lane) ? 1.f : 0.f;
#pragma unroll
                    for (int q4 = 0; q4 < (r + 3) / 4; ++q4) { const f32x4 a4 = *(const MM_LAS f32x4*)(ar + r * FP + 4 * q4);
#pragma unroll
                        for (int e = 0; e < 4; ++e) if (4 * q4 + e < r) acc += a4[e] * Tc[4 * q4 + e]; }
                    Tc[r] = acc; TF[(16 * wave + r) * FP + 16 * wave + lane] = acc; } } }
        else { const int z = (wave - 4) * 64 + lane, zb = z >> 7, zi = (z >> 4) & 7, zj = z & 15;
#pragma unroll
            for (int hh = 0; hh < 2; ++hh) TF[(32 * zb + zi + 8 * hh) * FP + 32 * zb + 16 + zj] = 0.f; }
        __syncthreads();
        {
            const int pr_ = tid >> 8, i = (tid >> 4) & 15, j = tid & 15, rb = 32 * pr_ + 16, cb = 32 * pr_; float acc = 0.f;
#pragma unroll
            for (int k4 = 0; k4 < 4; ++k4) { const f32x4 a4 = *(const MM_LAS f32x4*)(AF + (rb + i) * FP + cb + 4 * k4);
#pragma unroll
                for (int e = 0; e < 4; ++e) acc += a4[e] * TF[(cb + 4 * k4 + e) * FP + cb + j]; }
            PQ[pr_ * 256 + i * 16 + j] = acc; }
        __syncthreads();
        {
            const int pr_ = tid >> 8, i = (tid >> 4) & 15, j = tid & 15, rb = 32 * pr_ + 16, cb = 32 * pr_; float acc = 0.f;
#pragma unroll
            for (int k4 = 0; k4 < 4; ++k4) { const f32x4 a4 = *(const MM_LAS f32x4*)(TF + (rb + i) * FP + rb + 4 * k4);
#pragma unroll
                for (int e = 0; e < 4; ++e) acc += a4[e] * PQ[pr_ * 256 + (4 * k4 + e) * 16 + j]; }
            TF[(rb + i) * FP + cb + j] = acc; }
        __syncthreads();
        {
            const int i = tid >> 4, jq = tid & 15; float acc0 = 0.f, acc1 = 0.f;
#pragma unroll
            for (int k4 = 0; k4 < 8; ++k4) { const f32x4 a4 = *(const MM_LAS f32x4*)(AF + (32 + i) * FP + 4 * k4);
#pragma unroll
                for (int e = 0; e < 4; ++e) { acc0 += a4[e] * TF[(4 * k4 + e) * FP + jq]; acc1 += a4[e] * TF[(4 * k4 + e) * FP + 16 + jq]; }
                if (k4 & 1) asm volatile("" ::: "memory"); }
            PQ[i * 32 + jq] = acc0; PQ[i * 32 + 16 + jq] = acc1; }
        __syncthreads();
        {
            const int i = tid >> 4, jq = tid & 15; float acc0 = 0.f, acc1 = 0.f;
#pragma unroll
            for (int k4 = 0; k4 < 8; ++k4) { const f32x4 a4 = *(const MM_LAS f32x4*)(TF + (32 + i) * FP + 32 + 4 * k4);
#pragma unroll
                for (int e = 0; e < 4; ++e) { acc0 += a4[e] * PQ[(4 * k4 + e) * 32 + jq]; acc1 += a4[e] * PQ[(4 * k4 + e) * 32 + 16 + jq]; }
                if (k4 & 1) asm volatile("" ::: "memory"); }
            TF[(32 + i) * FP + jq] = acc0; TF[(32 + i) * FP + 16 + jq] = acc1; }
        __syncthreads();
        {
            const int tr = tid >> 3, s8 = (tid & 7) * 8; const f32x4 x0 = *(const MM_LAS f32x4*)(TF + tr * FP + s8), x1 = *(const MM_LAS f32x4*)(TF + tr * FP + s8 + 4);
            float y[8];
#pragma unroll
            for (int e = 0; e < 4; ++e) { y[e] = (s8 + e <= tr) ? x0[e] : 0.f; y[4 + e] = (s8 + 4 + e <= tr) ? x1[e] : 0.f; }
            typedef unsigned u32x4_ __attribute__((ext_vector_type(4))); u32x4_ w;
            w.x = mm::cvtpk(y[0], y[1]); w.y = mm::cvtpk(y[2], y[3]); w.z = mm::cvtpk(y[4], y[5]); w.w = mm::cvtpk(y[6], y[7]);
            *(MM_LAS u32x4_*)(SL(S_T0) + tr * PS + s8 * 2) = w; }
        {
#pragma unroll
            for (int jj = 0; jj < 2; ++jj) { const int bj = bj0 + jj; f32x4 d = (f32x4){0.f, 0.f, 0.f, 0.f};
                mm::blk<2>(d, SL(S_AAK) + bi * 16 * PS, PS, SL(S_VTT) + bj * 16 * PS, PS, lane);
                mm::store_T(d, SL(S_Z2), PS, 16 * bj, 16 * bi, lane); }
        }
        __syncthreads();
        {
#pragma unroll
            for (int jj = 0; jj < 2; ++jj) { const int bj = bj0 + jj; f32x4 d = (f32x4){0.f, 0.f, 0.f, 0.f}, e2 = d;
                mm::blk<2>(d, SL(S_T0) + bi * 16 * PS, PS, SL(S_ATT) + bj * 16 * PS, PS, lane); mm::store_T(d, SL(S_TAT), PS, 16 * bj, 16 * bi, lane);
                mm::blk<2>(e2, SL(S_T0) + bi * 16 * PS, PS, SL(S_Z2) + bj * 16 * PS, PS, lane); mm::store_T(e2, SL(S_Z3), PS, 16 * bj, 16 * bi, lane); }
        }
        __syncthreads();
        {
#pragma unroll
            for (int jj = 0; jj < 2; ++jj) { const int bj = bj0 + jj;
                f32x4 d;
#pragma unroll
                for (int r = 0; r < 4; ++r) d[r] = mm::bfl(*(const MM_LAS unsigned short*)(SL(S_RT) + (16 * bi + 4 * lq + r) * PS + (16 * bj + lj) * 2));
                mm::blk<2>(d, SL(S_ARB) + bi * 16 * PS, PS, SL(S_TAT) + bj * 16 * PS, PS, lane);
#pragma unroll
                for (int r = 0; r < 4; ++r) *(unsigned short*)(rec + R_RA + ((16 * bi + 4 * lq + r) * 64 + 16 * bj + lj) * 2) = mm::f2b(d[r]);
                asm volatile("" ::: "memory");
                f32x4 mt = (f32x4){0.f, 0.f, 0.f, 0.f};
                mm::blk<2>(mt, SL(S_TAT) + bi * 16 * PS, PS, SL(S_BTT) + bj * 16 * PS, PS, lane);
                const float wl = WLT[16 * bj + lj];
#pragma unroll
                for (int r = 0; r < 4; ++r) mt[r] = (mt[r] + ((16 * bi + 4 * lq + r) == (16 * bj + lj) ? 1.f : 0.f)) * wl;
                { mm::u32x2 w; w.x = mm::cvtpk(mt[0], mt[1]); w.y = mm::cvtpk(mt[2], mt[3]); *(mm::u32x2*)(rec + R_MT + ((16 * bj + lj) * 64 + 16 * bi + 4 * lq) * 2) = w; }
                asm volatile("" ::: "memory");
                f32x4 yc = (f32x4){0.f, 0.f, 0.f, 0.f};
                mm::blk<2>(yc, SL(S_ARB) + bi * 16 * PS, PS, SL(S_Z3) + bj * 16 * PS, PS, lane); mm::blk<2>(yc, SL(S_ARK) + bi * 16 * PS, PS, SL(S_VTT) + bj * 16 * PS, PS, lane);
                { mm::u32x2 w; w.x = mm::cvtpk(yc[0], yc[1]); w.y = mm::cvtpk(yc[2], yc[3]); *(mm::u32x2*)(rec + R_YC + (((bi * 4 + bj) * 64) + lane) * 8) = w; }
                asm volatile("" ::: "memory");
                f32x4 nt = (f32x4){0.f, 0.f, 0.f, 0.f};
                mm::blk<2>(nt, SL(S_BTT) + bi * 16 * PS, PS, SL(S_Z3) + bj * 16 * PS, PS, lane); mm::blk<2>(nt, SL(S_KTT) + bi * 16 * PS, PS, SL(S_VTT) + bj * 16 * PS, PS, lane);
#pragma unroll
                for (int r = 0; r < 4; ++r) nt[r] *= WLT[16 * bi + 4 * lq + r];
                { mm::u32x2 w; w.x = mm::cvtpk(nt[0], nt[1]); w.y = mm::cvtpk(nt[2], nt[3]); *(mm::u32x2*)(rec + R_NT + (((bi * 4 + bj) * 64) + lane) * 8) = w; } }
        }
    }
    __syncthreads();
#undef RW_LOAD
}
namespace rws { constexpr int PS = 144, SLOT = 9216, S_RA = 0, S_MT = 1, S_SA = 2, S_SB = 3, O_YB = 4 * SLOT, YP = 68, O_LN = O_YB + 64 * YP * 4, LDS_END = O_LN + 512; }
__device__ __forceinline__ void rwkv_seq(unsigned char* lds_g, int b, int h, const unsigned char* RWX, const bf16_t* RWB, size_t RWS, const float* BONUS, const bf16_t* PROJ, const float* ln_g, const float* ln_b, bf16_t* MIXED) {
    using namespace rws; using mm::f32x4;
    MM_LAS unsigned char* L = (MM_LAS unsigned char*)lds_g;
    int tid_o = threadIdx.x; asm volatile("" : "+v"(tid_o));
    const int tid = tid_o, lane = tid & 63, wave = __builtin_amdgcn_readfirstlane(tid >> 6);
    MM_LAS float* YB = (MM_LAS float*)(L + O_YB); MM_LAS float* LNT = (MM_LAS float*)(L + O_LN);
    for (int i = tid; i < 2 * SLOT / 4; i += 512) ((MM_LAS unsigned*)SL(S_SA))[i] = 0u;
    if (tid < 128) LNT[tid] = tid < 64 ? ln_g[tid] : ln_b[tid - 64];
    const int bi = wave >> 1, bj0 = 2 * (wave & 1), lj = lane & 15, lq = lane >> 4, et = tid >> 3, ep = tid & 7;
    const size_t mrow0 = (size_t)b * T; const unsigned char* rec0 = RWX + (size_t)((b * 8 + h) * 64) * rwk::REC;
    typedef unsigned u32x4e __attribute__((ext_vector_type(4)));
    u32x4e gra, gmt; mm::u32x2 gyc[2], gnt[2];
#define SQ_LOAD(c_) do { const unsigned char* r_ = rec0 + (size_t)(c_) * rwk::REC; gra = *(const u32x4e*)(r_ + rwk::R_RA + tid * 16); gmt = *(const u32x4e*)(r_ + rwk::R_MT + tid * 16); \
        _Pragma("unroll") for (int jj = 0; jj < 2; ++jj) { gyc[jj] = *(const mm::u32x2*)(r_ + rwk::R_YC + (((bi * 4 + bj0 + jj) * 64) + lane) * 8); gnt[jj] = *(const mm::u32x2*)(r_ + rwk::R_NT + (((bi * 4 + bj0 + jj) * 64) + lane) * 8); } } while (0)
    SQ_LOAD(0);
    for (int c = 0; c < 64; ++c) {
        const size_t em_ = mrow0 + (size_t)c * 64 + et;
        const u32x4e ez = *(const u32x4e*)(PROJ + em_ * NPROJ + PC_RWZ + h * 64 + 8 * ep), ev = *(const u32x4e*)(RWB + 2 * RWS + em_ * 512 + h * 64 + 8 * ep);
        const float ebon = BONUS[em_ * 8 + h];
        MM_LAS unsigned char* S0 = SL((c & 1) ? S_SB : S_SA); MM_LAS unsigned char* S0n = SL((c & 1) ? S_SA : S_SB);
        *(MM_LAS u32x4e*)(SL(S_RA) + et * PS + ep * 16) = gra; *(MM_LAS u32x4e*)(SL(S_MT) + et * PS + ep * 16) = gmt;
        f32x4 yi[2], ni[2];
#pragma unroll
        for (int jj = 0; jj < 2; ++jj) { yi[jj] = (f32x4){__uint_as_float(gyc[jj].x << 16), __uint_as_float(gyc[jj].x & 0xffff0000u), __uint_as_float(gyc[jj].y << 16), __uint_as_float(gyc[jj].y & 0xffff0000u)};
            ni[jj] = (f32x4){__uint_as_float(gnt[jj].x << 16), __uint_as_float(gnt[jj].x & 0xffff0000u), __uint_as_float(gnt[jj].y << 16), __uint_as_float(gnt[jj].y & 0xffff0000u)}; }
        if (c + 1 < 64) SQ_LOAD(c + 1);
        __syncthreads();
#pragma unroll
        for (int jj = 0; jj < 2; ++jj) { const int bj = bj0 + jj;
            mm::blk<2>(yi[jj], SL(S_RA) + bi * 16 * PS, PS, S0 + bj * 16 * PS, PS, lane);
#pragma unroll
            for (int r = 0; r < 4; ++r) YB[(16 * bi + 4 * lq + r) * YP + 16 * bj + lj] = yi[jj][r];
            mm::blk<2>(ni[jj], SL(S_MT) + bi * 16 * PS, PS, S0 + bj * 16 * PS, PS, lane);
            mm::store_T(ni[jj], S0n, PS, 16 * bj, 16 * bi, lane); }
        __syncthreads();
        {
            f32x4 y0 = *(const MM_LAS f32x4*)(YB + et * YP + 8 * ep), y1 = *(const MM_LAS f32x4*)(YB + et * YP + 8 * ep + 4);
            float sm = ((y0[0] + y0[1]) + (y0[2] + y0[3])) + ((y1[0] + y1[1]) + (y1[2] + y1[3]));
            sm += __shfl_xor(sm, 1); sm += __shfl_xor(sm, 2); sm += __shfl_xor(sm, 4);
            const float mean = sm * (1.f / 64.f); y0 = y0 - mean; y1 = y1 - mean;
            float sq = ((y0[0] * y0[0] + y0[1] * y0[1]) + (y0[2] * y0[2] + y0[3] * y0[3])) + ((y1[0] * y1[0] + y1[1] * y1[1]) + (y1[2] * y1[2] + y1[3] * y1[3]));
            sq += __shfl_xor(sq, 1); sq += __shfl_xor(sq, 2); sq += __shfl_xor(sq, 4);
            const float rstd = 1.f / sqrtf(sq * (1.f / 64.f) + RW_GN_EPS);
            const f32x4 lg0 = *(const MM_LAS f32x4*)(LNT + 8 * ep), lg1 = *(const MM_LAS f32x4*)(LNT + 8 * ep + 4), lb0 = *(const MM_LAS f32x4*)(LNT + 64 + 8 * ep), lb1 = *(const MM_LAS f32x4*)(LNT + 64 + 8 * ep + 4);
            u32x4e o;
#pragma unroll
            for (int i = 0; i < 4; ++i) { const float ya = (i < 2 ? y0 : y1)[(2 * i) & 3], yb = (i < 2 ? y0 : y1)[(2 * i + 1) & 3], ga = (i < 2 ? lg0 : lg1)[(2 * i) & 3], gb_ = (i < 2 ? lg0 : lg1)[(2 * i + 1) & 3], ba = (i < 2 ? lb0 : lb1)[(2 * i) & 3], bb_ = (i < 2 ? lb0 : lb1)[(2 * i + 1) & 3];
                const float na = ya * rstd * ga + ba + ebon * bf2f(ev[i] & 0xffffu), nb = yb * rstd * gb_ + bb_ + ebon * bf2f(ev[i] >> 16);
                o[i] = mm::cvtpk(siluf_(bf2f(ez[i] & 0xffffu)) * na, siluf_(bf2f(ez[i] >> 16)) * nb); }
            *(u32x4e*)(MIXED + em_ * DM + 1536 + h * 64 + 8 * ep) = o;
        }
    }
    __syncthreads();
#undef SQ_LOAD
#undef SL
}
namespace prp {
constexpr int PS = 144, PW = 1040, PT = 80;
constexpr int O_X = 0, O_A = 9216, O_AIM = 18432, O_VIM = 84992, O_T1 = 151552, LDS_END = 156672;
typedef unsigned u32x4 __attribute__((ext_vector_type(4)));
template <int NK>
__device__ __forceinline__ void blk_g(mm::f32x4& acc, const MM_LAS unsigned char* A, int apitch, const bf16_t* Bt, int bpitch, int lane) {
    const MM_LAS unsigned char* ap = A + (lane & 15) * apitch + (lane >> 4) * 16; const bf16_t* bp = Bt + (size_t)(lane & 15) * bpitch + (lane >> 4) * 8;
#pragma unroll
    for (int ks = 0; ks < NK; ++ks) { const mm::bf16x8 a = *(const MM_LAS mm::bf16x8*)(ap + ks * 64), b = *(const mm::bf16x8*)(bp + ks * 32); acc = __builtin_amdgcn_mfma_f32_16x16x32_bf16(a, b, acc, 0, 0, 0); }
}
__device__ __forceinline__ void unpack8(const u32x4 w, float (&f)[8]) {
#pragma unroll
    for (int i = 0; i < 4; ++i) { f[2 * i] = __uint_as_float(w[i] << 16); f[2 * i + 1] = __uint_as_float(w[i] & 0xffff0000u); } }
__device__ __forceinline__ u32x4 pack8(const float (&f)[8]) { u32x4 w; w.x = mm::cvtpk(f[0], f[1]); w.y = mm::cvtpk(f[2], f[3]); w.z = mm::cvtpk(f[4], f[5]); w.w = mm::cvtpk(f[6], f[7]); return w; }
}
struct PrepP {
    const float *mu, *w0, *a0, *v0, *k_k, *k_a, *r_k, *conv_w, *conv_b, *i_bias, *f_bias; const bf16_t *W2T, *A2T, *V1T, *V2T; int layer;
    const bf16_t* PROJ; const float* SPEC; const float* CS; float* RWW; bf16_t* RWB; bf16_t* VFIRST; float* BONUS; bf16_t* CQN; bf16_t* CKVN; bf16_t* KR; bf16_t* QKC; float* LI; float* LF; float* PMX;
};
__device__ __forceinline__ void prep_tile(unsigned char* lds_g, int tile, const PrepP& P) {
    using namespace prp; using mm::f32x4; using mm::bf16x8;
    MM_LAS unsigned char* L = (MM_LAS unsigned char*)lds_g;
    int tid_o = threadIdx.x; asm volatile("" : "+v"(tid_o));
    const int tid = tid_o, lane = tid & 63, wave = __builtin_amdgcn_readfirstlane(tid >> 6);
    const int m0 = tile * 64, t0 = m0 % T;
    constexpr size_t RWS = (size_t)M * 512;
    const bool resid = P.layer > 0;
    { const int t = tid >> 3, p = tid & 7; const size_t m = (size_t)m0 + t; const bool has_prev = (t0 + t) > 0;
#pragma unroll
      for (int which = 0; which < 2; ++which) { const float* cp = P.SPEC + m * 256 + which * 64 + 8 * p; const f32x4 c0 = *(const f32x4*)cp, c1 = *(const f32x4*)(cp + 4);
          f32x4 p0 = (f32x4){0.f, 0.f, 0.f, 0.f}, p1 = p0; if (has_prev) { p0 = *(const f32x4*)(cp - 256); p1 = *(const f32x4*)(cp - 252); }
          const f32x4 mu0 = *(const f32x4*)(P.mu + 1536 + which * 64 + 8 * p), mu1 = *(const f32x4*)(P.mu + 1536 + which * 64 + 8 * p + 4);
          float f[8];
#pragma unroll
          for (int e = 0; e < 4; ++e) { f[e] = c0[e] + mu0[e] * (p0[e] - c0[e]); f[4 + e] = c1[e] + mu1[e] * (p1[e] - c1[e]); }
          if (which == 0) {
#pragma unroll
              for (int e = 0; e < 8; ++e) f[e] = tanhf_(f[e]); }
          *(MM_LAS u32x4*)(L + (which ? O_A : O_X) + t * PS + p * 16) = pack8(f); } }
    if (resid) { const int t = lane, hh = wave; const size_t m = (size_t)m0 + t; const bool has_prev = (t0 + t) > 0;
        const bf16_t* cp = P.PROJ + m * NPROJ + PC_RW + 1024 + hh * 64;
#pragma unroll
        for (int g = 0; g < 8; ++g) { float c[8], pv[8], mu_[8], o[8]; unpack8(*(const u32x4*)(cp + 8 * g), c);
            if (has_prev) unpack8(*(const u32x4*)(cp - NPROJ + 8 * g), pv); else {
#pragma unroll
                for (int e = 0; e < 8; ++e) pv[e] = 0.f; }
            const f32x4 m0_ = *(const f32x4*)(P.mu + 1024 + hh * 64 + 8 * g), m1_ = *(const f32x4*)(P.mu + 1024 + hh * 64 + 8 * g + 4);
#pragma unroll
            for (int e = 0; e < 4; ++e) { mu_[e] = m0_[e]; mu_[4 + e] = m1_[e]; }
#pragma unroll
            for (int e = 0; e < 8; ++e) o[e] = c[e] + mu_[e] * (pv[e] - c[e]);
            *(MM_LAS u32x4*)(L + O_VIM + t * PW + hh * 128 + g * 16) = pack8(o); } }
    __syncthreads();
    { bf16x8 fx[4][2], fa[4][2];
#pragma unroll
      for (int bi = 0; bi < 4; ++bi)
#pragma unroll
          for (int ks = 0; ks < 2; ++ks) { fx[bi][ks] = *(const MM_LAS bf16x8*)(L + O_X + (16 * bi + (lane & 15)) * PS + (lane >> 4) * 16 + ks * 64); fa[bi][ks] = *(const MM_LAS bf16x8*)(L + O_A + (16 * bi + (lane & 15)) * PS + (lane >> 4) * 16 + ks * 64); }
#pragma unroll
      for (int bjl = 0; bjl < 4; ++bjl) { const int c = 64 * wave + 16 * bjl + (lane & 15);
          const bf16_t* wp = P.W2T + (size_t)c * 64 + (lane >> 4) * 8; const bf16_t* ap = P.A2T + (size_t)c * 64 + (lane >> 4) * 8;
          const bf16x8 bw0 = *(const bf16x8*)wp, bw1 = *(const bf16x8*)(wp + 32), ba0 = *(const bf16x8*)ap, ba1 = *(const bf16x8*)(ap + 32);
          const float w0c = P.w0[c], a0c = P.a0[c];
#pragma unroll
          for (int bi = 0; bi < 4; ++bi) { f32x4 aw = (f32x4){0.f, 0.f, 0.f, 0.f}, aa = aw;
              aw = __builtin_amdgcn_mfma_f32_16x16x32_bf16(fx[bi][0], bw0, aw, 0, 0, 0); aw = __builtin_amdgcn_mfma_f32_16x16x32_bf16(fx[bi][1], bw1, aw, 0, 0, 0);
              aa = __builtin_amdgcn_mfma_f32_16x16x32_bf16(fa[bi][0], ba0, aa, 0, 0, 0); aa = __builtin_amdgcn_mfma_f32_16x16x32_bf16(fa[bi][1], ba1, aa, 0, 0, 0);
#pragma unroll
              for (int r = 0; r < 4; ++r) { const int t = 16 * bi + 4 * (lane >> 4) + r;
                  const float logw = -softplusf_(-(aw[r] + w0c)) - 0.5f;
                  P.RWW[((size_t)m0 + t) * 512 + c] = -__expf(logw);
                  *(MM_LAS unsigned short*)(L + O_AIM + t * PW + c * 2) = mm::f2b(sigmoidf_(aa[r] + a0c)); } }
          asm volatile("" ::: "memory"); }
      if (resid) { const int bi = wave >> 1, bj = wave & 1; f32x4 d = (f32x4){0.f, 0.f, 0.f, 0.f};
          blk_g<16>(d, L + O_VIM + bi * 16 * PW, PW, P.V1T + (size_t)bj * 16 * 512, 512, lane);
#pragma unroll
          for (int r = 0; r < 4; ++r) *(MM_LAS unsigned short*)(L + O_T1 + (16 * bi + 4 * (lane >> 4) + r) * PT + (16 * bj + (lane & 15)) * 2) = mm::f2b(d[r]); } }
    __syncthreads();
    { MM_LAS float* PT_ = (MM_LAS float*)(L + O_X);
      PT_[tid] = P.mu[tid]; PT_[512 + tid] = P.mu[512 + tid]; PT_[1024 + tid] = P.mu[1024 + tid]; PT_[1536 + tid] = P.k_k[tid]; PT_[2048 + tid] = P.k_a[tid]; PT_[2560 + tid] = P.r_k[tid]; }
    if (resid) { bf16x8 ft[4];
#pragma unroll
        for (int bi = 0; bi < 4; ++bi) ft[bi] = *(const MM_LAS bf16x8*)(L + O_T1 + (16 * bi + (lane & 15)) * PT + (lane >> 4) * 16);
#pragma unroll
        for (int bjl = 0; bjl < 4; ++bjl) { const int c = 64 * wave + 16 * bjl + (lane & 15); const bf16x8 b = *(const bf16x8*)(P.V2T + (size_t)c * 32 + (lane >> 4) * 8); const float v0c = P.v0[c];
#pragma unroll
            for (int bi = 0; bi < 4; ++bi) { f32x4 d = (f32x4){0.f, 0.f, 0.f, 0.f}; d = __builtin_amdgcn_mfma_f32_16x16x32_bf16(ft[bi], b, d, 0, 0, 0);
#pragma unroll
                for (int r = 0; r < 4; ++r) *(MM_LAS unsigned short*)(L + O_VIM + (16 * bi + 4 * (lane >> 4) + r) * PW + c * 2) = mm::f2b(sigmoidf_(d[r] + v0c)); } } }
    __syncthreads();
    { const int t = lane, hh = wave; const size_t m = (size_t)m0 + t; const bool has_prev = (t0 + t) > 0; const int cb = hh * 64;
      const bf16_t* cp = P.PROJ + m * NPROJ + PC_RW + cb; const size_t ob = m * 512 + cb;
      const MM_LAS float* PT_ = (const MM_LAS float*)(L + O_X) + cb;
#define PRM(arr, g, e) (PT_[(arr) * 512 + 8 * (g) + (e)])
      float ss = 0.f, bon = 0.f;
      u32x4 ksp[8];
      const u32x4 zero4 = (u32x4){0u, 0u, 0u, 0u};
#define LDC(off, g) (*(const u32x4*)(cp + (off) + 8 * (g)))
#define LDP(off, g) (has_prev ? *(const u32x4*)(cp + (off) - NPROJ + 8 * (g)) : zero4)
      { u32x4 nc = LDC(512, 0), np = LDP(512, 0);
#pragma unroll
        for (int g = 0; g < 8; ++g) { const u32x4 rc = nc, rp = np; if (g < 7) { nc = LDC(512, g + 1); np = LDP(512, g + 1); }
          float c[8], pv[8], o[8]; unpack8(rc, c); unpack8(rp, pv);
#pragma unroll
          for (int e = 0; e < 8; ++e) { o[e] = c[e] + PRM(1, g, e) * (pv[e] - c[e]); const float q = o[e] * PRM(3, g, e); ss += q * q; }
          ksp[g] = pack8(o); asm volatile("" ::: "memory"); } }
      const float rn = 1.f / fmaxf(sqrtf(ss), 1e-12f);
      { u32x4 nc = LDC(0, 0), np = LDP(0, 0);
#pragma unroll
        for (int g = 0; g < 8; ++g) { const u32x4 rc = nc, rp = np; if (g < 7) { nc = LDC(0, g + 1); np = LDP(0, g + 1); }
          float ks_[8], a_[8], c[8], pv[8], rr[8], okh[8], oa[8], ob_[8]; unpack8(ksp[g], ks_); unpack8(*(const MM_LAS u32x4*)(L + O_AIM + t * PW + cb * 2 + g * 16), a_); unpack8(rc, c); unpack8(rp, pv);
#pragma unroll
          for (int e = 0; e < 8; ++e) { rr[e] = c[e] + PRM(0, g, e) * (pv[e] - c[e]); const float kkn = ks_[e] * PRM(3, g, e) * rn; okh[e] = ks_[e] * (1.f + (a_[e] - 1.f) * PRM(4, g, e)); oa[e] = -kkn; ob_[e] = kkn * a_[e]; bon += rr[e] * okh[e] * PRM(5, g, e); }
          *(u32x4*)(P.RWB + ob + 8 * g) = pack8(rr); *(u32x4*)(P.RWB + RWS + ob + 8 * g) = pack8(okh); *(u32x4*)(P.RWB + 3 * RWS + ob + 8 * g) = pack8(oa); *(u32x4*)(P.RWB + 4 * RWS + ob + 8 * g) = pack8(ob_);
          asm volatile("" ::: "memory"); } }
      P.BONUS[m * 8 + hh] = bon;
      { u32x4 nc = LDC(1024, 0), np = LDP(1024, 0), nf = resid ? *(const u32x4*)(P.VFIRST + ob) : zero4;
#pragma unroll
        for (int g = 0; g < 8; ++g) { const u32x4 rc = nc, rp = np, rf = nf; if (g < 7) { nc = LDC(1024, g + 1); np = LDP(1024, g + 1); if (resid) nf = *(const u32x4*)(P.VFIRST + ob + 8 * (g + 1)); }
          float c[8], pv[8], o[8]; unpack8(rc, c); unpack8(rp, pv);
#pragma unroll
          for (int e = 0; e < 8; ++e) o[e] = c[e] + PRM(2, g, e) * (pv[e] - c[e]);
          if (resid) { float gg[8], vf[8]; unpack8(*(const MM_LAS u32x4*)(L + O_VIM + t * PW + cb * 2 + g * 16), gg); unpack8(rf, vf);
#pragma unroll
              for (int e = 0; e < 8; ++e) o[e] = o[e] + (vf[e] - o[e]) * gg[e]; }
          else *(u32x4*)(P.VFIRST + ob + 8 * g) = pack8(o);
          *(u32x4*)(P.RWB + 2 * RWS + ob + 8 * g) = pack8(o); asm volatile("" ::: "memory"); } }
#undef LDC
#undef LDP
#undef PRM
    }
    { const int t = tid >> 3, p = tid & 7; const size_t m = (size_t)m0 + t;
      { const bf16_t* cp = P.PROJ + m * NPROJ + PC_CQ + 64 * p; u32x4 w[8]; float s = 0.f;
#pragma unroll
        for (int g = 0; g < 8; ++g) { w[g] = *(const u32x4*)(cp + 8 * g); float f[8]; unpack8(w[g], f);
#pragma unroll
            for (int e = 0; e < 8; ++e) s += f[e] * f[e]; }
        s += __shfl_xor(s, 1); s += __shfl_xor(s, 2); s += __shfl_xor(s, 4);
        const float rstd = 1.f / sqrtf(s * (1.f / 512.f) + NORM_EPS);
#pragma unroll
        for (int g = 0; g < 8; ++g) { float f[8]; unpack8(w[g], f);
#pragma unroll
            for (int e = 0; e < 8; ++e) f[e] *= rstd;
            *(u32x4*)(P.CQN + m * 512 + 64 * p + 8 * g) = pack8(f); } }
      { const bf16_t* cp = P.PROJ + m * NPROJ + PC_CKV + 32 * p; u32x4 w[4]; float s = 0.f;
#pragma unroll
        for (int g = 0; g < 4; ++g) { w[g] = *(const u32x4*)(cp + 8 * g); float f[8]; unpack8(w[g], f);
#pragma unroll
            for (int e = 0; e < 8; ++e) s += f[e] * f[e]; }
        s += __shfl_xor(s, 1); s += __shfl_xor(s, 2); s += __shfl_xor(s, 4);
        const float rstd = 1.f / sqrtf(s * (1.f / 256.f) + NORM_EPS);
#pragma unroll
        for (int g = 0; g < 4; ++g) { float f[8]; unpack8(w[g], f);
#pragma unroll
            for (int e = 0; e < 8; ++e) f[e] *= rstd;
            *(u32x4*)(P.CKVN + m * 256 + 32 * p + 8 * g) = pack8(f); } }
      { const float* sp = P.SPEC + m * 256 + 128 + 8 * p; const f32x4 x0 = *(const f32x4*)sp, x1 = *(const f32x4*)(sp + 4);
        const float* cs = P.CS + (m * 32 + 4 * p) * 2; const f32x4 c0 = *(const f32x4*)cs, c1 = *(const f32x4*)(cs + 4);
        float o[8];
        o[0] = x0[0] * c0[0] - x0[1] * c0[1]; o[1] = x0[1] * c0[0] + x0[0] * c0[1]; o[2] = x0[2] * c0[2] - x0[3] * c0[3]; o[3] = x0[3] * c0[2] + x0[2] * c0[3];
        o[4] = x1[0] * c1[0] - x1[1] * c1[1]; o[5] = x1[1] * c1[0] + x1[0] * c1[1]; o[6] = x1[2] * c1[2] - x1[3] * c1[3]; o[7] = x1[3] * c1[2] + x1[2] * c1[3];
        *(u32x4*)(P.KR + m * 64 + 8 * p) = pack8(o); }
      { bf16_t* op = const_cast<bf16_t*>(P.PROJ) + m * NPROJ + PC_MLO + 64 * p; const bf16_t* zp = P.PROJ + m * NPROJ + PC_MLZ + 64 * p;
#pragma unroll
        for (int g = 0; g < 8; ++g) { float o_[8], z_[8], r_[8]; unpack8(*(const u32x4*)(op + 8 * g), o_); unpack8(*(const u32x4*)(zp + 8 * g), z_);
#pragma unroll
            for (int e = 0; e < 8; ++e) r_[e] = siluf_(z_[e]) * sigmoidf_(o_[e]);
            *(u32x4*)(op + 8 * g) = pack8(r_); if (g & 1) asm volatile("" ::: "memory"); } }
      { const int gh = p; const float val = P.SPEC[m * 256 + 192 + gh]; MM_LAS float* GT = (MM_LAS float*)(L + O_T1);
        GT[gh * 64 + t] = gh < 4 ? val + P.i_bias[gh] : -softplusf_(-(val + P.f_bias[gh - 4])); } }
    __syncthreads();
    if (wave < 4) { const MM_LAS float* GT = (const MM_LAS float*)(L + O_T1); const float li = GT[wave * 64 + lane]; float bb = GT[(4 + wave) * 64 + lane];
#pragma unroll
        for (int o = 1; o < 64; o <<= 1) { const float u = __shfl_up(bb, o); if (lane >= o) bb += u; }
        const float a = li - bb; float pm = a;
#pragma unroll
        for (int o = 1; o < 64; o <<= 1) { const float u = __shfl_up(pm, o); if (lane >= o) pm = fmaxf(pm, u); }
        const size_t gi = ((size_t)m0 + lane) * 4 + wave; P.LI[gi] = a; P.LF[gi] = bb; P.PMX[gi] = pm; }
    { const int cgp = tid & 127, tq = tid >> 7, ch = 8 * cgp; const float sc_ = ch < 512 ? 0.08838834764831845f : 1.f;
      float cw[4][8], cbv[8];
#pragma unroll
      for (int j = 0; j < 4; ++j) { const f32x4 a = *(const f32x4*)(P.conv_w + j * 1024 + ch), b = *(const f32x4*)(P.conv_w + j * 1024 + ch + 4);
#pragma unroll
          for (int e = 0; e < 4; ++e) { cw[j][e] = a[e]; cw[j][4 + e] = b[e]; } }
      { const f32x4 a = *(const f32x4*)(P.conv_b + ch), b = *(const f32x4*)(P.conv_b + ch + 4);
#pragma unroll
        for (int e = 0; e < 4; ++e) { cbv[e] = a[e]; cbv[4 + e] = b[e]; } }
      float x0[8], x1[8], x2[8];
      const int tb = 16 * tq;
#pragma unroll
      for (int e = 0; e < 8; ++e) { x0[e] = 0.f; x1[e] = 0.f; x2[e] = 0.f; }
      if (t0 + tb >= 3) { unpack8(*(const u32x4*)(P.PROJ + ((size_t)m0 + tb - 3) * NPROJ + PC_MLQK + ch), x0); unpack8(*(const u32x4*)(P.PROJ + ((size_t)m0 + tb - 2) * NPROJ + PC_MLQK + ch), x1); unpack8(*(const u32x4*)(P.PROJ + ((size_t)m0 + tb - 1) * NPROJ + PC_MLQK + ch), x2); }
#pragma unroll 4
      for (int i = 0; i < 16; ++i) { float x3[8], y[8]; unpack8(*(const u32x4*)(P.PROJ + ((size_t)m0 + tb + i) * NPROJ + PC_MLQK + ch), x3);
#pragma unroll
          for (int e = 0; e < 8; ++e) { const float v = cbv[e] + cw[0][e] * x0[e] + cw[1][e] * x1[e] + cw[2][e] * x2[e] + cw[3][e] * x3[e]; y[e] = siluf_(v) * sc_; x0[e] = x1[e]; x1[e] = x2[e]; x2[e] = x3[e]; }
          *(u32x4*)(P.QKC + ((size_t)m0 + tb + i) * 1024 + ch) = pack8(y); } }
    __syncthreads();
}
constexpr size_t MiB = 1u << 20;
constexpr size_t WS_CTL = 0, CTL_ZERO_BYTES = 1 * MiB;
constexpr size_t WS_WIN = 1 * MiB;
constexpr size_t WS_WUQ = WS_WIN + 104 * MiB;
constexpr size_t WS_WUKV = WS_WUQ + 6 * MiB;
constexpr size_t WS_WOUT = WS_WUKV + 4 * MiB;
constexpr size_t WS_CS = WS_WOUT + 32 * MiB;
constexpr size_t WS_XN = WS_CS + 4 * MiB;
constexpr size_t WS_PROJ = WS_XN + 64 * MiB;
constexpr size_t WS_SPEC = WS_PROJ + 208 * MiB;
constexpr size_t WS_CQN = WS_SPEC + 16 * MiB;
constexpr size_t WS_CKVN = WS_CQN + 16 * MiB;
constexpr size_t WS_KR = WS_CKVN + 8 * MiB;
constexpr size_t WS_Q = WS_KR + 2 * MiB;
constexpr size_t WS_KV = WS_Q + 48 * MiB;
constexpr size_t WS_QKC = WS_KV + 64 * MiB;
constexpr size_t WS_GATE = WS_QKC + 32 * MiB;
constexpr size_t WS_RWW = WS_GATE + 1 * MiB;
constexpr size_t WS_RWB = WS_RWW + 32 * MiB;
constexpr size_t WS_VFIRST = WS_RWB + 80 * MiB;
constexpr size_t WS_BONUS = WS_VFIRST + 16 * MiB;
constexpr size_t WS_LR = WS_BONUS + 1 * MiB;
constexpr size_t LR_STRIDE = 196608, LR_W2T = 0, LR_A2T = 65536, LR_V1T = 131072, LR_V2T = 163840;
constexpr size_t WS_RWX = WS_LR + 1 * MiB;
constexpr size_t WS_MLX = WS_RWX + 64 * MiB;
constexpr size_t WS_END = WS_MLX + 18 * MiB;
static_assert(WS_END <= 865075200ull, "d_ws map exceeds the guaranteed workspace (4 x the largest tensor)");
constexpr int CW_BAR = 4096, CW_QUEUE = 16384;
constexpr int LDS_BYTES = 163840, RING_BYTES = 158720, MISC_OFF = RING_BYTES + 320;
static_assert(att::LDS_BYTES <= RING_BYTES, "attention LDS");

struct Args { const float* in[28]; float* out; unsigned char* ws; int ph_lo, ph_hi; };

struct MapWin { __device__ __forceinline__ int operator()(int n) const {
    if (n < 1536) return n;
    if (n < 2048) return SC_MLO + (n - 1536);
    if (n < 2560) return SC_MLZ + (n - 2048);
    if (n < 3072) return SC_CQ + (n - 2560);
    if (n < 3328) return SC_CKV + (n - 3072);
    if (n < 4352) return SC_MLAZ + (n - 3328);
    if (n < 5888) return SC_RW + (n - 4352);
    if (n < 6144) { const int j = n - 5888;
        if (j < 128) return SC_RW + 1536 + j;
        if (j < 192) { const int q = j - 128; return SC_KR + ((q & 1) ? 32 + (q >> 1) : (q >> 1)); }
        if (j < 196) return SC_MLI + (j - 192);
        if (j < 200) return SC_MLF + (j - 196);
        return -1; }
    return SC_RWZ + (n - 6144); } };
struct MapUq { __device__ __forceinline__ int operator()(int n) const { const int h = n / 192, d = n % 192; if (d < 128) return n; const int q = d - 128; return h * 192 + 128 + ((q & 1) ? 32 + (q >> 1) : (q >> 1)); } };
struct MapId { __device__ __forceinline__ int operator()(int n) const { return n; } };

template <class Map>
__device__ __forceinline__ void transpose_item(const float* W, int K, int Nsrc, bf16_t* WT, const float* gain, LAS float* scr, int kb, int nb, int lane, Map map) {
    const int k0 = 64 * kb, n0 = 32 * nb, sc = map(n0 + (lane & 31));
#pragma unroll 8
    for (int i = 0; i < 32; ++i) { const int kk = 2 * i + (lane >> 5); float v = 0.f;
        if (sc >= 0) { v = W[(size_t)(k0 + kk) * Nsrc + sc]; if (gain) v *= gain[k0 + kk]; }
        scr[kk * 33 + (lane & 31)] = v; }
    LDS_WAIT(); asm volatile("" ::: "memory");
    const int c = lane & 7;
#pragma unroll
    for (int j = 0; j < 4; ++j) { const int n = (lane >> 3) + 8 * j; const LAS float* s = scr + (8 * c) * 33 + n;
        v4u o; o.x = pk2(s[0 * 33], s[1 * 33]); o.y = pk2(s[2 * 33], s[3 * 33]); o.z = pk2(s[4 * 33], s[5 * 33]); o.w = pk2(s[6 * 33], s[7 * 33]);
        *(v4u*)(WT + (size_t)(n0 + n) * K + k0 + 8 * c) = o; }
    LDS_WAIT(); asm volatile("" ::: "memory");
}

template <int MODE>
__device__ __forceinline__ void norm_row(const float* xrow, bf16_t* orow, float* frow, const float* g, int lane) {
    const f32x4* xr = (const f32x4*)xrow + lane;
    f32x4 v[8]; float s = 0.f;
#pragma unroll
    for (int j = 0; j < 8; ++j) { v[j] = xr[64 * j]; s += (v[j].x * v[j].x + v[j].y * v[j].y) + (v[j].z * v[j].z + v[j].w * v[j].w); }
    const float rstd = 1.f / sqrtf(wave_sum(s) * (1.f / DM) + NORM_EPS);
    if (MODE == 0) { unsigned long long* o8 = (unsigned long long*)orow + lane;
#pragma unroll
        for (int j = 0; j < 8; ++j) o8[64 * j] = (unsigned long long)pk2(v[j].x * rstd, v[j].y * rstd) | ((unsigned long long)pk2(v[j].z * rstd, v[j].w * rstd) << 32);
    } else { f32x4* o = (f32x4*)frow + lane; const f32x4* gr = (const f32x4*)g + lane;
#pragma unroll
        for (int j = 0; j < 8; ++j) { const f32x4 gg = gr[64 * j]; o[64 * j] = v[j] * rstd * gg; } }
}

__device__ __forceinline__ att::BlockRef mk_block(const bf16_t* Q, const bf16_t* KV, const bf16_t* KR, bf16_t* MIXED, const bf16_t* PROJ, const float* CS, int bh, int qb) {
    const int b = bh >> 3, h = bh & 7; att::BlockRef r;
    const size_t rb = (size_t)b * T, rq = rb + (size_t)qb * 256;
    r.Q = Q + rq * NQ + h * 192; r.K = KV + rb * NKV + h * 256; r.V = r.K + 128; r.KR = KR + rb * 64; r.O = MIXED + rq * DM + 512 + h * 128; r.Z = PROJ + rq * NPROJ + PC_MLAZ + h * 128; r.CSq = CS + rq * 64; r.P0 = qb * 256; return r;
}
#ifndef REP_PREP
#define REP_PREP 1
#endif
#ifndef REP_MIX
#define REP_MIX 1
#endif
#ifndef REP_RW
#define REP_RW 1
#endif
#ifndef REP_ML
#define REP_ML 1
#endif
#ifndef REP_ATT
#define REP_ATT 1
#endif
__global__ void __launch_bounds__(512, 2) fwd(Args args) {
    extern __shared__ __attribute__((aligned(16))) unsigned char lds[];
    const int tid = threadIdx.x, lane = tid & 63, wave = __builtin_amdgcn_readfirstlane(tid >> 6);
    const int G = gridDim.x, bid = blockIdx.x;
    unsigned char* ws = args.ws;
    volatile LAS unsigned* MISC = (volatile LAS unsigned*)((LAS unsigned char*)lds + MISC_OFF);
    for (int u = tid; u < (LDS_BYTES - RING_BYTES) / 4; u += 512) ((LAS unsigned*)((LAS unsigned char*)lds + RING_BYTES))[u] = 0u;
    __syncthreads();
    const bool one_launch = (args.ph_hi - args.ph_lo) > 1;
    XcdBarrier bar; bar.bar = (unsigned*)(ws + WS_CTL) + CW_BAR; bar.x = 0; bar.st = nullptr;
    if (one_launch) bar = xcd_barrier_post((unsigned*)(ws + WS_CTL) + CW_BAR, MISC + 8);
    const int lo = args.ph_lo, hi = args.ph_hi;
#define IN(k) (lo <= (k) && (k) < hi)
#define SEAM(k) do { if (IN(k) && IN((k) + 1)) xcd_barrier(bar); } while (0)

    const float* x_in = args.in[0]; const int* positions = (const int*)args.in[1];
    float* X = args.out;
    bf16_t* WIN = (bf16_t*)(ws + WS_WIN); bf16_t* WUQ = (bf16_t*)(ws + WS_WUQ); bf16_t* WUKV = (bf16_t*)(ws + WS_WUKV); bf16_t* WOUT = (bf16_t*)(ws + WS_WOUT);
    float* CS = (float*)(ws + WS_CS); bf16_t* XN = (bf16_t*)(ws + WS_XN); bf16_t* MIXED = XN; bf16_t* PROJ = (bf16_t*)(ws + WS_PROJ); float* SPEC = (float*)(ws + WS_SPEC);
    bf16_t* CQN = (bf16_t*)(ws + WS_CQN); bf16_t* CKVN = (bf16_t*)(ws + WS_CKVN); bf16_t* KR = (bf16_t*)(ws + WS_KR); bf16_t* Q = (bf16_t*)(ws + WS_Q); bf16_t* KV = (bf16_t*)(ws + WS_KV);
    bf16_t* QKC = (bf16_t*)(ws + WS_QKC); float* LI = (float*)(ws + WS_GATE); float* LF = LI + (size_t)M * 4;
    float* RWW = (float*)(ws + WS_RWW); bf16_t* RWB = (bf16_t*)(ws + WS_RWB); bf16_t* VFIRST = (bf16_t*)(ws + WS_VFIRST); float* BONUS = (float*)(ws + WS_BONUS);
    constexpr size_t RWS = (size_t)M * 512;

    if (IN(0)) {
#ifndef NO_PRO
        LAS float* scr = (LAS float*)((LAS unsigned char*)lds + wave * 16384);
        const int gw = bid * 8 + wave, NGW = G * 8;
        constexpr int I_IN = (DM / 64) * (NPROJ / 32), I_UQ = (512 / 64) * (NQ / 32), I_UKV = (256 / 64) * (NKV / 32), I_OUT = (DM / 64) * (DM / 32), I_L = I_IN + I_UQ + I_UKV + I_OUT;
        for (int it = gw; it < DEPTH * I_L; it += NGW) {
            const int l = it / I_L; int r = it % I_L;
            if (r < I_IN) { transpose_item(args.in[3] + (size_t)l * DM * D_IN, DM, D_IN, WIN + (size_t)l * NPROJ * DM, args.in[2] + l * DM, scr, r / (NPROJ / 32), r % (NPROJ / 32), lane, MapWin()); continue; } r -= I_IN;
            if (r < I_UQ) { transpose_item(args.in[10] + (size_t)l * 512 * NQ, 512, NQ, WUQ + (size_t)l * NQ * 512, args.in[9] + l * 512, scr, r / (NQ / 32), r % (NQ / 32), lane, MapUq()); continue; } r -= I_UQ;
            if (r < I_UKV) { transpose_item(args.in[12] + (size_t)l * 256 * NKV, 256, NKV, WUKV + (size_t)l * NKV * 256, args.in[11] + l * 256, scr, r / (NKV / 32), r % (NKV / 32), lane, MapId()); continue; } r -= I_UKV;
            transpose_item(args.in[26] + (size_t)l * DM * DM, DM, DM, WOUT + (size_t)l * DM * DM, (const float*)nullptr, scr, r / (DM / 32), r % (DM / 32), lane, MapId());
        }
        for (int it = gw; it < DEPTH * 40; it += NGW) {
            const int l = it / 40, r = it % 40; unsigned char* lr = ws + WS_LR + (size_t)l * LR_STRIDE;
            if (r < 16) transpose_item(args.in[15] + (size_t)l * 64 * 512, 64, 512, (bf16_t*)(lr + LR_W2T), (const float*)nullptr, scr, 0, r, lane, MapId());
            else if (r < 32) transpose_item(args.in[17] + (size_t)l * 64 * 512, 64, 512, (bf16_t*)(lr + LR_A2T), (const float*)nullptr, scr, 0, r - 16, lane, MapId());
            else if (l > 0) transpose_item(args.in[19] + (size_t)(l - 1) * 512 * 32, 512, 32, (bf16_t*)(lr + LR_V1T), (const float*)nullptr, scr, r - 32, 0, lane, MapId());
        }
        for (int i = bid * 512 + tid; i < (DEPTH - 1) * 512 * 32; i += G * 512) { const int l = 1 + i / 16384, e = i % 16384, c = e >> 5, j = e & 31;
            ((bf16_t*)(ws + WS_LR + (size_t)l * LR_STRIDE + LR_V2T))[c * 32 + j] = (bf16_t)f2bf(args.in[20][(size_t)(l - 1) * 32 * 512 + j * 512 + c]); }
        for (int i = bid * 512 + tid; i < M * 32; i += G * 512) { const int m = i >> 5, j = i & 31;
            const float inv_freq = powf(10000.f, -(float)(2 * j) / 64.f);
            const float ang = (float)positions[m] * inv_freq;
            const double a = (double)ang; const double n = rint(a * 0.15915494309189535); const float r = (float)(a - n * 6.283185307179586);
            CS[2 * i] = cosf(r); CS[2 * i + 1] = sinf(r); }
        for (int m = gw; m < M; m += NGW) norm_row<0>(x_in + (size_t)m * DM, XN + (size_t)m * DM, nullptr, nullptr, lane);
#endif
    }
    SEAM(0);

#ifdef FIXL
    for (int l = 0; l < 1; ++l) {
#else
    for (int l = 0; l < DEPTH; ++l) {
#endif
        const int pb = 1 + l * 6;
        int tid_o = threadIdx.x; asm volatile("" : "+v"(tid_o));
        const int tid = tid_o, lane = tid & 63, wave = __builtin_amdgcn_readfirstlane(tid >> 6);
        if (IN(pb + 0)) {
#ifndef NO_G1
            pg8::Gemm g{XN, WIN + (size_t)l * NPROJ * DM, M, NPROJ, DM}; pg8::StaticOrder S; S.init(M, NPROJ, G, bid);
            pg8::EpiProj E{PROJ, NPROJ, SPEC, SPEC_TILE};
            pg8::gemm_phase<pg8::EpiProj, pg8::StaticOrder, true, true>((LAS unsigned char*)lds, g, S, E);
#endif
        }
        SEAM(pb + 0);
        if (IN(pb + 1)) {
#ifndef NO_PREP
            PrepP P;
            P.mu = args.in[13] + l * 1664; P.w0 = args.in[14] + l * 512; P.a0 = args.in[16] + l * 512; P.v0 = args.in[18] + (l > 0 ? (l - 1) * 512 : 0);
            P.k_k = args.in[21] + l * 512; P.k_a = args.in[22] + l * 512; P.r_k = args.in[23] + l * 512;
            P.conv_w = args.in[4] + (size_t)l * 4 * 1024; P.conv_b = args.in[5] + l * 1024; P.i_bias = args.in[6] + l * 4; P.f_bias = args.in[7] + l * 4;
            const unsigned char* lr = ws + WS_LR + (size_t)l * LR_STRIDE;
            P.W2T = (const bf16_t*)(lr + LR_W2T); P.A2T = (const bf16_t*)(lr + LR_A2T); P.V1T = (const bf16_t*)(lr + LR_V1T); P.V2T = (const bf16_t*)(lr + LR_V2T); P.layer = l;
            P.PROJ = PROJ; P.SPEC = SPEC; P.CS = CS; P.RWW = RWW; P.RWB = RWB; P.VFIRST = VFIRST; P.BONUS = BONUS; P.CQN = CQN; P.CKVN = CKVN; P.KR = KR; P.QKC = QKC; P.LI = LI; P.LF = LF; P.PMX = LF + (size_t)M * 4;
            for (int tile = bid; tile < M / 64; tile += G) prep_tile(lds, tile, P);
#endif
        }
        SEAM(pb + 1);
        if (IN(pb + 2)) {
#ifndef NO_G23
            { pg8::Gemm g{CQN, WUQ + (size_t)l * NQ * 512, M, NQ, 512}; pg8::StaticOrder S; S.init(M, NQ, G, bid);
              pg8::EpiPlain E{Q, NQ};
              pg8::gemm_phase<pg8::EpiPlain, pg8::StaticOrder, true, true>((LAS unsigned char*)lds, g, S, E); }
            { pg8::Gemm g{CKVN, WUKV + (size_t)l * NKV * 256, M, NKV, 256}; pg8::StaticOrder S; S.init(M, NKV, G, bid);
              pg8::EpiPlain E{KV, NKV};
              pg8::gemm_phase<pg8::EpiPlain, pg8::StaticOrder, true, true>((LAS unsigned char*)lds, g, S, E); }
#endif
            rwkv_local(lds, bid, G, RWW, RWB, RWS, ws + WS_RWX);
            mlstm_local(lds, bid, G, QKC, PROJ, LI, LF + (size_t)M * 4, ws + WS_MLX);
        }
        SEAM(pb + 2);
        if (IN(pb + 3)) {
#ifndef NO_SCANS
            if (bid < 32 && G >= 64) {
                rwkv_seq(lds, bid >> 3, bid & 7, ws + WS_RWX, RWB, RWS, BONUS, PROJ, args.in[24] + l * 512 + (bid & 7) * 64, args.in[25] + l * 512 + (bid & 7) * 64, MIXED);
            } else if (bid < 48 && G >= 64) {
                const int u = bid - 32;
                mlstm_seq(lds, u >> 2, u & 3, QKC, PROJ, LI, LF, LF + (size_t)M * 4, ws + WS_MLX, args.in[8] + l * 512 + (u & 3) * 128, MIXED);
            }
#endif
#ifndef NO_ATT
            {
                unsigned* qctr = (unsigned*)(ws + WS_CTL) + CW_QUEUE + 64 * l; volatile LAS unsigned* qslot = MISC + 16;
                constexpr int total = BATCH * 8 * 16;
#define CLAIM(dst) do { if (tid == 0) qslot[0] = atomicAdd(qctr, 1u); __syncthreads(); dst = (int)qslot[0]; __syncthreads(); } while (0)
#define mk(i_) mk_block(Q, KV, KR, MIXED, PROJ, CS, (i_) & 31, 15 - ((i_) >> 5))
                int ci, ni; CLAIM(ci);
                if (ci < total) {
                    att::Seam S; att::BlockRef cur = mk(ci);
                    att::attn_prime(cur, (char*)lds, S);
                    for (;;) {
                        CLAIM(ni); const bool last = ni >= total;
                        const att::BlockRef nxt = last ? cur : mk(ni);
                        att::attn_block(cur, nxt, (char*)lds, S);
                        if (last) break;
                        cur = nxt;
                    }
                }
#undef mk
#undef CLAIM
            }
#endif
        }
        SEAM(pb + 3);
        if (IN(pb + 4)) {
#ifndef NO_G4
            pg8::Gemm g{MIXED, WOUT + (size_t)l * DM * DM, M, DM, DM}; pg8::StaticOrder S; S.init(M, DM, G, bid);
            pg8::EpiResid E{l == 0 ? x_in : (const float*)X, X, DM};
            pg8::gemm_phase<pg8::EpiResid, pg8::StaticOrder, true, true>((LAS unsigned char*)lds, g, S, E);
#endif
        }
        SEAM(pb + 4);
        if (IN(pb + 5)) {
            const int gw = bid * 8 + wave, NGW = G * 8;
            if (l + 1 < DEPTH) { for (int m = gw; m < M; m += NGW) norm_row<0>(X + (size_t)m * DM, XN + (size_t)m * DM, nullptr, nullptr, lane); }
            else { for (int m = gw; m < M; m += NGW) norm_row<1>(X + (size_t)m * DM, nullptr, X + (size_t)m * DM, args.in[27], lane); }
        }
        SEAM(pb + 5);
    }
#undef IN
#undef SEAM
}

constexpr int N_PHASES = 1 + DEPTH * 6;
#ifndef MK_ONE_LAUNCH
#define MK_ONE_LAUNCH 1
#endif
extern "C" void kernel_launch(void* const* d_in, const int* in_sizes, int n_in, void* d_out, int out_size, void* d_ws, size_t ws_size, hipStream_t stream) {
    static int grid = 0;
    if (grid == 0) {
        if (n_in != 28 || out_size != M * DM || ws_size < WS_END) { fprintf(stderr, "kernel_launch: unexpected shapes (n_in %d, out %d, ws %zu < %zu)\n", n_in, out_size, ws_size, (size_t)WS_END); grid = -1; return; }
        int dev = 0, cus = 0;
        if (hipGetDevice(&dev) != hipSuccess || hipDeviceGetAttribute(&cus, hipDeviceAttributeMultiprocessorCount, dev) != hipSuccess) { grid = -1; return; }
        if (hipFuncSetAttribute((const void*)fwd, hipFuncAttributeMaxDynamicSharedMemorySize, LDS_BYTES) != hipSuccess) { fprintf(stderr, "kernel_launch: hipFuncSetAttribute failed\n"); grid = -1; return; }
        int per_cu = 0;
        if (hipOccupancyMaxActiveBlocksPerMultiprocessor(&per_cu, (const void*)fwd, 512, LDS_BYTES) != hipSuccess || per_cu < 1) fprintf(stderr, "kernel_launch: occupancy query says %d\n", per_cu);
        (void)hipGetLastError();
        grid = cus;
    }
    if (grid < 0) return;
    if (hipMemsetAsync((char*)d_ws + WS_CTL, 0, CTL_ZERO_BYTES, stream) != hipSuccess) return;
    Args a; memset(&a, 0, sizeof(a));
    for (int i = 0; i < 28; ++i) a.in[i] = (const float*)d_in[i];
    a.out = (float*)d_out; a.ws = (unsigned char*)d_ws;
#if MK_ONE_LAUNCH
    a.ph_lo = 0; a.ph_hi = N_PHASES;
    hipLaunchKernelGGL(fwd, dim3(grid), dim3(512), LDS_BYTES, stream, a);
#else
    for (int p = 0; p < N_PHASES; ++p) { a.ph_lo = p; a.ph_hi = p + 1; hipLaunchKernelGGL(fwd, dim3(grid), dim3(512), LDS_BYTES, stream, a); }
#endif
}
```
